# Optimizing an MI355X kernel written in HIP

```python
import jax, jax.numpy as jnp
from jax import lax
import numpy as np

D_MODEL = 1024
BATCH = 16
SEQ = 4096
DEPTH = 4

CHUNK = 64
Q_BLOCK = 128
ROPE_THETA = 10000.0
EPS = 1e-6

A_HEADS = 6
A_HEAD_DIM = 64
A_WIDTH = A_HEADS * A_HEAD_DIM
IDX_HEADS = 8
IDX_DIM = 32
TOPK_MAX = 256

S5_GROUP = 16
S5_WIDTH = 256
S5_GROUPS = S5_WIDTH // S5_GROUP
S5_STATE = 64
STEP_MIN = 1e-3
STEP_MAX = 1e-1

C_HEADS = 6
C_NOPE = 64
C_ROPE = 32
C_VDIM = 64
C_QK = C_NOPE + C_ROPE
C_WIDTH = C_HEADS * C_VDIM
Q_LORA = 256
KV_LORA = 128

D_MIX = A_WIDTH + S5_WIDTH + C_WIDTH

SPLIT_SIZES = (
    A_WIDTH,
    A_HEAD_DIM,
    A_HEAD_DIM,
    IDX_HEADS * IDX_DIM,
    IDX_DIM,
    IDX_HEADS,
    A_WIDTH,
    S5_WIDTH,
    S5_WIDTH,
    Q_LORA,
    KV_LORA,
    C_ROPE,
    C_WIDTH,
)
D_IN = sum(SPLIT_SIZES)

kernel_name = "hybrid_dsa_s5_mla_parallel_heads"


def _split_points():
    return [int(v) for v in np.cumsum(SPLIT_SIZES)[:-1]]


def rms_norm(x, g):
    xf = x.astype(jnp.float32)
    y = xf * lax.rsqrt(jnp.mean(xf * xf, axis=-1, keepdims=True) + EPS)
    return (y * g.astype(jnp.float32)).astype(x.dtype)


def apply_rope(x, pos):
    d = x.shape[-1]
    half = d // 2
    inv = ROPE_THETA ** (-jnp.arange(half, dtype=jnp.float32) * 2.0 / d)
    ang = pos.astype(jnp.float32)[:, None] * inv[None, :]
    cos = jnp.cos(ang)[:, None, :]
    sin = jnp.sin(ang)[:, None, :]
    xf = x.astype(jnp.float32)
    x1, x2 = xf[..., :half], xf[..., half:]
    return jnp.concatenate([x1 * cos - x2 * sin, x2 * cos + x1 * sin], axis=-1).astype(x.dtype)


def to_blocks(t):
    b, s = t.shape[:2]
    return t.reshape((b, s // Q_BLOCK, Q_BLOCK) + t.shape[2:]).swapaxes(0, 1)


def from_blocks(t):
    nb, b, q = t.shape[:3]
    return t.swapaxes(0, 1).reshape((b, nb * q) + t.shape[3:])


def gather_rows(src, idx):
    return jax.vmap(lambda s_, i_: s_[i_])(src, idx)


def dsa_branch(qa, ka, va, iq, ik, iw, q_norm_g, k_norm_g, pos, limit):
    b, s, _ = qa.shape
    q = apply_rope(rms_norm(qa.reshape(b, s, A_HEADS, A_HEAD_DIM), q_norm_g), pos)
    k = apply_rope(rms_norm(ka.reshape(b, s, 1, A_HEAD_DIM), k_norm_g), pos)[:, :, 0]
    v = va
    iq = apply_rope(iq.reshape(b, s, IDX_HEADS, IDX_DIM), pos)
    ik = apply_rope(ik[:, :, None, :], pos)[:, :, 0].astype(jnp.float32)
    iw = iw.astype(jnp.float32) * (IDX_HEADS ** -0.5)
    k_top = min(TOPK_MAX, s // 4)
    key_pos = jnp.arange(s)

    def one_block(args):
        qb, iqb, iwb, limb = args
        sc = jnp.einsum('bthd,bsd->bths', iqb.astype(jnp.float32), ik) * (IDX_DIM ** -0.5)
        sc = jnp.einsum('bths,bth->bts', jax.nn.relu(sc), iwb)
        admissible = key_pos[None, :] < limb[:, None]
        sc = jnp.where(admissible[None], sc, -jnp.inf)
        _, idx = lax.top_k(sc, k_top)
        valid = idx < limb[None, :, None]
        k_sel = gather_rows(k, idx)
        v_sel = gather_rows(v, idx)
        att = jnp.einsum('bthd,btkd->bthk', qb, k_sel).astype(jnp.float32) * (A_HEAD_DIM ** -0.5)
        att = jnp.where(valid[:, :, None, :], att, -jnp.inf)
        p = jax.nn.softmax(att, axis=-1).astype(v_sel.dtype)
        return jnp.einsum('bthk,btkd->bthd', p, v_sel)

    out = lax.map(one_block, (to_blocks(q), to_blocks(iq), to_blocks(iw),
                              limit.reshape(s // Q_BLOCK, Q_BLOCK)))
    return from_blocks(out).reshape(b, s, A_WIDTH)


def s5_branch(u, a_re, a_im, b_re, b_im, c_re, c_im, d_skip, log_step, w_glu):
    b, s, _ = u.shape
    ug = u.reshape(b, s, S5_GROUPS, S5_GROUP).astype(jnp.float32)
    ar = a_re.astype(jnp.float32)
    ai = a_im.astype(jnp.float32)
    step = jnp.exp(log_step.astype(jnp.float32))[:, None]
    mag = jnp.exp(ar * step)
    abar_re = mag * jnp.cos(ai * step)
    abar_im = mag * jnp.sin(ai * step)
    den = ar * ar + ai * ai
    nr = abar_re - 1.0
    f_re = (nr * ar + abar_im * ai) / den
    f_im = (abar_im * ar - nr * ai) / den
    bu_re = jnp.einsum('bsgc,gpc->bsgp', ug, b_re.astype(jnp.float32))
    bu_im = jnp.einsum('bsgc,gpc->bsgp', ug, b_im.astype(jnp.float32))
    bb_re = f_re * bu_re - f_im * bu_im
    bb_im = f_re * bu_im + f_im * bu_re
    aa_re = jnp.broadcast_to(abar_re, bb_re.shape)
    aa_im = jnp.broadcast_to(abar_im, bb_im.shape)

    def combine(e1, e2):
        a1r, a1i, b1r, b1i = e1
        a2r, a2i, b2r, b2i = e2
        return (a2r * a1r - a2i * a1i,
                a2r * a1i + a2i * a1r,
                a2r * b1r - a2i * b1i + b2r,
                a2r * b1i + a2i * b1r + b2i)

    _, _, xr, xi = lax.associative_scan(combine, (aa_re, aa_im, bb_re, bb_im), axis=1)
    y = (jnp.einsum('bsgp,gcp->bsgc', xr, c_re.astype(jnp.float32))
         - jnp.einsum('bsgp,gcp->bsgc', xi, c_im.astype(jnp.float32))
         + d_skip.astype(jnp.float32) * ug)
    y = y.reshape(b, s, S5_WIDTH)
    g = jax.nn.gelu(y)
    y = g * jax.nn.sigmoid(g @ w_glu.astype(jnp.float32))
    return y.astype(u.dtype)


def mla_branch(cq, ckv, kpe, q_lora_g, kv_lora_g, w_uq, w_ukv, q_norm_g, k_norm_g, pos, limit):
    b, s, _ = cq.shape
    q = (rms_norm(cq, q_lora_g) @ w_uq).reshape(b, s, C_HEADS, C_QK)
    kv = (rms_norm(ckv, kv_lora_g) @ w_ukv).reshape(b, s, C_HEADS, C_NOPE + C_VDIM)
    k_nope, v = kv[..., :C_NOPE], kv[..., C_NOPE:]
    k_rope = jnp.broadcast_to(kpe[:, :, None, :], (b, s, C_HEADS, C_ROPE))
    k = jnp.concatenate([k_nope, k_rope], axis=-1)
    q = rms_norm(q, q_norm_g)
    k = rms_norm(k, k_norm_g)
    q = jnp.concatenate([q[..., :C_NOPE], apply_rope(q[..., C_NOPE:], pos)], axis=-1)
    k = jnp.concatenate([k[..., :C_NOPE], apply_rope(k[..., C_NOPE:], pos)], axis=-1)
    key_pos = jnp.arange(s)

    def one_block(args):
        qb, limb = args
        att = jnp.einsum('bthd,bshd->bhts', qb, k).astype(jnp.float32) * (C_QK ** -0.5)
        mask = key_pos[None, :] < limb[:, None]
        att = jnp.where(mask[None, None], att, -jnp.inf)
        p = jax.nn.softmax(att, axis=-1).astype(v.dtype)
        return jnp.einsum('bhts,bshd->bthd', p, v)

    out = lax.map(one_block, (to_blocks(q), limit.reshape(s // Q_BLOCK, Q_BLOCK)))
    return from_blocks(out).reshape(b, s, C_WIDTH)


def setup_inputs(seed: int = 0) -> dict:
    key = jax.random.key(seed)
    ks = jax.random.split(key, 24)
    f32 = jnp.float32
    nrm = lambda k, shape, sc: jax.random.normal(k, shape, f32) * sc
    gain = lambda k, shape: 1.0 + 0.05 * jax.random.normal(k, shape, f32)
    L, G, P, Cg = DEPTH, S5_GROUPS, S5_STATE, S5_GROUP
    a_re = -0.5 + 0.01 * jax.random.normal(ks[11], (L, G, P), f32)
    a_im = jnp.pi * jnp.arange(P, dtype=f32)[None, None, :] + 0.01 * jax.random.normal(ks[12], (L, G, P), f32)
    log_step = jax.random.uniform(ks[19], (L, G), f32, np.log(STEP_MIN), np.log(STEP_MAX))
    return {
        "x": jax.random.normal(ks[0], (BATCH, SEQ, D_MODEL), f32),
        "norm_g": gain(ks[1], (L, D_MODEL)),
        "w_in": nrm(ks[2], (L, D_MODEL, D_IN), D_MODEL ** -0.5),
        "attn_q_norm": gain(ks[3], (L, A_HEAD_DIM)),
        "attn_k_norm": gain(ks[4], (L, A_HEAD_DIM)),
        "mla_q_lora_norm": gain(ks[5], (L, Q_LORA)),
        "mla_kv_lora_norm": gain(ks[6], (L, KV_LORA)),
        "mla_w_uq": nrm(ks[7], (L, Q_LORA, C_HEADS * C_QK), Q_LORA ** -0.5),
        "mla_w_ukv": nrm(ks[8], (L, KV_LORA, C_HEADS * (C_NOPE + C_VDIM)), KV_LORA ** -0.5),
        "mla_q_norm": gain(ks[9], (L, C_QK)),
        "mla_k_norm": gain(ks[10], (L, C_QK)),
        "ssm_a_re": a_re,
        "ssm_a_im": a_im,
        "ssm_b_re": nrm(ks[13], (L, G, P, Cg), (2.0 * Cg) ** -0.5),
        "ssm_b_im": nrm(ks[14], (L, G, P, Cg), (2.0 * Cg) ** -0.5),
        "ssm_c_re": nrm(ks[15], (L, G, Cg, P), P ** -0.5),
        "ssm_c_im": nrm(ks[16], (L, G, Cg, P), P ** -0.5),
        "ssm_d": nrm(ks[17], (L, G, Cg), 1.0),
        "ssm_log_step": log_step,
        "ssm_w_glu": nrm(ks[18], (L, S5_WIDTH, S5_WIDTH), S5_WIDTH ** -0.5),
        "w_out": nrm(ks[20], (L, D_MIX, D_MODEL), 0.5 * D_MIX ** -0.5),
    }


def reference(x, norm_g, w_in, attn_q_norm, attn_k_norm, mla_q_lora_norm, mla_kv_lora_norm,
              mla_w_uq, mla_w_ukv, mla_q_norm, mla_k_norm, ssm_a_re, ssm_a_im, ssm_b_re,
              ssm_b_im, ssm_c_re, ssm_c_im, ssm_d, ssm_log_step, ssm_w_glu, w_out):
    s = x.shape[1]
    pos = jnp.arange(s, dtype=jnp.int32)
    limit = (pos // CHUNK + 1) * CHUNK
    points = _split_points()
    for l in range(DEPTH):
        h = rms_norm(x, norm_g[l])
        proj = h @ w_in[l]
        (qa, ka, va, iq, ik, iw, ga, u, gb, cq, ckv, kpe, gc) = jnp.split(proj, points, axis=-1)
        ya = dsa_branch(qa, ka, va, iq, ik, iw, attn_q_norm[l], attn_k_norm[l], pos, limit)
        yb = s5_branch(u, ssm_a_re[l], ssm_a_im[l], ssm_b_re[l], ssm_b_im[l], ssm_c_re[l],
                       ssm_c_im[l], ssm_d[l], ssm_log_step[l], ssm_w_glu[l])
        yc = mla_branch(cq, ckv, kpe, mla_q_lora_norm[l], mla_kv_lora_norm[l], mla_w_uq[l],
                        mla_w_ukv[l], mla_q_norm[l], mla_k_norm[l], pos, limit)
        mixed = jnp.concatenate([ya * jax.nn.silu(ga), yb * jax.nn.silu(gb),
                                 yc * jax.nn.silu(gc)], axis=-1)
        x = x + mixed @ w_out[l]
    return x
```

```cpp
#include <hip/hip_runtime.h>
#include <hip/hip_cooperative_groups.h>
#include <cstdio>
#include <type_traits>
namespace cg = cooperative_groups;

#define DI __device__ __forceinline__
typedef __attribute__((ext_vector_type(8))) short bf16x8;
typedef __attribute__((ext_vector_type(4))) short s16x4;
typedef __attribute__((ext_vector_type(4))) float f32x4;
typedef unsigned short u16;
typedef unsigned long long u64;

constexpr int NB = 16, S = 4096, T = NB * S, DM = 1024, DIN = 2504, DINP = 2560, NL = 4;
constexpr int C_QA = 0, C_KA = 384, C_VA = 448, C_IQ = 512, C_IK = 768, C_IW = 800, C_GA = 808, C_U = 1192,
              C_GB = 1448, C_CQ = 1704, C_CKV = 1960, C_KPE = 2088, C_GC = 2120;
constexpr float EPS = 1e-6f;
constexpr float LOG2E = 1.4426950408889634f;

constexpr size_t O_WTIN = 0;
constexpr size_t O_WTOUT = O_WTIN + (size_t)NL * DINP * DM * 2;
constexpr size_t O_WTUQ = O_WTOUT + (size_t)NL * DM * DM * 2;
constexpr size_t O_WTUKV = O_WTUQ + (size_t)NL * 768 * 256 * 2;
constexpr size_t O_WTGLU = O_WTUKV + (size_t)NL * 768 * 128 * 2;
constexpr size_t O_W1 = O_WTGLU + (size_t)NL * 256 * 256 * 2;
constexpr size_t O_W3 = O_W1 + (size_t)NL * 16 * 128 * 1024 * 2;
constexpr size_t O_KT = O_W3 + (size_t)NL * 16 * 1024 * 128 * 2;
constexpr size_t O_PW = O_KT + (size_t)NL * 16 * 64 * 256 * 2;
constexpr size_t O_FZ = O_PW + (size_t)NL * 16 * 65 * 64 * 8;
constexpr size_t O_R64 = O_FZ + (size_t)NL * 16 * 64 * 8;
constexpr size_t O_R32 = O_R64 + (size_t)4096 * 32 * 8;
constexpr size_t O_XB = O_R32 + (size_t)4096 * 16 * 8;
constexpr size_t O_RSTD = O_XB + (size_t)T * 1024 * 2;
constexpr size_t O_PROJ = O_RSTD + (size_t)T * 4;
constexpr size_t O_MQ = O_PROJ + (size_t)T * DINP * 2;
constexpr size_t O_MK = O_MQ + (size_t)T * 576 * 2;
constexpr size_t O_MVT = O_MK + (size_t)T * 576 * 2;
constexpr size_t O_AVT = O_MVT + (size_t)T * 384 * 2;
constexpr size_t O_MASK = O_AVT + (size_t)T * 64 * 2;
constexpr size_t O_S5S = O_MASK + (size_t)T * 512;
constexpr size_t O_YG = O_S5S + (size_t)16 * 16 * 64 * 128 * 4;
constexpr size_t O_CTR = O_YG + (size_t)T * 256 * 2;
constexpr size_t O_XB2 = O_CTR + 256;
constexpr size_t O_END = O_XB2 + (size_t)T * 1024 * 2;

struct Params {
  const float* in[21];
  float* out;
  char* ws;
};

DI int opaque_tid() { int t = threadIdx.x; asm volatile("" : "+v"(t)); return t; }
DI u16 f2bf(float f) { unsigned u = __float_as_uint(f); u += 0x7fffu + ((u >> 16) & 1u); return (u16)(u >> 16); }
DI float bf2f(u16 h) { return __uint_as_float(((unsigned)h) << 16); }
typedef __attribute__((ext_vector_type(2))) __bf16 bf16x2_t;
typedef __attribute__((ext_vector_type(2))) float f32x2_t;
DI unsigned pack2(float a, float b) { return __builtin_bit_cast(unsigned, __builtin_convertvector((f32x2_t){a, b}, bf16x2_t)); }
DI float lo2f(unsigned w) { return __uint_as_float(w << 16); }
DI float hi2f(unsigned w) { return __uint_as_float(w & 0xffff0000u); }
DI bf16x8 ld8(const u16* p) { return *reinterpret_cast<const bf16x8*>(p); }
DI uint2 ld4(const u16* p) { return *reinterpret_cast<const uint2*>(p); }
DI void st4(u16* p, float a, float b, float c, float d) { uint2 v; v.x = pack2(a, b); v.y = pack2(c, d); *reinterpret_cast<uint2*>(p) = v; }
DI f32x4 mfma16(bf16x8 a, bf16x8 b, f32x4 c) { return __builtin_amdgcn_mfma_f32_16x16x32_bf16(a, b, c, 0, 0, 0); }
DI float fexp2(float x) { return __builtin_amdgcn_exp2f(x); }
DI float sigmoidf_(float x) { return 1.0f / (1.0f + __expf(-x)); }
DI float siluf_(float x) { return x * sigmoidf_(x); }
DI float geluf_(float x) { float u = 0.7978845608028654f * (x + 0.044715f * x * x * x); return 0.5f * x * (1.0f + tanhf(u)); }
DI float red4(float v) { v += __shfl_xor(v, 16); v += __shfl_xor(v, 32); return v; }

template <int AT, int BT, class FA, class FB>
DI void wgemm(f32x4 (&acc)[AT][BT], int ksteps, FA fa, FB fb) {
  bf16x8 a0[AT], b0[BT], a1[AT], b1[BT];
  const int k1 = (ksteps > 1) ? 1 : 0;
#pragma unroll
  for (int i = 0; i < AT; ++i) { a0[i] = fa(i, 0); a1[i] = fa(i, k1); }
#pragma unroll
  for (int j = 0; j < BT; ++j) { b0[j] = fb(j, 0); b1[j] = fb(j, k1); }
  for (int ks = 0; ks < ksteps; ++ks) {
    bf16x8 a2[AT], b2[BT];
    const int kn = (ks + 2 < ksteps) ? ks + 2 : ksteps - 1;
#pragma unroll
    for (int i = 0; i < AT; ++i) a2[i] = fa(i, kn);
#pragma unroll
    for (int j = 0; j < BT; ++j) b2[j] = fb(j, kn);
    __builtin_amdgcn_sched_barrier(0);
#pragma unroll
    for (int i = 0; i < AT; ++i)
#pragma unroll
      for (int j = 0; j < BT; ++j) acc[i][j] = mfma16(a0[i], b0[j], acc[i][j]);
    __builtin_amdgcn_sched_barrier(0);
#pragma unroll
    for (int i = 0; i < AT; ++i) { a0[i] = a1[i]; a1[i] = a2[i]; }
#pragma unroll
    for (int j = 0; j < BT; ++j) { b0[j] = b1[j]; b1[j] = b2[j]; }
  }
}

constexpr int GROW = 72;
constexpr int G_TILE_BYTES = 128 * GROW * 2;
constexpr int G_BUF_BYTES = 2 * G_TILE_BYTES;
DI void gemm_block(f32x4 (&acc)[4][4], const u16* Ap, int lda, const u16* Bp, int ldb, int K, char* lds, int tid) {
  const int lane = tid & 63, q = lane >> 4, jn = lane & 15;
  const int wave = __builtin_amdgcn_readfirstlane(tid >> 6), wa = wave >> 1, wb = wave & 1;
  uint4 xa0, xa1, xa2, xa3, xb0, xb1, xb2, xb3;
  uint4 ya0, ya1, ya2, ya3, yb0, yb1, yb2, yb3;
  const int srow = tid >> 3, scol = tid & 7;
  const unsigned voa = (unsigned)(srow * lda + scol * 8) * 2u, vob = (unsigned)(srow * ldb + scol * 8) * 2u;
  const char* ag = reinterpret_cast<const char*>(Ap);
  const char* bg = reinterpret_cast<const char*>(Bp);
  char* st0 = lds + (srow * GROW + scol * 8) * 2;
  const char* a0p = lds + (wa * 64 + jn) * GROW * 2 + q * 16;
  const char* b0p = lds + G_TILE_BYTES + (wb * 64 + jn) * GROW * 2 + q * 16;
#define GL(v, base, ld, vo, i, kt) v = *reinterpret_cast<const uint4*>(base + ((size_t)(32 * (i)) * (ld) + (size_t)(kt) * 64) * 2 + vo)
#define GLOAD0(kt) { GL(xa0, ag, lda, voa, 0, kt); GL(xa1, ag, lda, voa, 1, kt); GL(xa2, ag, lda, voa, 2, kt); GL(xa3, ag, lda, voa, 3, kt); GL(xb0, bg, ldb, vob, 0, kt); GL(xb1, bg, ldb, vob, 1, kt); GL(xb2, bg, ldb, vob, 2, kt); GL(xb3, bg, ldb, vob, 3, kt); }
#define GLOAD1(kt) { GL(ya0, ag, lda, voa, 0, kt); GL(ya1, ag, lda, voa, 1, kt); GL(ya2, ag, lda, voa, 2, kt); GL(ya3, ag, lda, voa, 3, kt); GL(yb0, bg, ldb, vob, 0, kt); GL(yb1, bg, ldb, vob, 1, kt); GL(yb2, bg, ldb, vob, 2, kt); GL(yb3, bg, ldb, vob, 3, kt); }
#define GS(v, off) *reinterpret_cast<uint4*>(st0 + (off)) = v
#define GSTORE0(buf) { GS(xa0, (buf) * G_BUF_BYTES); GS(xa1, (buf) * G_BUF_BYTES + 32 * GROW * 2); GS(xa2, (buf) * G_BUF_BYTES + 64 * GROW * 2); GS(xa3, (buf) * G_BUF_BYTES + 96 * GROW * 2); \
                       GS(xb0, (buf) * G_BUF_BYTES + G_TILE_BYTES); GS(xb1, (buf) * G_BUF_BYTES + G_TILE_BYTES + 32 * GROW * 2); GS(xb2, (buf) * G_BUF_BYTES + G_TILE_BYTES + 64 * GROW * 2); GS(xb3, (buf) * G_BUF_BYTES + G_TILE_BYTES + 96 * GROW * 2); }
#define GSTORE1(buf) { GS(ya0, (buf) * G_BUF_BYTES); GS(ya1, (buf) * G_BUF_BYTES + 32 * GROW * 2); GS(ya2, (buf) * G_BUF_BYTES + 64 * GROW * 2); GS(ya3, (buf) * G_BUF_BYTES + 96 * GROW * 2); \
                       GS(yb0, (buf) * G_BUF_BYTES + G_TILE_BYTES); GS(yb1, (buf) * G_BUF_BYTES + G_TILE_BYTES + 32 * GROW * 2); GS(yb2, (buf) * G_BUF_BYTES + G_TILE_BYTES + 64 * GROW * 2); GS(yb3, (buf) * G_BUF_BYTES + G_TILE_BYTES + 96 * GROW * 2); }
  auto compute = [&](int buf) {
#pragma unroll
    for (int ks = 0; ks < 2; ++ks) {
      bf16x8 a[4], b[4];
#pragma unroll
      for (int i = 0; i < 4; ++i) a[i] = *reinterpret_cast<const bf16x8*>(a0p + buf * G_BUF_BYTES + i * 16 * GROW * 2 + ks * 64);
#pragma unroll
      for (int j = 0; j < 4; ++j) b[j] = *reinterpret_cast<const bf16x8*>(b0p + buf * G_BUF_BYTES + j * 16 * GROW * 2 + ks * 64);
      __builtin_amdgcn_s_setprio(1);
#pragma unroll
      for (int i = 0; i < 4; ++i)
#pragma unroll
        for (int j = 0; j < 4; ++j) acc[i][j] = mfma16(a[i], b[j], acc[i][j]);
      __builtin_amdgcn_s_setprio(0);
    }
  };
  const int nkt = K >> 6;
  GLOAD0(0);
  GLOAD1(1);
  GSTORE0(0);
  __syncthreads();
  for (int kt = 0; kt < nkt; kt += 2) {
    if (kt + 2 < nkt) GLOAD0(kt + 2);
    compute(0);
    GSTORE1(1);
    __syncthreads();
    if (kt + 3 < nkt) GLOAD1(kt + 3);
    compute(1);
    if (kt + 2 < nkt) GSTORE0(0);
    __syncthreads();
  }
#undef GL
#undef GLOAD0
#undef GLOAD1
#undef GS
#undef GSTORE0
#undef GSTORE1
}

template <int A, int B>
DI void zero_acc(f32x4 (&acc)[A][B]) {
#pragma unroll
  for (int i = 0; i < A; ++i)
#pragma unroll
    for (int j = 0; j < B; ++j) acc[i][j] = f32x4{0.f, 0.f, 0.f, 0.f};
}

DI void sincos_d(double a, double& c, double& s) {
  const double TWO_PI = 6.283185307179586476925;
  double n = rint(a / TWO_PI);
  double r = a - n * TWO_PI;
  c = cos(r); s = sin(r);
}

DI void phase_w0(const Params& P, long gtid, long gsz) {
  char* ws = P.ws;
  {
    u16* dst = (u16*)(ws + O_WTIN);
    const float* w = P.in[2]; const float* g = P.in[1];
    for (long idx = gtid; idx < (long)NL * 128 * DINP; idx += gsz) {
      int n = (int)(idx % DINP); long r = idx / DINP; int kb = (int)(r % 128); int l = (int)(r / 128);
      float v[8];
#pragma unroll
      for (int j = 0; j < 8; ++j) { int k = kb * 8 + j; v[j] = (n < DIN) ? w[((size_t)l * DM + k) * DIN + n] * g[l * DM + k] : 0.f; }
      uint4 o; o.x = pack2(v[0], v[1]); o.y = pack2(v[2], v[3]); o.z = pack2(v[4], v[5]); o.w = pack2(v[6], v[7]);
      *reinterpret_cast<uint4*>(dst + ((size_t)l * DINP + n) * DM + kb * 8) = o;
    }
  }
  {
    u16* dst = (u16*)(ws + O_WTOUT);
    const float* w = P.in[20];
    for (long idx = gtid; idx < (long)NL * 128 * DM; idx += gsz) {
      int n = (int)(idx % DM); long r = idx / DM; int kb = (int)(r % 128); int l = (int)(r / 128);
      float v[8];
#pragma unroll
      for (int j = 0; j < 8; ++j) { int k = kb * 8 + j; v[j] = w[((size_t)l * DM + k) * DM + n]; }
      uint4 o; o.x = pack2(v[0], v[1]); o.y = pack2(v[2], v[3]); o.z = pack2(v[4], v[5]); o.w = pack2(v[6], v[7]);
      *reinterpret_cast<uint4*>(dst + ((size_t)l * DM + n) * DM + kb * 8) = o;
    }
  }
  {
    u16* dst = (u16*)(ws + O_WTUQ);
    const float* w = P.in[7]; const float* g = P.in[5];
    for (long idx = gtid; idx < (long)NL * 32 * 768; idx += gsz) {
      int n = (int)(idx % 768); long r = idx / 768; int kb = (int)(r % 32); int l = (int)(r / 32);
      const int h = n >> 7, d = n & 127;
      float v[8];
#pragma unroll
      for (int j = 0; j < 8; ++j) { int k = kb * 8 + j; v[j] = (d < 96) ? w[((size_t)l * 256 + k) * 576 + h * 96 + d] * g[l * 256 + k] : 0.f; }
      uint4 o; o.x = pack2(v[0], v[1]); o.y = pack2(v[2], v[3]); o.z = pack2(v[4], v[5]); o.w = pack2(v[6], v[7]);
      *reinterpret_cast<uint4*>(dst + ((size_t)l * 768 + n) * 256 + kb * 8) = o;
    }
  }
  {
    u16* dst = (u16*)(ws + O_WTUKV);
    const float* w = P.in[8]; const float* g = P.in[6];
    for (long idx = gtid; idx < (long)NL * 16 * 768; idx += gsz) {
      int n = (int)(idx % 768); long r = idx / 768; int kb = (int)(r % 16); int l = (int)(r / 16);
      float v[8];
#pragma unroll
      for (int j = 0; j < 8; ++j) { int k = kb * 8 + j; v[j] = w[((size_t)l * 128 + k) * 768 + n] * g[l * 128 + k]; }
      uint4 o; o.x = pack2(v[0], v[1]); o.y = pack2(v[2], v[3]); o.z = pack2(v[4], v[5]); o.w = pack2(v[6], v[7]);
      *reinterpret_cast<uint4*>(dst + ((size_t)l * 768 + n) * 128 + kb * 8) = o;
    }
  }
  {
    u16* dst = (u16*)(ws + O_WTGLU);
    const float* w = P.in[19];
    for (long idx = gtid; idx < (long)NL * 32 * 256; idx += gsz) {
      int n = (int)(idx % 256); long r = idx / 256; int kb = (int)(r % 32); int l = (int)(r / 32);
      float v[8];
#pragma unroll
      for (int j = 0; j < 8; ++j) { int k = kb * 8 + j; v[j] = w[((size_t)l * 256 + k) * 256 + n]; }
      uint4 o; o.x = pack2(v[0], v[1]); o.y = pack2(v[2], v[3]); o.z = pack2(v[4], v[5]); o.w = pack2(v[6], v[7]);
      *reinterpret_cast<uint4*>(dst + ((size_t)l * 256 + n) * 256 + kb * 8) = o;
    }
  }
  {
    float2* r64 = (float2*)(ws + O_R64);
    for (long idx = gtid; idx < 4096L * 32; idx += gsz) {
      int i = (int)(idx & 31); int pos = (int)(idx >> 5);
      float inv = (float)pow(10000.0, -(double)i / 32.0);
      float ang = (float)pos * inv;
      double c, s; sincos_d((double)ang, c, s);
      r64[idx] = make_float2((float)c, (float)s);
    }
    float2* r32 = (float2*)(ws + O_R32);
    for (long idx = gtid; idx < 4096L * 16; idx += gsz) {
      int i = (int)(idx & 15); int pos = (int)(idx >> 4);
      float inv = (float)pow(10000.0, -(double)i / 16.0);
      float ang = (float)pos * inv;
      double c, s; sincos_d((double)ang, c, s);
      r32[idx] = make_float2((float)c, (float)s);
    }
  }
  {
    float2* pw = (float2*)(ws + O_PW);
    float2* fz = (float2*)(ws + O_FZ);
    const float* a_re = P.in[11]; const float* a_im = P.in[12]; const float* lstep = P.in[18];
    for (long idx = gtid; idx < (long)NL * 16 * 65 * 64; idx += gsz) {
      int p = (int)(idx & 63); long r = idx >> 6; int d = (int)(r % 65); int lg = (int)(r / 65);
      double step = exp((double)lstep[lg]);
      double ar = (double)a_re[lg * 64 + p], ai = (double)a_im[lg * 64 + p];
      double mag = exp((double)d * ar * step);
      double c, s; sincos_d((double)d * ai * step, c, s);
      pw[idx] = make_float2((float)(mag * c), (float)(mag * s));
      if (d == 1) {
        double abr = mag * c, abi = mag * s;
        double den = ar * ar + ai * ai, nr = abr - 1.0;
        double fre = (nr * ar + abi * ai) / den, fim = (abi * ar - nr * ai) / den;
        fz[lg * 64 + p] = make_float2((float)fre, (float)fim);
      }
    }
  }
}

DI void phase_w1(const Params& P, long gtid, long gsz) {
  char* ws = P.ws;
  const float2* pw = (const float2*)(ws + O_PW);
  const float2* fz = (const float2*)(ws + O_FZ);
  const float* b_re = P.in[13]; const float* b_im = P.in[14]; const float* c_re = P.in[15]; const float* c_im = P.in[16];
  {
    u16* w1 = (u16*)(ws + O_W1);
    for (long idx = gtid; idx < (long)NL * 16 * 128 * 128; idx += gsz) {
      int kb = (int)(idx & 127); long r = idx >> 7; int row = (int)(r & 127); int lg = (int)(r >> 7);
      int p = row >> 1, ri = row & 1; int i = kb >> 1, c0 = (kb & 1) * 8;
      float2 e = pw[((size_t)lg * 65 + (63 - i)) * 64 + p]; float2 f = fz[lg * 64 + p];
      float er = e.x * f.x - e.y * f.y, ei = e.x * f.y + e.y * f.x;
      float v[8];
#pragma unroll
      for (int j = 0; j < 8; ++j) {
        float br = b_re[((size_t)lg * 64 + p) * 16 + c0 + j], bi = b_im[((size_t)lg * 64 + p) * 16 + c0 + j];
        v[j] = ri ? (er * bi + ei * br) : (er * br - ei * bi);
      }
      uint4 o; o.x = pack2(v[0], v[1]); o.y = pack2(v[2], v[3]); o.z = pack2(v[4], v[5]); o.w = pack2(v[6], v[7]);
      *reinterpret_cast<uint4*>(w1 + ((size_t)lg * 128 + row) * 1024 + kb * 8) = o;
    }
  }
  {
    u16* w3 = (u16*)(ws + O_W3);
    for (long idx = gtid; idx < (long)NL * 16 * 1024 * 16; idx += gsz) {
      int kb = (int)(idx & 15); long r = idx >> 4; int f = (int)(r & 1023); int lg = (int)(r >> 10);
      int j = f >> 4, c = f & 15;
      float v[8];
#pragma unroll
      for (int jj = 0; jj < 4; ++jj) {
        int p = kb * 4 + jj;
        float2 e = pw[((size_t)lg * 65 + (j + 1)) * 64 + p];
        float cr = c_re[((size_t)lg * 16 + c) * 64 + p], ci = c_im[((size_t)lg * 16 + c) * 64 + p];
        v[2 * jj] = cr * e.x - ci * e.y;
        v[2 * jj + 1] = -(cr * e.y + ci * e.x);
      }
      uint4 o; o.x = pack2(v[0], v[1]); o.y = pack2(v[2], v[3]); o.z = pack2(v[4], v[5]); o.w = pack2(v[6], v[7]);
      *reinterpret_cast<uint4*>(w3 + ((size_t)lg * 1024 + f) * 128 + kb * 8) = o;
    }
  }
  {
    u16* kt = (u16*)(ws + O_KT);
    for (long idx = gtid; idx < (long)NL * 16 * 64 * 16 * 2; idx += gsz) {
      int cb = (int)(idx & 1); long r = idx >> 1; int c = (int)(r & 15); r >>= 4; int d = (int)(r & 63); int lg = (int)(r >> 6);
      float v[8];
#pragma unroll
      for (int j = 0; j < 8; ++j) v[j] = 0.f;
      for (int p = 0; p < 64; ++p) {
        float2 e = pw[((size_t)lg * 65 + d) * 64 + p]; float2 f = fz[lg * 64 + p];
        float er = e.x * f.x - e.y * f.y, ei = e.x * f.y + e.y * f.x;
        float cr = c_re[((size_t)lg * 16 + c) * 64 + p], ci = c_im[((size_t)lg * 16 + c) * 64 + p];
        float gr = cr * er - ci * ei, gi = cr * ei + ci * er;
#pragma unroll
        for (int j = 0; j < 8; ++j) {
          float br = b_re[((size_t)lg * 64 + p) * 16 + cb * 8 + j], bi = b_im[((size_t)lg * 64 + p) * 16 + cb * 8 + j];
          v[j] += gr * br - gi * bi;
        }
      }
      uint4 o; o.x = pack2(v[0], v[1]); o.y = pack2(v[2], v[3]); o.z = pack2(v[4], v[5]); o.w = pack2(v[6], v[7]);
      *reinterpret_cast<uint4*>(kt + (((size_t)lg * 64 + d) * 16 + c) * 16 + cb * 8) = o;
    }
  }
}

DI void phase_p0(const Params& P, int l) {
  const float* x = (l == 0) ? P.in[0] : P.out;
  u16* xb = (u16*)(P.ws + O_XB2);
  const int tid = opaque_tid();
  const int lane = tid & 63;
  const int gw = blockIdx.x * 4 + (tid >> 6), nw = gridDim.x * 4;
  for (int row = gw; row < T; row += nw) {
    const float4* xr = reinterpret_cast<const float4*>(x + (size_t)row * DM);
#pragma unroll
    for (int i = 0; i < 4; ++i) {
      float4 v = xr[i * 64 + lane];
      st4(xb + (size_t)row * DM + (i * 64 + lane) * 4, v.x, v.y, v.z, v.w);
    }
  }
}

DI void prep_mla_q(const Params& P, int l, int tw0, int lane) {
  const int q = lane >> 4, jn = lane & 15;
  const u16* proj = (const u16*)(P.ws + O_PROJ);
  const u16* W = (const u16*)(P.ws + O_WTUQ) + (size_t)l * 576 * 256;
  u16* mq = (u16*)(P.ws + O_MQ);
  const float2* r32 = (const float2*)(P.ws + O_R32);
  const float* gq = P.in[9] + l * 96;
  const u16* bp = proj + (size_t)(tw0 + jn) * DINP + C_CQ + q * 8;
  float rq[2];
#pragma unroll
  for (int t = 0; t < 2; ++t) {
    float ss = 0.f;
    for (int ks = 0; ks < 8; ++ks) {
      bf16x8 v = ld8(bp + (size_t)t * 16 * DINP + ks * 32);
#pragma unroll
      for (int j = 0; j < 8; ++j) { float f = bf2f((u16)v[j]); ss += f * f; }
    }
    ss = red4(ss);
    rq[t] = rsqrtf(ss * (1.0f / 256) + EPS);
  }
  const float qscale = 0.10206207261596577f * LOG2E;
  for (int h = 0; h < 6; ++h) {
    f32x4 acc[6][2]; zero_acc(acc);
    const u16* ap = W + (size_t)(h * 96 + jn) * 256 + q * 8;
    wgemm<6, 2>(acc, 8, [&](int i, int ks) { return ld8(ap + (size_t)i * 16 * 256 + ks * 32); },
                [&](int j, int ks) { return ld8(bp + (size_t)j * 16 * DINP + ks * 32); });
#pragma unroll
    for (int t = 0; t < 2; ++t) {
      const int tok = tw0 + 16 * t + jn, pos = tok & (S - 1);
      float ss = 0.f;
#pragma unroll
      for (int i = 0; i < 6; ++i)
#pragma unroll
        for (int r = 0; r < 4; ++r) { float v = acc[i][t][r] * rq[t]; acc[i][t][r] = v; ss += v * v; }
      ss = red4(ss);
      const float rs = rsqrtf(ss * (1.0f / 96) + EPS);
#pragma unroll
      for (int i = 0; i < 6; ++i)
#pragma unroll
        for (int r = 0; r < 4; ++r) acc[i][t][r] *= rs * gq[16 * i + 4 * q + r];
#pragma unroll
      for (int r = 0; r < 4; ++r) {
        float2 cs = r32[pos * 16 + 4 * q + r];
        float x1 = acc[4][t][r], x2 = acc[5][t][r];
        acc[4][t][r] = x1 * cs.x - x2 * cs.y; acc[5][t][r] = x2 * cs.x + x1 * cs.y;
      }
#pragma unroll
      for (int i = 0; i < 6; ++i)
        st4(mq + (size_t)tok * 576 + h * 96 + 16 * i + 4 * q, acc[i][t][0] * qscale, acc[i][t][1] * qscale, acc[i][t][2] * qscale, acc[i][t][3] * qscale);
    }
  }
}

DI void prep_mla_kv(const Params& P, int l, int tw0, int lane) {
  const int q = lane >> 4, jn = lane & 15;
  const u16* proj = (const u16*)(P.ws + O_PROJ);
  const u16* W = (const u16*)(P.ws + O_WTUKV) + (size_t)l * 768 * 128;
  u16* mk = (u16*)(P.ws + O_MK);
  u16* mvt = (u16*)(P.ws + O_MVT);
  const float2* r32 = (const float2*)(P.ws + O_R32);
  const float* gk = P.in[10] + l * 96;
  const u16* bp = proj + (size_t)(tw0 + jn) * DINP + C_CKV + q * 8;
  const int b = tw0 >> 12, pos0 = tw0 & (S - 1);
  float rkv[2];
#pragma unroll
  for (int t = 0; t < 2; ++t) {
    float ss = 0.f;
    for (int ks = 0; ks < 4; ++ks) {
      bf16x8 v = ld8(bp + (size_t)t * 16 * DINP + ks * 32);
#pragma unroll
      for (int j = 0; j < 8; ++j) { float f = bf2f((u16)v[j]); ss += f * f; }
    }
    ss = red4(ss);
    rkv[t] = rsqrtf(ss * (1.0f / 128) + EPS);
  }
  for (int h = 0; h < 6; ++h) {
    {
      f32x4 acc[4][2]; zero_acc(acc);
      const u16* ap = W + (size_t)(h * 128 + jn) * 128 + q * 8;
      wgemm<4, 2>(acc, 4, [&](int i, int ks) { return ld8(ap + (size_t)i * 16 * 128 + ks * 32); },
                  [&](int j, int ks) { return ld8(bp + (size_t)j * 16 * DINP + ks * 32); });
#pragma unroll
      for (int t = 0; t < 2; ++t) {
        const int tok = tw0 + 16 * t + jn, pos = tok & (S - 1);
        uint2 pl = ld4(proj + (size_t)tok * DINP + C_KPE + 4 * q);
        uint2 ph = ld4(proj + (size_t)tok * DINP + C_KPE + 16 + 4 * q);
        float kl[4] = {lo2f(pl.x), hi2f(pl.x), lo2f(pl.y), hi2f(pl.y)};
        float kh[4] = {lo2f(ph.x), hi2f(ph.x), lo2f(ph.y), hi2f(ph.y)};
        float ss = 0.f;
#pragma unroll
        for (int i = 0; i < 4; ++i)
#pragma unroll
          for (int r = 0; r < 4; ++r) { float v = acc[i][t][r] * rkv[t]; acc[i][t][r] = v; ss += v * v; }
#pragma unroll
        for (int r = 0; r < 4; ++r) ss += kl[r] * kl[r] + kh[r] * kh[r];
        ss = red4(ss);
        const float rs = rsqrtf(ss * (1.0f / 96) + EPS);
#pragma unroll
        for (int i = 0; i < 4; ++i) {
          const int d = 16 * i + 4 * q;
          st4(mk + (size_t)tok * 576 + h * 96 + d, acc[i][t][0] * rs * gk[d], acc[i][t][1] * rs * gk[d + 1], acc[i][t][2] * rs * gk[d + 2], acc[i][t][3] * rs * gk[d + 3]);
        }
        float y1[4], y2[4];
#pragma unroll
        for (int r = 0; r < 4; ++r) {
          float2 cs = r32[pos * 16 + 4 * q + r];
          float x1 = kl[r] * rs * gk[64 + 4 * q + r], x2 = kh[r] * rs * gk[80 + 4 * q + r];
          y1[r] = x1 * cs.x - x2 * cs.y; y2[r] = x2 * cs.x + x1 * cs.y;
        }
        st4(mk + (size_t)tok * 576 + h * 96 + 64 + 4 * q, y1[0], y1[1], y1[2], y1[3]);
        st4(mk + (size_t)tok * 576 + h * 96 + 80 + 4 * q, y2[0], y2[1], y2[2], y2[3]);
      }
    }
    {
      f32x4 acc[2][4]; zero_acc(acc);
      const u16* wp = W + (size_t)(h * 128 + 64 + jn) * 128 + q * 8;
      wgemm<2, 4>(acc, 4, [&](int i, int ks) { return ld8(bp + (size_t)i * 16 * DINP + ks * 32); },
                  [&](int j, int ks) { return ld8(wp + (size_t)j * 16 * 128 + ks * 32); });
#pragma unroll
      for (int i = 0; i < 2; ++i) {
        float rr[4];
#pragma unroll
        for (int r = 0; r < 4; ++r) rr[r] = __shfl(rkv[i], 4 * q + r);
#pragma unroll
        for (int j = 0; j < 4; ++j)
          st4(mvt + ((size_t)(b * 6 + h) * 64 + 16 * j + jn) * S + pos0 + 16 * i + 4 * q,
              acc[i][j][0] * rr[0], acc[i][j][1] * rr[1], acc[i][j][2] * rr[2], acc[i][j][3] * rr[3]);
      }
    }
  }
}

DI void prep_mla_tile(const Params& P, int l, int tt, char* lds, float* s_r, float* s_ss) {
  const int tid = opaque_tid();
  const int wave = __builtin_amdgcn_readfirstlane(tid >> 6), lane = tid & 63, q = lane >> 4, jn = lane & 15;
  const int wa = wave >> 1, wb = wave & 1;
  const int tok0 = tt * 128;
  const u16* proj = (const u16*)(P.ws + O_PROJ);
  const u16* Wq = (const u16*)(P.ws + O_WTUQ) + (size_t)l * 768 * 256;
  const u16* Wkv = (const u16*)(P.ws + O_WTUKV) + (size_t)l * 768 * 128;
  u16* mq = (u16*)(P.ws + O_MQ); u16* mk = (u16*)(P.ws + O_MK); u16* mvt = (u16*)(P.ws + O_MVT);
  const float2* r32 = (const float2*)(P.ws + O_R32);
  const float* gq = P.in[9] + l * 96; const float* gk = P.in[10] + l * 96;
  {
    const int row = tid >> 1, half = tid & 1;
    const u16* pq = proj + (size_t)(tok0 + row) * DINP + C_CQ + half * 128;
    const u16* pk = proj + (size_t)(tok0 + row) * DINP + C_CKV + half * 64;
    bf16x8 vq[16], vk[8];
#pragma unroll
    for (int u = 0; u < 16; ++u) vq[u] = ld8(pq + u * 8);
#pragma unroll
    for (int u = 0; u < 8; ++u) vk[u] = ld8(pk + u * 8);
    float sq = 0.f, sk = 0.f;
#pragma unroll
    for (int u = 0; u < 16; ++u)
#pragma unroll
      for (int j = 0; j < 8; ++j) { const float f = bf2f((u16)vq[u][j]); sq += f * f; }
#pragma unroll
    for (int u = 0; u < 8; ++u)
#pragma unroll
      for (int j = 0; j < 8; ++j) { const float f = bf2f((u16)vk[u][j]); sk += f * f; }
    sq += __shfl_xor(sq, 1); sk += __shfl_xor(sk, 1);
    if (half == 0) { s_r[row] = rsqrtf(sq * (1.0f / 256) + EPS); s_r[128 + row] = rsqrtf(sk * (1.0f / 128) + EPS); }
  }
  __syncthreads();
  const float qscale = 0.10206207261596577f * LOG2E;
#pragma unroll 1
  for (int h0 = 0; h0 < 6; ++h0) {
    int h = h0; asm volatile("" : "+s"(h));
    f32x4 acc[4][4]; zero_acc(acc);
    gemm_block(acc, Wq + (size_t)(h * 128) * 256, 256, proj + (size_t)tok0 * DINP + C_CQ, DINP, 256, lds, tid);
#pragma unroll
    for (int j = 0; j < 4; ++j) {
      const int tl = wb * 64 + 16 * j + jn; const float rq = s_r[tl];
      float ss = 0.f;
#pragma unroll
      for (int i = 0; i < 4; ++i)
#pragma unroll
        for (int r = 0; r < 4; ++r) { const float v = acc[i][j][r] * rq; acc[i][j][r] = v; ss += v * v; }
      ss = red4(ss);
      if (q == 0) s_ss[wa * 128 + tl] = ss;
    }
    __syncthreads();
#pragma unroll
    for (int j = 0; j < 4; ++j) {
      const int tl = wb * 64 + 16 * j + jn, tok = tok0 + tl, pos = tok & (S - 1);
      const float rs = rsqrtf((s_ss[tl] + s_ss[128 + tl]) * (1.0f / 96) + EPS);
      if (wa == 0) {
#pragma unroll
        for (int i = 0; i < 4; ++i) {
          const int d = 16 * i + 4 * q;
          st4(mq + (size_t)tok * 576 + h * 96 + d, acc[i][j][0] * rs * gq[d] * qscale, acc[i][j][1] * rs * gq[d + 1] * qscale,
              acc[i][j][2] * rs * gq[d + 2] * qscale, acc[i][j][3] * rs * gq[d + 3] * qscale);
        }
      } else {
        float y1[4], y2[4];
#pragma unroll
        for (int r = 0; r < 4; ++r) {
          const float2 cs = r32[pos * 16 + 4 * q + r];
          const float x1 = acc[0][j][r] * rs * gq[64 + 4 * q + r], x2 = acc[1][j][r] * rs * gq[80 + 4 * q + r];
          y1[r] = (x1 * cs.x - x2 * cs.y) * qscale; y2[r] = (x2 * cs.x + x1 * cs.y) * qscale;
        }
        st4(mq + (size_t)tok * 576 + h * 96 + 64 + 4 * q, y1[0], y1[1], y1[2], y1[3]);
        st4(mq + (size_t)tok * 576 + h * 96 + 80 + 4 * q, y2[0], y2[1], y2[2], y2[3]);
      }
    }
    __syncthreads();
  }
  const int b = tok0 >> 12, pos0 = tok0 & (S - 1);
#pragma unroll 1
  for (int h0 = 0; h0 < 6; ++h0) {
    int h = h0; asm volatile("" : "+s"(h));
    f32x4 acc[4][4]; zero_acc(acc);
    gemm_block(acc, Wkv + (size_t)(h * 128) * 128, 128, proj + (size_t)tok0 * DINP + C_CKV, DINP, 128, lds, tid);
    if (wa == 0) {
#pragma unroll
      for (int j = 0; j < 4; ++j) {
        const int tl = wb * 64 + 16 * j + jn, tok = tok0 + tl, pos = tok & (S - 1);
        const float rkv = s_r[128 + tl];
        const uint2 pl = ld4(proj + (size_t)tok * DINP + C_KPE + 4 * q);
        const uint2 ph = ld4(proj + (size_t)tok * DINP + C_KPE + 16 + 4 * q);
        const float kl[4] = {lo2f(pl.x), hi2f(pl.x), lo2f(pl.y), hi2f(pl.y)};
        const float kh[4] = {lo2f(ph.x), hi2f(ph.x), lo2f(ph.y), hi2f(ph.y)};
        float ss = 0.f;
#pragma unroll
        for (int i = 0; i < 4; ++i)
#pragma unroll
          for (int r = 0; r < 4; ++r) { const float v = acc[i][j][r] * rkv; acc[i][j][r] = v; ss += v * v; }
#pragma unroll
        for (int r = 0; r < 4; ++r) ss += kl[r] * kl[r] + kh[r] * kh[r];
        ss = red4(ss);
        const float rs = rsqrtf(ss * (1.0f / 96) + EPS);
#pragma unroll
        for (int i = 0; i < 4; ++i) {
          const int d = 16 * i + 4 * q;
          st4(mk + (size_t)tok * 576 + h * 96 + d, acc[i][j][0] * rs * gk[d], acc[i][j][1] * rs * gk[d + 1], acc[i][j][2] * rs * gk[d + 2], acc[i][j][3] * rs * gk[d + 3]);
        }
        float y1[4], y2[4];
#pragma unroll
        for (int r = 0; r < 4; ++r) {
          const float2 cs = r32[pos * 16 + 4 * q + r];
          const float x1 = kl[r] * rs * gk[64 + 4 * q + r], x2 = kh[r] * rs * gk[80 + 4 * q + r];
          y1[r] = x1 * cs.x - x2 * cs.y; y2[r] = x2 * cs.x + x1 * cs.y;
        }
        st4(mk + (size_t)tok * 576 + h * 96 + 64 + 4 * q, y1[0], y1[1], y1[2], y1[3]);
        st4(mk + (size_t)tok * 576 + h * 96 + 80 + 4 * q, y2[0], y2[1], y2[2], y2[3]);
      }
    } else {
#pragma unroll
      for (int j = 0; j < 4; ++j) {
        const int tl = wb * 64 + 16 * j + jn;
        const float rkv = s_r[128 + tl];
#pragma unroll
        for (int i = 0; i < 4; ++i)
#pragma unroll
          for (int r = 0; r < 4; ++r)
            mvt[((size_t)(b * 6 + h) * 64 + 16 * i + 4 * q + r) * S + pos0 + tl] = f2bf(acc[i][j][r] * rkv);
      }
    }
  }
}

DI void prep_dsa(const Params& P, int l, int tok0) {
  u16* proj = (u16*)(P.ws + O_PROJ);
  u16* avt = (u16*)(P.ws + O_AVT);
  const float2* r64 = (const float2*)(P.ws + O_R64);
  const float2* r32 = (const float2*)(P.ws + O_R32);
  const int tid = opaque_tid();
  for (int task = tid; task < 512; task += 256) {
    const int tok = tok0 + (task >> 2), c = task & 3, pos = tok & (S - 1);
    u16* row = proj + (size_t)tok * DINP;
    bf16x8 lo[7], hi[7];
#pragma unroll
    for (int hh = 0; hh < 7; ++hh) {
      const int base = (hh < 6) ? C_QA + 64 * hh : C_KA;
      lo[hh] = ld8(row + base + 8 * c); hi[hh] = ld8(row + base + 32 + 8 * c);
    }
    float2 cs[8];
    float gql[8], gqh[8], gkl[8], gkh[8];
    const float* gq = P.in[3] + l * 64; const float* gk = P.in[4] + l * 64;
#pragma unroll
    for (int j = 0; j < 8; ++j) {
      cs[j] = r64[pos * 32 + 8 * c + j];
      gql[j] = gq[8 * c + j]; gqh[j] = gq[32 + 8 * c + j]; gkl[j] = gk[8 * c + j]; gkh[j] = gk[32 + 8 * c + j];
    }
#pragma unroll
    for (int hh = 0; hh < 7; ++hh) {
      const int base = (hh < 6) ? C_QA + 64 * hh : C_KA;
      float xl[8], xh[8];
      float ss = 0.f;
#pragma unroll
      for (int j = 0; j < 8; ++j) { xl[j] = bf2f((u16)lo[hh][j]); xh[j] = bf2f((u16)hi[hh][j]); ss += xl[j] * xl[j] + xh[j] * xh[j]; }
      ss += __shfl_xor(ss, 1); ss += __shfl_xor(ss, 2);
      const float rs = rsqrtf(ss * (1.0f / 64) + EPS);
      const float sc = (hh < 6) ? 0.125f * LOG2E : 1.0f;
      float y1[8], y2[8];
#pragma unroll
      for (int j = 0; j < 8; ++j) {
        const float x1 = xl[j] * rs * ((hh < 6) ? gql[j] : gkl[j]), x2 = xh[j] * rs * ((hh < 6) ? gqh[j] : gkh[j]);
        y1[j] = (x1 * cs[j].x - x2 * cs[j].y) * sc; y2[j] = (x2 * cs[j].x + x1 * cs[j].y) * sc;
      }
      uint4 o; o.x = pack2(y1[0], y1[1]); o.y = pack2(y1[2], y1[3]); o.z = pack2(y1[4], y1[5]); o.w = pack2(y1[6], y1[7]);
      *reinterpret_cast<uint4*>(row + base + 8 * c) = o;
      o.x = pack2(y2[0], y2[1]); o.y = pack2(y2[2], y2[3]); o.z = pack2(y2[4], y2[5]); o.w = pack2(y2[6], y2[7]);
      *reinterpret_cast<uint4*>(row + base + 32 + 8 * c) = o;
    }
  }
  {
    const int tok = tok0 + (tid >> 1), c2 = tid & 1, pos = tok & (S - 1);
    u16* row = proj + (size_t)tok * DINP;
    bf16x8 lo[9], hi[9];
#pragma unroll
    for (int hh = 0; hh < 9; ++hh) {
      const int base = (hh < 8) ? C_IQ + 32 * hh : C_IK;
      lo[hh] = ld8(row + base + 8 * c2); hi[hh] = ld8(row + base + 16 + 8 * c2);
    }
    float2 cs[8];
#pragma unroll
    for (int j = 0; j < 8; ++j) cs[j] = r32[pos * 16 + 8 * c2 + j];
#pragma unroll
    for (int hh = 0; hh < 9; ++hh) {
      const int base = (hh < 8) ? C_IQ + 32 * hh : C_IK;
      float y1[8], y2[8];
#pragma unroll
      for (int j = 0; j < 8; ++j) {
        const float x1 = bf2f((u16)lo[hh][j]), x2 = bf2f((u16)hi[hh][j]);
        y1[j] = x1 * cs[j].x - x2 * cs[j].y; y2[j] = x2 * cs[j].x + x1 * cs[j].y;
      }
      uint4 o; o.x = pack2(y1[0], y1[1]); o.y = pack2(y1[2], y1[3]); o.z = pack2(y1[4], y1[5]); o.w = pack2(y1[6], y1[7]);
      *reinterpret_cast<uint4*>(row + base + 8 * c2) = o;
      o.x = pack2(y2[0], y2[1]); o.y = pack2(y2[2], y2[3]); o.z = pack2(y2[4], y2[5]); o.w = pack2(y2[6], y2[7]);
      *reinterpret_cast<uint4*>(row + base + 16 + 8 * c2) = o;
    }
  }
  {
    const int b = tok0 >> 12, pos0 = tok0 & (S - 1);
    const int dim = tid & 63, tg0 = tid >> 6;
    unsigned short v[8][4];
#pragma unroll
    for (int u = 0; u < 8; ++u) {
      const u16* p = proj + (size_t)(tok0 + 4 * (tg0 + 4 * u)) * DINP + C_VA + dim;
#pragma unroll
      for (int k = 0; k < 4; ++k) v[u][k] = p[k * DINP];
    }
#pragma unroll
    for (int u = 0; u < 8; ++u) {
      uint2 o; o.x = (unsigned)v[u][0] | ((unsigned)v[u][1] << 16); o.y = (unsigned)v[u][2] | ((unsigned)v[u][3] << 16);
      *reinterpret_cast<uint2*>(avt + ((size_t)b * 64 + dim) * S + pos0 + 4 * (tg0 + 4 * u)) = o;
    }
  }
}

DI void prep_tile(const Params& P, int l, int tile, char* lds, float* s_r) {
  const int tid = opaque_tid();
  const int wave = __builtin_amdgcn_readfirstlane(tid >> 6), lane = tid & 63;
  const int tok0 = tile * 128;
  prep_mla_tile(P, l, tile, lds, s_r, s_r + 256);
  prep_dsa(P, l, tok0);
}

DI void inproj_tile(const Params& P, int l, int tt, char* lds, float* s_rstd, float* s_prep) {
  const u16* W = (const u16*)(P.ws + O_WTIN) + (size_t)l * DINP * DM;
  const u16* xb = (const u16*)(P.ws + O_XB2);
  u16* proj = (u16*)(P.ws + O_PROJ);
  const int tid = opaque_tid();
  const int wave = __builtin_amdgcn_readfirstlane(tid >> 6), lane = tid & 63, q = lane >> 4, jn = lane & 15;
  {
    {
      const u16* rp = xb + (size_t)(tt * 128 + (tid >> 1)) * DM + (tid & 1) * 512;
      float ss = 0.f;
#pragma unroll 1
      for (int c = 0; c < 8; ++c) {
        bf16x8 v[8];
#pragma unroll
        for (int u = 0; u < 8; ++u) v[u] = ld8(rp + (c * 8 + u) * 8);
#pragma unroll
        for (int u = 0; u < 8; ++u)
#pragma unroll
          for (int j = 0; j < 8; ++j) { const float f = bf2f((u16)v[u][j]); ss += f * f; }
      }
      ss += __shfl_xor(ss, 1);
      if ((tid & 1) == 0) s_rstd[tid >> 1] = rsqrtf(ss * (1.0f / DM) + EPS);
    }
    __syncthreads();
#pragma unroll 1
    for (int ftile0 = 0; ftile0 < 20; ++ftile0) {
      int ftile = ftile0; asm volatile("" : "+s"(ftile));
      const int f0 = ftile * 128 + (wave >> 1) * 64, t0 = tt * 128 + (wave & 1) * 64;
      f32x4 acc[4][4]; zero_acc(acc);
      gemm_block(acc, W + (size_t)(ftile * 128) * DM, DM, xb + (size_t)(tt * 128) * DM, DM, DM, lds, tid);
#pragma unroll
      for (int j = 0; j < 4; ++j) {
        const int tok = t0 + 16 * j + jn; const float rs = s_rstd[(wave & 1) * 64 + 16 * j + jn];
#pragma unroll
        for (int i = 0; i < 4; ++i)
          st4(proj + (size_t)tok * DINP + f0 + 16 * i + 4 * q, acc[i][j][0] * rs, acc[i][j][1] * rs, acc[i][j][2] * rs, acc[i][j][3] * rs);
      }
    }
    asm volatile("s_waitcnt vmcnt(0)" ::: "memory");
    __syncthreads();
    prep_tile(P, l, tt, lds, s_prep);
    __syncthreads();
  }
}

DI void phase_inproj(const Params& P, int l, char* lds, float* s_rstd, float* s_prep) {
  for (int tt = blockIdx.x; tt < 512; tt += gridDim.x) inproj_tile(P, l, tt, lds, s_rstd, s_prep);
}

template <int KS, bool MASK>
DI void attn_block_v1(const u16* Qp, int qstride, const u16* Kp, int kstride, const u16* Vtp, const u64* maskp, int nkt_w, int nkt_max,
                   const u16* gatep, int gstride, u16* outp, int ostride, char* lds, int tid) {
  constexpr int DQK = KS * 32, KROW = DQK + 8, VROW = 72;
  constexpr int KCH = DQK / 8, NKC = 64 * KCH / 256;
  constexpr int K_BYTES = 64 * KROW * 2, BUF_BYTES = K_BYTES + 64 * VROW * 2;
  const int lane = tid & 63, q = lane >> 4, jn = lane & 15;
  const float NEG_INF = -__builtin_inff();
  uint4 kst[NKC], vst[2];
  auto gload = [&](int kt) {
#pragma unroll
    for (int i = 0; i < NKC; ++i) {
      const int c = tid + 256 * i, row = c / KCH, col = c % KCH;
      kst[i] = *reinterpret_cast<const uint4*>(Kp + (size_t)(kt * 64 + row) * kstride + col * 8);
    }
#pragma unroll
    for (int i = 0; i < 2; ++i) {
      const int c = tid + 256 * i, dim = c >> 3, part = c & 7;
      vst[i] = *reinterpret_cast<const uint4*>(Vtp + (size_t)dim * S + kt * 64 + part * 8);
    }
  };
  auto lstore = [&](int buf) {
    char* kb = lds + buf * BUF_BYTES; char* vb = kb + K_BYTES;
#pragma unroll
    for (int i = 0; i < NKC; ++i) {
      const int c = tid + 256 * i, row = c / KCH, col = c % KCH;
      *reinterpret_cast<uint4*>(kb + (row * KROW + col * 8) * 2) = kst[i];
    }
#pragma unroll
    for (int i = 0; i < 2; ++i) {
      const int c = tid + 256 * i, dim = c >> 3, part = c & 7;
      *reinterpret_cast<uint4*>(vb + (dim * VROW + part * 8) * 2) = vst[i];
    }
  };
  bf16x8 qf[2][KS];
#pragma unroll
  for (int c = 0; c < 2; ++c)
#pragma unroll
    for (int ks = 0; ks < KS; ++ks) qf[c][ks] = ld8(Qp + (size_t)(16 * c + jn) * qstride + ks * 32 + q * 8);
  f32x4 o[4][2]; zero_acc(o);
  float m[2] = {NEG_INF, NEG_INF}, lsum[2] = {0.f, 0.f};
  u64 mw[2] = {0ull, 0ull}, mwn[2] = {0ull, 0ull};
  if (MASK) {
#pragma unroll
    for (int c = 0; c < 2; ++c) mw[c] = maskp[(size_t)(16 * c + jn) * 64];
  }
  gload(0);
  lstore(0);
  __syncthreads();
  for (int kt = 0; kt < nkt_max; ++kt) {
    const bool more = kt + 1 < nkt_max;
    if (more) {
      gload(kt + 1);
      if (MASK) {
        if (kt + 1 < nkt_w) {
#pragma unroll
          for (int c = 0; c < 2; ++c) mwn[c] = maskp[(size_t)(16 * c + jn) * 64 + kt + 1];
        }
      }
    }
    if (kt < nkt_w) {
      const char* kb = lds + (kt & 1) * BUF_BYTES; const char* vb = kb + K_BYTES;
      f32x4 s[4][2]; zero_acc(s);
#pragma unroll
      for (int a = 0; a < 4; ++a)
#pragma unroll
        for (int ks = 0; ks < KS; ++ks) {
          const bf16x8 kf = *reinterpret_cast<const bf16x8*>(kb + ((16 * a + jn) * KROW + ks * 32 + q * 8) * 2);
#pragma unroll
          for (int c = 0; c < 2; ++c) s[a][c] = mfma16(kf, qf[c][ks], s[a][c]);
        }
      if (MASK) {
#pragma unroll
        for (int c = 0; c < 2; ++c) {
          const u64 w = mw[c] >> (4 * q);
#pragma unroll
          for (int a = 0; a < 4; ++a)
#pragma unroll
            for (int r = 0; r < 4; ++r)
              if (!((w >> (16 * a + r)) & 1ull)) s[a][c][r] = NEG_INF;
        }
      }
      float alpha[2];
#pragma unroll
      for (int c = 0; c < 2; ++c) {
        float mx = NEG_INF;
#pragma unroll
        for (int a = 0; a < 4; ++a)
#pragma unroll
          for (int r = 0; r < 4; ++r) mx = fmaxf(mx, s[a][c][r]);
        mx = fmaxf(mx, __shfl_xor(mx, 16)); mx = fmaxf(mx, __shfl_xor(mx, 32));
        const float mn = fmaxf(m[c], mx);
        const float mu = (mn == NEG_INF) ? 0.f : mn;
        alpha[c] = fexp2(m[c] - mu);
        m[c] = mn;
        float ps = 0.f;
#pragma unroll
        for (int a = 0; a < 4; ++a)
#pragma unroll
          for (int r = 0; r < 4; ++r) { float p = fexp2(s[a][c][r] - mu); s[a][c][r] = p; ps += p; }
        lsum[c] = lsum[c] * alpha[c] + ps;
      }
      if (__builtin_amdgcn_ballot_w64(alpha[0] != 1.0f || alpha[1] != 1.0f) != 0ull) {
#pragma unroll
        for (int c = 0; c < 2; ++c)
#pragma unroll
          for (int dt = 0; dt < 4; ++dt)
#pragma unroll
            for (int r = 0; r < 4; ++r) o[dt][c][r] *= alpha[c];
      }
#pragma unroll
      for (int kk = 0; kk < 2; ++kk) {
        bf16x8 pf[2];
#pragma unroll
        for (int c = 0; c < 2; ++c) {
          uint4 w; w.x = pack2(s[2 * kk][c][0], s[2 * kk][c][1]); w.y = pack2(s[2 * kk][c][2], s[2 * kk][c][3]);
          w.z = pack2(s[2 * kk + 1][c][0], s[2 * kk + 1][c][1]); w.w = pack2(s[2 * kk + 1][c][2], s[2 * kk + 1][c][3]);
          pf[c] = __builtin_bit_cast(bf16x8, w);
        }
#pragma unroll
        for (int dt = 0; dt < 4; ++dt) {
          const char* vp = vb + ((16 * dt + jn) * VROW + kk * 32 + 4 * q) * 2;
          const uint2 lo = *reinterpret_cast<const uint2*>(vp), hi = *reinterpret_cast<const uint2*>(vp + 32);
          uint4 w; w.x = lo.x; w.y = lo.y; w.z = hi.x; w.w = hi.y;
          const bf16x8 vf = __builtin_bit_cast(bf16x8, w);
#pragma unroll
          for (int c = 0; c < 2; ++c) o[dt][c] = mfma16(vf, pf[c], o[dt][c]);
        }
      }
    }
    if (more) lstore((kt + 1) & 1);
    if (MASK) { mw[0] = mwn[0]; mw[1] = mwn[1]; }
    __syncthreads();
  }
#pragma unroll
  for (int c = 0; c < 2; ++c) {
    const float inv = 1.0f / red4(lsum[c]);
    const int row = 16 * c + jn;
#pragma unroll
    for (int dt = 0; dt < 4; ++dt) {
      uint2 gw = ld4(gatep + (size_t)row * gstride + 16 * dt + 4 * q);
      st4(outp + (size_t)row * ostride + 16 * dt + 4 * q, o[dt][c][0] * inv * siluf_(lo2f(gw.x)), o[dt][c][1] * inv * siluf_(hi2f(gw.x)),
          o[dt][c][2] * inv * siluf_(lo2f(gw.y)), o[dt][c][3] * inv * siluf_(hi2f(gw.y)));
    }
  }
}

template <int KS, bool MASK, int NC, bool SH>
DI void attn_block(const u16* Qp, int qstride, const u16* Kp, int kstride, const u16* Vtp, const u64* maskp, int nkt_w, int nkt_max,
                   const u16* gatep, int gstride, u16* outp, int ostride, char* lds, int tid) {
  constexpr int DQK = KS * 32, KROW = DQK + 8, VROW = 72;
  constexpr int KCH = DQK / 8, NKC = 64 * KCH / 256;
  constexpr int K_BYTES = 64 * KROW * 2, BUF_BYTES = K_BYTES + 64 * VROW * 2;
  const int lane = tid & 63, q = lane >> 4, jn = lane & 15;
  const float NEG_INF = -__builtin_inff();
  uint4 xk0, xk1, xk2, xv0, xv1, yk0, yk1, yk2, yv0, yv1;
  xk2 = yk2 = make_uint4(0, 0, 0, 0);
  const int c0 = tid, c1 = tid + 256, c2 = tid + 512;
  const u16* kg0 = Kp + (size_t)(c0 / KCH) * kstride + (c0 % KCH) * 8;
  const u16* kg1 = Kp + (size_t)(c1 / KCH) * kstride + (c1 % KCH) * 8;
  const u16* kg2 = Kp + (size_t)(c2 / KCH) * kstride + (c2 % KCH) * 8;
  const u16* vg0 = Vtp + (size_t)(c0 >> 3) * S + (c0 & 7) * 8;
  const u16* vg1 = Vtp + (size_t)(c1 >> 3) * S + (c1 & 7) * 8;
  char* ks0 = lds + ((c0 / KCH) * KROW + (c0 % KCH) * 8) * 2;
  char* ks1 = lds + ((c1 / KCH) * KROW + (c1 % KCH) * 8) * 2;
  char* ks2 = lds + ((c2 / KCH) * KROW + (c2 % KCH) * 8) * 2;
  char* vs0 = lds + K_BYTES + ((c0 >> 3) * VROW + (c0 & 7) * 8) * 2;
  char* vs1 = lds + K_BYTES + ((c1 >> 3) * VROW + (c1 & 7) * 8) * 2;
#define A_LOAD(P, kt) { const size_t ko = (size_t)(kt) * 64 * kstride; const int vo = (kt) * 64;                     \
    P##k0 = *reinterpret_cast<const uint4*>(kg0 + ko); P##k1 = *reinterpret_cast<const uint4*>(kg1 + ko);            \
    if (NKC == 3) P##k2 = *reinterpret_cast<const uint4*>(kg2 + ko);                                                 \
    P##v0 = *reinterpret_cast<const uint4*>(vg0 + vo); P##v1 = *reinterpret_cast<const uint4*>(vg1 + vo); }
#define A_STORE(P, buf) { *reinterpret_cast<uint4*>(ks0 + (buf) * BUF_BYTES) = P##k0; *reinterpret_cast<uint4*>(ks1 + (buf) * BUF_BYTES) = P##k1; \
    if (NKC == 3) *reinterpret_cast<uint4*>(ks2 + (buf) * BUF_BYTES) = P##k2;                                        \
    *reinterpret_cast<uint4*>(vs0 + (buf) * BUF_BYTES) = P##v0; *reinterpret_cast<uint4*>(vs1 + (buf) * BUF_BYTES) = P##v1; }
  bf16x8 qf[NC][KS];
#pragma unroll
  for (int c = 0; c < NC; ++c)
#pragma unroll
    for (int ks = 0; ks < KS; ++ks) qf[c][ks] = ld8(Qp + (size_t)((SH ? 0 : 16 * c) + jn) * qstride + (SH ? 64 * c : 0) + ks * 32 + q * 8);
  f32x4 o[4][NC]; zero_acc(o);
  float m[NC], lsum[NC];
#pragma unroll
  for (int c = 0; c < NC; ++c) { m[c] = NEG_INF; lsum[c] = 0.f; }
  u64 mce0 = 0ull, mce1 = 0ull, mco0 = 0ull, mco1 = 0ull, mne0 = 0ull, mne1 = 0ull, mno0 = 0ull, mno1 = 0ull;
  const u64* mrow0 = maskp + (size_t)jn * 64;
  const u64* mrow1 = maskp + (size_t)(16 + jn) * 64;
  if (MASK) {
    mce0 = mrow0[0]; if (!SH) mce1 = mrow1[0];
    if (1 < nkt_w) { mco0 = mrow0[1]; if (!SH) mco1 = mrow1[1]; }
  }
  auto compute = [&](int buf, u64 w0, u64 w1) {
    const char* kb = lds + buf * BUF_BYTES; const char* vb = kb + K_BYTES;
    f32x4 s[4][NC]; zero_acc(s);
#pragma unroll
    for (int a = 0; a < 4; ++a)
#pragma unroll
      for (int ks = 0; ks < KS; ++ks) {
        const bf16x8 kf = *reinterpret_cast<const bf16x8*>(kb + ((16 * a + jn) * KROW + ks * 32 + q * 8) * 2);
#pragma unroll
        for (int c = 0; c < NC; ++c) s[a][c] = mfma16(kf, qf[c][ks], s[a][c]);
      }
    if (MASK) {
#pragma unroll
      for (int c = 0; c < NC; ++c) {
        const u64 w = ((SH || c == 0) ? w0 : w1) >> (4 * q);
#pragma unroll
        for (int a = 0; a < 4; ++a)
#pragma unroll
          for (int r = 0; r < 4; ++r)
            if (!((w >> (16 * a + r)) & 1ull)) s[a][c][r] = NEG_INF;
      }
    }
    float alpha[NC];
#pragma unroll
    for (int c = 0; c < NC; ++c) {
      float mx = NEG_INF;
#pragma unroll
      for (int a = 0; a < 4; ++a)
#pragma unroll
        for (int r = 0; r < 4; ++r) mx = fmaxf(mx, s[a][c][r]);
      mx = fmaxf(mx, __shfl_xor(mx, 16)); mx = fmaxf(mx, __shfl_xor(mx, 32));
      const float mn = fmaxf(m[c], mx);
      const float mu = (mn == NEG_INF) ? 0.f : mn;
      alpha[c] = fexp2(m[c] - mu);
      m[c] = mn;
      float ps = 0.f;
#pragma unroll
      for (int a = 0; a < 4; ++a)
#pragma unroll
        for (int r = 0; r < 4; ++r) { float p = fexp2(s[a][c][r] - mu); s[a][c][r] = p; ps += p; }
      lsum[c] = lsum[c] * alpha[c] + ps;
    }
    bool resc = false;
#pragma unroll
    for (int c = 0; c < NC; ++c) resc = resc || (alpha[c] != 1.0f);
    if (__builtin_amdgcn_ballot_w64(resc) != 0ull) {
#pragma unroll
      for (int c = 0; c < NC; ++c)
#pragma unroll
        for (int dt = 0; dt < 4; ++dt)
#pragma unroll
          for (int r = 0; r < 4; ++r) o[dt][c][r] *= alpha[c];
    }
#pragma unroll
    for (int kk = 0; kk < 2; ++kk) {
      bf16x8 pf[NC];
#pragma unroll
      for (int c = 0; c < NC; ++c) {
        uint4 w; w.x = pack2(s[2 * kk][c][0], s[2 * kk][c][1]); w.y = pack2(s[2 * kk][c][2], s[2 * kk][c][3]);
        w.z = pack2(s[2 * kk + 1][c][0], s[2 * kk + 1][c][1]); w.w = pack2(s[2 * kk + 1][c][2], s[2 * kk + 1][c][3]);
        pf[c] = __builtin_bit_cast(bf16x8, w);
      }
#pragma unroll
      for (int dt = 0; dt < 4; ++dt) {
        const char* vp = vb + ((16 * dt + jn) * VROW + kk * 32 + 4 * q) * 2;
        const uint2 lo = *reinterpret_cast<const uint2*>(vp), hi = *reinterpret_cast<const uint2*>(vp + 32);
        uint4 w; w.x = lo.x; w.y = lo.y; w.z = hi.x; w.w = hi.y;
        const bf16x8 vf = __builtin_bit_cast(bf16x8, w);
#pragma unroll
        for (int c = 0; c < NC; ++c) o[dt][c] = mfma16(vf, pf[c], o[dt][c]);
      }
    }
  };

  A_LOAD(x, 0);
  { const int t1 = (nkt_max > 1) ? 1 : 0; A_LOAD(y, t1); }
  A_STORE(x, 0);
  __syncthreads();
  for (int kt = 0; kt < nkt_max; kt += 2) {
    const bool more = kt + 2 < nkt_max;
    if (more) {
      A_LOAD(x, kt + 2);
      if (MASK) {
        if (kt + 2 < nkt_w) { mne0 = mrow0[kt + 2]; if (!SH) mne1 = mrow1[kt + 2]; }
        if (kt + 3 < nkt_w) { mno0 = mrow0[kt + 3]; if (!SH) mno1 = mrow1[kt + 3]; }
      }
    }
    if (kt < nkt_w) compute(0, mce0, mce1);
    A_STORE(y, 1);
    __syncthreads();
    if (kt + 3 < nkt_max) A_LOAD(y, kt + 3);
    if (kt + 1 < nkt_w) compute(1, mco0, mco1);
    if (more) A_STORE(x, 0);
    if (MASK) { mce0 = mne0; mce1 = mne1; mco0 = mno0; mco1 = mno1; }
    __syncthreads();
  }
#undef A_LOAD
#undef A_STORE
#pragma unroll
  for (int c = 0; c < NC; ++c) {
    const float inv = 1.0f / red4(lsum[c]);
    const int row = (SH ? 0 : 16 * c) + jn;
    const int hc = SH ? 64 * c : 0;
#pragma unroll
    for (int dt = 0; dt < 4; ++dt) {
      uint2 gw = ld4(gatep + (size_t)row * gstride + hc + 16 * dt + 4 * q);
      st4(outp + (size_t)row * ostride + hc + 16 * dt + 4 * q, o[dt][c][0] * inv * siluf_(lo2f(gw.x)), o[dt][c][1] * inv * siluf_(hi2f(gw.x)),
          o[dt][c][2] * inv * siluf_(lo2f(gw.y)), o[dt][c][3] * inv * siluf_(hi2f(gw.y)));
    }
  }
}

DI void mla_attn_item(const Params& P, int it, char* lds, int tid) {
  const int wave = __builtin_amdgcn_readfirstlane(tid >> 6);
  const int qb = 31 - it / 96, bh = it % 96, b = bh / 6, h = bh % 6;
  const int q0 = qb * 128 + wave * 32;
  const int nkt = (q0 >> 6) + 1;
  const u16* mq = (const u16*)(P.ws + O_MQ); const u16* mk = (const u16*)(P.ws + O_MK); const u16* mvt = (const u16*)(P.ws + O_MVT);
  const u16* proj = (const u16*)(P.ws + O_PROJ); u16* mixed = (u16*)(P.ws + O_XB);
  const size_t tok = (size_t)b * S + q0;
  attn_block<3, false, 2, false>(mq + tok * 576 + h * 96, 576, mk + (size_t)b * S * 576 + h * 96, 576, mvt + (size_t)(b * 6 + h) * 64 * S, nullptr, nkt, 2 * qb + 2,
                       proj + tok * DINP + C_GC + h * 64, DINP, mixed + tok * DM + 640 + h * 64, DM, lds, tid);
}

DI void dsa_attn_item(const Params& P, int it, char* lds, int tid) {
  const int wave = __builtin_amdgcn_readfirstlane(tid >> 6);
  const int ch = 63 - it / 32, bh = it % 32, b = bh >> 1, hg = bh & 1;
  const int q0 = ch * 64 + wave * 16;
  const int nkt = ch + 1;
  const u16* proj = (const u16*)(P.ws + O_PROJ); const u16* avt = (const u16*)(P.ws + O_AVT); u16* mixed = (u16*)(P.ws + O_XB);
  const u64* mask = (const u64*)(P.ws + O_MASK);
  const size_t tok = (size_t)b * S + q0;
  attn_block<2, true, 3, true>(proj + tok * DINP + C_QA + hg * 192, DINP, proj + (size_t)b * S * DINP + C_KA, DINP, avt + (size_t)b * 64 * S, mask + tok * 64, nkt, nkt,
                               proj + tok * DINP + C_GA + hg * 192, DINP, mixed + tok * DM + hg * 192, DM, lds, tid);
}

constexpr int SC_STRIDE = 4096 + 16;
DI unsigned fkey(float f) { unsigned u = __float_as_uint(f); return (u & 0x80000000u) ? ~u : (u | 0x80000000u); }
DI float funkey(unsigned k) { return __uint_as_float((k & 0x80000000u) ? (k ^ 0x80000000u) : ~k); }

template <int NR>
DI u64 select_wave(float* scw, int nreg, int lane) {
  unsigned key[NR];
  unsigned kmin = 0xffffffffu, kmax = 0u;
#pragma unroll
  for (int r = 0; r < NR; ++r) {
    const unsigned k = fkey(scw[64 * r + lane]);
    const bool ok = r < nreg;
    key[r] = ok ? k : 0u;
    kmin = min(kmin, ok ? k : 0xffffffffu); kmax = max(kmax, key[r]);
  }
#pragma unroll
  for (int o = 1; o < 64; o <<= 1) { kmin = min(kmin, (unsigned)__shfl_xor((int)kmin, o)); kmax = max(kmax, (unsigned)__shfl_xor((int)kmax, o)); }
  unsigned lo = __builtin_amdgcn_readfirstlane(kmin), hi = __builtin_amdgcn_readfirstlane(kmax);
  int clo = 64 * nreg, chi = 0;
  bool exact = false;
  int iter = 0;
  while (lo < hi && clo - chi > 512) {
    unsigned mid = fkey(0.5f * (funkey(lo) + funkey(hi)));
    if (iter >= 16) mid = lo + ((hi - lo + 1u) >> 1);
    if (mid <= lo) mid = lo + 1;
    if (mid > hi) mid = hi;
    ++iter;
    int cnt = 0;
#pragma unroll
    for (int r = 0; r < NR; ++r) cnt += __builtin_popcountll(__builtin_amdgcn_ballot_w64(key[r] >= mid));
    if (cnt >= 256) { lo = mid; clo = cnt; if (cnt == 256) { exact = true; break; } }
    else { hi = mid - 1; chi = cnt; }
  }
  if (!exact && lo < hi) {
    unsigned* cand = reinterpret_cast<unsigned*>(scw);
    int base = 0;
#pragma unroll
    for (int r = 0; r < NR; ++r) {
      const bool pred = (key[r] >= lo) && (key[r] <= hi);
      const u64 bal = __builtin_amdgcn_ballot_w64(pred);
      const int pos = base + __builtin_amdgcn_mbcnt_hi((unsigned)(bal >> 32), __builtin_amdgcn_mbcnt_lo((unsigned)bal, 0u));
      if (pred) cand[pos] = key[r];
      base += __builtin_popcountll(bal);
    }
    __builtin_amdgcn_fence(__ATOMIC_RELEASE, "wavefront");
    __builtin_amdgcn_fence(__ATOMIC_ACQUIRE, "wavefront");
    unsigned ck[8];
#pragma unroll
    for (int i = 0; i < 8; ++i) { const unsigned v = cand[64 * i + lane]; ck[i] = (64 * i + lane < base) ? v : 0u; }
    const int cabove = chi;
    while (lo < hi) {
      unsigned mid = fkey(0.5f * (funkey(lo) + funkey(hi)));
      if (iter >= 16) mid = lo + ((hi - lo + 1u) >> 1);
      if (mid <= lo) mid = lo + 1;
      if (mid > hi) mid = hi;
      ++iter;
      int cnt = cabove;
#pragma unroll
      for (int i = 0; i < 8; ++i) cnt += __builtin_popcountll(__builtin_amdgcn_ballot_w64(ck[i] >= mid));
      if (cnt >= 256) { lo = mid; if (cnt == 256) { exact = true; break; } }
      else { hi = mid - 1; }
    }
  }
  const unsigned thr = lo;
  u64 myword = 0ull;
  if (exact) {
#pragma unroll
    for (int r = 0; r < NR; ++r) { const u64 bal = __builtin_amdgcn_ballot_w64(key[r] >= thr); if (lane == r) myword = bal; }
  } else {
    int cgt = 0;
#pragma unroll
    for (int r = 0; r < NR; ++r) cgt += __builtin_popcountll(__builtin_amdgcn_ballot_w64(key[r] > thr));
    const int need = 256 - cgt;
    int run = 0;
    const u64 below = (1ull << lane) - 1ull;
#pragma unroll
    for (int r = 0; r < NR; ++r) {
      const u64 eq = __builtin_amdgcn_ballot_w64(key[r] == thr);
      const int rank = run + __builtin_popcountll(eq & below);
      const bool sel = (key[r] > thr) || ((key[r] == thr) && (rank < need));
      const u64 bal = __builtin_amdgcn_ballot_w64(sel);
      run += __builtin_popcountll(eq);
      if (lane == r) myword = bal;
    }
  }
  return myword;
}

DI void dsa_select_item(const Params& P, int it, float* sc, int wave, int lane) {
  const int qd = 1023 - it / 16, b = it % 16;
  const int t0 = qd * 4;
  const int N = ((t0 >> 6) + 1) * 64, nreg = N >> 6;
  const u16* base = (const u16*)(P.ws + O_PROJ) + (size_t)b * S * DINP;
  u64* mask = (u64*)(P.ws + O_MASK);
  const int q = lane >> 4, jn = lane & 15;
  if (N > 256) {
    const bf16x8 a0 = ld8(base + (size_t)(t0 + (jn >> 2)) * DINP + C_IQ + (jn & 3) * 32 + q * 8);
    const bf16x8 a1 = ld8(base + (size_t)(t0 + (jn >> 2)) * DINP + C_IQ + (4 + (jn & 3)) * 32 + q * 8);
    float w[8];
    {
      bf16x8 wv = ld8(base + (size_t)(t0 + q) * DINP + C_IW);
#pragma unroll
      for (int h = 0; h < 8; ++h) w[h] = bf2f((u16)wv[h]) * (0.35355339059327373f * 0.17677669529663687f);
    }
    const int tpw = N >> 6;
    const u16* kbase = base + (size_t)jn * DINP + C_IK + q * 8;
    for (int tl = 0; tl < tpw; tl += 16) {
      bf16x8 bk[16];
#pragma unroll
      for (int u = 0; u < 16; ++u) {
        const int t = (tl + u < tpw) ? tl + u : tpw - 1;
        bk[u] = ld8(kbase + (size_t)((wave * tpw + t) * 16) * DINP);
      }
#pragma unroll
      for (int u = 0; u < 16; ++u) {
        const int t = (tl + u < tpw) ? tl + u : tpw - 1;
        const int key0 = (wave * tpw + t) * 16;
        const f32x4 z = {0.f, 0.f, 0.f, 0.f};
        f32x4 d0 = mfma16(a0, bk[u], z), d1 = mfma16(a1, bk[u], z);
        float sv = 0.f;
#pragma unroll
        for (int r = 0; r < 4; ++r) sv += fmaxf(d0[r], 0.f) * w[r];
#pragma unroll
        for (int r = 0; r < 4; ++r) sv += fmaxf(d1[r], 0.f) * w[4 + r];
        sc[q * SC_STRIDE + key0 + jn] = sv;
      }
    }
  }
  __syncthreads();
  u64 myword = ~0ull;
  if (N > 256) {
    float* scw = sc + wave * SC_STRIDE;
    if (nreg <= 8) myword = select_wave<8>(scw, nreg, lane);
    else if (nreg <= 16) myword = select_wave<16>(scw, nreg, lane);
    else if (nreg <= 24) myword = select_wave<24>(scw, nreg, lane);
    else if (nreg <= 32) myword = select_wave<32>(scw, nreg, lane);
    else if (nreg <= 48) myword = select_wave<48>(scw, nreg, lane);
    else myword = select_wave<64>(scw, nreg, lane);
  }
  if (lane < nreg) mask[((size_t)b * S + t0 + wave) * 64 + lane] = myword;
  __syncthreads();
}

DI void s5_stage1_item(const Params& P, int l, int it, int wave, int lane) {
  const int b = it >> 4, g = it & 15, q = lane >> 4, jn = lane & 15;
  const u16* proj = (const u16*)(P.ws + O_PROJ);
  const u16* W1 = (const u16*)(P.ws + O_W1) + (size_t)(l * 16 + g) * 128 * 1024;
  float* s5s = (float*)(P.ws + O_S5S) + (size_t)it * 64 * 128;
  f32x4 acc[2][4]; zero_acc(acc);
  const u16* ap = W1 + (size_t)(wave * 32 + jn) * 1024 + q * 8;
  const u16* up = proj + ((size_t)b * S + (size_t)jn * 64 + (q >> 1)) * DINP + C_U + g * 16 + (q & 1) * 8;
  wgemm<2, 4>(acc, 32, [&](int i, int ks) { return ld8(ap + (size_t)i * 16 * 1024 + ks * 32); },
              [&](int j, int ks) { return ld8(up + ((size_t)j * 16 * 64 + 2 * ks) * DINP); });
#pragma unroll
  for (int j = 0; j < 4; ++j) {
    const int n = 16 * j + jn;
#pragma unroll
    for (int i = 0; i < 2; ++i)
      *reinterpret_cast<f32x4*>(s5s + (size_t)n * 128 + wave * 32 + 16 * i + 4 * q) = acc[i][j];
  }
}

constexpr int HS_STRIDE = 136;
DI void s5_stage3_item(const Params& P, int l, int it, u16* hs, int wave, int lane) {
  const int b = it >> 4, g = it & 15, q = lane >> 4, jn = lane & 15;
  const u16* proj = (const u16*)(P.ws + O_PROJ);
  const u16* Kt = (const u16*)(P.ws + O_KT) + (size_t)(l * 16 + g) * 64 * 256;
  const u16* W3 = (const u16*)(P.ws + O_W3) + (size_t)(l * 16 + g) * 1024 * 128;
  const float* s5s = (const float*)(P.ws + O_S5S) + (size_t)it * 64 * 128;
  const float2* pw = (const float2*)(P.ws + O_PW);
  u16* yg = (u16*)(P.ws + O_YG);
  const float* dsk = P.in[17] + (l * 16 + g) * 16;
  if (wave == 0) {
    const int p = lane;
    const float2 aL = pw[((size_t)(l * 16 + g) * 65 + 64) * 64 + p];
    float hr = 0.f, hi = 0.f;
#pragma unroll
    for (int half = 0; half < 2; ++half) {
      float2 sv[32];
#pragma unroll
      for (int n = 0; n < 32; ++n) sv[n] = *reinterpret_cast<const float2*>(s5s + (size_t)(half * 32 + n) * 128 + 2 * p);
#pragma unroll
      for (int n = 0; n < 32; ++n) {
        *reinterpret_cast<unsigned*>(hs + (half * 32 + n) * HS_STRIDE + 2 * p) = pack2(hr, hi);
        const float nr = aL.x * hr - aL.y * hi + sv[n].x, ni = aL.x * hi + aL.y * hr + sv[n].y;
        hr = nr; hi = ni;
      }
    }
  }
  __syncthreads();
  const u16* up = proj + ((size_t)b * S + (size_t)jn * 64 + (q >> 1)) * DINP + C_U + g * 16 + (q & 1) * 8;
  const bf16x8 zf = {0, 0, 0, 0, 0, 0, 0, 0};
  for (int gi = 0; gi < 8; ++gi) {
    const int jg = wave + 4 * (gi >> 1);
    const int th = gi & 1;
    f32x4 acc[4][2]; zero_acc(acc);
    wgemm<4, 2>(acc, 2 * jg + 2,
                [&](int i, int ks) { const int j = 4 * jg + i, ii = 2 * ks + (q >> 1); const int d = j - ii;
                                     return (d >= 0) ? ld8(Kt + ((size_t)d * 16 + jn) * 16 + (q & 1) * 8) : zf; },
                [&](int jt, int ks) { return ld8(up + ((size_t)(2 * th + jt) * 16 * 64 + 2 * ks) * DINP); });
    wgemm<4, 2>(acc, 4,
                [&](int i, int ks) { return ld8(W3 + ((size_t)(4 * jg + i) * 16 + jn) * 128 + ks * 32 + q * 8); },
                [&](int jt, int ks) { return *reinterpret_cast<const bf16x8*>(hs + (16 * (2 * th + jt) + jn) * HS_STRIDE + ks * 32 + q * 8); });
#pragma unroll
    for (int jt = 0; jt < 2; ++jt) {
      const int n = 16 * (2 * th + jt) + jn;
#pragma unroll
      for (int i = 0; i < 4; ++i) {
        const size_t tok = (size_t)b * S + n * 64 + 4 * jg + i;
        uint2 uw = ld4(proj + tok * DINP + C_U + g * 16 + 4 * q);
        const float y0 = acc[i][jt][0] + dsk[4 * q] * lo2f(uw.x), y1 = acc[i][jt][1] + dsk[4 * q + 1] * hi2f(uw.x);
        const float y2 = acc[i][jt][2] + dsk[4 * q + 2] * lo2f(uw.y), y3 = acc[i][jt][3] + dsk[4 * q + 3] * hi2f(uw.y);
        st4(yg + tok * 256 + g * 16 + 4 * q, geluf_(y0), geluf_(y1), geluf_(y2), geluf_(y3));
      }
    }
  }
  __syncthreads();
}

DI void glu_tile(const Params& P, int l, int tt, char* lds) {
  const u16* W = (const u16*)(P.ws + O_WTGLU) + (size_t)l * 256 * 256;
  const u16* yg = (const u16*)(P.ws + O_YG);
  const u16* proj = (const u16*)(P.ws + O_PROJ);
  u16* mixed = (u16*)(P.ws + O_XB);
  const int tid = opaque_tid();
  const int wave = __builtin_amdgcn_readfirstlane(tid >> 6), lane = tid & 63, q = lane >> 4, jn = lane & 15;
#pragma unroll 1
  for (int ftile = 0; ftile < 2; ++ftile) {
    const int f0 = ftile * 128 + (wave >> 1) * 64, t0 = tt * 128 + (wave & 1) * 64;
    f32x4 acc[4][4]; zero_acc(acc);
    gemm_block(acc, W + (size_t)(ftile * 128) * 256, 256, yg + (size_t)(tt * 128) * 256, 256, 256, lds, tid);
#pragma unroll
    for (int j = 0; j < 4; ++j) {
      const size_t tok = t0 + 16 * j + jn;
#pragma unroll
      for (int i = 0; i < 4; ++i) {
        const int f = f0 + 16 * i + 4 * q;
        uint2 gw = ld4(yg + tok * 256 + f), bw = ld4(proj + tok * DINP + C_GB + f);
        st4(mixed + tok * DM + 384 + f, lo2f(gw.x) * sigmoidf_(acc[i][j][0]) * siluf_(lo2f(bw.x)), hi2f(gw.x) * sigmoidf_(acc[i][j][1]) * siluf_(hi2f(bw.x)),
            lo2f(gw.y) * sigmoidf_(acc[i][j][2]) * siluf_(lo2f(bw.y)), hi2f(gw.y) * sigmoidf_(acc[i][j][3]) * siluf_(hi2f(bw.y)));
      }
    }
  }
}

DI void outproj_tile(const Params& P, int l, int tt, char* lds) {
  const u16* W = (const u16*)(P.ws + O_WTOUT) + (size_t)l * DM * DM;
  const u16* mixed = (const u16*)(P.ws + O_XB);
  const float* xin = (l == 0) ? P.in[0] : P.out;
  float* xout = P.out;
  u16* xb2 = (u16*)(P.ws + O_XB2);
  const int tid = opaque_tid();
  const int wave = __builtin_amdgcn_readfirstlane(tid >> 6), lane = tid & 63, q = lane >> 4, jn = lane & 15;
#pragma unroll 1
  for (int ftile0 = 0; ftile0 < 8; ++ftile0) {
    int ftile = ftile0; asm volatile("" : "+s"(ftile));
    const int f0 = ftile * 128 + (wave >> 1) * 64, t0 = tt * 128 + (wave & 1) * 64;
    f32x4 acc[4][4]; zero_acc(acc);
    gemm_block(acc, W + (size_t)(ftile * 128) * DM, DM, mixed + (size_t)(tt * 128) * DM, DM, DM, lds, tid);
#pragma unroll
    for (int j = 0; j < 4; ++j) {
      const size_t tok = t0 + 16 * j + jn;
#pragma unroll
      for (int i = 0; i < 4; ++i) {
        const int f = f0 + 16 * i + 4 * q;
        f32x4 xv;
        if (l == 0) xv = *reinterpret_cast<const f32x4*>(xin + tok * DM + f);
        else { const uint2 xw = ld4(xb2 + tok * DM + f); xv = f32x4{lo2f(xw.x), hi2f(xw.x), lo2f(xw.y), hi2f(xw.y)}; }
        const f32x4 xn = xv + acc[i][j];
        if (l == NL - 1) *reinterpret_cast<f32x4*>(xout + tok * DM + f) = xn;
        else st4(xb2 + tok * DM + f, xn[0], xn[1], xn[2], xn[3]);
      }
    }
  }
}

DI void phase_tail(const Params& P, int l, char* lds, float* s_rstd, float* s_prep) {
  for (int tt = blockIdx.x; tt < 512; tt += gridDim.x) {
    glu_tile(P, l, tt, lds);
    asm volatile("s_waitcnt vmcnt(0)" ::: "memory");
    __syncthreads();
    outproj_tile(P, l, tt, lds);
    if (l + 1 < NL) {
      asm volatile("s_waitcnt vmcnt(0)" ::: "memory");
      __syncthreads();
      inproj_tile(P, l + 1, tt, lds, s_rstd, s_prep);
    }
  }
}

DI void gbar(unsigned* ctr, unsigned& epoch) {
  asm volatile("s_waitcnt vmcnt(0)" ::: "memory");
  __syncthreads();
  epoch += gridDim.x;
  if (threadIdx.x == 0) {
    __builtin_amdgcn_fence(__ATOMIC_RELEASE, "agent");
    asm volatile("s_waitcnt vmcnt(0)" ::: "memory");
    __hip_atomic_fetch_add(ctr, 1u, __ATOMIC_RELAXED, __HIP_MEMORY_SCOPE_AGENT);
    while (__hip_atomic_load(ctr, __ATOMIC_RELAXED, __HIP_MEMORY_SCOPE_AGENT) < epoch) __builtin_amdgcn_s_sleep(1);
    __builtin_amdgcn_fence(__ATOMIC_ACQUIRE, "agent");
    asm volatile("s_waitcnt vmcnt(0)" ::: "memory");
  }
  __syncthreads();
}

__global__ void __launch_bounds__(256, 2) fwd_megakernel(Params P) {
  cg::grid_group grid = cg::this_grid();
  __shared__ __attribute__((aligned(16))) float lds_f[2 * G_BUF_BYTES / 4];
  static_assert(2 * G_BUF_BYTES >= 4 * SC_STRIDE * 4, "lds");
  __shared__ int s_item;
  __shared__ float s_rstd[128];
  __shared__ float s_prep[512];
  const long gtid = (long)blockIdx.x * 256 + threadIdx.x, gsz = (long)gridDim.x * 256;

  if (blockIdx.x == 0 && threadIdx.x < 64) ((unsigned*)(P.ws + O_CTR))[threadIdx.x] = 0u;
  phase_w0(P, gtid, gsz);
  grid.sync();
  unsigned* bar = (unsigned*)(P.ws + O_CTR) + 32;
  unsigned epoch = 0u;
  phase_w1(P, gtid, gsz);
#ifdef DUP_W
  phase_w0(P, gtid, gsz);
  phase_w1(P, gtid, gsz);
#endif

  for (int tt = blockIdx.x; tt < 512; tt += gridDim.x) {
    {
      const float* x = P.in[0]; u16* xb = (u16*)(P.ws + O_XB2);
      const int tid = opaque_tid();
#pragma unroll 4
      for (int e = tid; e < 128 * 256; e += 256) {
        const float4 v = *reinterpret_cast<const float4*>(x + (size_t)tt * 128 * DM + (size_t)e * 4);
        st4(xb + (size_t)tt * 128 * DM + (size_t)e * 4, v.x, v.y, v.z, v.w);
      }
    }
    asm volatile("s_waitcnt vmcnt(0)" ::: "memory");
    __syncthreads();
    inproj_tile(P, 0, tt, (char*)lds_f, s_rstd, s_prep);
  }
  gbar(bar, epoch);
  for (int l = 0; l < NL; ++l) {
    {
      unsigned* ctr = (unsigned*)(P.ws + O_CTR) + l * 2;
      for (;;) {
        const int tid = opaque_tid();
        if (tid == 0) s_item = (int)atomicAdd(ctr, 1u);
        __syncthreads();
        const int it = s_item;
        __syncthreads();
        if (it >= 256 + 3072 + 4096) break;
        const int wave = __builtin_amdgcn_readfirstlane(tid >> 6), lane = tid & 63;
        if (it < 256) s5_stage1_item(P, l, it, wave, lane);
        else if (it < 256 + 3072) mla_attn_item(P, it - 256, (char*)lds_f, tid);
        else {
#pragma unroll 1
          for (int k = 0; k < 4; ++k) dsa_select_item(P, (it - 256 - 3072) * 4 + k, lds_f, wave, lane);
        }
      }
    }
    gbar(bar, epoch);
    {
      unsigned* ctr = (unsigned*)(P.ws + O_CTR) + l * 2 + 1;
      for (;;) {
        const int tid = opaque_tid();
        if (tid == 0) s_item = (int)atomicAdd(ctr, 1u);
        __syncthreads();
        const int it = s_item;
        __syncthreads();
        if (it >= 256 + 2048) break;
        const int wave = __builtin_amdgcn_readfirstlane(tid >> 6), lane = tid & 63;
        if (it < 256) s5_stage3_item(P, l, it, (u16*)lds_f, wave, lane);
        else dsa_attn_item(P, it - 256, (char*)lds_f, tid);
      }
    }
    gbar(bar, epoch);
    phase_tail(P, l, (char*)lds_f, s_rstd, s_prep);
    if (l + 1 < NL) gbar(bar, epoch);
  }
}

extern "C" void kernel_launch(void* const* d_in, const int* in_sizes, int n_in, void* d_out, int out_size, void* d_ws, size_t ws_size,
                              hipStream_t stream) {
  static int grid_blocks = 0;
  if (!grid_blocks) {
    int dev = 0, cus = 0, per_cu = 0;
    hipGetDevice(&dev);
    hipDeviceGetAttribute(&cus, hipDeviceAttributeMultiprocessorCount, dev);
    hipOccupancyMaxActiveBlocksPerMultiprocessor(&per_cu, fwd_megakernel, 256, 0);
    if (per_cu < 1) per_cu = 1;
    if (per_cu > 2) per_cu = 2;
    grid_blocks = cus * per_cu;
    if (ws_size < O_END) fprintf(stderr, "workspace too small: %zu < %zu\n", ws_size, (size_t)O_END);
  }
  Params p{};
  for (int i = 0; i < 21; ++i) p.in[i] = (const float*)d_in[i];
  p.out = (float*)d_out;
  p.ws = (char*)d_ws;
  void* args[] = {&p};
  hipError_t e = hipLaunchCooperativeKernel((void*)fwd_megakernel, dim3(grid_blocks), dim3(256), args, 0, stream);
  if (e != hipSuccess) fprintf(stderr, "cooperative launch failed: %s (grid %d)\n", hipGetErrorString(e), grid_blocks);
}
```

```cpp
#include <hip/hip_runtime.h>
#include <hip/hip_cooperative_groups.h>
#include <cstdio>
#include <type_traits>
namespace cg = cooperative_groups;

#define DI __device__ __forceinline__
typedef __attribute__((ext_vector_type(8))) short bf16x8;
typedef __attribute__((ext_vector_type(4))) short s16x4;
typedef __attribute__((ext_vector_type(4))) float f32x4;
typedef unsigned short u16;
typedef unsigned long long u64;

constexpr int NB = 16, S = 4096, T = NB * S, DM = 1024, DIN = 2504, DINP = 2560, NL = 4;
constexpr int C_QA = 0, C_KA = 384, C_VA = 448, C_IQ = 512, C_IK = 768, C_IW = 800, C_GA = 808, C_U = 1192,
              C_GB = 1448, C_CQ = 1704, C_CKV = 1960, C_KPE = 2088, C_GC = 2120;
constexpr float EPS = 1e-6f;
constexpr float LOG2E = 1.4426950408889634f;

constexpr size_t O_WTIN = 0;
constexpr size_t O_WTOUT = O_WTIN + (size_t)NL * DINP * DM * 2;
constexpr size_t O_WTUQ = O_WTOUT + (size_t)NL * DM * DM * 2;
constexpr size_t O_WTUKV = O_WTUQ + (size_t)NL * 768 * 256 * 2;
constexpr size_t O_WTGLU = O_WTUKV + (size_t)NL * 768 * 128 * 2;
constexpr size_t O_W1 = O_WTGLU + (size_t)NL * 256 * 256 * 2;
constexpr size_t O_W3 = O_W1 + (size_t)NL * 16 * 128 * 1024 * 2;
constexpr size_t O_KT = O_W3 + (size_t)NL * 16 * 1024 * 128 * 2;
constexpr size_t O_PW = O_KT + (size_t)NL * 16 * 64 * 256 * 2;
constexpr size_t O_FZ = O_PW + (size_t)NL * 16 * 65 * 64 * 8;
constexpr size_t O_R64 = O_FZ + (size_t)NL * 16 * 64 * 8;
constexpr size_t O_R32 = O_R64 + (size_t)4096 * 32 * 8;
constexpr size_t O_XB = O_R32 + (size_t)4096 * 16 * 8;
constexpr size_t O_RSTD = O_XB + (size_t)T * 1024 * 2;
constexpr size_t O_PROJ = O_RSTD + (size_t)T * 4;
constexpr size_t O_MQ = O_PROJ + (size_t)T * DINP * 2;
constexpr size_t O_MK = O_MQ + (size_t)T * 576 * 2;
constexpr size_t O_MVT = O_MK + (size_t)T * 576 * 2;
constexpr size_t O_AVT = O_MVT + (size_t)T * 384 * 2;
constexpr size_t O_MASK = O_AVT + (size_t)T * 64 * 2;
constexpr size_t O_S5S = O_MASK + (size_t)T * 512;
constexpr size_t O_YG = O_S5S + (size_t)16 * 16 * 64 * 128 * 4;
constexpr size_t O_CTR = O_YG + (size_t)T * 256 * 2;
constexpr size_t O_XB2 = O_CTR + 256;
constexpr size_t O_END = O_XB2 + (size_t)T * 1024 * 2;

struct Params {
  const float* in[21];
  float* out;
  char* ws;
};

DI int opaque_tid() { int t = threadIdx.x; asm volatile("" : "+v"(t)); return t; }
DI u16 f2bf(float f) { unsigned u = __float_as_uint(f); u += 0x7fffu + ((u >> 16) & 1u); return (u16)(u >> 16); }
DI float bf2f(u16 h) { return __uint_as_float(((unsigned)h) << 16); }
typedef __attribute__((ext_vector_type(2))) __bf16 bf16x2_t;
typedef __attribute__((ext_vector_type(2))) float f32x2_t;
DI unsigned pack2(float a, float b) { return __builtin_bit_cast(unsigned, __builtin_convertvector((f32x2_t){a, b}, bf16x2_t)); }
DI float lo2f(unsigned w) { return __uint_as_float(w << 16); }
DI float hi2f(unsigned w) { return __uint_as_float(w & 0xffff0000u); }
DI bf16x8 ld8(const u16* p) { return *reinterpret_cast<const bf16x8*>(p); }
DI uint2 ld4(const u16* p) { return *reinterpret_cast<const uint2*>(p); }
DI void st4(u16* p, float a, float b, float c, float d) { uint2 v; v.x = pack2(a, b); v.y = pack2(c, d); *reinterpret_cast<uint2*>(p) = v; }
DI f32x4 mfma16(bf16x8 a, bf16x8 b, f32x4 c) { return __builtin_amdgcn_mfma_f32_16x16x32_bf16(a, b, c, 0, 0, 0); }
DI float fexp2(float x) { return __builtin_amdgcn_exp2f(x); }
DI float sigmoidf_(float x) { return __builtin_amdgcn_rcpf(1.0f + __expf(-x)); }
DI float siluf_(float x) { return x * sigmoidf_(x); }
DI float geluf_(float x) { float u = 0.7978845608028654f * (x + 0.044715f * x * x * x); return x * sigmoidf_(2.0f * u); }
DI float red4(float v) { v += __shfl_xor(v, 16); v += __shfl_xor(v, 32); return v; }

template <int AT, int BT, class FA, class FB>
DI void wgemm(f32x4 (&acc)[AT][BT], int ksteps, FA fa, FB fb) {
  bf16x8 a0[AT], b0[BT], a1[AT], b1[BT];
  const int k1 = (ksteps > 1) ? 1 : 0;
#pragma unroll
  for (int i = 0; i < AT; ++i) { a0[i] = fa(i, 0); a1[i] = fa(i, k1); }
#pragma unroll
  for (int j = 0; j < BT; ++j) { b0[j] = fb(j, 0); b1[j] = fb(j, k1); }
  for (int ks = 0; ks < ksteps; ++ks) {
    bf16x8 a2[AT], b2[BT];
    const int kn = (ks + 2 < ksteps) ? ks + 2 : ksteps - 1;
#pragma unroll
    for (int i = 0; i < AT; ++i) a2[i] = fa(i, kn);
#pragma unroll
    for (int j = 0; j < BT; ++j) b2[j] = fb(j, kn);
    __builtin_amdgcn_sched_barrier(0);
#pragma unroll
    for (int i = 0; i < AT; ++i)
#pragma unroll
      for (int j = 0; j < BT; ++j) acc[i][j] = mfma16(a0[i], b0[j], acc[i][j]);
    __builtin_amdgcn_sched_barrier(0);
#pragma unroll
    for (int i = 0; i < AT; ++i) { a0[i] = a1[i]; a1[i] = a2[i]; }
#pragma unroll
    for (int j = 0; j < BT; ++j) { b0[j] = b1[j]; b1[j] = b2[j]; }
  }
}

constexpr int GROW = 72;
constexpr int G_TILE_BYTES = 128 * GROW * 2;
constexpr int G_BUF_BYTES = 2 * G_TILE_BYTES;
DI void gemm_block(f32x4 (&acc)[4][4], const u16* Ap, int lda, const u16* Bp, int ldb, int K, char* lds, int tid) {
  const int lane = tid & 63, q = lane >> 4, jn = lane & 15;
  const int wave = __builtin_amdgcn_readfirstlane(tid >> 6), wa = wave >> 1, wb = wave & 1;
  uint4 xa0, xa1, xa2, xa3, xb0, xb1, xb2, xb3;
  uint4 ya0, ya1, ya2, ya3, yb0, yb1, yb2, yb3;
  const int srow = tid >> 3, scol = tid & 7;
  const unsigned voa = (unsigned)(srow * lda + scol * 8) * 2u, vob = (unsigned)(srow * ldb + scol * 8) * 2u;
  const char* ag = reinterpret_cast<const char*>(Ap);
  const char* bg = reinterpret_cast<const char*>(Bp);
  char* st0 = lds + (srow * GROW + scol * 8) * 2;
  const char* a0p = lds + (wa * 64 + jn) * GROW * 2 + q * 16;
  const char* b0p = lds + G_TILE_BYTES + (wb * 64 + jn) * GROW * 2 + q * 16;
#define GL(v, base, ld, vo, i, kt) v = *reinterpret_cast<const uint4*>(base + ((size_t)(32 * (i)) * (ld) + (size_t)(kt) * 64) * 2 + vo)
#define GLOAD0(kt) { GL(xa0, ag, lda, voa, 0, kt); GL(xa1, ag, lda, voa, 1, kt); GL(xa2, ag, lda, voa, 2, kt); GL(xa3, ag, lda, voa, 3, kt); GL(xb0, bg, ldb, vob, 0, kt); GL(xb1, bg, ldb, vob, 1, kt); GL(xb2, bg, ldb, vob, 2, kt); GL(xb3, bg, ldb, vob, 3, kt); }
#define GLOAD1(kt) { GL(ya0, ag, lda, voa, 0, kt); GL(ya1, ag, lda, voa, 1, kt); GL(ya2, ag, lda, voa, 2, kt); GL(ya3, ag, lda, voa, 3, kt); GL(yb0, bg, ldb, vob, 0, kt); GL(yb1, bg, ldb, vob, 1, kt); GL(yb2, bg, ldb, vob, 2, kt); GL(yb3, bg, ldb, vob, 3, kt); }
#define GS(v, off) *reinterpret_cast<uint4*>(st0 + (off)) = v
#define GSTORE0(buf) { GS(xa0, (buf) * G_BUF_BYTES); GS(xa1, (buf) * G_BUF_BYTES + 32 * GROW * 2); GS(xa2, (buf) * G_BUF_BYTES + 64 * GROW * 2); GS(xa3, (buf) * G_BUF_BYTES + 96 * GROW * 2); \
                       GS(xb0, (buf) * G_BUF_BYTES + G_TILE_BYTES); GS(xb1, (buf) * G_BUF_BYTES + G_TILE_BYTES + 32 * GROW * 2); GS(xb2, (buf) * G_BUF_BYTES + G_TILE_BYTES + 64 * GROW * 2); GS(xb3, (buf) * G_BUF_BYTES + G_TILE_BYTES + 96 * GROW * 2); }
#define GSTORE1(buf) { GS(ya0, (buf) * G_BUF_BYTES); GS(ya1, (buf) * G_BUF_BYTES + 32 * GROW * 2); GS(ya2, (buf) * G_BUF_BYTES + 64 * GROW * 2); GS(ya3, (buf) * G_BUF_BYTES + 96 * GROW * 2); \
                       GS(yb0, (buf) * G_BUF_BYTES + G_TILE_BYTES); GS(yb1, (buf) * G_BUF_BYTES + G_TILE_BYTES + 32 * GROW * 2); GS(yb2, (buf) * G_BUF_BYTES + G_TILE_BYTES + 64 * GROW * 2); GS(yb3, (buf) * G_BUF_BYTES + G_TILE_BYTES + 96 * GROW * 2); }
  auto compute = [&](int buf) {
#pragma unroll
    for (int ks = 0; ks < 2; ++ks) {
      bf16x8 a[4], b[4];
#pragma unroll
      for (int i = 0; i < 4; ++i) a[i] = *reinterpret_cast<const bf16x8*>(a0p + buf * G_BUF_BYTES + i * 16 * GROW * 2 + ks * 64);
#pragma unroll
      for (int j = 0; j < 4; ++j) b[j] = *reinterpret_cast<const bf16x8*>(b0p + buf * G_BUF_BYTES + j * 16 * GROW * 2 + ks * 64);
      __builtin_amdgcn_s_setprio(1);
#pragma unroll
      for (int i = 0; i < 4; ++i)
#pragma unroll
        for (int j = 0; j < 4; ++j) acc[i][j] = mfma16(a[i], b[j], acc[i][j]);
      __builtin_amdgcn_s_setprio(0);
    }
  };
  const int nkt = K >> 6;
  GLOAD0(0);
  GLOAD1(1);
  GSTORE0(0);
  __syncthreads();
  for (int kt = 0; kt < nkt; kt += 2) {
    if (kt + 2 < nkt) GLOAD0(kt + 2);
    compute(0);
    GSTORE1(1);
    __syncthreads();
    if (kt + 3 < nkt) GLOAD1(kt + 3);
    compute(1);
    if (kt + 2 < nkt) GSTORE0(0);
    __syncthreads();
  }
#undef GL
#undef GLOAD0
#undef GLOAD1
#undef GS
#undef GSTORE0
#undef GSTORE1
}

template <int A, int B>
DI void zero_acc(f32x4 (&acc)[A][B]) {
#pragma unroll
  for (int i = 0; i < A; ++i)
#pragma unroll
    for (int j = 0; j < B; ++j) acc[i][j] = f32x4{0.f, 0.f, 0.f, 0.f};
}

DI void sincos_d(double a, double& c, double& s) {
  const double TWO_PI = 6.283185307179586476925;
  double n = rint(a / TWO_PI);
  double r = a - n * TWO_PI;
  c = cos(r); s = sin(r);
}

DI void phase_w0(const Params& P, long gtid, long gsz) {
  char* ws = P.ws;
  {
    u16* dst = (u16*)(ws + O_WTIN);
    const float* w = P.in[2]; const float* g = P.in[1];
    for (long idx = gtid; idx < (long)NL * 128 * DINP; idx += gsz) {
      int n = (int)(idx % DINP); long r = idx / DINP; int kb = (int)(r % 128); int l = (int)(r / 128);
      float v[8];
#pragma unroll
      for (int j = 0; j < 8; ++j) { int k = kb * 8 + j; v[j] = (n < DIN) ? w[((size_t)l * DM + k) * DIN + n] * g[l * DM + k] : 0.f; }
      uint4 o; o.x = pack2(v[0], v[1]); o.y = pack2(v[2], v[3]); o.z = pack2(v[4], v[5]); o.w = pack2(v[6], v[7]);
      *reinterpret_cast<uint4*>(dst + ((size_t)l * DINP + n) * DM + kb * 8) = o;
    }
  }
  {
    u16* dst = (u16*)(ws + O_WTOUT);
    const float* w = P.in[20];
    for (long idx = gtid; idx < (long)NL * 128 * DM; idx += gsz) {
      int n = (int)(idx % DM); long r = idx / DM; int kb = (int)(r % 128); int l = (int)(r / 128);
      float v[8];
#pragma unroll
      for (int j = 0; j < 8; ++j) { int k = kb * 8 + j; v[j] = w[((size_t)l * DM + k) * DM + n]; }
      uint4 o; o.x = pack2(v[0], v[1]); o.y = pack2(v[2], v[3]); o.z = pack2(v[4], v[5]); o.w = pack2(v[6], v[7]);
      *reinterpret_cast<uint4*>(dst + ((size_t)l * DM + n) * DM + kb * 8) = o;
    }
  }
  {
    u16* dst = (u16*)(ws + O_WTUQ);
    const float* w = P.in[7]; const float* g = P.in[5];
    for (long idx = gtid; idx < (long)NL * 32 * 768; idx += gsz) {
      int n = (int)(idx % 768); long r = idx / 768; int kb = (int)(r % 32); int l = (int)(r / 32);
      const int h = n >> 7, d = n & 127;
      float v[8];
#pragma unroll
      for (int j = 0; j < 8; ++j) { int k = kb * 8 + j; v[j] = (d < 96) ? w[((size_t)l * 256 + k) * 576 + h * 96 + d] * g[l * 256 + k] : 0.f; }
      uint4 o; o.x = pack2(v[0], v[1]); o.y = pack2(v[2], v[3]); o.z = pack2(v[4], v[5]); o.w = pack2(v[6], v[7]);
      *reinterpret_cast<uint4*>(dst + ((size_t)l * 768 + n) * 256 + kb * 8) = o;
    }
  }
  {
    u16* dst = (u16*)(ws + O_WTUKV);
    const float* w = P.in[8]; const float* g = P.in[6];
    for (long idx = gtid; idx < (long)NL * 16 * 768; idx += gsz) {
      int n = (int)(idx % 768); long r = idx / 768; int kb = (int)(r % 16); int l = (int)(r / 16);
      float v[8];
#pragma unroll
      for (int j = 0; j < 8; ++j) { int k = kb * 8 + j; v[j] = w[((size_t)l * 128 + k) * 768 + n] * g[l * 128 + k]; }
      uint4 o; o.x = pack2(v[0], v[1]); o.y = pack2(v[2], v[3]); o.z = pack2(v[4], v[5]); o.w = pack2(v[6], v[7]);
      *reinterpret_cast<uint4*>(dst + ((size_t)l * 768 + n) * 128 + kb * 8) = o;
    }
  }
  {
    u16* dst = (u16*)(ws + O_WTGLU);
    const float* w = P.in[19];
    for (long idx = gtid; idx < (long)NL * 32 * 256; idx += gsz) {
      int n = (int)(idx % 256); long r = idx / 256; int kb = (int)(r % 32); int l = (int)(r / 32);
      float v[8];
#pragma unroll
      for (int j = 0; j < 8; ++j) { int k = kb * 8 + j; v[j] = w[((size_t)l * 256 + k) * 256 + n]; }
      uint4 o; o.x = pack2(v[0], v[1]); o.y = pack2(v[2], v[3]); o.z = pack2(v[4], v[5]); o.w = pack2(v[6], v[7]);
      *reinterpret_cast<uint4*>(dst + ((size_t)l * 256 + n) * 256 + kb * 8) = o;
    }
  }
  {
    float2* r64 = (float2*)(ws + O_R64);
    for (long idx = gtid; idx < 4096L * 32; idx += gsz) {
      int i = (int)(idx & 31); int pos = (int)(idx >> 5);
      float inv = (float)pow(10000.0, -(double)i / 32.0);
      float ang = (float)pos * inv;
      double c, s; sincos_d((double)ang, c, s);
      r64[idx] = make_float2((float)c, (float)s);
    }
    float2* r32 = (float2*)(ws + O_R32);
    for (long idx = gtid; idx < 4096L * 16; idx += gsz) {
      int i = (int)(idx & 15); int pos = (int)(idx >> 4);
      float inv = (float)pow(10000.0, -(double)i / 16.0);
      float ang = (float)pos * inv;
      double c, s; sincos_d((double)ang, c, s);
      r32[idx] = make_float2((float)c, (float)s);
    }
  }
  {
    float2* pw = (float2*)(ws + O_PW);
    float2* fz = (float2*)(ws + O_FZ);
    const float* a_re = P.in[11]; const float* a_im = P.in[12]; const float* lstep = P.in[18];
    for (long idx = gtid; idx < (long)NL * 16 * 65 * 64; idx += gsz) {
      int p = (int)(idx & 63); long r = idx >> 6; int d = (int)(r % 65); int lg = (int)(r / 65);
      double step = exp((double)lstep[lg]);
      double ar = (double)a_re[lg * 64 + p], ai = (double)a_im[lg * 64 + p];
      double mag = exp((double)d * ar * step);
      double c, s; sincos_d((double)d * ai * step, c, s);
      pw[idx] = make_float2((float)(mag * c), (float)(mag * s));
      if (d == 1) {
        double abr = mag * c, abi = mag * s;
        double den = ar * ar + ai * ai, nr = abr - 1.0;
        double fre = (nr * ar + abi * ai) / den, fim = (abi * ar - nr * ai) / den;
        fz[lg * 64 + p] = make_float2((float)fre, (float)fim);
      }
    }
  }
}

DI void phase_w1(const Params& P, long gtid, long gsz) {
  char* ws = P.ws;
  const float2* pw = (const float2*)(ws + O_PW);
  const float2* fz = (const float2*)(ws + O_FZ);
  const float* b_re = P.in[13]; const float* b_im = P.in[14]; const float* c_re = P.in[15]; const float* c_im = P.in[16];
  {
    u16* w1 = (u16*)(ws + O_W1);
    for (long idx = gtid; idx < (long)NL * 16 * 128 * 128; idx += gsz) {
      int kb = (int)(idx & 127); long r = idx >> 7; int row = (int)(r & 127); int lg = (int)(r >> 7);
      int p = row >> 1, ri = row & 1; int i = kb >> 1, c0 = (kb & 1) * 8;
      float2 e = pw[((size_t)lg * 65 + (63 - i)) * 64 + p]; float2 f = fz[lg * 64 + p];
      float er = e.x * f.x - e.y * f.y, ei = e.x * f.y + e.y * f.x;
      float v[8];
#pragma unroll
      for (int j = 0; j < 8; ++j) {
        float br = b_re[((size_t)lg * 64 + p) * 16 + c0 + j], bi = b_im[((size_t)lg * 64 + p) * 16 + c0 + j];
        v[j] = ri ? (er * bi + ei * br) : (er * br - ei * bi);
      }
      uint4 o; o.x = pack2(v[0], v[1]); o.y = pack2(v[2], v[3]); o.z = pack2(v[4], v[5]); o.w = pack2(v[6], v[7]);
      *reinterpret_cast<uint4*>(w1 + ((size_t)lg * 128 + row) * 1024 + kb * 8) = o;
    }
  }
  {
    u16* w3 = (u16*)(ws + O_W3);
    for (long idx = gtid; idx < (long)NL * 16 * 1024 * 16; idx += gsz) {
      int kb = (int)(idx & 15); long r = idx >> 4; int f = (int)(r & 1023); int lg = (int)(r >> 10);
      int j = f >> 4, c = f & 15;
      float v[8];
#pragma unroll
      for (int jj = 0; jj < 4; ++jj) {
        int p = kb * 4 + jj;
        float2 e = pw[((size_t)lg * 65 + (j + 1)) * 64 + p];
        float cr = c_re[((size_t)lg * 16 + c) * 64 + p], ci = c_im[((size_t)lg * 16 + c) * 64 + p];
        v[2 * jj] = cr * e.x - ci * e.y;
        v[2 * jj + 1] = -(cr * e.y + ci * e.x);
      }
      uint4 o; o.x = pack2(v[0], v[1]); o.y = pack2(v[2], v[3]); o.z = pack2(v[4], v[5]); o.w = pack2(v[6], v[7]);
      *reinterpret_cast<uint4*>(w3 + ((size_t)lg * 1024 + f) * 128 + kb * 8) = o;
    }
  }
  {
    u16* kt = (u16*)(ws + O_KT);
    for (long idx = gtid; idx < (long)NL * 16 * 64 * 16 * 2; idx += gsz) {
      int cb = (int)(idx & 1); long r = idx >> 1; int c = (int)(r & 15); r >>= 4; int d = (int)(r & 63); int lg = (int)(r >> 6);
      float v[8];
#pragma unroll
      for (int j = 0; j < 8; ++j) v[j] = 0.f;
      for (int p = 0; p < 64; ++p) {
        float2 e = pw[((size_t)lg * 65 + d) * 64 + p]; float2 f = fz[lg * 64 + p];
        float er = e.x * f.x - e.y * f.y, ei = e.x * f.y + e.y * f.x;
        float cr = c_re[((size_t)lg * 16 + c) * 64 + p], ci = c_im[((size_t)lg * 16 + c) * 64 + p];
        float gr = cr * er - ci * ei, gi = cr * ei + ci * er;
#pragma unroll
        for (int j = 0; j < 8; ++j) {
          float br = b_re[((size_t)lg * 64 + p) * 16 + cb * 8 + j], bi = b_im[((size_t)lg * 64 + p) * 16 + cb * 8 + j];
          v[j] += gr * br - gi * bi;
        }
      }
      uint4 o; o.x = pack2(v[0], v[1]); o.y = pack2(v[2], v[3]); o.z = pack2(v[4], v[5]); o.w = pack2(v[6], v[7]);
      *reinterpret_cast<uint4*>(kt + (((size_t)lg * 64 + d) * 16 + c) * 16 + cb * 8) = o;
    }
  }
}

DI void phase_p0(const Params& P, int l) {
  const float* x = (l == 0) ? P.in[0] : P.out;
  u16* xb = (u16*)(P.ws + O_XB2);
  const int tid = opaque_tid();
  const int lane = tid & 63;
  const int gw = blockIdx.x * 4 + (tid >> 6), nw = gridDim.x * 4;
  for (int row = gw; row < T; row += nw) {
    const float4* xr = reinterpret_cast<const float4*>(x + (size_t)row * DM);
#pragma unroll
    for (int i = 0; i < 4; ++i) {
      float4 v = xr[i * 64 + lane];
      st4(xb + (size_t)row * DM + (i * 64 + lane) * 4, v.x, v.y, v.z, v.w);
    }
  }
}

DI void prep_mla_q(const Params& P, int l, int tw0, int lane) {
  const int q = lane >> 4, jn = lane & 15;
  const u16* proj = (const u16*)(P.ws + O_PROJ);
  const u16* W = (const u16*)(P.ws + O_WTUQ) + (size_t)l * 576 * 256;
  u16* mq = (u16*)(P.ws + O_MQ);
  const float2* r32 = (const float2*)(P.ws + O_R32);
  const float* gq = P.in[9] + l * 96;
  const u16* bp = proj + (size_t)(tw0 + jn) * DINP + C_CQ + q * 8;
  float rq[2];
#pragma unroll
  for (int t = 0; t < 2; ++t) {
    float ss = 0.f;
    for (int ks = 0; ks < 8; ++ks) {
      bf16x8 v = ld8(bp + (size_t)t * 16 * DINP + ks * 32);
#pragma unroll
      for (int j = 0; j < 8; ++j) { float f = bf2f((u16)v[j]); ss += f * f; }
    }
    ss = red4(ss);
    rq[t] = rsqrtf(ss * (1.0f / 256) + EPS);
  }
  const float qscale = 0.10206207261596577f * LOG2E;
  for (int h = 0; h < 6; ++h) {
    f32x4 acc[6][2]; zero_acc(acc);
    const u16* ap = W + (size_t)(h * 96 + jn) * 256 + q * 8;
    wgemm<6, 2>(acc, 8, [&](int i, int ks) { return ld8(ap + (size_t)i * 16 * 256 + ks * 32); },
                [&](int j, int ks) { return ld8(bp + (size_t)j * 16 * DINP + ks * 32); });
#pragma unroll
    for (int t = 0; t < 2; ++t) {
      const int tok = tw0 + 16 * t + jn, pos = tok & (S - 1);
      float ss = 0.f;
#pragma unroll
      for (int i = 0; i < 6; ++i)
#pragma unroll
        for (int r = 0; r < 4; ++r) { float v = acc[i][t][r] * rq[t]; acc[i][t][r] = v; ss += v * v; }
      ss = red4(ss);
      const float rs = rsqrtf(ss * (1.0f / 96) + EPS);
#pragma unroll
      for (int i = 0; i < 6; ++i)
#pragma unroll
        for (int r = 0; r < 4; ++r) acc[i][t][r] *= rs * gq[16 * i + 4 * q + r];
#pragma unroll
      for (int r = 0; r < 4; ++r) {
        float2 cs = r32[pos * 16 + 4 * q + r];
        float x1 = acc[4][t][r], x2 = acc[5][t][r];
        acc[4][t][r] = x1 * cs.x - x2 * cs.y; acc[5][t][r] = x2 * cs.x + x1 * cs.y;
      }
#pragma unroll
      for (int i = 0; i < 6; ++i)
        st4(mq + (size_t)tok * 576 + h * 96 + 16 * i + 4 * q, acc[i][t][0] * qscale, acc[i][t][1] * qscale, acc[i][t][2] * qscale, acc[i][t][3] * qscale);
    }
  }
}

DI void prep_mla_kv(const Params& P, int l, int tw0, int lane) {
  const int q = lane >> 4, jn = lane & 15;
  const u16* proj = (const u16*)(P.ws + O_PROJ);
  const u16* W = (const u16*)(P.ws + O_WTUKV) + (size_t)l * 768 * 128;
  u16* mk = (u16*)(P.ws + O_MK);
  u16* mvt = (u16*)(P.ws + O_MVT);
  const float2* r32 = (const float2*)(P.ws + O_R32);
  const float* gk = P.in[10] + l * 96;
  const u16* bp = proj + (size_t)(tw0 + jn) * DINP + C_CKV + q * 8;
  const int b = tw0 >> 12, pos0 = tw0 & (S - 1);
  float rkv[2];
#pragma unroll
  for (int t = 0; t < 2; ++t) {
    float ss = 0.f;
    for (int ks = 0; ks < 4; ++ks) {
      bf16x8 v = ld8(bp + (size_t)t * 16 * DINP + ks * 32);
#pragma unroll
      for (int j = 0; j < 8; ++j) { float f = bf2f((u16)v[j]); ss += f * f; }
    }
    ss = red4(ss);
    rkv[t] = rsqrtf(ss * (1.0f / 128) + EPS);
  }
  for (int h = 0; h < 6; ++h) {
    {
      f32x4 acc[4][2]; zero_acc(acc);
      const u16* ap = W + (size_t)(h * 128 + jn) * 128 + q * 8;
      wgemm<4, 2>(acc, 4, [&](int i, int ks) { return ld8(ap + (size_t)i * 16 * 128 + ks * 32); },
                  [&](int j, int ks) { return ld8(bp + (size_t)j * 16 * DINP + ks * 32); });
#pragma unroll
      for (int t = 0; t < 2; ++t) {
        const int tok = tw0 + 16 * t + jn, pos = tok & (S - 1);
        uint2 pl = ld4(proj + (size_t)tok * DINP + C_KPE + 4 * q);
        uint2 ph = ld4(proj + (size_t)tok * DINP + C_KPE + 16 + 4 * q);
        float kl[4] = {lo2f(pl.x), hi2f(pl.x), lo2f(pl.y), hi2f(pl.y)};
        float kh[4] = {lo2f(ph.x), hi2f(ph.x), lo2f(ph.y), hi2f(ph.y)};
        float ss = 0.f;
#pragma unroll
        for (int i = 0; i < 4; ++i)
#pragma unroll
          for (int r = 0; r < 4; ++r) { float v = acc[i][t][r] * rkv[t]; acc[i][t][r] = v; ss += v * v; }
#pragma unroll
        for (int r = 0; r < 4; ++r) ss += kl[r] * kl[r] + kh[r] * kh[r];
        ss = red4(ss);
        const float rs = rsqrtf(ss * (1.0f / 96) + EPS);
#pragma unroll
        for (int i = 0; i < 4; ++i) {
          const int d = 16 * i + 4 * q;
          st4(mk + (size_t)tok * 576 + h * 96 + d, acc[i][t][0] * rs * gk[d], acc[i][t][1] * rs * gk[d + 1], acc[i][t][2] * rs * gk[d + 2], acc[i][t][3] * rs * gk[d + 3]);
        }
        float y1[4], y2[4];
#pragma unroll
        for (int r = 0; r < 4; ++r) {
          float2 cs = r32[pos * 16 + 4 * q + r];
          float x1 = kl[r] * rs * gk[64 + 4 * q + r], x2 = kh[r] * rs * gk[80 + 4 * q + r];
          y1[r] = x1 * cs.x - x2 * cs.y; y2[r] = x2 * cs.x + x1 * cs.y;
        }
        st4(mk + (size_t)tok * 576 + h * 96 + 64 + 4 * q, y1[0], y1[1], y1[2], y1[3]);
        st4(mk + (size_t)tok * 576 + h * 96 + 80 + 4 * q, y2[0], y2[1], y2[2], y2[3]);
      }
    }
    {
      f32x4 acc[2][4]; zero_acc(acc);
      const u16* wp = W + (size_t)(h * 128 + 64 + jn) * 128 + q * 8;
      wgemm<2, 4>(acc, 4, [&](int i, int ks) { return ld8(bp + (size_t)i * 16 * DINP + ks * 32); },
                  [&](int j, int ks) { return ld8(wp + (size_t)j * 16 * 128 + ks * 32); });
#pragma unroll
      for (int i = 0; i < 2; ++i) {
        float rr[4];
#pragma unroll
        for (int r = 0; r < 4; ++r) rr[r] = __shfl(rkv[i], 4 * q + r);
#pragma unroll
        for (int j = 0; j < 4; ++j)
          st4(mvt + ((size_t)(b * 6 + h) * 64 + 16 * j + jn) * S + pos0 + 16 * i + 4 * q,
              acc[i][j][0] * rr[0], acc[i][j][1] * rr[1], acc[i][j][2] * rr[2], acc[i][j][3] * rr[3]);
      }
    }
  }
}

DI void prep_mla_tile(const Params& P, int l, int tt, char* lds, float* s_r, float* s_ss) {
  const int tid = opaque_tid();
  const int wave = __builtin_amdgcn_readfirstlane(tid >> 6), lane = tid & 63, q = lane >> 4, jn = lane & 15;
  const int wa = wave >> 1, wb = wave & 1;
  const int tok0 = tt * 128;
  const u16* proj = (const u16*)(P.ws + O_PROJ);
  const u16* Wq = (const u16*)(P.ws + O_WTUQ) + (size_t)l * 768 * 256;
  const u16* Wkv = (const u16*)(P.ws + O_WTUKV) + (size_t)l * 768 * 128;
  u16* mq = (u16*)(P.ws + O_MQ); u16* mk = (u16*)(P.ws + O_MK); u16* mvt = (u16*)(P.ws + O_MVT);
  const float2* r32 = (const float2*)(P.ws + O_R32);
  const float* gq = P.in[9] + l * 96; const float* gk = P.in[10] + l * 96;
  {
    const int row = tid >> 1, half = tid & 1;
    const u16* pq = proj + (size_t)(tok0 + row) * DINP + C_CQ + half * 128;
    const u16* pk = proj + (size_t)(tok0 + row) * DINP + C_CKV + half * 64;
    bf16x8 vq[16], vk[8];
#pragma unroll
    for (int u = 0; u < 16; ++u) vq[u] = ld8(pq + u * 8);
#pragma unroll
    for (int u = 0; u < 8; ++u) vk[u] = ld8(pk + u * 8);
    float sq = 0.f, sk = 0.f;
#pragma unroll
    for (int u = 0; u < 16; ++u)
#pragma unroll
      for (int j = 0; j < 8; ++j) { const float f = bf2f((u16)vq[u][j]); sq += f * f; }
#pragma unroll
    for (int u = 0; u < 8; ++u)
#pragma unroll
      for (int j = 0; j < 8; ++j) { const float f = bf2f((u16)vk[u][j]); sk += f * f; }
    sq += __shfl_xor(sq, 1); sk += __shfl_xor(sk, 1);
    if (half == 0) { s_r[row] = rsqrtf(sq * (1.0f / 256) + EPS); s_r[128 + row] = rsqrtf(sk * (1.0f / 128) + EPS); }
  }
  __syncthreads();
  const float qscale = 0.10206207261596577f * LOG2E;
#pragma unroll 1
  for (int h0 = 0; h0 < 6; ++h0) {
    int h = h0; asm volatile("" : "+s"(h));
    f32x4 acc[4][4]; zero_acc(acc);
    gemm_block(acc, Wq + (size_t)(h * 128) * 256, 256, proj + (size_t)tok0 * DINP + C_CQ, DINP, 256, lds, tid);
#pragma unroll
    for (int j = 0; j < 4; ++j) {
      const int tl = wb * 64 + 16 * j + jn; const float rq = s_r[tl];
      float ss = 0.f;
#pragma unroll
      for (int i = 0; i < 4; ++i)
#pragma unroll
        for (int r = 0; r < 4; ++r) { const float v = acc[i][j][r] * rq; acc[i][j][r] = v; ss += v * v; }
      ss = red4(ss);
      if (q == 0) s_ss[wa * 128 + tl] = ss;
    }
    __syncthreads();
#pragma unroll
    for (int j = 0; j < 4; ++j) {
      const int tl = wb * 64 + 16 * j + jn, tok = tok0 + tl, pos = tok & (S - 1);
      const float rs = rsqrtf((s_ss[tl] + s_ss[128 + tl]) * (1.0f / 96) + EPS);
      if (wa == 0) {
#pragma unroll
        for (int i = 0; i < 4; ++i) {
          const int d = 16 * i + 4 * q;
          st4(mq + (size_t)tok * 576 + h * 96 + d, acc[i][j][0] * rs * gq[d] * qscale, acc[i][j][1] * rs * gq[d + 1] * qscale,
              acc[i][j][2] * rs * gq[d + 2] * qscale, acc[i][j][3] * rs * gq[d + 3] * qscale);
        }
      } else {
        float y1[4], y2[4];
#pragma unroll
        for (int r = 0; r < 4; ++r) {
          const float2 cs = r32[pos * 16 + 4 * q + r];
          const float x1 = acc[0][j][r] * rs * gq[64 + 4 * q + r], x2 = acc[1][j][r] * rs * gq[80 + 4 * q + r];
          y1[r] = (x1 * cs.x - x2 * cs.y) * qscale; y2[r] = (x2 * cs.x + x1 * cs.y) * qscale;
        }
        st4(mq + (size_t)tok * 576 + h * 96 + 64 + 4 * q, y1[0], y1[1], y1[2], y1[3]);
        st4(mq + (size_t)tok * 576 + h * 96 + 80 + 4 * q, y2[0], y2[1], y2[2], y2[3]);
      }
    }
    __syncthreads();
  }
  const int b = tok0 >> 12, pos0 = tok0 & (S - 1);
#pragma unroll 1
  for (int h0 = 0; h0 < 6; ++h0) {
    int h = h0; asm volatile("" : "+s"(h));
    f32x4 acc[4][4]; zero_acc(acc);
    gemm_block(acc, Wkv + (size_t)(h * 128) * 128, 128, proj + (size_t)tok0 * DINP + C_CKV, DINP, 128, lds, tid);
    if (wa == 0) {
#pragma unroll
      for (int j = 0; j < 4; ++j) {
        const int tl = wb * 64 + 16 * j + jn, tok = tok0 + tl, pos = tok & (S - 1);
        const float rkv = s_r[128 + tl];
        const uint2 pl = ld4(proj + (size_t)tok * DINP + C_KPE + 4 * q);
        const uint2 ph = ld4(proj + (size_t)tok * DINP + C_KPE + 16 + 4 * q);
        const float kl[4] = {lo2f(pl.x), hi2f(pl.x), lo2f(pl.y), hi2f(pl.y)};
        const float kh[4] = {lo2f(ph.x), hi2f(ph.x), lo2f(ph.y), hi2f(ph.y)};
        float ss = 0.f;
#pragma unroll
        for (int i = 0; i < 4; ++i)
#pragma unroll
          for (int r = 0; r < 4; ++r) { const float v = acc[i][j][r] * rkv; acc[i][j][r] = v; ss += v * v; }
#pragma unroll
        for (int r = 0; r < 4; ++r) ss += kl[r] * kl[r] + kh[r] * kh[r];
        ss = red4(ss);
        const float rs = rsqrtf(ss * (1.0f / 96) + EPS);
#pragma unroll
        for (int i = 0; i < 4; ++i) {
          const int d = 16 * i + 4 * q;
          st4(mk + (size_t)tok * 576 + h * 96 + d, acc[i][j][0] * rs * gk[d], acc[i][j][1] * rs * gk[d + 1], acc[i][j][2] * rs * gk[d + 2], acc[i][j][3] * rs * gk[d + 3]);
        }
        float y1[4], y2[4];
#pragma unroll
        for (int r = 0; r < 4; ++r) {
          const float2 cs = r32[pos * 16 + 4 * q + r];
          const float x1 = kl[r] * rs * gk[64 + 4 * q + r], x2 = kh[r] * rs * gk[80 + 4 * q + r];
          y1[r] = x1 * cs.x - x2 * cs.y; y2[r] = x2 * cs.x + x1 * cs.y;
        }
        st4(mk + (size_t)tok * 576 + h * 96 + 64 + 4 * q, y1[0], y1[1], y1[2], y1[3]);
        st4(mk + (size_t)tok * 576 + h * 96 + 80 + 4 * q, y2[0], y2[1], y2[2], y2[3]);
      }
    } else {
#pragma unroll
      for (int j = 0; j < 4; ++j) {
        const int tl = wb * 64 + 16 * j + jn;
        const float rkv = s_r[128 + tl];
#pragma unroll
        for (int i = 0; i < 4; ++i)
#pragma unroll
          for (int r = 0; r < 4; ++r)
            mvt[((size_t)(b * 6 + h) * 64 + 16 * i + 4 * q + r) * S + pos0 + tl] = f2bf(acc[i][j][r] * rkv);
      }
    }
  }
}

DI void prep_dsa(const Params& P, int l, int tok0) {
  u16* proj = (u16*)(P.ws + O_PROJ);
  u16* avt = (u16*)(P.ws + O_AVT);
  const float2* r64 = (const float2*)(P.ws + O_R64);
  const float2* r32 = (const float2*)(P.ws + O_R32);
  const int tid = opaque_tid();
  for (int task = tid; task < 512; task += 256) {
    const int tok = tok0 + (task >> 2), c = task & 3, pos = tok & (S - 1);
    u16* row = proj + (size_t)tok * DINP;
    bf16x8 lo[7], hi[7];
#pragma unroll
    for (int hh = 0; hh < 7; ++hh) {
      const int base = (hh < 6) ? C_QA + 64 * hh : C_KA;
      lo[hh] = ld8(row + base + 8 * c); hi[hh] = ld8(row + base + 32 + 8 * c);
    }
    float2 cs[8];
    float gql[8], gqh[8], gkl[8], gkh[8];
    const float* gq = P.in[3] + l * 64; const float* gk = P.in[4] + l * 64;
#pragma unroll
    for (int j = 0; j < 8; ++j) {
      cs[j] = r64[pos * 32 + 8 * c + j];
      gql[j] = gq[8 * c + j]; gqh[j] = gq[32 + 8 * c + j]; gkl[j] = gk[8 * c + j]; gkh[j] = gk[32 + 8 * c + j];
    }
#pragma unroll
    for (int hh = 0; hh < 7; ++hh) {
      const int base = (hh < 6) ? C_QA + 64 * hh : C_KA;
      float xl[8], xh[8];
      float ss = 0.f;
#pragma unroll
      for (int j = 0; j < 8; ++j) { xl[j] = bf2f((u16)lo[hh][j]); xh[j] = bf2f((u16)hi[hh][j]); ss += xl[j] * xl[j] + xh[j] * xh[j]; }
      ss += __shfl_xor(ss, 1); ss += __shfl_xor(ss, 2);
      const float rs = rsqrtf(ss * (1.0f / 64) + EPS);
      const float sc = (hh < 6) ? 0.125f * LOG2E : 1.0f;
      float y1[8], y2[8];
#pragma unroll
      for (int j = 0; j < 8; ++j) {
        const float x1 = xl[j] * rs * ((hh < 6) ? gql[j] : gkl[j]), x2 = xh[j] * rs * ((hh < 6) ? gqh[j] : gkh[j]);
        y1[j] = (x1 * cs[j].x - x2 * cs[j].y) * sc; y2[j] = (x2 * cs[j].x + x1 * cs[j].y) * sc;
      }
      uint4 o; o.x = pack2(y1[0], y1[1]); o.y = pack2(y1[2], y1[3]); o.z = pack2(y1[4], y1[5]); o.w = pack2(y1[6], y1[7]);
      *reinterpret_cast<uint4*>(row + base + 8 * c) = o;
      o.x = pack2(y2[0], y2[1]); o.y = pack2(y2[2], y2[3]); o.z = pack2(y2[4], y2[5]); o.w = pack2(y2[6], y2[7]);
      *reinterpret_cast<uint4*>(row + base + 32 + 8 * c) = o;
    }
  }
  {
    const int tok = tok0 + (tid >> 1), c2 = tid & 1, pos = tok & (S - 1);
    u16* row = proj + (size_t)tok * DINP;
    bf16x8 lo[9], hi[9];
#pragma unroll
    for (int hh = 0; hh < 9; ++hh) {
      const int base = (hh < 8) ? C_IQ + 32 * hh : C_IK;
      lo[hh] = ld8(row + base + 8 * c2); hi[hh] = ld8(row + base + 16 + 8 * c2);
    }
    float2 cs[8];
#pragma unroll
    for (int j = 0; j < 8; ++j) cs[j] = r32[pos * 16 + 8 * c2 + j];
#pragma unroll
    for (int hh = 0; hh < 9; ++hh) {
      const int base = (hh < 8) ? C_IQ + 32 * hh : C_IK;
      float y1[8], y2[8];
#pragma unroll
      for (int j = 0; j < 8; ++j) {
        const float x1 = bf2f((u16)lo[hh][j]), x2 = bf2f((u16)hi[hh][j]);
        y1[j] = x1 * cs[j].x - x2 * cs[j].y; y2[j] = x2 * cs[j].x + x1 * cs[j].y;
      }
      uint4 o; o.x = pack2(y1[0], y1[1]); o.y = pack2(y1[2], y1[3]); o.z = pack2(y1[4], y1[5]); o.w = pack2(y1[6], y1[7]);
      *reinterpret_cast<uint4*>(row + base + 8 * c2) = o;
      o.x = pack2(y2[0], y2[1]); o.y = pack2(y2[2], y2[3]); o.z = pack2(y2[4], y2[5]); o.w = pack2(y2[6], y2[7]);
      *reinterpret_cast<uint4*>(row + base + 16 + 8 * c2) = o;
    }
  }
  {
    const int b = tok0 >> 12, pos0 = tok0 & (S - 1);
    const int dim = tid & 63, tg0 = tid >> 6;
    unsigned short v[8][4];
#pragma unroll
    for (int u = 0; u < 8; ++u) {
      const u16* p = proj + (size_t)(tok0 + 4 * (tg0 + 4 * u)) * DINP + C_VA + dim;
#pragma unroll
      for (int k = 0; k < 4; ++k) v[u][k] = p[k * DINP];
    }
#pragma unroll
    for (int u = 0; u < 8; ++u) {
      uint2 o; o.x = (unsigned)v[u][0] | ((unsigned)v[u][1] << 16); o.y = (unsigned)v[u][2] | ((unsigned)v[u][3] << 16);
      *reinterpret_cast<uint2*>(avt + ((size_t)b * 64 + dim) * S + pos0 + 4 * (tg0 + 4 * u)) = o;
    }
  }
}

DI void prep_tile(const Params& P, int l, int tile, char* lds, float* s_r) {
  const int tid = opaque_tid();
  const int wave = __builtin_amdgcn_readfirstlane(tid >> 6), lane = tid & 63;
  const int tok0 = tile * 128;
  prep_mla_tile(P, l, tile, lds, s_r, s_r + 256);
  prep_dsa(P, l, tok0);
}

DI void inproj_tile(const Params& P, int l, int tt, char* lds, float* s_rstd, float* s_prep) {
  const u16* W = (const u16*)(P.ws + O_WTIN) + (size_t)l * DINP * DM;
  const u16* xb = (const u16*)(P.ws + O_XB2);
  u16* proj = (u16*)(P.ws + O_PROJ);
  const int tid = opaque_tid();
  const int wave = __builtin_amdgcn_readfirstlane(tid >> 6), lane = tid & 63, q = lane >> 4, jn = lane & 15;
  {
    {
      const u16* rp = xb + (size_t)(tt * 128 + (tid >> 1)) * DM + (tid & 1) * 512;
      float ss = 0.f;
#pragma unroll 1
      for (int c = 0; c < 8; ++c) {
        bf16x8 v[8];
#pragma unroll
        for (int u = 0; u < 8; ++u) v[u] = ld8(rp + (c * 8 + u) * 8);
#pragma unroll
        for (int u = 0; u < 8; ++u)
#pragma unroll
          for (int j = 0; j < 8; ++j) { const float f = bf2f((u16)v[u][j]); ss += f * f; }
      }
      ss += __shfl_xor(ss, 1);
      if ((tid & 1) == 0) s_rstd[tid >> 1] = rsqrtf(ss * (1.0f / DM) + EPS);
    }
    __syncthreads();
#pragma unroll 1
    for (int ftile0 = 0; ftile0 < 20; ++ftile0) {
      int ftile = ftile0; asm volatile("" : "+s"(ftile));
      const int f0 = ftile * 128 + (wave >> 1) * 64, t0 = tt * 128 + (wave & 1) * 64;
      f32x4 acc[4][4]; zero_acc(acc);
      gemm_block(acc, W + (size_t)(ftile * 128) * DM, DM, xb + (size_t)(tt * 128) * DM, DM, DM, lds, tid);
#pragma unroll
      for (int j = 0; j < 4; ++j) {
        const int tok = t0 + 16 * j + jn; const float rs = s_rstd[(wave & 1) * 64 + 16 * j + jn];
#pragma unroll
        for (int i = 0; i < 4; ++i)
          st4(proj + (size_t)tok * DINP + f0 + 16 * i + 4 * q, acc[i][j][0] * rs, acc[i][j][1] * rs, acc[i][j][2] * rs, acc[i][j][3] * rs);
      }
    }
    asm volatile("s_waitcnt vmcnt(0)" ::: "memory");
    __syncthreads();
    prep_tile(P, l, tt, lds, s_prep);
    __syncthreads();
  }
}

DI void phase_inproj(const Params& P, int l, char* lds, float* s_rstd, float* s_prep) {
  for (int tt = blockIdx.x; tt < 512; tt += gridDim.x) inproj_tile(P, l, tt, lds, s_rstd, s_prep);
}

template <int KS, bool MASK>
DI void attn_block_v1(const u16* Qp, int qstride, const u16* Kp, int kstride, const u16* Vtp, const u64* maskp, int nkt_w, int nkt_max,
                   const u16* gatep, int gstride, u16* outp, int ostride, char* lds, int tid) {
  constexpr int DQK = KS * 32, KROW = DQK + 8, VROW = 72;
  constexpr int KCH = DQK / 8, NKC = 64 * KCH / 256;
  constexpr int K_BYTES = 64 * KROW * 2, BUF_BYTES = K_BYTES + 64 * VROW * 2;
  const int lane = tid & 63, q = lane >> 4, jn = lane & 15;
  const float NEG_INF = -__builtin_inff();
  uint4 kst[NKC], vst[2];
  auto gload = [&](int kt) {
#pragma unroll
    for (int i = 0; i < NKC; ++i) {
      const int c = tid + 256 * i, row = c / KCH, col = c % KCH;
      kst[i] = *reinterpret_cast<const uint4*>(Kp + (size_t)(kt * 64 + row) * kstride + col * 8);
    }
#pragma unroll
    for (int i = 0; i < 2; ++i) {
      const int c = tid + 256 * i, dim = c >> 3, part = c & 7;
      vst[i] = *reinterpret_cast<const uint4*>(Vtp + (size_t)dim * S + kt * 64 + part * 8);
    }
  };
  auto lstore = [&](int buf) {
    char* kb = lds + buf * BUF_BYTES; char* vb = kb + K_BYTES;
#pragma unroll
    for (int i = 0; i < NKC; ++i) {
      const int c = tid + 256 * i, row = c / KCH, col = c % KCH;
      *reinterpret_cast<uint4*>(kb + (row * KROW + col * 8) * 2) = kst[i];
    }
#pragma unroll
    for (int i = 0; i < 2; ++i) {
      const int c = tid + 256 * i, dim = c >> 3, part = c & 7;
      *reinterpret_cast<uint4*>(vb + (dim * VROW + part * 8) * 2) = vst[i];
    }
  };
  bf16x8 qf[2][KS];
#pragma unroll
  for (int c = 0; c < 2; ++c)
#pragma unroll
    for (int ks = 0; ks < KS; ++ks) qf[c][ks] = ld8(Qp + (size_t)(16 * c + jn) * qstride + ks * 32 + q * 8);
  f32x4 o[4][2]; zero_acc(o);
  float m[2] = {NEG_INF, NEG_INF}, lsum[2] = {0.f, 0.f};
  u64 mw[2] = {0ull, 0ull}, mwn[2] = {0ull, 0ull};
  if (MASK) {
#pragma unroll
    for (int c = 0; c < 2; ++c) mw[c] = maskp[(size_t)(16 * c + jn) * 64];
  }
  gload(0);
  lstore(0);
  __syncthreads();
  for (int kt = 0; kt < nkt_max; ++kt) {
    const bool more = kt + 1 < nkt_max;
    if (more) {
      gload(kt + 1);
      if (MASK) {
        if (kt + 1 < nkt_w) {
#pragma unroll
          for (int c = 0; c < 2; ++c) mwn[c] = maskp[(size_t)(16 * c + jn) * 64 + kt + 1];
        }
      }
    }
    if (kt < nkt_w) {
      const char* kb = lds + (kt & 1) * BUF_BYTES; const char* vb = kb + K_BYTES;
      f32x4 s[4][2]; zero_acc(s);
#pragma unroll
      for (int a = 0; a < 4; ++a)
#pragma unroll
        for (int ks = 0; ks < KS; ++ks) {
          const bf16x8 kf = *reinterpret_cast<const bf16x8*>(kb + ((16 * a + jn) * KROW + ks * 32 + q * 8) * 2);
#pragma unroll
          for (int c = 0; c < 2; ++c) s[a][c] = mfma16(kf, qf[c][ks], s[a][c]);
        }
      if (MASK) {
#pragma unroll
        for (int c = 0; c < 2; ++c) {
          const u64 w = mw[c] >> (4 * q);
#pragma unroll
          for (int a = 0; a < 4; ++a)
#pragma unroll
            for (int r = 0; r < 4; ++r)
              if (!((w >> (16 * a + r)) & 1ull)) s[a][c][r] = NEG_INF;
        }
      }
      float alpha[2];
#pragma unroll
      for (int c = 0; c < 2; ++c) {
        float mx = NEG_INF;
#pragma unroll
        for (int a = 0; a < 4; ++a)
#pragma unroll
          for (int r = 0; r < 4; ++r) mx = fmaxf(mx, s[a][c][r]);
        mx = fmaxf(mx, __shfl_xor(mx, 16)); mx = fmaxf(mx, __shfl_xor(mx, 32));
        const float mn = fmaxf(m[c], mx);
        const float mu = (mn == NEG_INF) ? 0.f : mn;
        alpha[c] = fexp2(m[c] - mu);
        m[c] = mn;
        float ps = 0.f;
#pragma unroll
        for (int a = 0; a < 4; ++a)
#pragma unroll
          for (int r = 0; r < 4; ++r) { float p = fexp2(s[a][c][r] - mu); s[a][c][r] = p; ps += p; }
        lsum[c] = lsum[c] * alpha[c] + ps;
      }
      if (__builtin_amdgcn_ballot_w64(alpha[0] != 1.0f || alpha[1] != 1.0f) != 0ull) {
#pragma unroll
        for (int c = 0; c < 2; ++c)
#pragma unroll
          for (int dt = 0; dt < 4; ++dt)
#pragma unroll
            for (int r = 0; r < 4; ++r) o[dt][c][r] *= alpha[c];
      }
#pragma unroll
      for (int kk = 0; kk < 2; ++kk) {
        bf16x8 pf[2];
#pragma unroll
        for (int c = 0; c < 2; ++c) {
          uint4 w; w.x = pack2(s[2 * kk][c][0], s[2 * kk][c][1]); w.y = pack2(s[2 * kk][c][2], s[2 * kk][c][3]);
          w.z = pack2(s[2 * kk + 1][c][0], s[2 * kk + 1][c][1]); w.w = pack2(s[2 * kk + 1][c][2], s[2 * kk + 1][c][3]);
          pf[c] = __builtin_bit_cast(bf16x8, w);
        }
#pragma unroll
        for (int dt = 0; dt < 4; ++dt) {
          const char* vp = vb + ((16 * dt + jn) * VROW + kk * 32 + 4 * q) * 2;
          const uint2 lo = *reinterpret_cast<const uint2*>(vp), hi = *reinterpret_cast<const uint2*>(vp + 32);
          uint4 w; w.x = lo.x; w.y = lo.y; w.z = hi.x; w.w = hi.y;
          const bf16x8 vf = __builtin_bit_cast(bf16x8, w);
#pragma unroll
          for (int c = 0; c < 2; ++c) o[dt][c] = mfma16(vf, pf[c], o[dt][c]);
        }
      }
    }
    if (more) lstore((kt + 1) & 1);
    if (MASK) { mw[0] = mwn[0]; mw[1] = mwn[1]; }
    __syncthreads();
  }
#pragma unroll
  for (int c = 0; c < 2; ++c) {
    const float inv = 1.0f / red4(lsum[c]);
    const int row = 16 * c + jn;
#pragma unroll
    for (int dt = 0; dt < 4; ++dt) {
      uint2 gw = ld4(gatep + (size_t)row * gstride + 16 * dt + 4 * q);
      st4(outp + (size_t)row * ostride + 16 * dt + 4 * q, o[dt][c][0] * inv * siluf_(lo2f(gw.x)), o[dt][c][1] * inv * siluf_(hi2f(gw.x)),
          o[dt][c][2] * inv * siluf_(lo2f(gw.y)), o[dt][c][3] * inv * siluf_(hi2f(gw.y)));
    }
  }
}

template <int KS, bool MASK, int NC, bool SH>
DI void attn_block(const u16* Qp, int qstride, const u16* Kp, int kstride, const u16* Vtp, const u64* maskp, int nkt_w, int nkt_max,
                   const u16* gatep, int gstride, u16* outp, int ostride, char* lds, int tid) {
  constexpr int DQK = KS * 32, KROW = DQK + 8, VROW = 72;
  constexpr int KCH = DQK / 8, NKC = 64 * KCH / 256;
  constexpr int K_BYTES = 64 * KROW * 2, BUF_BYTES = K_BYTES + 64 * VROW * 2;
  const int lane = tid & 63, q = lane >> 4, jn = lane & 15;
  const float NEG_INF = -__builtin_inff();
  uint4 xk0, xk1, xk2, xv0, xv1, yk0, yk1, yk2, yv0, yv1;
  xk2 = yk2 = make_uint4(0, 0, 0, 0);
  const int c0 = tid, c1 = tid + 256, c2 = tid + 512;
  const u16* kg0 = Kp + (size_t)(c0 / KCH) * kstride + (c0 % KCH) * 8;
  const u16* kg1 = Kp + (size_t)(c1 / KCH) * kstride + (c1 % KCH) * 8;
  const u16* kg2 = Kp + (size_t)(c2 / KCH) * kstride + (c2 % KCH) * 8;
  const u16* vg0 = Vtp + (size_t)(c0 >> 3) * S + (c0 & 7) * 8;
  const u16* vg1 = Vtp + (size_t)(c1 >> 3) * S + (c1 & 7) * 8;
  char* ks0 = lds + ((c0 / KCH) * KROW + (c0 % KCH) * 8) * 2;
  char* ks1 = lds + ((c1 / KCH) * KROW + (c1 % KCH) * 8) * 2;
  char* ks2 = lds + ((c2 / KCH) * KROW + (c2 % KCH) * 8) * 2;
  char* vs0 = lds + K_BYTES + ((c0 >> 3) * VROW + (c0 & 7) * 8) * 2;
  char* vs1 = lds + K_BYTES + ((c1 >> 3) * VROW + (c1 & 7) * 8) * 2;
#define A_LOAD(P, kt) { const size_t ko = (size_t)(kt) * 64 * kstride; const int vo = (kt) * 64;                     \
    P##k0 = *reinterpret_cast<const uint4*>(kg0 + ko); P##k1 = *reinterpret_cast<const uint4*>(kg1 + ko);            \
    if (NKC == 3) P##k2 = *reinterpret_cast<const uint4*>(kg2 + ko);                                                 \
    P##v0 = *reinterpret_cast<const uint4*>(vg0 + vo); P##v1 = *reinterpret_cast<const uint4*>(vg1 + vo); }
#define A_STORE(P, buf) { *reinterpret_cast<uint4*>(ks0 + (buf) * BUF_BYTES) = P##k0; *reinterpret_cast<uint4*>(ks1 + (buf) * BUF_BYTES) = P##k1; \
    if (NKC == 3) *reinterpret_cast<uint4*>(ks2 + (buf) * BUF_BYTES) = P##k2;                                        \
    *reinterpret_cast<uint4*>(vs0 + (buf) * BUF_BYTES) = P##v0; *reinterpret_cast<uint4*>(vs1 + (buf) * BUF_BYTES) = P##v1; }
  bf16x8 qf[NC][KS];
#pragma unroll
  for (int c = 0; c < NC; ++c)
#pragma unroll
    for (int ks = 0; ks < KS; ++ks) qf[c][ks] = ld8(Qp + (size_t)((SH ? 0 : 16 * c) + jn) * qstride + (SH ? 64 * c : 0) + ks * 32 + q * 8);
  f32x4 o[4][NC]; zero_acc(o);
  float m[NC], lsum[NC];
#pragma unroll
  for (int c = 0; c < NC; ++c) { m[c] = NEG_INF; lsum[c] = 0.f; }
  u64 mce0 = 0ull, mce1 = 0ull, mco0 = 0ull, mco1 = 0ull, mne0 = 0ull, mne1 = 0ull, mno0 = 0ull, mno1 = 0ull;
  const u64* mrow0 = maskp + (size_t)jn * 64;
  const u64* mrow1 = maskp + (size_t)(16 + jn) * 64;
  if (MASK) {
    mce0 = mrow0[0]; if (!SH) mce1 = mrow1[0];
    if (1 < nkt_w) { mco0 = mrow0[1]; if (!SH) mco1 = mrow1[1]; }
  }
  auto compute = [&](int buf, u64 w0, u64 w1) {
    const char* kb = lds + buf * BUF_BYTES; const char* vb = kb + K_BYTES;
    f32x4 s[4][NC]; zero_acc(s);
#pragma unroll
    for (int a = 0; a < 4; ++a)
#pragma unroll
      for (int ks = 0; ks < KS; ++ks) {
        const bf16x8 kf = *reinterpret_cast<const bf16x8*>(kb + ((16 * a + jn) * KROW + ks * 32 + q * 8) * 2);
#pragma unroll
        for (int c = 0; c < NC; ++c) s[a][c] = mfma16(kf, qf[c][ks], s[a][c]);
      }
    if (MASK) {
#pragma unroll
      for (int c = 0; c < NC; ++c) {
        const u64 w = ((SH || c == 0) ? w0 : w1) >> (4 * q);
#pragma unroll
        for (int a = 0; a < 4; ++a)
#pragma unroll
          for (int r = 0; r < 4; ++r)
            if (!((w >> (16 * a + r)) & 1ull)) s[a][c][r] = NEG_INF;
      }
    }
    float alpha[NC];
#pragma unroll
    for (int c = 0; c < NC; ++c) {
      float mx = NEG_INF;
#pragma unroll
      for (int a = 0; a < 4; ++a)
#pragma unroll
        for (int r = 0; r < 4; ++r) mx = fmaxf(mx, s[a][c][r]);
      mx = fmaxf(mx, __shfl_xor(mx, 16)); mx = fmaxf(mx, __shfl_xor(mx, 32));
      const float mn = fmaxf(m[c], mx);
      const float mu = (mn == NEG_INF) ? 0.f : mn;
      alpha[c] = fexp2(m[c] - mu);
      m[c] = mn;
      float ps = 0.f;
#pragma unroll
      for (int a = 0; a < 4; ++a)
#pragma unroll
        for (int r = 0; r < 4; ++r) { float p = fexp2(s[a][c][r] - mu); s[a][c][r] = p; ps += p; }
      lsum[c] = lsum[c] * alpha[c] + ps;
    }
    bool resc = false;
#pragma unroll
    for (int c = 0; c < NC; ++c) resc = resc || (alpha[c] != 1.0f);
    if (__builtin_amdgcn_ballot_w64(resc) != 0ull) {
#pragma unroll
      for (int c = 0; c < NC; ++c)
#pragma unroll
        for (int dt = 0; dt < 4; ++dt)
#pragma unroll
          for (int r = 0; r < 4; ++r) o[dt][c][r] *= alpha[c];
    }
#pragma unroll
    for (int kk = 0; kk < 2; ++kk) {
      bf16x8 pf[NC];
#pragma unroll
      for (int c = 0; c < NC; ++c) {
        uint4 w; w.x = pack2(s[2 * kk][c][0], s[2 * kk][c][1]); w.y = pack2(s[2 * kk][c][2], s[2 * kk][c][3]);
        w.z = pack2(s[2 * kk + 1][c][0], s[2 * kk + 1][c][1]); w.w = pack2(s[2 * kk + 1][c][2], s[2 * kk + 1][c][3]);
        pf[c] = __builtin_bit_cast(bf16x8, w);
      }
#pragma unroll
      for (int dt = 0; dt < 4; ++dt) {
        const char* vp = vb + ((16 * dt + jn) * VROW + kk * 32 + 4 * q) * 2;
        const uint2 lo = *reinterpret_cast<const uint2*>(vp), hi = *reinterpret_cast<const uint2*>(vp + 32);
        uint4 w; w.x = lo.x; w.y = lo.y; w.z = hi.x; w.w = hi.y;
        const bf16x8 vf = __builtin_bit_cast(bf16x8, w);
#pragma unroll
        for (int c = 0; c < NC; ++c) o[dt][c] = mfma16(vf, pf[c], o[dt][c]);
      }
    }
  };

  A_LOAD(x, 0);
  { const int t1 = (nkt_max > 1) ? 1 : 0; A_LOAD(y, t1); }
  A_STORE(x, 0);
  __syncthreads();
  for (int kt = 0; kt < nkt_max; kt += 2) {
    const bool more = kt + 2 < nkt_max;
    if (more) {
      A_LOAD(x, kt + 2);
      if (MASK) {
        if (kt + 2 < nkt_w) { mne0 = mrow0[kt + 2]; if (!SH) mne1 = mrow1[kt + 2]; }
        if (kt + 3 < nkt_w) { mno0 = mrow0[kt + 3]; if (!SH) mno1 = mrow1[kt + 3]; }
      }
    }
    if (kt < nkt_w) compute(0, mce0, mce1);
    A_STORE(y, 1);
    __syncthreads();
    if (kt + 3 < nkt_max) A_LOAD(y, kt + 3);
    if (kt + 1 < nkt_w) compute(1, mco0, mco1);
    if (more) A_STORE(x, 0);
    if (MASK) { mce0 = mne0; mce1 = mne1; mco0 = mno0; mco1 = mno1; }
    __syncthreads();
  }
#undef A_LOAD
#undef A_STORE
#pragma unroll
  for (int c = 0; c < NC; ++c) {
    const float inv = 1.0f / red4(lsum[c]);
    const int row = (SH ? 0 : 16 * c) + jn;
    const int hc = SH ? 64 * c : 0;
#pragma unroll
    for (int dt = 0; dt < 4; ++dt) {
      uint2 gw = ld4(gatep + (size_t)row * gstride + hc + 16 * dt + 4 * q);
      st4(outp + (size_t)row * ostride + hc + 16 * dt + 4 * q, o[dt][c][0] * inv * siluf_(lo2f(gw.x)), o[dt][c][1] * inv * siluf_(hi2f(gw.x)),
          o[dt][c][2] * inv * siluf_(lo2f(gw.y)), o[dt][c][3] * inv * siluf_(hi2f(gw.y)));
    }
  }
}

DI void mla_attn_item(const Params& P, int it, char* lds, int tid) {
  const int wave = __builtin_amdgcn_readfirstlane(tid >> 6);
  const int qb = 31 - it / 96, bh = it % 96, b = bh / 6, h = bh % 6;
  const int q0 = qb * 128 + wave * 32;
  const int nkt = (q0 >> 6) + 1;
  const u16* mq = (const u16*)(P.ws + O_MQ); const u16* mk = (const u16*)(P.ws + O_MK); const u16* mvt = (const u16*)(P.ws + O_MVT);
  const u16* proj = (const u16*)(P.ws + O_PROJ); u16* mixed = (u16*)(P.ws + O_XB);
  const size_t tok = (size_t)b * S + q0;
  attn_block<3, false, 2, false>(mq + tok * 576 + h * 96, 576, mk + (size_t)b * S * 576 + h * 96, 576, mvt + (size_t)(b * 6 + h) * 64 * S, nullptr, nkt, 2 * qb + 2,
                       proj + tok * DINP + C_GC + h * 64, DINP, mixed + tok * DM + 640 + h * 64, DM, lds, tid);
}

DI void dsa_attn_item(const Params& P, int it, char* lds, int tid) {
  const int wave = __builtin_amdgcn_readfirstlane(tid >> 6);
  const int ch = 63 - it / 32, bh = it % 32, b = bh >> 1, hg = bh & 1;
  const int q0 = ch * 64 + wave * 16;
  const int nkt = ch + 1;
  const u16* proj = (const u16*)(P.ws + O_PROJ); const u16* avt = (const u16*)(P.ws + O_AVT); u16* mixed = (u16*)(P.ws + O_XB);
  const u64* mask = (const u64*)(P.ws + O_MASK);
  const size_t tok = (size_t)b * S + q0;
  attn_block<2, true, 3, true>(proj + tok * DINP + C_QA + hg * 192, DINP, proj + (size_t)b * S * DINP + C_KA, DINP, avt + (size_t)b * 64 * S, mask + tok * 64, nkt, nkt,
                               proj + tok * DINP + C_GA + hg * 192, DINP, mixed + tok * DM + hg * 192, DM, lds, tid);
}

constexpr int SC_STRIDE = 4096 + 16;
DI unsigned fkey(float f) { unsigned u = __float_as_uint(f); return (u & 0x80000000u) ? ~u : (u | 0x80000000u); }
DI float funkey(unsigned k) { return __uint_as_float((k & 0x80000000u) ? (k ^ 0x80000000u) : ~k); }

template <int NR>
DI u64 select_wave(float* scw, int nreg, int lane) {
  unsigned key[NR];
  unsigned kmin = 0xffffffffu, kmax = 0u;
#pragma unroll
  for (int r = 0; r < NR; ++r) {
    const unsigned k = fkey(scw[64 * r + lane]);
    const bool ok = r < nreg;
    key[r] = ok ? k : 0u;
    kmin = min(kmin, ok ? k : 0xffffffffu); kmax = max(kmax, key[r]);
  }
#pragma unroll
  for (int o = 1; o < 64; o <<= 1) { kmin = min(kmin, (unsigned)__shfl_xor((int)kmin, o)); kmax = max(kmax, (unsigned)__shfl_xor((int)kmax, o)); }
  unsigned lo = __builtin_amdgcn_readfirstlane(kmin), hi = __builtin_amdgcn_readfirstlane(kmax);
  int clo = 64 * nreg, chi = 0;
  bool exact = false;
  int iter = 0;
  while (lo < hi && clo - chi > 512) {
    unsigned mid = fkey(0.5f * (funkey(lo) + funkey(hi)));
    if (iter >= 16) mid = lo + ((hi - lo + 1u) >> 1);
    if (mid <= lo) mid = lo + 1;
    if (mid > hi) mid = hi;
    ++iter;
    int cnt = 0;
#pragma unroll
    for (int r = 0; r < NR; ++r) cnt += __builtin_popcountll(__builtin_amdgcn_ballot_w64(key[r] >= mid));
    if (cnt >= 256) { lo = mid; clo = cnt; if (cnt == 256) { exact = true; break; } }
    else { hi = mid - 1; chi = cnt; }
  }
  if (!exact && lo < hi) {
    unsigned* cand = reinterpret_cast<unsigned*>(scw);
    int base = 0;
#pragma unroll
    for (int r = 0; r < NR; ++r) {
      const bool pred = (key[r] >= lo) && (key[r] <= hi);
      const u64 bal = __builtin_amdgcn_ballot_w64(pred);
      const int pos = base + __builtin_amdgcn_mbcnt_hi((unsigned)(bal >> 32), __builtin_amdgcn_mbcnt_lo((unsigned)bal, 0u));
      if (pred) cand[pos] = key[r];
      base += __builtin_popcountll(bal);
    }
    __builtin_amdgcn_fence(__ATOMIC_RELEASE, "wavefront");
    __builtin_amdgcn_fence(__ATOMIC_ACQUIRE, "wavefront");
    unsigned ck[8];
#pragma unroll
    for (int i = 0; i < 8; ++i) { const unsigned v = cand[64 * i + lane]; ck[i] = (64 * i + lane < base) ? v : 0u; }
    const int cabove = chi;
    while (lo < hi) {
      unsigned mid = fkey(0.5f * (funkey(lo) + funkey(hi)));
      if (iter >= 16) mid = lo + ((hi - lo + 1u) >> 1);
      if (mid <= lo) mid = lo + 1;
      if (mid > hi) mid = hi;
      ++iter;
      int cnt = cabove;
#pragma unroll
      for (int i = 0; i < 8; ++i) cnt += __builtin_popcountll(__builtin_amdgcn_ballot_w64(ck[i] >= mid));
      if (cnt >= 256) { lo = mid; if (cnt == 256) { exact = true; break; } }
      else { hi = mid - 1; }
    }
  }
  const unsigned thr = lo;
  u64 myword = 0ull;
  if (exact) {
#pragma unroll
    for (int r = 0; r < NR; ++r) { const u64 bal = __builtin_amdgcn_ballot_w64(key[r] >= thr); if (lane == r) myword = bal; }
  } else {
    int cgt = 0;
#pragma unroll
    for (int r = 0; r < NR; ++r) cgt += __builtin_popcountll(__builtin_amdgcn_ballot_w64(key[r] > thr));
    const int need = 256 - cgt;
    int run = 0;
    const u64 below = (1ull << lane) - 1ull;
#pragma unroll
    for (int r = 0; r < NR; ++r) {
      const u64 eq = __builtin_amdgcn_ballot_w64(key[r] == thr);
      const int rank = run + __builtin_popcountll(eq & below);
      const bool sel = (key[r] > thr) || ((key[r] == thr) && (rank < need));
      const u64 bal = __builtin_amdgcn_ballot_w64(sel);
      run += __builtin_popcountll(eq);
      if (lane == r) myword = bal;
    }
  }
  return myword;
}

DI void dsa_select_item(const Params& P, int it, float* sc, int wave, int lane) {
  const int qd = 1023 - it / 16, b = it % 16;
  const int t0 = qd * 4;
  const int N = ((t0 >> 6) + 1) * 64, nreg = N >> 6;
  const u16* base = (const u16*)(P.ws + O_PROJ) + (size_t)b * S * DINP;
  u64* mask = (u64*)(P.ws + O_MASK);
  const int q = lane >> 4, jn = lane & 15;
  if (N > 256) {
    const bf16x8 a0 = ld8(base + (size_t)(t0 + (jn >> 2)) * DINP + C_IQ + (jn & 3) * 32 + q * 8);
    const bf16x8 a1 = ld8(base + (size_t)(t0 + (jn >> 2)) * DINP + C_IQ + (4 + (jn & 3)) * 32 + q * 8);
    float w[8];
    {
      bf16x8 wv = ld8(base + (size_t)(t0 + q) * DINP + C_IW);
#pragma unroll
      for (int h = 0; h < 8; ++h) w[h] = bf2f((u16)wv[h]) * (0.35355339059327373f * 0.17677669529663687f);
    }
    const int tpw = N >> 6;
    const u16* kbase = base + (size_t)jn * DINP + C_IK + q * 8;
    for (int tl = 0; tl < tpw; tl += 16) {
      bf16x8 bk[16];
#pragma unroll
      for (int u = 0; u < 16; ++u) {
        const int t = (tl + u < tpw) ? tl + u : tpw - 1;
        bk[u] = ld8(kbase + (size_t)((wave * tpw + t) * 16) * DINP);
      }
#pragma unroll
      for (int u = 0; u < 16; ++u) {
        const int t = (tl + u < tpw) ? tl + u : tpw - 1;
        const int key0 = (wave * tpw + t) * 16;
        const f32x4 z = {0.f, 0.f, 0.f, 0.f};
        f32x4 d0 = mfma16(a0, bk[u], z), d1 = mfma16(a1, bk[u], z);
        float sv = 0.f;
#pragma unroll
        for (int r = 0; r < 4; ++r) sv += fmaxf(d0[r], 0.f) * w[r];
#pragma unroll
        for (int r = 0; r < 4; ++r) sv += fmaxf(d1[r], 0.f) * w[4 + r];
        sc[q * SC_STRIDE + key0 + jn] = sv;
      }
    }
  }
  __syncthreads();
  u64 myword = ~0ull;
  if (N > 256) {
    float* scw = sc + wave * SC_STRIDE;
    if (nreg <= 8) myword = select_wave<8>(scw, nreg, lane);
    else if (nreg <= 16) myword = select_wave<16>(scw, nreg, lane);
    else if (nreg <= 24) myword = select_wave<24>(scw, nreg, lane);
    else if (nreg <= 32) myword = select_wave<32>(scw, nreg, lane);
    else if (nreg <= 48) myword = select_wave<48>(scw, nreg, lane);
    else myword = select_wave<64>(scw, nreg, lane);
  }
  if (lane < nreg) mask[((size_t)b * S + t0 + wave) * 64 + lane] = myword;
  __syncthreads();
}

DI void s5_stage1_item(const Params& P, int l, int it, int wave, int lane) {
  const int b = it >> 4, g = it & 15, q = lane >> 4, jn = lane & 15;
  const u16* proj = (const u16*)(P.ws + O_PROJ);
  const u16* W1 = (const u16*)(P.ws + O_W1) + (size_t)(l * 16 + g) * 128 * 1024;
  float* s5s = (float*)(P.ws + O_S5S) + (size_t)it * 64 * 128;
  f32x4 acc[2][4]; zero_acc(acc);
  const u16* ap = W1 + (size_t)(wave * 32 + jn) * 1024 + q * 8;
  const u16* up = proj + ((size_t)b * S + (size_t)jn * 64 + (q >> 1)) * DINP + C_U + g * 16 + (q & 1) * 8;
  wgemm<2, 4>(acc, 32, [&](int i, int ks) { return ld8(ap + (size_t)i * 16 * 1024 + ks * 32); },
              [&](int j, int ks) { return ld8(up + ((size_t)j * 16 * 64 + 2 * ks) * DINP); });
#pragma unroll
  for (int j = 0; j < 4; ++j) {
    const int n = 16 * j + jn;
#pragma unroll
    for (int i = 0; i < 2; ++i)
      *reinterpret_cast<f32x4*>(s5s + (size_t)n * 128 + wave * 32 + 16 * i + 4 * q) = acc[i][j];
  }
}

constexpr int HS_STRIDE = 136;
DI void s5_stage3_item(const Params& P, int l, int it, u16* hs, int wave, int lane) {
  const int b = it >> 4, g = it & 15, q = lane >> 4, jn = lane & 15;
  const u16* proj = (const u16*)(P.ws + O_PROJ);
  const u16* Kt = (const u16*)(P.ws + O_KT) + (size_t)(l * 16 + g) * 64 * 256;
  const u16* W3 = (const u16*)(P.ws + O_W3) + (size_t)(l * 16 + g) * 1024 * 128;
  const float* s5s = (const float*)(P.ws + O_S5S) + (size_t)it * 64 * 128;
  const float2* pw = (const float2*)(P.ws + O_PW);
  u16* yg = (u16*)(P.ws + O_YG);
  const float* dsk = P.in[17] + (l * 16 + g) * 16;
  if (wave == 0) {
    const int p = lane;
    const float2 aL = pw[((size_t)(l * 16 + g) * 65 + 64) * 64 + p];
    float hr = 0.f, hi = 0.f;
#pragma unroll
    for (int half = 0; half < 2; ++half) {
      float2 sv[32];
#pragma unroll
      for (int n = 0; n < 32; ++n) sv[n] = *reinterpret_cast<const float2*>(s5s + (size_t)(half * 32 + n) * 128 + 2 * p);
#pragma unroll
      for (int n = 0; n < 32; ++n) {
        *reinterpret_cast<unsigned*>(hs + (half * 32 + n) * HS_STRIDE + 2 * p) = pack2(hr, hi);
        const float nr = aL.x * hr - aL.y * hi + sv[n].x, ni = aL.x * hi + aL.y * hr + sv[n].y;
        hr = nr; hi = ni;
      }
    }
  }
  __syncthreads();
  const u16* up = proj + ((size_t)b * S + (size_t)jn * 64 + (q >> 1)) * DINP + C_U + g * 16 + (q & 1) * 8;
  const bf16x8 zf = {0, 0, 0, 0, 0, 0, 0, 0};
  for (int gi = 0; gi < 8; ++gi) {
    const int jg = wave + 4 * (gi >> 1);
    const int th = gi & 1;
    f32x4 acc[4][2]; zero_acc(acc);
    wgemm<4, 2>(acc, 2 * jg + 2,
                [&](int i, int ks) { const int j = 4 * jg + i, ii = 2 * ks + (q >> 1); const int d = j - ii;
                                     return (d >= 0) ? ld8(Kt + ((size_t)d * 16 + jn) * 16 + (q & 1) * 8) : zf; },
                [&](int jt, int ks) { return ld8(up + ((size_t)(2 * th + jt) * 16 * 64 + 2 * ks) * DINP); });
    wgemm<4, 2>(acc, 4,
                [&](int i, int ks) { return ld8(W3 + ((size_t)(4 * jg + i) * 16 + jn) * 128 + ks * 32 + q * 8); },
                [&](int jt, int ks) { return *reinterpret_cast<const bf16x8*>(hs + (16 * (2 * th + jt) + jn) * HS_STRIDE + ks * 32 + q * 8); });
#pragma unroll
    for (int jt = 0; jt < 2; ++jt) {
      const int n = 16 * (2 * th + jt) + jn;
#pragma unroll
      for (int i = 0; i < 4; ++i) {
        const size_t tok = (size_t)b * S + n * 64 + 4 * jg + i;
        uint2 uw = ld4(proj + tok * DINP + C_U + g * 16 + 4 * q);
        const float y0 = acc[i][jt][0] + dsk[4 * q] * lo2f(uw.x), y1 = acc[i][jt][1] + dsk[4 * q + 1] * hi2f(uw.x);
        const float y2 = acc[i][jt][2] + dsk[4 * q + 2] * lo2f(uw.y), y3 = acc[i][jt][3] + dsk[4 * q + 3] * hi2f(uw.y);
        st4(yg + tok * 256 + g * 16 + 4 * q, geluf_(y0), geluf_(y1), geluf_(y2), geluf_(y3));
      }
    }
  }
  __syncthreads();
}

DI void glu_tile(const Params& P, int l, int tt, char* lds) {
  const u16* W = (const u16*)(P.ws + O_WTGLU) + (size_t)l * 256 * 256;
  const u16* yg = (const u16*)(P.ws + O_YG);
  const u16* proj = (const u16*)(P.ws + O_PROJ);
  u16* mixed = (u16*)(P.ws + O_XB);
  const int tid = opaque_tid();
  const int wave = __builtin_amdgcn_readfirstlane(tid >> 6), lane = tid & 63, q = lane >> 4, jn = lane & 15;
#pragma unroll 1
  for (int ftile = 0; ftile < 2; ++ftile) {
    const int f0 = ftile * 128 + (wave >> 1) * 64, t0 = tt * 128 + (wave & 1) * 64;
    f32x4 acc[4][4]; zero_acc(acc);
    gemm_block(acc, W + (size_t)(ftile * 128) * 256, 256, yg + (size_t)(tt * 128) * 256, 256, 256, lds, tid);
#pragma unroll
    for (int j = 0; j < 4; ++j) {
      const size_t tok = t0 + 16 * j + jn;
#pragma unroll
      for (int i = 0; i < 4; ++i) {
        const int f = f0 + 16 * i + 4 * q;
        uint2 gw = ld4(yg + tok * 256 + f), bw = ld4(proj + tok * DINP + C_GB + f);
        st4(mixed + tok * DM + 384 + f, lo2f(gw.x) * sigmoidf_(acc[i][j][0]) * siluf_(lo2f(bw.x)), hi2f(gw.x) * sigmoidf_(acc[i][j][1]) * siluf_(hi2f(bw.x)),
            lo2f(gw.y) * sigmoidf_(acc[i][j][2]) * siluf_(lo2f(bw.y)), hi2f(gw.y) * sigmoidf_(acc[i][j][3]) * siluf_(hi2f(bw.y)));
      }
    }
  }
}

DI void outproj_tile(const Params& P, int l, int tt, char* lds) {
  const u16* W = (const u16*)(P.ws + O_WTOUT) + (size_t)l * DM * DM;
  const u16* mixed = (const u16*)(P.ws + O_XB);
  const float* xin = (l == 0) ? P.in[0] : P.out;
  float* xout = P.out;
  u16* xb2 = (u16*)(P.ws + O_XB2);
  const int tid = opaque_tid();
  const int wave = __builtin_amdgcn_readfirstlane(tid >> 6), lane = tid & 63, q = lane >> 4, jn = lane & 15;
#pragma unroll 1
  for (int ftile0 = 0; ftile0 < 8; ++ftile0) {
    int ftile = ftile0; asm volatile("" : "+s"(ftile));
    const int f0 = ftile * 128 + (wave >> 1) * 64, t0 = tt * 128 + (wave & 1) * 64;
    f32x4 acc[4][4]; zero_acc(acc);
    gemm_block(acc, W + (size_t)(ftile * 128) * DM, DM, mixed + (size_t)(tt * 128) * DM, DM, DM, lds, tid);
#pragma unroll
    for (int j = 0; j < 4; ++j) {
      const size_t tok = t0 + 16 * j + jn;
#pragma unroll
      for (int i = 0; i < 4; ++i) {
        const int f = f0 + 16 * i + 4 * q;
        f32x4 xv;
        if (l == 0) xv = *reinterpret_cast<const f32x4*>(xin + tok * DM + f);
        else { const uint2 xw = ld4(xb2 + tok * DM + f); xv = f32x4{lo2f(xw.x), hi2f(xw.x), lo2f(xw.y), hi2f(xw.y)}; }
        const f32x4 xn = xv + acc[i][j];
        if (l == NL - 1) *reinterpret_cast<f32x4*>(xout + tok * DM + f) = xn;
        else st4(xb2 + tok * DM + f, xn[0], xn[1], xn[2], xn[3]);
      }
    }
  }
}

DI void phase_tail(const Params& P, int l, char* lds, float* s_rstd, float* s_prep) {
  for (int tt = blockIdx.x; tt < 512; tt += gridDim.x) {
    glu_tile(P, l, tt, lds);
    asm volatile("s_waitcnt vmcnt(0)" ::: "memory");
    __syncthreads();
    outproj_tile(P, l, tt, lds);
    if (l + 1 < NL) {
      asm volatile("s_waitcnt vmcnt(0)" ::: "memory");
      __syncthreads();
      inproj_tile(P, l + 1, tt, lds, s_rstd, s_prep);
    }
  }
}

DI void gbar(unsigned* ctr, unsigned& epoch) {
  asm volatile("s_waitcnt vmcnt(0)" ::: "memory");
  __syncthreads();
  epoch += gridDim.x;
  if (threadIdx.x == 0) {
    __builtin_amdgcn_fence(__ATOMIC_RELEASE, "agent");
    asm volatile("s_waitcnt vmcnt(0)" ::: "memory");
    __hip_atomic_fetch_add(ctr, 1u, __ATOMIC_RELAXED, __HIP_MEMORY_SCOPE_AGENT);
    while (__hip_atomic_load(ctr, __ATOMIC_RELAXED, __HIP_MEMORY_SCOPE_AGENT) < epoch) __builtin_amdgcn_s_sleep(1);
    __builtin_amdgcn_fence(__ATOMIC_ACQUIRE, "agent");
    asm volatile("s_waitcnt vmcnt(0)" ::: "memory");
  }
  __syncthreads();
}

__global__ void __launch_bounds__(256, 2) fwd_megakernel(Params P) {
  cg::grid_group grid = cg::this_grid();
  __shared__ __attribute__((aligned(16))) float lds_f[2 * G_BUF_BYTES / 4];
  static_assert(2 * G_BUF_BYTES >= 4 * SC_STRIDE * 4, "lds");
  __shared__ int s_item;
  __shared__ float s_rstd[128];
  __shared__ float s_prep[512];
  const long gtid = (long)blockIdx.x * 256 + threadIdx.x, gsz = (long)gridDim.x * 256;

  if (blockIdx.x == 0 && threadIdx.x < 64) ((unsigned*)(P.ws + O_CTR))[threadIdx.x] = 0u;
  phase_w0(P, gtid, gsz);
  grid.sync();
  unsigned* bar = (unsigned*)(P.ws + O_CTR) + 32;
  unsigned epoch = 0u;
  phase_w1(P, gtid, gsz);
#ifdef DUP_W
  phase_w0(P, gtid, gsz);
  phase_w1(P, gtid, gsz);
#endif

  for (int tt = blockIdx.x; tt < 512; tt += gridDim.x) {
    {
      const float* x = P.in[0]; u16* xb = (u16*)(P.ws + O_XB2);
      const int tid = opaque_tid();
#pragma unroll 4
      for (int e = tid; e < 128 * 256; e += 256) {
        const float4 v = *reinterpret_cast<const float4*>(x + (size_t)tt * 128 * DM + (size_t)e * 4);
        st4(xb + (size_t)tt * 128 * DM + (size_t)e * 4, v.x, v.y, v.z, v.w);
      }
    }
    asm volatile("s_waitcnt vmcnt(0)" ::: "memory");
    __syncthreads();
    inproj_tile(P, 0, tt, (char*)lds_f, s_rstd, s_prep);
  }
  gbar(bar, epoch);
  for (int l = 0; l < NL; ++l) {
    {
      unsigned* ctr = (unsigned*)(P.ws + O_CTR) + l * 2;
      for (;;) {
        const int tid = opaque_tid();
        if (tid == 0) s_item = (int)atomicAdd(ctr, 1u);
        __syncthreads();
        const int it = s_item;
        __syncthreads();
        if (it >= 256 + 3072 + 4096) break;
        const int wave = __builtin_amdgcn_readfirstlane(tid >> 6), lane = tid & 63;
        if (it < 256) s5_stage1_item(P, l, it, wave, lane);
        else if (it < 256 + 3072) mla_attn_item(P, it - 256, (char*)lds_f, tid);
        else {
#pragma unroll 1
          for (int k = 0; k < 4; ++k) dsa_select_item(P, (it - 256 - 3072) * 4 + k, lds_f, wave, lane);
        }
      }
    }
    gbar(bar, epoch);
    {
      unsigned* ctr = (unsigned*)(P.ws + O_CTR) + l * 2 + 1;
      for (;;) {
        const int tid = opaque_tid();
        if (tid == 0) s_item = (int)atomicAdd(ctr, 1u);
        __syncthreads();
        const int it = s_item;
        __syncthreads();
        if (it >= 256 + 2048) break;
        const int wave = __builtin_amdgcn_readfirstlane(tid >> 6), lane = tid & 63;
        if (it < 256) s5_stage3_item(P, l, it, (u16*)lds_f, wave, lane);
        else dsa_attn_item(P, it - 256, (char*)lds_f, tid);
      }
    }
    gbar(bar, epoch);
    phase_tail(P, l, (char*)lds_f, s_rstd, s_prep);
    if (l + 1 < NL) gbar(bar, epoch);
  }
}

extern "C" void kernel_launch(void* const* d_in, const int* in_sizes, int n_in, void* d_out, int out_size, void* d_ws, size_t ws_size,
                              hipStream_t stream) {
  static int grid_blocks = 0;
  if (!grid_blocks) {
    int dev = 0, cus = 0, per_cu = 0;
    hipGetDevice(&dev);
    hipDeviceGetAttribute(&cus, hipDeviceAttributeMultiprocessorCount, dev);
    hipOccupancyMaxActiveBlocksPerMultiprocessor(&per_cu, fwd_megakernel, 256, 0);
    if (per_cu < 1) per_cu = 1;
    if (per_cu > 2) per_cu = 2;
    grid_blocks = cus * per_cu;
    if (ws_size < O_END) fprintf(stderr, "workspace too small: %zu < %zu\n", ws_size, (size_t)O_END);
  }
  Params p{};
  for (int i = 0; i < 21; ++i) p.in[i] = (const float*)d_in[i];
  p.out = (float*)d_out;
  p.ws = (char*)d_ws;
  void* args[] = {&p};
  hipError_t e = hipLaunchCooperativeKernel((void*)fwd_megakernel, dim3(grid_blocks), dim3(256), args, 0, stream);
  if (e != hipSuccess) fprintf(stderr, "cooperative launch failed: %s (grid %d)\n", hipGetErrorString(e), grid_blocks);
}
```

```cpp
#include <hip/hip_runtime.h>
#include <hip/hip_cooperative_groups.h>
#include <cstdio>
#include <type_traits>
namespace cg = cooperative_groups;

#define DI __device__ __forceinline__
typedef __attribute__((ext_vector_type(8))) short bf16x8;
typedef __attribute__((ext_vector_type(4))) short s16x4;
typedef __attribute__((ext_vector_type(4))) float f32x4;
typedef unsigned short u16;
typedef unsigned long long u64;

constexpr int NB = 16, S = 4096, T = NB * S, DM = 1024, DIN = 2504, DINP = 2560, NL = 4;
constexpr int C_QA = 0, C_KA = 384, C_VA = 448, C_IQ = 512, C_IK = 768, C_IW = 800, C_GA = 808, C_U = 1192,
              C_GB = 1448, C_CQ = 1704, C_CKV = 1960, C_KPE = 2088, C_GC = 2120;
constexpr float EPS = 1e-6f;
constexpr float LOG2E = 1.4426950408889634f;

constexpr size_t O_WTIN = 0;
constexpr size_t O_WTOUT = O_WTIN + (size_t)NL * DINP * DM * 2;
constexpr size_t O_WTUQ = O_WTOUT + (size_t)NL * DM * DM * 2;
constexpr size_t O_WTUKV = O_WTUQ + (size_t)NL * 768 * 256 * 2;
constexpr size_t O_WTGLU = O_WTUKV + (size_t)NL * 768 * 128 * 2;
constexpr size_t O_W1 = O_WTGLU + (size_t)NL * 256 * 256 * 2;
constexpr size_t O_W3 = O_W1 + (size_t)NL * 16 * 128 * 1024 * 2;
constexpr size_t O_KT = O_W3 + (size_t)NL * 16 * 1024 * 128 * 2;
constexpr size_t O_PW = O_KT + (size_t)NL * 16 * 64 * 256 * 2;
constexpr size_t O_FZ = O_PW + (size_t)NL * 16 * 65 * 64 * 8;
constexpr size_t O_R64 = O_FZ + (size_t)NL * 16 * 64 * 8;
constexpr size_t O_R32 = O_R64 + (size_t)4096 * 32 * 8;
constexpr size_t O_XB = O_R32 + (size_t)4096 * 16 * 8;
constexpr size_t O_RSTD = O_XB + (size_t)T * 1024 * 2;
constexpr size_t O_PROJ = O_RSTD + (size_t)T * 4;
constexpr size_t O_MQ = O_PROJ + (size_t)T * DINP * 2;
constexpr size_t O_MK = O_MQ + (size_t)T * 576 * 2;
constexpr size_t O_MVT = O_MK + (size_t)T * 576 * 2;
constexpr size_t O_AVT = O_MVT + (size_t)T * 384 * 2;
constexpr size_t O_MASK = O_AVT + (size_t)T * 64 * 2;
constexpr size_t O_S5S = O_MASK + (size_t)T * 512;
constexpr size_t O_YG = O_S5S + (size_t)16 * 16 * 64 * 128 * 4;
constexpr size_t O_CTR = O_YG + (size_t)T * 256 * 2;
constexpr size_t O_XB2 = O_CTR + 256;
constexpr size_t O_END = O_XB2 + (size_t)T * 1024 * 2;

struct Params {
  const float* in[21];
  float* out;
  char* ws;
};

DI int opaque_tid() { int t = threadIdx.x; asm volatile("" : "+v"(t)); return t; }
DI u16 f2bf(float f) { unsigned u = __float_as_uint(f); u += 0x7fffu + ((u >> 16) & 1u); return (u16)(u >> 16); }
DI float bf2f(u16 h) { return __uint_as_float(((unsigned)h) << 16); }
typedef __attribute__((ext_vector_type(2))) __bf16 bf16x2_t;
typedef __attribute__((ext_vector_type(2))) float f32x2_t;
DI unsigned pack2(float a, float b) { return __builtin_bit_cast(unsigned, __builtin_convertvector((f32x2_t){a, b}, bf16x2_t)); }
DI float lo2f(unsigned w) { return __uint_as_float(w << 16); }
DI float hi2f(unsigned w) { return __uint_as_float(w & 0xffff0000u); }
DI bf16x8 ld8(const u16* p) { return *reinterpret_cast<const bf16x8*>(p); }
DI uint2 ld4(const u16* p) { return *reinterpret_cast<const uint2*>(p); }
DI void st4(u16* p, float a, float b, float c, float d) { uint2 v; v.x = pack2(a, b); v.y = pack2(c, d); *reinterpret_cast<uint2*>(p) = v; }
DI f32x4 mfma16(bf16x8 a, bf16x8 b, f32x4 c) { return __builtin_amdgcn_mfma_f32_16x16x32_bf16(a, b, c, 0, 0, 0); }
DI float fexp2(float x) { return __builtin_amdgcn_exp2f(x); }
DI float sigmoidf_(float x) { return __builtin_amdgcn_rcpf(1.0f + __expf(-x)); }
DI float siluf_(float x) { return x * sigmoidf_(x); }
DI float geluf_(float x) { float u = 0.7978845608028654f * (x + 0.044715f * x * x * x); return x * sigmoidf_(2.0f * u); }
DI float red4(float v) { v += __shfl_xor(v, 16); v += __shfl_xor(v, 32); return v; }

template <int AT, int BT, class FA, class FB>
DI void wgemm(f32x4 (&acc)[AT][BT], int ksteps, FA fa, FB fb) {
  bf16x8 a0[AT], b0[BT], a1[AT], b1[BT];
  const int k1 = (ksteps > 1) ? 1 : 0;
#pragma unroll
  for (int i = 0; i < AT; ++i) { a0[i] = fa(i, 0); a1[i] = fa(i, k1); }
#pragma unroll
  for (int j = 0; j < BT; ++j) { b0[j] = fb(j, 0); b1[j] = fb(j, k1); }
  for (int ks = 0; ks < ksteps; ++ks) {
    bf16x8 a2[AT], b2[BT];
    const int kn = (ks + 2 < ksteps) ? ks + 2 : ksteps - 1;
#pragma unroll
    for (int i = 0; i < AT; ++i) a2[i] = fa(i, kn);
#pragma unroll
    for (int j = 0; j < BT; ++j) b2[j] = fb(j, kn);
    __builtin_amdgcn_sched_barrier(0);
#pragma unroll
    for (int i = 0; i < AT; ++i)
#pragma unroll
      for (int j = 0; j < BT; ++j) acc[i][j] = mfma16(a0[i], b0[j], acc[i][j]);
    __builtin_amdgcn_sched_barrier(0);
#pragma unroll
    for (int i = 0; i < AT; ++i) { a0[i] = a1[i]; a1[i] = a2[i]; }
#pragma unroll
    for (int j = 0; j < BT; ++j) { b0[j] = b1[j]; b1[j] = b2[j]; }
  }
}

constexpr int GROW = 72;
constexpr int G_TILE_BYTES = 128 * GROW * 2;
constexpr int G_BUF_BYTES = 2 * G_TILE_BYTES;
DI void gemm_block(f32x4 (&acc)[4][4], const u16* Ap, int lda, const u16* Bp, int ldb, int K, char* lds, int tid, bool swap_w1 = false) {
  const int lane = tid & 63, q = lane >> 4, jn = lane & 15;
  const int wave = __builtin_amdgcn_readfirstlane(tid >> 6), wa = wave >> 1, wb = wave & 1;
  uint4 xa0, xa1, xa2, xa3, xb0, xb1, xb2, xb3;
  uint4 ya0, ya1, ya2, ya3, yb0, yb1, yb2, yb3;
  const int srow = tid >> 3, scol = tid & 7;
  const unsigned voa = (unsigned)(srow * lda + scol * 8) * 2u, vob = (unsigned)(srow * ldb + scol * 8) * 2u;
  const char* ag = reinterpret_cast<const char*>(Ap);
  const char* bg = reinterpret_cast<const char*>(Bp);
  char* st0 = lds + (srow * GROW + scol * 8) * 2;
  const bool sw = swap_w1 && (wa == 1);
  const char* a0p = sw ? (lds + G_TILE_BYTES + (wb * 64 + jn) * GROW * 2 + q * 16) : (lds + (wa * 64 + jn) * GROW * 2 + q * 16);
  const char* b0p = sw ? (lds + (wa * 64 + jn) * GROW * 2 + q * 16) : (lds + G_TILE_BYTES + (wb * 64 + jn) * GROW * 2 + q * 16);
#define GL(v, base, ld, vo, i, kt) v = *reinterpret_cast<const uint4*>(base + ((size_t)(32 * (i)) * (ld) + (size_t)(kt) * 64) * 2 + vo)
#define GLOAD0(kt) { GL(xa0, ag, lda, voa, 0, kt); GL(xa1, ag, lda, voa, 1, kt); GL(xa2, ag, lda, voa, 2, kt); GL(xa3, ag, lda, voa, 3, kt); GL(xb0, bg, ldb, vob, 0, kt); GL(xb1, bg, ldb, vob, 1, kt); GL(xb2, bg, ldb, vob, 2, kt); GL(xb3, bg, ldb, vob, 3, kt); }
#define GLOAD1(kt) { GL(ya0, ag, lda, voa, 0, kt); GL(ya1, ag, lda, voa, 1, kt); GL(ya2, ag, lda, voa, 2, kt); GL(ya3, ag, lda, voa, 3, kt); GL(yb0, bg, ldb, vob, 0, kt); GL(yb1, bg, ldb, vob, 1, kt); GL(yb2, bg, ldb, vob, 2, kt); GL(yb3, bg, ldb, vob, 3, kt); }
#define GS(v, off) *reinterpret_cast<uint4*>(st0 + (off)) = v
#define GSTORE0(buf) { GS(xa0, (buf) * G_BUF_BYTES); GS(xa1, (buf) * G_BUF_BYTES + 32 * GROW * 2); GS(xa2, (buf) * G_BUF_BYTES + 64 * GROW * 2); GS(xa3, (buf) * G_BUF_BYTES + 96 * GROW * 2); \
                       GS(xb0, (buf) * G_BUF_BYTES + G_TILE_BYTES); GS(xb1, (buf) * G_BUF_BYTES + G_TILE_BYTES + 32 * GROW * 2); GS(xb2, (buf) * G_BUF_BYTES + G_TILE_BYTES + 64 * GROW * 2); GS(xb3, (buf) * G_BUF_BYTES + G_TILE_BYTES + 96 * GROW * 2); }
#define GSTORE1(buf) { GS(ya0, (buf) * G_BUF_BYTES); GS(ya1, (buf) * G_BUF_BYTES + 32 * GROW * 2); GS(ya2, (buf) * G_BUF_BYTES + 64 * GROW * 2); GS(ya3, (buf) * G_BUF_BYTES + 96 * GROW * 2); \
                       GS(yb0, (buf) * G_BUF_BYTES + G_TILE_BYTES); GS(yb1, (buf) * G_BUF_BYTES + G_TILE_BYTES + 32 * GROW * 2); GS(yb2, (buf) * G_BUF_BYTES + G_TILE_BYTES + 64 * GROW * 2); GS(yb3, (buf) * G_BUF_BYTES + G_TILE_BYTES + 96 * GROW * 2); }
  auto compute = [&](int buf) {
#pragma unroll
    for (int ks = 0; ks < 2; ++ks) {
      bf16x8 a[4], b[4];
#pragma unroll
      for (int i = 0; i < 4; ++i) a[i] = *reinterpret_cast<const bf16x8*>(a0p + buf * G_BUF_BYTES + i * 16 * GROW * 2 + ks * 64);
#pragma unroll
      for (int j = 0; j < 4; ++j) b[j] = *reinterpret_cast<const bf16x8*>(b0p + buf * G_BUF_BYTES + j * 16 * GROW * 2 + ks * 64);
      __builtin_amdgcn_s_setprio(1);
#pragma unroll
      for (int i = 0; i < 4; ++i)
#pragma unroll
        for (int j = 0; j < 4; ++j) acc[i][j] = mfma16(a[i], b[j], acc[i][j]);
      __builtin_amdgcn_s_setprio(0);
    }
  };
  const int nkt = K >> 6;
  GLOAD0(0);
  GLOAD1(1);
  GSTORE0(0);
  __syncthreads();
  for (int kt = 0; kt < nkt; kt += 2) {
    if (kt + 2 < nkt) GLOAD0(kt + 2);
    compute(0);
    GSTORE1(1);
    __syncthreads();
    if (kt + 3 < nkt) GLOAD1(kt + 3);
    compute(1);
    if (kt + 2 < nkt) GSTORE0(0);
    __syncthreads();
  }
#undef GL
#undef GLOAD0
#undef GLOAD1
#undef GS
#undef GSTORE0
#undef GSTORE1
}

template <int A, int B>
DI void zero_acc(f32x4 (&acc)[A][B]) {
#pragma unroll
  for (int i = 0; i < A; ++i)
#pragma unroll
    for (int j = 0; j < B; ++j) acc[i][j] = f32x4{0.f, 0.f, 0.f, 0.f};
}

DI void sincos_d(double a, double& c, double& s) {
  const double TWO_PI = 6.283185307179586476925;
  double n = rint(a / TWO_PI);
  double r = a - n * TWO_PI;
  c = cos(r); s = sin(r);
}

DI void phase_w0(const Params& P, long gtid, long gsz) {
  char* ws = P.ws;
  {
    u16* dst = (u16*)(ws + O_WTIN);
    const float* w = P.in[2]; const float* g = P.in[1];
    for (long idx = gtid; idx < (long)NL * 128 * DINP; idx += gsz) {
      int n = (int)(idx % DINP); long r = idx / DINP; int kb = (int)(r % 128); int l = (int)(r / 128);
      float v[8];
#pragma unroll
      for (int j = 0; j < 8; ++j) { int k = kb * 8 + j; v[j] = (n < DIN) ? w[((size_t)l * DM + k) * DIN + n] * g[l * DM + k] : 0.f; }
      uint4 o; o.x = pack2(v[0], v[1]); o.y = pack2(v[2], v[3]); o.z = pack2(v[4], v[5]); o.w = pack2(v[6], v[7]);
      *reinterpret_cast<uint4*>(dst + ((size_t)l * DINP + n) * DM + kb * 8) = o;
    }
  }
  {
    u16* dst = (u16*)(ws + O_WTOUT);
    const float* w = P.in[20];
    for (long idx = gtid; idx < (long)NL * 128 * DM; idx += gsz) {
      int n = (int)(idx % DM); long r = idx / DM; int kb = (int)(r % 128); int l = (int)(r / 128);
      float v[8];
#pragma unroll
      for (int j = 0; j < 8; ++j) { int k = kb * 8 + j; v[j] = w[((size_t)l * DM + k) * DM + n]; }
      uint4 o; o.x = pack2(v[0], v[1]); o.y = pack2(v[2], v[3]); o.z = pack2(v[4], v[5]); o.w = pack2(v[6], v[7]);
      *reinterpret_cast<uint4*>(dst + ((size_t)l * DM + n) * DM + kb * 8) = o;
    }
  }
  {
    u16* dst = (u16*)(ws + O_WTUQ);
    const float* w = P.in[7]; const float* g = P.in[5];
    for (long idx = gtid; idx < (long)NL * 32 * 768; idx += gsz) {
      int n = (int)(idx % 768); long r = idx / 768; int kb = (int)(r % 32); int l = (int)(r / 32);
      const int h = n >> 7, d = n & 127;
      float v[8];
#pragma unroll
      for (int j = 0; j < 8; ++j) { int k = kb * 8 + j; v[j] = (d < 96) ? w[((size_t)l * 256 + k) * 576 + h * 96 + d] * g[l * 256 + k] : 0.f; }
      uint4 o; o.x = pack2(v[0], v[1]); o.y = pack2(v[2], v[3]); o.z = pack2(v[4], v[5]); o.w = pack2(v[6], v[7]);
      *reinterpret_cast<uint4*>(dst + ((size_t)l * 768 + n) * 256 + kb * 8) = o;
    }
  }
  {
    u16* dst = (u16*)(ws + O_WTUKV);
    const float* w = P.in[8]; const float* g = P.in[6];
    for (long idx = gtid; idx < (long)NL * 16 * 768; idx += gsz) {
      int n = (int)(idx % 768); long r = idx / 768; int kb = (int)(r % 16); int l = (int)(r / 16);
      float v[8];
#pragma unroll
      for (int j = 0; j < 8; ++j) { int k = kb * 8 + j; v[j] = w[((size_t)l * 128 + k) * 768 + n] * g[l * 128 + k]; }
      uint4 o; o.x = pack2(v[0], v[1]); o.y = pack2(v[2], v[3]); o.z = pack2(v[4], v[5]); o.w = pack2(v[6], v[7]);
      *reinterpret_cast<uint4*>(dst + ((size_t)l * 768 + n) * 128 + kb * 8) = o;
    }
  }
  {
    u16* dst = (u16*)(ws + O_WTGLU);
    const float* w = P.in[19];
    for (long idx = gtid; idx < (long)NL * 32 * 256; idx += gsz) {
      int n = (int)(idx % 256); long r = idx / 256; int kb = (int)(r % 32); int l = (int)(r / 32);
      float v[8];
#pragma unroll
      for (int j = 0; j < 8; ++j) { int k = kb * 8 + j; v[j] = w[((size_t)l * 256 + k) * 256 + n]; }
      uint4 o; o.x = pack2(v[0], v[1]); o.y = pack2(v[2], v[3]); o.z = pack2(v[4], v[5]); o.w = pack2(v[6], v[7]);
      *reinterpret_cast<uint4*>(dst + ((size_t)l * 256 + n) * 256 + kb * 8) = o;
    }
  }
  {
    float2* r64 = (float2*)(ws + O_R64);
    for (long idx = gtid; idx < 4096L * 32; idx += gsz) {
      int i = (int)(idx & 31); int pos = (int)(idx >> 5);
      float inv = (float)pow(10000.0, -(double)i / 32.0);
      float ang = (float)pos * inv;
      double c, s; sincos_d((double)ang, c, s);
      r64[idx] = make_float2((float)c, (float)s);
    }
    float2* r32 = (float2*)(ws + O_R32);
    for (long idx = gtid; idx < 4096L * 16; idx += gsz) {
      int i = (int)(idx & 15); int pos = (int)(idx >> 4);
      float inv = (float)pow(10000.0, -(double)i / 16.0);
      float ang = (float)pos * inv;
      double c, s; sincos_d((double)ang, c, s);
      r32[idx] = make_float2((float)c, (float)s);
    }
  }
  {
    float2* pw = (float2*)(ws + O_PW);
    float2* fz = (float2*)(ws + O_FZ);
    const float* a_re = P.in[11]; const float* a_im = P.in[12]; const float* lstep = P.in[18];
    for (long idx = gtid; idx < (long)NL * 16 * 65 * 64; idx += gsz) {
      int p = (int)(idx & 63); long r = idx >> 6; int d = (int)(r % 65); int lg = (int)(r / 65);
      double step = exp((double)lstep[lg]);
      double ar = (double)a_re[lg * 64 + p], ai = (double)a_im[lg * 64 + p];
      double mag = exp((double)d * ar * step);
      double c, s; sincos_d((double)d * ai * step, c, s);
      pw[idx] = make_float2((float)(mag * c), (float)(mag * s));
      if (d == 1) {
        double abr = mag * c, abi = mag * s;
        double den = ar * ar + ai * ai, nr = abr - 1.0;
        double fre = (nr * ar + abi * ai) / den, fim = (abi * ar - nr * ai) / den;
        fz[lg * 64 + p] = make_float2((float)fre, (float)fim);
      }
    }
  }
}

DI void phase_w1(const Params& P, long gtid, long gsz) {
  char* ws = P.ws;
  const float2* pw = (const float2*)(ws + O_PW);
  const float2* fz = (const float2*)(ws + O_FZ);
  const float* b_re = P.in[13]; const float* b_im = P.in[14]; const float* c_re = P.in[15]; const float* c_im = P.in[16];
  {
    u16* w1 = (u16*)(ws + O_W1);
    for (long idx = gtid; idx < (long)NL * 16 * 128 * 128; idx += gsz) {
      int kb = (int)(idx & 127); long r = idx >> 7; int row = (int)(r & 127); int lg = (int)(r >> 7);
      int p = row >> 1, ri = row & 1; int i = kb >> 1, c0 = (kb & 1) * 8;
      float2 e = pw[((size_t)lg * 65 + (63 - i)) * 64 + p]; float2 f = fz[lg * 64 + p];
      float er = e.x * f.x - e.y * f.y, ei = e.x * f.y + e.y * f.x;
      float v[8];
#pragma unroll
      for (int j = 0; j < 8; ++j) {
        float br = b_re[((size_t)lg * 64 + p) * 16 + c0 + j], bi = b_im[((size_t)lg * 64 + p) * 16 + c0 + j];
        v[j] = ri ? (er * bi + ei * br) : (er * br - ei * bi);
      }
      uint4 o; o.x = pack2(v[0], v[1]); o.y = pack2(v[2], v[3]); o.z = pack2(v[4], v[5]); o.w = pack2(v[6], v[7]);
      *reinterpret_cast<uint4*>(w1 + ((size_t)lg * 128 + row) * 1024 + kb * 8) = o;
    }
  }
  {
    u16* w3 = (u16*)(ws + O_W3);
    for (long idx = gtid; idx < (long)NL * 16 * 1024 * 16; idx += gsz) {
      int kb = (int)(idx & 15); long r = idx >> 4; int f = (int)(r & 1023); int lg = (int)(r >> 10);
      int j = f >> 4, c = f & 15;
      float v[8];
#pragma unroll
      for (int jj = 0; jj < 4; ++jj) {
        int p = kb * 4 + jj;
        float2 e = pw[((size_t)lg * 65 + (j + 1)) * 64 + p];
        float cr = c_re[((size_t)lg * 16 + c) * 64 + p], ci = c_im[((size_t)lg * 16 + c) * 64 + p];
        v[2 * jj] = cr * e.x - ci * e.y;
        v[2 * jj + 1] = -(cr * e.y + ci * e.x);
      }
      uint4 o; o.x = pack2(v[0], v[1]); o.y = pack2(v[2], v[3]); o.z = pack2(v[4], v[5]); o.w = pack2(v[6], v[7]);
      *reinterpret_cast<uint4*>(w3 + ((size_t)lg * 1024 + f) * 128 + kb * 8) = o;
    }
  }
  {
    u16* kt = (u16*)(ws + O_KT);
    for (long idx = gtid; idx < (long)NL * 16 * 64 * 16 * 2; idx += gsz) {
      int cb = (int)(idx & 1); long r = idx >> 1; int c = (int)(r & 15); r >>= 4; int d = (int)(r & 63); int lg = (int)(r >> 6);
      float v[8];
#pragma unroll
      for (int j = 0; j < 8; ++j) v[j] = 0.f;
      for (int p = 0; p < 64; ++p) {
        float2 e = pw[((size_t)lg * 65 + d) * 64 + p]; float2 f = fz[lg * 64 + p];
        float er = e.x * f.x - e.y * f.y, ei = e.x * f.y + e.y * f.x;
        float cr = c_re[((size_t)lg * 16 + c) * 64 + p], ci = c_im[((size_t)lg * 16 + c) * 64 + p];
        float gr = cr * er - ci * ei, gi = cr * ei + ci * er;
#pragma unroll
        for (int j = 0; j < 8; ++j) {
          float br = b_re[((size_t)lg * 64 + p) * 16 + cb * 8 + j], bi = b_im[((size_t)lg * 64 + p) * 16 + cb * 8 + j];
          v[j] += gr * br - gi * bi;
        }
      }
      uint4 o; o.x = pack2(v[0], v[1]); o.y = pack2(v[2], v[3]); o.z = pack2(v[4], v[5]); o.w = pack2(v[6], v[7]);
      *reinterpret_cast<uint4*>(kt + (((size_t)lg * 64 + d) * 16 + c) * 16 + cb * 8) = o;
    }
  }
}

DI void phase_p0(const Params& P, int l) {
  const float* x = (l == 0) ? P.in[0] : P.out;
  u16* xb = (u16*)(P.ws + O_XB2);
  const int tid = opaque_tid();
  const int lane = tid & 63;
  const int gw = blockIdx.x * 4 + (tid >> 6), nw = gridDim.x * 4;
  for (int row = gw; row < T; row += nw) {
    const float4* xr = reinterpret_cast<const float4*>(x + (size_t)row * DM);
#pragma unroll
    for (int i = 0; i < 4; ++i) {
      float4 v = xr[i * 64 + lane];
      st4(xb + (size_t)row * DM + (i * 64 + lane) * 4, v.x, v.y, v.z, v.w);
    }
  }
}

DI void prep_mla_q(const Params& P, int l, int tw0, int lane) {
  const int q = lane >> 4, jn = lane & 15;
  const u16* proj = (const u16*)(P.ws + O_PROJ);
  const u16* W = (const u16*)(P.ws + O_WTUQ) + (size_t)l * 576 * 256;
  u16* mq = (u16*)(P.ws + O_MQ);
  const float2* r32 = (const float2*)(P.ws + O_R32);
  const float* gq = P.in[9] + l * 96;
  const u16* bp = proj + (size_t)(tw0 + jn) * DINP + C_CQ + q * 8;
  float rq[2];
#pragma unroll
  for (int t = 0; t < 2; ++t) {
    float ss = 0.f;
    for (int ks = 0; ks < 8; ++ks) {
      bf16x8 v = ld8(bp + (size_t)t * 16 * DINP + ks * 32);
#pragma unroll
      for (int j = 0; j < 8; ++j) { float f = bf2f((u16)v[j]); ss += f * f; }
    }
    ss = red4(ss);
    rq[t] = rsqrtf(ss * (1.0f / 256) + EPS);
  }
  const float qscale = 0.10206207261596577f * LOG2E;
  for (int h = 0; h < 6; ++h) {
    f32x4 acc[6][2]; zero_acc(acc);
    const u16* ap = W + (size_t)(h * 96 + jn) * 256 + q * 8;
    wgemm<6, 2>(acc, 8, [&](int i, int ks) { return ld8(ap + (size_t)i * 16 * 256 + ks * 32); },
                [&](int j, int ks) { return ld8(bp + (size_t)j * 16 * DINP + ks * 32); });
#pragma unroll
    for (int t = 0; t < 2; ++t) {
      const int tok = tw0 + 16 * t + jn, pos = tok & (S - 1);
      float ss = 0.f;
#pragma unroll
      for (int i = 0; i < 6; ++i)
#pragma unroll
        for (int r = 0; r < 4; ++r) { float v = acc[i][t][r] * rq[t]; acc[i][t][r] = v; ss += v * v; }
      ss = red4(ss);
      const float rs = rsqrtf(ss * (1.0f / 96) + EPS);
#pragma unroll
      for (int i = 0; i < 6; ++i)
#pragma unroll
        for (int r = 0; r < 4; ++r) acc[i][t][r] *= rs * gq[16 * i + 4 * q + r];
#pragma unroll
      for (int r = 0; r < 4; ++r) {
        float2 cs = r32[pos * 16 + 4 * q + r];
        float x1 = acc[4][t][r], x2 = acc[5][t][r];
        acc[4][t][r] = x1 * cs.x - x2 * cs.y; acc[5][t][r] = x2 * cs.x + x1 * cs.y;
      }
#pragma unroll
      for (int i = 0; i < 6; ++i)
        st4(mq + (size_t)tok * 576 + h * 96 + 16 * i + 4 * q, acc[i][t][0] * qscale, acc[i][t][1] * qscale, acc[i][t][2] * qscale, acc[i][t][3] * qscale);
    }
  }
}

DI void prep_mla_kv(const Params& P, int l, int tw0, int lane) {
  const int q = lane >> 4, jn = lane & 15;
  const u16* proj = (const u16*)(P.ws + O_PROJ);
  const u16* W = (const u16*)(P.ws + O_WTUKV) + (size_t)l * 768 * 128;
  u16* mk = (u16*)(P.ws + O_MK);
  u16* mvt = (u16*)(P.ws + O_MVT);
  const float2* r32 = (const float2*)(P.ws + O_R32);
  const float* gk = P.in[10] + l * 96;
  const u16* bp = proj + (size_t)(tw0 + jn) * DINP + C_CKV + q * 8;
  const int b = tw0 >> 12, pos0 = tw0 & (S - 1);
  float rkv[2];
#pragma unroll
  for (int t = 0; t < 2; ++t) {
    float ss = 0.f;
    for (int ks = 0; ks < 4; ++ks) {
      bf16x8 v = ld8(bp + (size_t)t * 16 * DINP + ks * 32);
#pragma unroll
      for (int j = 0; j < 8; ++j) { float f = bf2f((u16)v[j]); ss += f * f; }
    }
    ss = red4(ss);
    rkv[t] = rsqrtf(ss * (1.0f / 128) + EPS);
  }
  for (int h = 0; h < 6; ++h) {
    {
      f32x4 acc[4][2]; zero_acc(acc);
      const u16* ap = W + (size_t)(h * 128 + jn) * 128 + q * 8;
      wgemm<4, 2>(acc, 4, [&](int i, int ks) { return ld8(ap + (size_t)i * 16 * 128 + ks * 32); },
                  [&](int j, int ks) { return ld8(bp + (size_t)j * 16 * DINP + ks * 32); });
#pragma unroll
      for (int t = 0; t < 2; ++t) {
        const int tok = tw0 + 16 * t + jn, pos = tok & (S - 1);
        uint2 pl = ld4(proj + (size_t)tok * DINP + C_KPE + 4 * q);
        uint2 ph = ld4(proj + (size_t)tok * DINP + C_KPE + 16 + 4 * q);
        float kl[4] = {lo2f(pl.x), hi2f(pl.x), lo2f(pl.y), hi2f(pl.y)};
        float kh[4] = {lo2f(ph.x), hi2f(ph.x), lo2f(ph.y), hi2f(ph.y)};
        float ss = 0.f;
#pragma unroll
        for (int i = 0; i < 4; ++i)
#pragma unroll
          for (int r = 0; r < 4; ++r) { float v = acc[i][t][r] * rkv[t]; acc[i][t][r] = v; ss += v * v; }
#pragma unroll
        for (int r = 0; r < 4; ++r) ss += kl[r] * kl[r] + kh[r] * kh[r];
        ss = red4(ss);
        const float rs = rsqrtf(ss * (1.0f / 96) + EPS);
#pragma unroll
        for (int i = 0; i < 4; ++i) {
          const int d = 16 * i + 4 * q;
          st4(mk + (size_t)tok * 576 + h * 96 + d, acc[i][t][0] * rs * gk[d], acc[i][t][1] * rs * gk[d + 1], acc[i][t][2] * rs * gk[d + 2], acc[i][t][3] * rs * gk[d + 3]);
        }
        float y1[4], y2[4];
#pragma unroll
        for (int r = 0; r < 4; ++r) {
          float2 cs = r32[pos * 16 + 4 * q + r];
          float x1 = kl[r] * rs * gk[64 + 4 * q + r], x2 = kh[r] * rs * gk[80 + 4 * q + r];
          y1[r] = x1 * cs.x - x2 * cs.y; y2[r] = x2 * cs.x + x1 * cs.y;
        }
        st4(mk + (size_t)tok * 576 + h * 96 + 64 + 4 * q, y1[0], y1[1], y1[2], y1[3]);
        st4(mk + (size_t)tok * 576 + h * 96 + 80 + 4 * q, y2[0], y2[1], y2[2], y2[3]);
      }
    }
    {
      f32x4 acc[2][4]; zero_acc(acc);
      const u16* wp = W + (size_t)(h * 128 + 64 + jn) * 128 + q * 8;
      wgemm<2, 4>(acc, 4, [&](int i, int ks) { return ld8(bp + (size_t)i * 16 * DINP + ks * 32); },
                  [&](int j, int ks) { return ld8(wp + (size_t)j * 16 * 128 + ks * 32); });
#pragma unroll
      for (int i = 0; i < 2; ++i) {
        float rr[4];
#pragma unroll
        for (int r = 0; r < 4; ++r) rr[r] = __shfl(rkv[i], 4 * q + r);
#pragma unroll
        for (int j = 0; j < 4; ++j)
          st4(mvt + ((size_t)(b * 6 + h) * 64 + 16 * j + jn) * S + pos0 + 16 * i + 4 * q,
              acc[i][j][0] * rr[0], acc[i][j][1] * rr[1], acc[i][j][2] * rr[2], acc[i][j][3] * rr[3]);
      }
    }
  }
}

DI void prep_mla_tile(const Params& P, int l, int tt, char* lds, float* s_r, float* s_ss) {
  const int tid = opaque_tid();
  const int wave = __builtin_amdgcn_readfirstlane(tid >> 6), lane = tid & 63, q = lane >> 4, jn = lane & 15;
  const int wa = wave >> 1, wb = wave & 1;
  const int tok0 = tt * 128;
  const u16* proj = (const u16*)(P.ws + O_PROJ);
  const u16* Wq = (const u16*)(P.ws + O_WTUQ) + (size_t)l * 768 * 256;
  const u16* Wkv = (const u16*)(P.ws + O_WTUKV) + (size_t)l * 768 * 128;
  u16* mq = (u16*)(P.ws + O_MQ); u16* mk = (u16*)(P.ws + O_MK); u16* mvt = (u16*)(P.ws + O_MVT);
  const float2* r32 = (const float2*)(P.ws + O_R32);
  const float* gq = P.in[9] + l * 96; const float* gk = P.in[10] + l * 96;
  {
    const int row = tid >> 1, half = tid & 1;
    const u16* pq = proj + (size_t)(tok0 + row) * DINP + C_CQ + half * 128;
    const u16* pk = proj + (size_t)(tok0 + row) * DINP + C_CKV + half * 64;
    bf16x8 vq[16], vk[8];
#pragma unroll
    for (int u = 0; u < 16; ++u) vq[u] = ld8(pq + u * 8);
#pragma unroll
    for (int u = 0; u < 8; ++u) vk[u] = ld8(pk + u * 8);
    float sq = 0.f, sk = 0.f;
#pragma unroll
    for (int u = 0; u < 16; ++u)
#pragma unroll
      for (int j = 0; j < 8; ++j) { const float f = bf2f((u16)vq[u][j]); sq += f * f; }
#pragma unroll
    for (int u = 0; u < 8; ++u)
#pragma unroll
      for (int j = 0; j < 8; ++j) { const float f = bf2f((u16)vk[u][j]); sk += f * f; }
    sq += __shfl_xor(sq, 1); sk += __shfl_xor(sk, 1);
    if (half == 0) { s_r[row] = rsqrtf(sq * (1.0f / 256) + EPS); s_r[128 + row] = rsqrtf(sk * (1.0f / 128) + EPS); }
  }
  __syncthreads();
  const float qscale = 0.10206207261596577f * LOG2E;
#pragma unroll 1
  for (int h0 = 0; h0 < 6; ++h0) {
    int h = h0; asm volatile("" : "+s"(h));
    f32x4 acc[4][4]; zero_acc(acc);
    gemm_block(acc, Wq + (size_t)(h * 128) * 256, 256, proj + (size_t)tok0 * DINP + C_CQ, DINP, 256, lds, tid);
#pragma unroll
    for (int j = 0; j < 4; ++j) {
      const int tl = wb * 64 + 16 * j + jn; const float rq = s_r[tl];
      float ss = 0.f;
#pragma unroll
      for (int i = 0; i < 4; ++i)
#pragma unroll
        for (int r = 0; r < 4; ++r) { const float v = acc[i][j][r] * rq; acc[i][j][r] = v; ss += v * v; }
      ss = red4(ss);
      if (q == 0) s_ss[wa * 128 + tl] = ss;
    }
    __syncthreads();
#pragma unroll
    for (int j = 0; j < 4; ++j) {
      const int tl = wb * 64 + 16 * j + jn, tok = tok0 + tl, pos = tok & (S - 1);
      const float rs = rsqrtf((s_ss[tl] + s_ss[128 + tl]) * (1.0f / 96) + EPS);
      if (wa == 0) {
#pragma unroll
        for (int i = 0; i < 4; ++i) {
          const int d = 16 * i + 4 * q;
          st4(mq + (size_t)tok * 576 + h * 96 + d, acc[i][j][0] * rs * gq[d] * qscale, acc[i][j][1] * rs * gq[d + 1] * qscale,
              acc[i][j][2] * rs * gq[d + 2] * qscale, acc[i][j][3] * rs * gq[d + 3] * qscale);
        }
      } else {
        float y1[4], y2[4];
#pragma unroll
        for (int r = 0; r < 4; ++r) {
          const float2 cs = r32[pos * 16 + 4 * q + r];
          const float x1 = acc[0][j][r] * rs * gq[64 + 4 * q + r], x2 = acc[1][j][r] * rs * gq[80 + 4 * q + r];
          y1[r] = (x1 * cs.x - x2 * cs.y) * qscale; y2[r] = (x2 * cs.x + x1 * cs.y) * qscale;
        }
        st4(mq + (size_t)tok * 576 + h * 96 + 64 + 4 * q, y1[0], y1[1], y1[2], y1[3]);
        st4(mq + (size_t)tok * 576 + h * 96 + 80 + 4 * q, y2[0], y2[1], y2[2], y2[3]);
      }
    }
    __syncthreads();
  }
  const int b = tok0 >> 12, pos0 = tok0 & (S - 1);
#pragma unroll 1
  for (int h0 = 0; h0 < 6; ++h0) {
    int h = h0; asm volatile("" : "+s"(h));
    f32x4 acc[4][4]; zero_acc(acc);
    gemm_block(acc, Wkv + (size_t)(h * 128) * 128, 128, proj + (size_t)tok0 * DINP + C_CKV, DINP, 128, lds, tid, true);
    if (wa == 0) {
#pragma unroll
      for (int j = 0; j < 4; ++j) {
        const int tl = wb * 64 + 16 * j + jn, tok = tok0 + tl, pos = tok & (S - 1);
        const float rkv = s_r[128 + tl];
        const uint2 pl = ld4(proj + (size_t)tok * DINP + C_KPE + 4 * q);
        const uint2 ph = ld4(proj + (size_t)tok * DINP + C_KPE + 16 + 4 * q);
        const float kl[4] = {lo2f(pl.x), hi2f(pl.x), lo2f(pl.y), hi2f(pl.y)};
        const float kh[4] = {lo2f(ph.x), hi2f(ph.x), lo2f(ph.y), hi2f(ph.y)};
        float ss = 0.f;
#pragma unroll
        for (int i = 0; i < 4; ++i)
#pragma unroll
          for (int r = 0; r < 4; ++r) { const float v = acc[i][j][r] * rkv; acc[i][j][r] = v; ss += v * v; }
#pragma unroll
        for (int r = 0; r < 4; ++r) ss += kl[r] * kl[r] + kh[r] * kh[r];
        ss = red4(ss);
        const float rs = rsqrtf(ss * (1.0f / 96) + EPS);
#pragma unroll
        for (int i = 0; i < 4; ++i) {
          const int d = 16 * i + 4 * q;
          st4(mk + (size_t)tok * 576 + h * 96 + d, acc[i][j][0] * rs * gk[d], acc[i][j][1] * rs * gk[d + 1], acc[i][j][2] * rs * gk[d + 2], acc[i][j][3] * rs * gk[d + 3]);
        }
        float y1[4], y2[4];
#pragma unroll
        for (int r = 0; r < 4; ++r) {
          const float2 cs = r32[pos * 16 + 4 * q + r];
          const float x1 = kl[r] * rs * gk[64 + 4 * q + r], x2 = kh[r] * rs * gk[80 + 4 * q + r];
          y1[r] = x1 * cs.x - x2 * cs.y; y2[r] = x2 * cs.x + x1 * cs.y;
        }
        st4(mk + (size_t)tok * 576 + h * 96 + 64 + 4 * q, y1[0], y1[1], y1[2], y1[3]);
        st4(mk + (size_t)tok * 576 + h * 96 + 80 + 4 * q, y2[0], y2[1], y2[2], y2[3]);
      }
    } else {
#pragma unroll
      for (int i = 0; i < 4; ++i) {
        const int tl0 = wb * 64 + 16 * i + 4 * q;
        const float r0 = s_r[128 + tl0], r1 = s_r[128 + tl0 + 1], r2 = s_r[128 + tl0 + 2], r3 = s_r[128 + tl0 + 3];
#pragma unroll
        for (int j = 0; j < 4; ++j)
          st4(mvt + ((size_t)(b * 6 + h) * 64 + 16 * j + jn) * S + pos0 + tl0, acc[i][j][0] * r0, acc[i][j][1] * r1, acc[i][j][2] * r2, acc[i][j][3] * r3);
      }
    }
  }
}

DI void prep_dsa(const Params& P, int l, int tok0) {
  u16* proj = (u16*)(P.ws + O_PROJ);
  u16* avt = (u16*)(P.ws + O_AVT);
  const float2* r64 = (const float2*)(P.ws + O_R64);
  const float2* r32 = (const float2*)(P.ws + O_R32);
  const int tid = opaque_tid();
  for (int task = tid; task < 512; task += 256) {
    const int tok = tok0 + (task >> 2), c = task & 3, pos = tok & (S - 1);
    u16* row = proj + (size_t)tok * DINP;
    bf16x8 lo[7], hi[7];
#pragma unroll
    for (int hh = 0; hh < 7; ++hh) {
      const int base = (hh < 6) ? C_QA + 64 * hh : C_KA;
      lo[hh] = ld8(row + base + 8 * c); hi[hh] = ld8(row + base + 32 + 8 * c);
    }
    float2 cs[8];
    float gql[8], gqh[8], gkl[8], gkh[8];
    const float* gq = P.in[3] + l * 64; const float* gk = P.in[4] + l * 64;
#pragma unroll
    for (int j = 0; j < 8; ++j) {
      cs[j] = r64[pos * 32 + 8 * c + j];
      gql[j] = gq[8 * c + j]; gqh[j] = gq[32 + 8 * c + j]; gkl[j] = gk[8 * c + j]; gkh[j] = gk[32 + 8 * c + j];
    }
#pragma unroll
    for (int hh = 0; hh < 7; ++hh) {
      const int base = (hh < 6) ? C_QA + 64 * hh : C_KA;
      float xl[8], xh[8];
      float ss = 0.f;
#pragma unroll
      for (int j = 0; j < 8; ++j) { xl[j] = bf2f((u16)lo[hh][j]); xh[j] = bf2f((u16)hi[hh][j]); ss += xl[j] * xl[j] + xh[j] * xh[j]; }
      ss += __shfl_xor(ss, 1); ss += __shfl_xor(ss, 2);
      const float rs = rsqrtf(ss * (1.0f / 64) + EPS);
      const float sc = (hh < 6) ? 0.125f * LOG2E : 1.0f;
      float y1[8], y2[8];
#pragma unroll
      for (int j = 0; j < 8; ++j) {
        const float x1 = xl[j] * rs * ((hh < 6) ? gql[j] : gkl[j]), x2 = xh[j] * rs * ((hh < 6) ? gqh[j] : gkh[j]);
        y1[j] = (x1 * cs[j].x - x2 * cs[j].y) * sc; y2[j] = (x2 * cs[j].x + x1 * cs[j].y) * sc;
      }
      uint4 o; o.x = pack2(y1[0], y1[1]); o.y = pack2(y1[2], y1[3]); o.z = pack2(y1[4], y1[5]); o.w = pack2(y1[6], y1[7]);
      *reinterpret_cast<uint4*>(row + base + 8 * c) = o;
      o.x = pack2(y2[0], y2[1]); o.y = pack2(y2[2], y2[3]); o.z = pack2(y2[4], y2[5]); o.w = pack2(y2[6], y2[7]);
      *reinterpret_cast<uint4*>(row + base + 32 + 8 * c) = o;
    }
  }
  {
    const int tok = tok0 + (tid >> 1), c2 = tid & 1, pos = tok & (S - 1);
    u16* row = proj + (size_t)tok * DINP;
    bf16x8 lo[9], hi[9];
#pragma unroll
    for (int hh = 0; hh < 9; ++hh) {
      const int base = (hh < 8) ? C_IQ + 32 * hh : C_IK;
      lo[hh] = ld8(row + base + 8 * c2); hi[hh] = ld8(row + base + 16 + 8 * c2);
    }
    float2 cs[8];
#pragma unroll
    for (int j = 0; j < 8; ++j) cs[j] = r32[pos * 16 + 8 * c2 + j];
#pragma unroll
    for (int hh = 0; hh < 9; ++hh) {
      const int base = (hh < 8) ? C_IQ + 32 * hh : C_IK;
      float y1[8], y2[8];
#pragma unroll
      for (int j = 0; j < 8; ++j) {
        const float x1 = bf2f((u16)lo[hh][j]), x2 = bf2f((u16)hi[hh][j]);
        y1[j] = x1 * cs[j].x - x2 * cs[j].y; y2[j] = x2 * cs[j].x + x1 * cs[j].y;
      }
      uint4 o; o.x = pack2(y1[0], y1[1]); o.y = pack2(y1[2], y1[3]); o.z = pack2(y1[4], y1[5]); o.w = pack2(y1[6], y1[7]);
      *reinterpret_cast<uint4*>(row + base + 8 * c2) = o;
      o.x = pack2(y2[0], y2[1]); o.y = pack2(y2[2], y2[3]); o.z = pack2(y2[4], y2[5]); o.w = pack2(y2[6], y2[7]);
      *reinterpret_cast<uint4*>(row + base + 16 + 8 * c2) = o;
    }
  }
  {
    const int b = tok0 >> 12, pos0 = tok0 & (S - 1);
    const int dim = tid & 63, tg0 = tid >> 6;
    unsigned short v[8][4];
#pragma unroll
    for (int u = 0; u < 8; ++u) {
      const u16* p = proj + (size_t)(tok0 + 4 * (tg0 + 4 * u)) * DINP + C_VA + dim;
#pragma unroll
      for (int k = 0; k < 4; ++k) v[u][k] = p[k * DINP];
    }
#pragma unroll
    for (int u = 0; u < 8; ++u) {
      uint2 o; o.x = (unsigned)v[u][0] | ((unsigned)v[u][1] << 16); o.y = (unsigned)v[u][2] | ((unsigned)v[u][3] << 16);
      *reinterpret_cast<uint2*>(avt + ((size_t)b * 64 + dim) * S + pos0 + 4 * (tg0 + 4 * u)) = o;
    }
  }
}

DI void prep_tile(const Params& P, int l, int tile, char* lds, float* s_r) {
  const int tid = opaque_tid();
  const int wave = __builtin_amdgcn_readfirstlane(tid >> 6), lane = tid & 63;
  const int tok0 = tile * 128;
  prep_mla_tile(P, l, tile, lds, s_r, s_r + 256);
  prep_dsa(P, l, tok0);
}

DI void inproj_tile(const Params& P, int l, int tt, char* lds, float* s_rstd, float* s_prep) {
  const u16* W = (const u16*)(P.ws + O_WTIN) + (size_t)l * DINP * DM;
  const u16* xb = (const u16*)(P.ws + O_XB2);
  u16* proj = (u16*)(P.ws + O_PROJ);
  const int tid = opaque_tid();
  const int wave = __builtin_amdgcn_readfirstlane(tid >> 6), lane = tid & 63, q = lane >> 4, jn = lane & 15;
  {
    {
      const u16* rp = xb + (size_t)(tt * 128 + (tid >> 1)) * DM + (tid & 1) * 512;
      float ss = 0.f;
#pragma unroll 1
      for (int c = 0; c < 8; ++c) {
        bf16x8 v[8];
#pragma unroll
        for (int u = 0; u < 8; ++u) v[u] = ld8(rp + (c * 8 + u) * 8);
#pragma unroll
        for (int u = 0; u < 8; ++u)
#pragma unroll
          for (int j = 0; j < 8; ++j) { const float f = bf2f((u16)v[u][j]); ss += f * f; }
      }
      ss += __shfl_xor(ss, 1);
      if ((tid & 1) == 0) s_rstd[tid >> 1] = rsqrtf(ss * (1.0f / DM) + EPS);
    }
    __syncthreads();
#pragma unroll 1
    for (int ftile0 = 0; ftile0 < 20; ++ftile0) {
      int ftile = ftile0; asm volatile("" : "+s"(ftile));
      const int f0 = ftile * 128 + (wave >> 1) * 64, t0 = tt * 128 + (wave & 1) * 64;
      f32x4 acc[4][4]; zero_acc(acc);
      gemm_block(acc, W + (size_t)(ftile * 128) * DM, DM, xb + (size_t)(tt * 128) * DM, DM, DM, lds, tid);
#pragma unroll
      for (int j = 0; j < 4; ++j) {
        const int tok = t0 + 16 * j + jn; const float rs = s_rstd[(wave & 1) * 64 + 16 * j + jn];
#pragma unroll
        for (int i = 0; i < 4; ++i)
          st4(proj + (size_t)tok * DINP + f0 + 16 * i + 4 * q, acc[i][j][0] * rs, acc[i][j][1] * rs, acc[i][j][2] * rs, acc[i][j][3] * rs);
      }
    }
    asm volatile("s_waitcnt vmcnt(0)" ::: "memory");
    __syncthreads();
    prep_tile(P, l, tt, lds, s_prep);
    __syncthreads();
  }
}

DI void phase_inproj(const Params& P, int l, char* lds, float* s_rstd, float* s_prep) {
  for (int tt = blockIdx.x; tt < 512; tt += gridDim.x) inproj_tile(P, l, tt, lds, s_rstd, s_prep);
}

template <int KS, bool MASK>
DI void attn_block_v1(const u16* Qp, int qstride, const u16* Kp, int kstride, const u16* Vtp, const u64* maskp, int nkt_w, int nkt_max,
                   const u16* gatep, int gstride, u16* outp, int ostride, char* lds, int tid) {
  constexpr int DQK = KS * 32, KROW = DQK + 8, VROW = 72;
  constexpr int KCH = DQK / 8, NKC = 64 * KCH / 256;
  constexpr int K_BYTES = 64 * KROW * 2, BUF_BYTES = K_BYTES + 64 * VROW * 2;
  const int lane = tid & 63, q = lane >> 4, jn = lane & 15;
  const float NEG_INF = -__builtin_inff();
  uint4 kst[NKC], vst[2];
  auto gload = [&](int kt) {
#pragma unroll
    for (int i = 0; i < NKC; ++i) {
      const int c = tid + 256 * i, row = c / KCH, col = c % KCH;
      kst[i] = *reinterpret_cast<const uint4*>(Kp + (size_t)(kt * 64 + row) * kstride + col * 8);
    }
#pragma unroll
    for (int i = 0; i < 2; ++i) {
      const int c = tid + 256 * i, dim = c >> 3, part = c & 7;
      vst[i] = *reinterpret_cast<const uint4*>(Vtp + (size_t)dim * S + kt * 64 + part * 8);
    }
  };
  auto lstore = [&](int buf) {
    char* kb = lds + buf * BUF_BYTES; char* vb = kb + K_BYTES;
#pragma unroll
    for (int i = 0; i < NKC; ++i) {
      const int c = tid + 256 * i, row = c / KCH, col = c % KCH;
      *reinterpret_cast<uint4*>(kb + (row * KROW + col * 8) * 2) = kst[i];
    }
#pragma unroll
    for (int i = 0; i < 2; ++i) {
      const int c = tid + 256 * i, dim = c >> 3, part = c & 7;
      *reinterpret_cast<uint4*>(vb + (dim * VROW + part * 8) * 2) = vst[i];
    }
  };
  bf16x8 qf[2][KS];
#pragma unroll
  for (int c = 0; c < 2; ++c)
#pragma unroll
    for (int ks = 0; ks < KS; ++ks) qf[c][ks] = ld8(Qp + (size_t)(16 * c + jn) * qstride + ks * 32 + q * 8);
  f32x4 o[4][2]; zero_acc(o);
  float m[2] = {NEG_INF, NEG_INF}, lsum[2] = {0.f, 0.f};
  u64 mw[2] = {0ull, 0ull}, mwn[2] = {0ull, 0ull};
  if (MASK) {
#pragma unroll
    for (int c = 0; c < 2; ++c) mw[c] = maskp[(size_t)(16 * c + jn) * 64];
  }
  gload(0);
  lstore(0);
  __syncthreads();
  for (int kt = 0; kt < nkt_max; ++kt) {
    const bool more = kt + 1 < nkt_max;
    if (more) {
      gload(kt + 1);
      if (MASK) {
        if (kt + 1 < nkt_w) {
#pragma unroll
          for (int c = 0; c < 2; ++c) mwn[c] = maskp[(size_t)(16 * c + jn) * 64 + kt + 1];
        }
      }
    }
    if (kt < nkt_w) {
      const char* kb = lds + (kt & 1) * BUF_BYTES; const char* vb = kb + K_BYTES;
      f32x4 s[4][2]; zero_acc(s);
#pragma unroll
      for (int a = 0; a < 4; ++a)
#pragma unroll
        for (int ks = 0; ks < KS; ++ks) {
          const bf16x8 kf = *reinterpret_cast<const bf16x8*>(kb + ((16 * a + jn) * KROW + ks * 32 + q * 8) * 2);
#pragma unroll
          for (int c = 0; c < 2; ++c) s[a][c] = mfma16(kf, qf[c][ks], s[a][c]);
        }
      if (MASK) {
#pragma unroll
        for (int c = 0; c < 2; ++c) {
          const u64 w = mw[c] >> (4 * q);
#pragma unroll
          for (int a = 0; a < 4; ++a)
#pragma unroll
            for (int r = 0; r < 4; ++r)
              if (!((w >> (16 * a + r)) & 1ull)) s[a][c][r] = NEG_INF;
        }
      }
      float alpha[2];
#pragma unroll
      for (int c = 0; c < 2; ++c) {
        float mx = NEG_INF;
#pragma unroll
        for (int a = 0; a < 4; ++a)
#pragma unroll
          for (int r = 0; r < 4; ++r) mx = fmaxf(mx, s[a][c][r]);
        mx = fmaxf(mx, __shfl_xor(mx, 16)); mx = fmaxf(mx, __shfl_xor(mx, 32));
        const float mn = fmaxf(m[c], mx);
        const float mu = (mn == NEG_INF) ? 0.f : mn;
        alpha[c] = fexp2(m[c] - mu);
        m[c] = mn;
        float ps = 0.f;
#pragma unroll
        for (int a = 0; a < 4; ++a)
#pragma unroll
          for (int r = 0; r < 4; ++r) { float p = fexp2(s[a][c][r] - mu); s[a][c][r] = p; ps += p; }
        lsum[c] = lsum[c] * alpha[c] + ps;
      }
      if (__builtin_amdgcn_ballot_w64(alpha[0] != 1.0f || alpha[1] != 1.0f) != 0ull) {
#pragma unroll
        for (int c = 0; c < 2; ++c)
#pragma unroll
          for (int dt = 0; dt < 4; ++dt)
#pragma unroll
            for (int r = 0; r < 4; ++r) o[dt][c][r] *= alpha[c];
      }
#pragma unroll
      for (int kk = 0; kk < 2; ++kk) {
        bf16x8 pf[2];
#pragma unroll
        for (int c = 0; c < 2; ++c) {
          uint4 w; w.x = pack2(s[2 * kk][c][0], s[2 * kk][c][1]); w.y = pack2(s[2 * kk][c][2], s[2 * kk][c][3]);
          w.z = pack2(s[2 * kk + 1][c][0], s[2 * kk + 1][c][1]); w.w = pack2(s[2 * kk + 1][c][2], s[2 * kk + 1][c][3]);
          pf[c] = __builtin_bit_cast(bf16x8, w);
        }
#pragma unroll
        for (int dt = 0; dt < 4; ++dt) {
          const char* vp = vb + ((16 * dt + jn) * VROW + kk * 32 + 4 * q) * 2;
          const uint2 lo = *reinterpret_cast<const uint2*>(vp), hi = *reinterpret_cast<const uint2*>(vp + 32);
          uint4 w; w.x = lo.x; w.y = lo.y; w.z = hi.x; w.w = hi.y;
          const bf16x8 vf = __builtin_bit_cast(bf16x8, w);
#pragma unroll
          for (int c = 0; c < 2; ++c) o[dt][c] = mfma16(vf, pf[c], o[dt][c]);
        }
      }
    }
    if (more) lstore((kt + 1) & 1);
    if (MASK) { mw[0] = mwn[0]; mw[1] = mwn[1]; }
    __syncthreads();
  }
#pragma unroll
  for (int c = 0; c < 2; ++c) {
    const float inv = 1.0f / red4(lsum[c]);
    const int row = 16 * c + jn;
#pragma unroll
    for (int dt = 0; dt < 4; ++dt) {
      uint2 gw = ld4(gatep + (size_t)row * gstride + 16 * dt + 4 * q);
      st4(outp + (size_t)row * ostride + 16 * dt + 4 * q, o[dt][c][0] * inv * siluf_(lo2f(gw.x)), o[dt][c][1] * inv * siluf_(hi2f(gw.x)),
          o[dt][c][2] * inv * siluf_(lo2f(gw.y)), o[dt][c][3] * inv * siluf_(hi2f(gw.y)));
    }
  }
}

template <int KS, bool MASK, int NC, bool SH>
DI void attn_block(const u16* Qp, int qstride, const u16* Kp, int kstride, const u16* Vtp, const u64* maskp, int nkt_w, int nkt_max,
                   const u16* gatep, int gstride, u16* outp, int ostride, char* lds, int tid) {
  constexpr int DQK = KS * 32, KROW = DQK + 8, VROW = 72;
  constexpr int KCH = DQK / 8, NKC = 64 * KCH / 256;
  constexpr int K_BYTES = 64 * KROW * 2, BUF_BYTES = K_BYTES + 64 * VROW * 2;
  const int lane = tid & 63, q = lane >> 4, jn = lane & 15;
  const float NEG_INF = -__builtin_inff();
  uint4 xk0, xk1, xk2, xv0, xv1, yk0, yk1, yk2, yv0, yv1;
  xk2 = yk2 = make_uint4(0, 0, 0, 0);
  const int c0 = tid, c1 = tid + 256, c2 = tid + 512;
  const u16* kg0 = Kp + (size_t)(c0 / KCH) * kstride + (c0 % KCH) * 8;
  const u16* kg1 = Kp + (size_t)(c1 / KCH) * kstride + (c1 % KCH) * 8;
  const u16* kg2 = Kp + (size_t)(c2 / KCH) * kstride + (c2 % KCH) * 8;
  const u16* vg0 = Vtp + (size_t)(c0 >> 3) * S + (c0 & 7) * 8;
  const u16* vg1 = Vtp + (size_t)(c1 >> 3) * S + (c1 & 7) * 8;
  char* ks0 = lds + ((c0 / KCH) * KROW + (c0 % KCH) * 8) * 2;
  char* ks1 = lds + ((c1 / KCH) * KROW + (c1 % KCH) * 8) * 2;
  char* ks2 = lds + ((c2 / KCH) * KROW + (c2 % KCH) * 8) * 2;
  char* vs0 = lds + K_BYTES + ((c0 >> 3) * VROW + (c0 & 7) * 8) * 2;
  char* vs1 = lds + K_BYTES + ((c1 >> 3) * VROW + (c1 & 7) * 8) * 2;
#define A_LOAD(P, kt) { const size_t ko = (size_t)(kt) * 64 * kstride; const int vo = (kt) * 64;                     \
    P##k0 = *reinterpret_cast<const uint4*>(kg0 + ko); P##k1 = *reinterpret_cast<const uint4*>(kg1 + ko);            \
    if (NKC == 3) P##k2 = *reinterpret_cast<const uint4*>(kg2 + ko);                                                 \
    P##v0 = *reinterpret_cast<const uint4*>(vg0 + vo); P##v1 = *reinterpret_cast<const uint4*>(vg1 + vo); }
#define A_STORE(P, buf) { *reinterpret_cast<uint4*>(ks0 + (buf) * BUF_BYTES) = P##k0; *reinterpret_cast<uint4*>(ks1 + (buf) * BUF_BYTES) = P##k1; \
    if (NKC == 3) *reinterpret_cast<uint4*>(ks2 + (buf) * BUF_BYTES) = P##k2;                                        \
    *reinterpret_cast<uint4*>(vs0 + (buf) * BUF_BYTES) = P##v0; *reinterpret_cast<uint4*>(vs1 + (buf) * BUF_BYTES) = P##v1; }
  bf16x8 qf[NC][KS];
#pragma unroll
  for (int c = 0; c < NC; ++c)
#pragma unroll
    for (int ks = 0; ks < KS; ++ks) qf[c][ks] = ld8(Qp + (size_t)((SH ? 0 : 16 * c) + jn) * qstride + (SH ? 64 * c : 0) + ks * 32 + q * 8);
  f32x4 o[4][NC]; zero_acc(o);
  float m[NC], lsum[NC];
#pragma unroll
  for (int c = 0; c < NC; ++c) { m[c] = NEG_INF; lsum[c] = 0.f; }
  u64 mce0 = 0ull, mce1 = 0ull, mco0 = 0ull, mco1 = 0ull, mne0 = 0ull, mne1 = 0ull, mno0 = 0ull, mno1 = 0ull;
  const u64* mrow0 = maskp + (size_t)jn * 64;
  const u64* mrow1 = maskp + (size_t)(16 + jn) * 64;
  if (MASK) {
    mce0 = mrow0[0]; if (!SH) mce1 = mrow1[0];
    if (1 < nkt_w) { mco0 = mrow0[1]; if (!SH) mco1 = mrow1[1]; }
  }
  auto compute = [&](int buf, u64 w0, u64 w1) {
    const char* kb = lds + buf * BUF_BYTES; const char* vb = kb + K_BYTES;
    f32x4 s[4][NC]; zero_acc(s);
#pragma unroll
    for (int a = 0; a < 4; ++a)
#pragma unroll
      for (int ks = 0; ks < KS; ++ks) {
        const bf16x8 kf = *reinterpret_cast<const bf16x8*>(kb + ((16 * a + jn) * KROW + ks * 32 + q * 8) * 2);
#pragma unroll
        for (int c = 0; c < NC; ++c) s[a][c] = mfma16(kf, qf[c][ks], s[a][c]);
      }
    if (MASK) {
#pragma unroll
      for (int c = 0; c < NC; ++c) {
        const u64 w = ((SH || c == 0) ? w0 : w1) >> (4 * q);
#pragma unroll
        for (int a = 0; a < 4; ++a)
#pragma unroll
          for (int r = 0; r < 4; ++r)
            if (!((w >> (16 * a + r)) & 1ull)) s[a][c][r] = NEG_INF;
      }
    }
    float alpha[NC];
#pragma unroll
    for (int c = 0; c < NC; ++c) {
      float mx = NEG_INF;
#pragma unroll
      for (int a = 0; a < 4; ++a)
#pragma unroll
        for (int r = 0; r < 4; ++r) mx = fmaxf(mx, s[a][c][r]);
      mx = fmaxf(mx, __shfl_xor(mx, 16)); mx = fmaxf(mx, __shfl_xor(mx, 32));
      const float mn = fmaxf(m[c], mx);
      const float mu = (mn == NEG_INF) ? 0.f : mn;
      alpha[c] = fexp2(m[c] - mu);
      m[c] = mn;
      float ps = 0.f;
#pragma unroll
      for (int a = 0; a < 4; ++a)
#pragma unroll
        for (int r = 0; r < 4; ++r) { float p = fexp2(s[a][c][r] - mu); s[a][c][r] = p; ps += p; }
      lsum[c] = lsum[c] * alpha[c] + ps;
    }
    bool resc = false;
#pragma unroll
    for (int c = 0; c < NC; ++c) resc = resc || (alpha[c] != 1.0f);
    if (__builtin_amdgcn_ballot_w64(resc) != 0ull) {
#pragma unroll
      for (int c = 0; c < NC; ++c)
#pragma unroll
        for (int dt = 0; dt < 4; ++dt)
#pragma unroll
          for (int r = 0; r < 4; ++r) o[dt][c][r] *= alpha[c];
    }
#pragma unroll
    for (int kk = 0; kk < 2; ++kk) {
      bf16x8 pf[NC];
#pragma unroll
      for (int c = 0; c < NC; ++c) {
        uint4 w; w.x = pack2(s[2 * kk][c][0], s[2 * kk][c][1]); w.y = pack2(s[2 * kk][c][2], s[2 * kk][c][3]);
        w.z = pack2(s[2 * kk + 1][c][0], s[2 * kk + 1][c][1]); w.w = pack2(s[2 * kk + 1][c][2], s[2 * kk + 1][c][3]);
        pf[c] = __builtin_bit_cast(bf16x8, w);
      }
#pragma unroll
      for (int dt = 0; dt < 4; ++dt) {
        const char* vp = vb + ((16 * dt + jn) * VROW + kk * 32 + 4 * q) * 2;
        const uint2 lo = *reinterpret_cast<const uint2*>(vp), hi = *reinterpret_cast<const uint2*>(vp + 32);
        uint4 w; w.x = lo.x; w.y = lo.y; w.z = hi.x; w.w = hi.y;
        const bf16x8 vf = __builtin_bit_cast(bf16x8, w);
#pragma unroll
        for (int c = 0; c < NC; ++c) o[dt][c] = mfma16(vf, pf[c], o[dt][c]);
      }
    }
  };

  A_LOAD(x, 0);
  { const int t1 = (nkt_max > 1) ? 1 : 0; A_LOAD(y, t1); }
  A_STORE(x, 0);
  __syncthreads();
  for (int kt = 0; kt < nkt_max; kt += 2) {
    const bool more = kt + 2 < nkt_max;
    if (more) {
      A_LOAD(x, kt + 2);
      if (MASK) {
        if (kt + 2 < nkt_w) { mne0 = mrow0[kt + 2]; if (!SH) mne1 = mrow1[kt + 2]; }
        if (kt + 3 < nkt_w) { mno0 = mrow0[kt + 3]; if (!SH) mno1 = mrow1[kt + 3]; }
      }
    }
    if (kt < nkt_w) compute(0, mce0, mce1);
    A_STORE(y, 1);
    __syncthreads();
    if (kt + 3 < nkt_max) A_LOAD(y, kt + 3);
    if (kt + 1 < nkt_w) compute(1, mco0, mco1);
    if (more) A_STORE(x, 0);
    if (MASK) { mce0 = mne0; mce1 = mne1; mco0 = mno0; mco1 = mno1; }
    __syncthreads();
  }
#undef A_LOAD
#undef A_STORE
#pragma unroll
  for (int c = 0; c < NC; ++c) {
    const float inv = 1.0f / red4(lsum[c]);
    const int row = (SH ? 0 : 16 * c) + jn;
    const int hc = SH ? 64 * c : 0;
#pragma unroll
    for (int dt = 0; dt < 4; ++dt) {
      uint2 gw = ld4(gatep + (size_t)row * gstride + hc + 16 * dt + 4 * q);
      st4(outp + (size_t)row * ostride + hc + 16 * dt + 4 * q, o[dt][c][0] * inv * siluf_(lo2f(gw.x)), o[dt][c][1] * inv * siluf_(hi2f(gw.x)),
          o[dt][c][2] * inv * siluf_(lo2f(gw.y)), o[dt][c][3] * inv * siluf_(hi2f(gw.y)));
    }
  }
}

DI void mla_attn_item(const Params& P, int it, char* lds, int tid) {
  const int wave = __builtin_amdgcn_readfirstlane(tid >> 6);
  const int qb = 31 - it / 96, bh = it % 96, b = bh / 6, h = bh % 6;
  const int q0 = qb * 128 + wave * 32;
  const int nkt = (q0 >> 6) + 1;
  const u16* mq = (const u16*)(P.ws + O_MQ); const u16* mk = (const u16*)(P.ws + O_MK); const u16* mvt = (const u16*)(P.ws + O_MVT);
  const u16* proj = (const u16*)(P.ws + O_PROJ); u16* mixed = (u16*)(P.ws + O_XB);
  const size_t tok = (size_t)b * S + q0;
  attn_block<3, false, 2, false>(mq + tok * 576 + h * 96, 576, mk + (size_t)b * S * 576 + h * 96, 576, mvt + (size_t)(b * 6 + h) * 64 * S, nullptr, nkt, 2 * qb + 2,
                       proj + tok * DINP + C_GC + h * 64, DINP, mixed + tok * DM + 640 + h * 64, DM, lds, tid);
}

DI void dsa_attn_item(const Params& P, int it, char* lds, int tid) {
  const int wave = __builtin_amdgcn_readfirstlane(tid >> 6);
  const int ch = 63 - it / 32, bh = it % 32, b = bh >> 1, hg = bh & 1;
  const int q0 = ch * 64 + wave * 16;
  const int nkt = ch + 1;
  const u16* proj = (const u16*)(P.ws + O_PROJ); const u16* avt = (const u16*)(P.ws + O_AVT); u16* mixed = (u16*)(P.ws + O_XB);
  const u64* mask = (const u64*)(P.ws + O_MASK);
  const size_t tok = (size_t)b * S + q0;
  attn_block<2, true, 3, true>(proj + tok * DINP + C_QA + hg * 192, DINP, proj + (size_t)b * S * DINP + C_KA, DINP, avt + (size_t)b * 64 * S, mask + tok * 64, nkt, nkt,
                               proj + tok * DINP + C_GA + hg * 192, DINP, mixed + tok * DM + hg * 192, DM, lds, tid);
}

constexpr int SC_STRIDE = 4096 + 16;
DI unsigned fkey(float f) { unsigned u = __float_as_uint(f); return (u & 0x80000000u) ? ~u : (u | 0x80000000u); }
DI float funkey(unsigned k) { return __uint_as_float((k & 0x80000000u) ? (k ^ 0x80000000u) : ~k); }

template <int NR>
DI u64 select_wave(float* scw, int nreg, int lane) {
  unsigned key[NR];
  unsigned kmin = 0xffffffffu, kmax = 0u;
#pragma unroll
  for (int r = 0; r < NR; ++r) {
    const unsigned k = fkey(scw[64 * r + lane]);
    const bool ok = r < nreg;
    key[r] = ok ? k : 0u;
    kmin = min(kmin, ok ? k : 0xffffffffu); kmax = max(kmax, key[r]);
  }
#pragma unroll
  for (int o = 1; o < 64; o <<= 1) { kmin = min(kmin, (unsigned)__shfl_xor((int)kmin, o)); kmax = max(kmax, (unsigned)__shfl_xor((int)kmax, o)); }
  unsigned lo = __builtin_amdgcn_readfirstlane(kmin), hi = __builtin_amdgcn_readfirstlane(kmax);
  int clo = 64 * nreg, chi = 0;
  bool exact = false;
  int iter = 0;
  while (lo < hi && clo - chi > 512) {
    unsigned mid = fkey(0.5f * (funkey(lo) + funkey(hi)));
    if (iter >= 16) mid = lo + ((hi - lo + 1u) >> 1);
    if (mid <= lo) mid = lo + 1;
    if (mid > hi) mid = hi;
    ++iter;
    int cnt = 0;
#pragma unroll
    for (int r = 0; r < NR; ++r) cnt += __builtin_popcountll(__builtin_amdgcn_ballot_w64(key[r] >= mid));
    if (cnt >= 256) { lo = mid; clo = cnt; if (cnt == 256) { exact = true; break; } }
    else { hi = mid - 1; chi = cnt; }
  }
  if (!exact && lo < hi) {
    unsigned* cand = reinterpret_cast<unsigned*>(scw);
    int base = 0;
#pragma unroll
    for (int r = 0; r < NR; ++r) {
      const bool pred = (key[r] >= lo) && (key[r] <= hi);
      const u64 bal = __builtin_amdgcn_ballot_w64(pred);
      const int pos = base + __builtin_amdgcn_mbcnt_hi((unsigned)(bal >> 32), __builtin_amdgcn_mbcnt_lo((unsigned)bal, 0u));
      if (pred) cand[pos] = key[r];
      base += __builtin_popcountll(bal);
    }
    __builtin_amdgcn_fence(__ATOMIC_RELEASE, "wavefront");
    __builtin_amdgcn_fence(__ATOMIC_ACQUIRE, "wavefront");
    unsigned ck[8];
#pragma unroll
    for (int i = 0; i < 8; ++i) { const unsigned v = cand[64 * i + lane]; ck[i] = (64 * i + lane < base) ? v : 0u; }
    const int cabove = chi;
    while (lo < hi) {
      unsigned mid = fkey(0.5f * (funkey(lo) + funkey(hi)));
      if (iter >= 16) mid = lo + ((hi - lo + 1u) >> 1);
      if (mid <= lo) mid = lo + 1;
      if (mid > hi) mid = hi;
      ++iter;
      int cnt = cabove;
#pragma unroll
      for (int i = 0; i < 8; ++i) cnt += __builtin_popcountll(__builtin_amdgcn_ballot_w64(ck[i] >= mid));
      if (cnt >= 256) { lo = mid; if (cnt == 256) { exact = true; break; } }
      else { hi = mid - 1; }
    }
  }
  const unsigned thr = lo;
  u64 myword = 0ull;
  if (exact) {
#pragma unroll
    for (int r = 0; r < NR; ++r) { const u64 bal = __builtin_amdgcn_ballot_w64(key[r] >= thr); if (lane == r) myword = bal; }
  } else {
    int cgt = 0;
#pragma unroll
    for (int r = 0; r < NR; ++r) cgt += __builtin_popcountll(__builtin_amdgcn_ballot_w64(key[r] > thr));
    const int need = 256 - cgt;
    int run = 0;
    const u64 below = (1ull << lane) - 1ull;
#pragma unroll
    for (int r = 0; r < NR; ++r) {
      const u64 eq = __builtin_amdgcn_ballot_w64(key[r] == thr);
      const int rank = run + __builtin_popcountll(eq & below);
      const bool sel = (key[r] > thr) || ((key[r] == thr) && (rank < need));
      const u64 bal = __builtin_amdgcn_ballot_w64(sel);
      run += __builtin_popcountll(eq);
      if (lane == r) myword = bal;
    }
  }
  return myword;
}

DI void dsa_select_item(const Params& P, int it, float* sc, int wave, int lane) {
  const int qd = 1023 - it / 16, b = it % 16;
  const int t0 = qd * 4;
  const int N = ((t0 >> 6) + 1) * 64, nreg = N >> 6;
  const u16* base = (const u16*)(P.ws + O_PROJ) + (size_t)b * S * DINP;
  u64* mask = (u64*)(P.ws + O_MASK);
  const int q = lane >> 4, jn = lane & 15;
  if (N > 256) {
    const bf16x8 a0 = ld8(base + (size_t)(t0 + (jn >> 2)) * DINP + C_IQ + (jn & 3) * 32 + q * 8);
    const bf16x8 a1 = ld8(base + (size_t)(t0 + (jn >> 2)) * DINP + C_IQ + (4 + (jn & 3)) * 32 + q * 8);
    float w[8];
    {
      bf16x8 wv = ld8(base + (size_t)(t0 + q) * DINP + C_IW);
#pragma unroll
      for (int h = 0; h < 8; ++h) w[h] = bf2f((u16)wv[h]) * (0.35355339059327373f * 0.17677669529663687f);
    }
    const int tpw = N >> 6;
    const u16* kbase = base + (size_t)jn * DINP + C_IK + q * 8;
    for (int tl = 0; tl < tpw; tl += 16) {
      bf16x8 bk[16];
#pragma unroll
      for (int u = 0; u < 16; ++u) {
        const int t = (tl + u < tpw) ? tl + u : tpw - 1;
        bk[u] = ld8(kbase + (size_t)((wave * tpw + t) * 16) * DINP);
      }
#pragma unroll
      for (int u = 0; u < 16; ++u) {
        const int t = (tl + u < tpw) ? tl + u : tpw - 1;
        const int key0 = (wave * tpw + t) * 16;
        const f32x4 z = {0.f, 0.f, 0.f, 0.f};
        f32x4 d0 = mfma16(a0, bk[u], z), d1 = mfma16(a1, bk[u], z);
        float sv = 0.f;
#pragma unroll
        for (int r = 0; r < 4; ++r) sv += fmaxf(d0[r], 0.f) * w[r];
#pragma unroll
        for (int r = 0; r < 4; ++r) sv += fmaxf(d1[r], 0.f) * w[4 + r];
        sc[q * SC_STRIDE + key0 + jn] = sv;
      }
    }
  }
  __syncthreads();
  u64 myword = ~0ull;
  if (N > 256) {
    float* scw = sc + wave * SC_STRIDE;
    if (nreg <= 8) myword = select_wave<8>(scw, nreg, lane);
    else if (nreg <= 16) myword = select_wave<16>(scw, nreg, lane);
    else if (nreg <= 24) myword = select_wave<24>(scw, nreg, lane);
    else if (nreg <= 32) myword = select_wave<32>(scw, nreg, lane);
    else if (nreg <= 48) myword = select_wave<48>(scw, nreg, lane);
    else myword = select_wave<64>(scw, nreg, lane);
  }
  if (lane < nreg) mask[((size_t)b * S + t0 + wave) * 64 + lane] = myword;
  __syncthreads();
}

DI void s5_stage1_item(const Params& P, int l, int it, int wave, int lane) {
  const int b = it >> 4, g = it & 15, q = lane >> 4, jn = lane & 15;
  const u16* proj = (const u16*)(P.ws + O_PROJ);
  const u16* W1 = (const u16*)(P.ws + O_W1) + (size_t)(l * 16 + g) * 128 * 1024;
  float* s5s = (float*)(P.ws + O_S5S) + (size_t)it * 64 * 128;
  f32x4 acc[2][4]; zero_acc(acc);
  const u16* ap = W1 + (size_t)(wave * 32 + jn) * 1024 + q * 8;
  const u16* up = proj + ((size_t)b * S + (size_t)jn * 64 + (q >> 1)) * DINP + C_U + g * 16 + (q & 1) * 8;
  wgemm<2, 4>(acc, 32, [&](int i, int ks) { return ld8(ap + (size_t)i * 16 * 1024 + ks * 32); },
              [&](int j, int ks) { return ld8(up + ((size_t)j * 16 * 64 + 2 * ks) * DINP); });
#pragma unroll
  for (int j = 0; j < 4; ++j) {
    const int n = 16 * j + jn;
#pragma unroll
    for (int i = 0; i < 2; ++i)
      *reinterpret_cast<f32x4*>(s5s + (size_t)n * 128 + wave * 32 + 16 * i + 4 * q) = acc[i][j];
  }
}

constexpr int HS_STRIDE = 136;
DI void s5_stage3_item(const Params& P, int l, int it, u16* hs, int wave, int lane) {
  const int b = it >> 4, g = it & 15, q = lane >> 4, jn = lane & 15;
  const u16* proj = (const u16*)(P.ws + O_PROJ);
  const u16* Kt = (const u16*)(P.ws + O_KT) + (size_t)(l * 16 + g) * 64 * 256;
  const u16* W3 = (const u16*)(P.ws + O_W3) + (size_t)(l * 16 + g) * 1024 * 128;
  const float* s5s = (const float*)(P.ws + O_S5S) + (size_t)it * 64 * 128;
  const float2* pw = (const float2*)(P.ws + O_PW);
  u16* yg = (u16*)(P.ws + O_YG);
  const float* dsk = P.in[17] + (l * 16 + g) * 16;
  if (wave == 0) {
    const int p = lane;
    const float2 aL = pw[((size_t)(l * 16 + g) * 65 + 64) * 64 + p];
    float hr = 0.f, hi = 0.f;
#pragma unroll
    for (int half = 0; half < 2; ++half) {
      float2 sv[32];
#pragma unroll
      for (int n = 0; n < 32; ++n) sv[n] = *reinterpret_cast<const float2*>(s5s + (size_t)(half * 32 + n) * 128 + 2 * p);
#pragma unroll
      for (int n = 0; n < 32; ++n) {
        *reinterpret_cast<unsigned*>(hs + (half * 32 + n) * HS_STRIDE + 2 * p) = pack2(hr, hi);
        const float nr = aL.x * hr - aL.y * hi + sv[n].x, ni = aL.x * hi + aL.y * hr + sv[n].y;
        hr = nr; hi = ni;
      }
    }
  }
  __syncthreads();
  const u16* up = proj + ((size_t)b * S + (size_t)jn * 64 + (q >> 1)) * DINP + C_U + g * 16 + (q & 1) * 8;
  const bf16x8 zf = {0, 0, 0, 0, 0, 0, 0, 0};
  for (int gi = 0; gi < 8; ++gi) {
    const int jg = wave + 4 * (gi >> 1);
    const int th = gi & 1;
    f32x4 acc[4][2]; zero_acc(acc);
    wgemm<4, 2>(acc, 2 * jg + 2,
                [&](int i, int ks) { const int j = 4 * jg + i, ii = 2 * ks + (q >> 1); const int d = j - ii;
                                     return (d >= 0) ? ld8(Kt + ((size_t)d * 16 + jn) * 16 + (q & 1) * 8) : zf; },
                [&](int jt, int ks) { return ld8(up + ((size_t)(2 * th + jt) * 16 * 64 + 2 * ks) * DINP); });
    wgemm<4, 2>(acc, 4,
                [&](int i, int ks) { return ld8(W3 + ((size_t)(4 * jg + i) * 16 + jn) * 128 + ks * 32 + q * 8); },
                [&](int jt, int ks) { return *reinterpret_cast<const bf16x8*>(hs + (16 * (2 * th + jt) + jn) * HS_STRIDE + ks * 32 + q * 8); });
#pragma unroll
    for (int jt = 0; jt < 2; ++jt) {
      const int n = 16 * (2 * th + jt) + jn;
#pragma unroll
      for (int i = 0; i < 4; ++i) {
        const size_t tok = (size_t)b * S + n * 64 + 4 * jg + i;
        uint2 uw = ld4(proj + tok * DINP + C_U + g * 16 + 4 * q);
        const float y0 = acc[i][jt][0] + dsk[4 * q] * lo2f(uw.x), y1 = acc[i][jt][1] + dsk[4 * q + 1] * hi2f(uw.x);
        const float y2 = acc[i][jt][2] + dsk[4 * q + 2] * lo2f(uw.y), y3 = acc[i][jt][3] + dsk[4 * q + 3] * hi2f(uw.y);
        st4(yg + tok * 256 + g * 16 + 4 * q, geluf_(y0), geluf_(y1), geluf_(y2), geluf_(y3));
      }
    }
  }
  __syncthreads();
}

DI void glu_tile(const Params& P, int l, int tt, char* lds) {
  const u16* W = (const u16*)(P.ws + O_WTGLU) + (size_t)l * 256 * 256;
  const u16* yg = (const u16*)(P.ws + O_YG);
  const u16* proj = (const u16*)(P.ws + O_PROJ);
  u16* mixed = (u16*)(P.ws + O_XB);
  const int tid = opaque_tid();
  const int wave = __builtin_amdgcn_readfirstlane(tid >> 6), lane = tid & 63, q = lane >> 4, jn = lane & 15;
#pragma unroll 1
  for (int ftile = 0; ftile < 2; ++ftile) {
    const int f0 = ftile * 128 + (wave >> 1) * 64, t0 = tt * 128 + (wave & 1) * 64;
    f32x4 acc[4][4]; zero_acc(acc);
    gemm_block(acc, W + (size_t)(ftile * 128) * 256, 256, yg + (size_t)(tt * 128) * 256, 256, 256, lds, tid);
#pragma unroll
    for (int j = 0; j < 4; ++j) {
      const size_t tok = t0 + 16 * j + jn;
#pragma unroll
      for (int i = 0; i < 4; ++i) {
        const int f = f0 + 16 * i + 4 * q;
        uint2 gw = ld4(yg + tok * 256 + f), bw = ld4(proj + tok * DINP + C_GB + f);
        st4(mixed + tok * DM + 384 + f, lo2f(gw.x) * sigmoidf_(acc[i][j][0]) * siluf_(lo2f(bw.x)), hi2f(gw.x) * sigmoidf_(acc[i][j][1]) * siluf_(hi2f(bw.x)),
            lo2f(gw.y) * sigmoidf_(acc[i][j][2]) * siluf_(lo2f(bw.y)), hi2f(gw.y) * sigmoidf_(acc[i][j][3]) * siluf_(hi2f(bw.y)));
      }
    }
  }
}

DI void outproj_tile(const Params& P, int l, int tt, char* lds) {
  const u16* W = (const u16*)(P.ws + O_WTOUT) + (size_t)l * DM * DM;
  const u16* mixed = (const u16*)(P.ws + O_XB);
  const float* xin = (l == 0) ? P.in[0] : P.out;
  float* xout = P.out;
  u16* xb2 = (u16*)(P.ws + O_XB2);
  const int tid = opaque_tid();
  const int wave = __builtin_amdgcn_readfirstlane(tid >> 6), lane = tid & 63, q = lane >> 4, jn = lane & 15;
#pragma unroll 1
  for (int ftile0 = 0; ftile0 < 8; ++ftile0) {
    int ftile = ftile0; asm volatile("" : "+s"(ftile));
    const int f0 = ftile * 128 + (wave >> 1) * 64, t0 = tt * 128 + (wave & 1) * 64;
    f32x4 acc[4][4]; zero_acc(acc);
    gemm_block(acc, W + (size_t)(ftile * 128) * DM, DM, mixed + (size_t)(tt * 128) * DM, DM, DM, lds, tid);
#pragma unroll
    for (int j = 0; j < 4; ++j) {
      const size_t tok = t0 + 16 * j + jn;
#pragma unroll
      for (int i = 0; i < 4; ++i) {
        const int f = f0 + 16 * i + 4 * q;
        f32x4 xv;
        if (l == 0) xv = *reinterpret_cast<const f32x4*>(xin + tok * DM + f);
        else { const uint2 xw = ld4(xb2 + tok * DM + f); xv = f32x4{lo2f(xw.x), hi2f(xw.x), lo2f(xw.y), hi2f(xw.y)}; }
        const f32x4 xn = xv + acc[i][j];
        if (l == NL - 1) *reinterpret_cast<f32x4*>(xout + tok * DM + f) = xn;
        else st4(xb2 + tok * DM + f, xn[0], xn[1], xn[2], xn[3]);
      }
    }
  }
}

DI void phase_tail(const Params& P, int l, char* lds, float* s_rstd, float* s_prep) {
  for (int tt = blockIdx.x; tt < 512; tt += gridDim.x) {
    glu_tile(P, l, tt, lds);
    asm volatile("s_waitcnt vmcnt(0)" ::: "memory");
    __syncthreads();
    outproj_tile(P, l, tt, lds);
    if (l + 1 < NL) {
      asm volatile("s_waitcnt vmcnt(0)" ::: "memory");
      __syncthreads();
      inproj_tile(P, l + 1, tt, lds, s_rstd, s_prep);
    }
  }
}

DI void gbar(unsigned* ctr, unsigned& epoch) {
  asm volatile("s_waitcnt vmcnt(0)" ::: "memory");
  __syncthreads();
  epoch += gridDim.x;
  if (threadIdx.x == 0) {
    __builtin_amdgcn_fence(__ATOMIC_RELEASE, "agent");
    asm volatile("s_waitcnt vmcnt(0)" ::: "memory");
    __hip_atomic_fetch_add(ctr, 1u, __ATOMIC_RELAXED, __HIP_MEMORY_SCOPE_AGENT);
    while (__hip_atomic_load(ctr, __ATOMIC_RELAXED, __HIP_MEMORY_SCOPE_AGENT) < epoch) __builtin_amdgcn_s_sleep(1);
    __builtin_amdgcn_fence(__ATOMIC_ACQUIRE, "agent");
    asm volatile("s_waitcnt vmcnt(0)" ::: "memory");
  }
  __syncthreads();
}

__global__ void __launch_bounds__(256, 2) fwd_megakernel(Params P) {
  cg::grid_group grid = cg::this_grid();
  __shared__ __attribute__((aligned(16))) float lds_f[2 * G_BUF_BYTES / 4];
  static_assert(2 * G_BUF_BYTES >= 4 * SC_STRIDE * 4, "lds");
  __shared__ int s_item;
  __shared__ float s_rstd[128];
  __shared__ float s_prep[512];
  const long gtid = (long)blockIdx.x * 256 + threadIdx.x, gsz = (long)gridDim.x * 256;

  if (blockIdx.x == 0 && threadIdx.x < 64) ((unsigned*)(P.ws + O_CTR))[threadIdx.x] = 0u;
  phase_w0(P, gtid, gsz);
  grid.sync();
  unsigned* bar = (unsigned*)(P.ws + O_CTR) + 32;
  unsigned epoch = 0u;
  phase_w1(P, gtid, gsz);
#ifdef DUP_W
  phase_w0(P, gtid, gsz);
  phase_w1(P, gtid, gsz);
#endif

  for (int tt = blockIdx.x; tt < 512; tt += gridDim.x) {
    {
      const float* x = P.in[0]; u16* xb = (u16*)(P.ws + O_XB2);
      const int tid = opaque_tid();
#pragma unroll 4
      for (int e = tid; e < 128 * 256; e += 256) {
        const float4 v = *reinterpret_cast<const float4*>(x + (size_t)tt * 128 * DM + (size_t)e * 4);
        st4(xb + (size_t)tt * 128 * DM + (size_t)e * 4, v.x, v.y, v.z, v.w);
      }
    }
    asm volatile("s_waitcnt vmcnt(0)" ::: "memory");
    __syncthreads();
    inproj_tile(P, 0, tt, (char*)lds_f, s_rstd, s_prep);
  }
  gbar(bar, epoch);
  for (int l = 0; l < NL; ++l) {
    {
      unsigned* ctr = (unsigned*)(P.ws + O_CTR) + l * 2;
      for (;;) {
        const int tid = opaque_tid();
        if (tid == 0) s_item = (int)atomicAdd(ctr, 1u);
        __syncthreads();
        const int it = s_item;
        __syncthreads();
        if (it >= 256 + 3072 + 4096) break;
        const int wave = __builtin_amdgcn_readfirstlane(tid >> 6), lane = tid & 63;
        if (it < 256) s5_stage1_item(P, l, it, wave, lane);
        else if (it < 256 + 3072) mla_attn_item(P, it - 256, (char*)lds_f, tid);
        else {
#pragma unroll 1
          for (int k = 0; k < 4; ++k) dsa_select_item(P, (it - 256 - 3072) * 4 + k, lds_f, wave, lane);
        }
      }
    }
    gbar(bar, epoch);
    {
      unsigned* ctr = (unsigned*)(P.ws + O_CTR) + l * 2 + 1;
      for (;;) {
        const int tid = opaque_tid();
        if (tid == 0) s_item = (int)atomicAdd(ctr, 1u);
        __syncthreads();
        const int it = s_item;
        __syncthreads();
        if (it >= 256 + 2048) break;
        const int wave = __builtin_amdgcn_readfirstlane(tid >> 6), lane = tid & 63;
        if (it < 256) s5_stage3_item(P, l, it, (u16*)lds_f, wave, lane);
        else dsa_attn_item(P, it - 256, (char*)lds_f, tid);
      }
    }
    gbar(bar, epoch);
    phase_tail(P, l, (char*)lds_f, s_rstd, s_prep);
    if (l + 1 < NL) gbar(bar, epoch);
  }
}

extern "C" void kernel_launch(void* const* d_in, const int* in_sizes, int n_in, void* d_out, int out_size, void* d_ws, size_t ws_size,
                              hipStream_t stream) {
  static int grid_blocks = 0;
  if (!grid_blocks) {
    int dev = 0, cus = 0, per_cu = 0;
    hipGetDevice(&dev);
    hipDeviceGetAttribute(&cus, hipDeviceAttributeMultiprocessorCount, dev);
    hipOccupancyMaxActiveBlocksPerMultiprocessor(&per_cu, fwd_megakernel, 256, 0);
    if (per_cu < 1) per_cu = 1;
    if (per_cu > 2) per_cu = 2;
    grid_blocks = cus * per_cu;
    if (ws_size < O_END) fprintf(stderr, "workspace too small: %zu < %zu\n", ws_size, (size_t)O_END);
  }
  Params p{};
  for (int i = 0; i < 21; ++i) p.in[i] = (const float*)d_in[i];
  p.out = (float*)d_out;
  p.ws = (char*)d_ws;
  void* args[] = {&p};
  hipError_t e = hipLaunchCooperativeKernel((void*)fwd_megakernel, dim3(grid_blocks), dim3(256), args, 0, stream);
  if (e != hipSuccess) fprintf(stderr, "cooperative launch failed: %s (grid %d)\n", hipGetErrorString(e), grid_blocks);
}
```

```cpp
#include <hip/hip_runtime.h>
#include <hip/hip_cooperative_groups.h>
#include <cstdio>
#include <type_traits>
namespace cg = cooperative_groups;

#define DI __device__ __forceinline__
typedef __attribute__((ext_vector_type(8))) short bf16x8;
typedef __attribute__((ext_vector_type(4))) short s16x4;
typedef __attribute__((ext_vector_type(4))) float f32x4;
typedef unsigned short u16;
typedef unsigned long long u64;

constexpr int NB = 16, S = 4096, T = NB * S, DM = 1024, DIN = 2504, DINP = 2560, NL = 4;
constexpr int C_QA = 0, C_KA = 384, C_VA = 448, C_IQ = 512, C_IK = 768, C_IW = 800, C_GA = 808, C_U = 1192,
              C_GB = 1448, C_CQ = 1704, C_CKV = 1960, C_KPE = 2088, C_GC = 2120;
constexpr float EPS = 1e-6f;
constexpr float LOG2E = 1.4426950408889634f;

constexpr size_t O_WTIN = 0;
constexpr size_t O_WTOUT = O_WTIN + (size_t)NL * DINP * DM * 2;
constexpr size_t O_WTUQ = O_WTOUT + (size_t)NL * DM * DM * 2;
constexpr size_t O_WTUKV = O_WTUQ + (size_t)NL * 768 * 256 * 2;
constexpr size_t O_WTGLU = O_WTUKV + (size_t)NL * 768 * 128 * 2;
constexpr size_t O_W1 = O_WTGLU + (size_t)NL * 256 * 256 * 2;
constexpr size_t O_W3 = O_W1 + (size_t)NL * 16 * 128 * 1024 * 2;
constexpr size_t O_KT = O_W3 + (size_t)NL * 16 * 1024 * 128 * 2;
constexpr size_t O_PW = O_KT + (size_t)NL * 16 * 64 * 256 * 2;
constexpr size_t O_FZ = O_PW + (size_t)NL * 16 * 65 * 64 * 8;
constexpr size_t O_R64 = O_FZ + (size_t)NL * 16 * 64 * 8;
constexpr size_t O_R32 = O_R64 + (size_t)4096 * 32 * 8;
constexpr size_t O_XB = O_R32 + (size_t)4096 * 16 * 8;
constexpr size_t O_RSTD = O_XB + (size_t)T * 1024 * 2;
constexpr size_t O_PROJ = O_RSTD + (size_t)T * 4;
constexpr size_t O_MQ = O_PROJ + (size_t)T * DINP * 2;
constexpr size_t O_MK = O_MQ + (size_t)T * 576 * 2;
constexpr size_t O_MVT = O_MK + (size_t)T * 576 * 2;
constexpr size_t O_AVT = O_MVT + (size_t)T * 384 * 2;
constexpr size_t O_MASK = O_AVT + (size_t)T * 64 * 2;
constexpr size_t O_S5S = O_MASK + (size_t)T * 512;
constexpr size_t O_YG = O_S5S + (size_t)16 * 16 * 64 * 128 * 4;
constexpr size_t O_CTR = O_YG + (size_t)T * 256 * 2;
constexpr size_t O_XB2 = O_CTR + 32768;
constexpr size_t O_END = O_XB2 + (size_t)T * 1024 * 2;

struct Params {
  const float* in[21];
  float* out;
  char* ws;
};

DI int opaque_tid() { int t = threadIdx.x; asm volatile("" : "+v"(t)); return t; }
DI u16 f2bf(float f) { unsigned u = __float_as_uint(f); u += 0x7fffu + ((u >> 16) & 1u); return (u16)(u >> 16); }
DI float bf2f(u16 h) { return __uint_as_float(((unsigned)h) << 16); }
typedef __attribute__((ext_vector_type(2))) __bf16 bf16x2_t;
typedef __attribute__((ext_vector_type(2))) float f32x2_t;
DI unsigned pack2(float a, float b) { return __builtin_bit_cast(unsigned, __builtin_convertvector((f32x2_t){a, b}, bf16x2_t)); }
DI float lo2f(unsigned w) { return __uint_as_float(w << 16); }
DI float hi2f(unsigned w) { return __uint_as_float(w & 0xffff0000u); }
DI bf16x8 ld8(const u16* p) { return *reinterpret_cast<const bf16x8*>(p); }
DI uint2 ld4(const u16* p) { return *reinterpret_cast<const uint2*>(p); }
DI void st4(u16* p, float a, float b, float c, float d) { uint2 v; v.x = pack2(a, b); v.y = pack2(c, d); *reinterpret_cast<uint2*>(p) = v; }
DI f32x4 mfma16(bf16x8 a, bf16x8 b, f32x4 c) { return __builtin_amdgcn_mfma_f32_16x16x32_bf16(a, b, c, 0, 0, 0); }
DI float fexp2(float x) { return __builtin_amdgcn_exp2f(x); }
DI float sigmoidf_(float x) { return __builtin_amdgcn_rcpf(1.0f + __expf(-x)); }
DI float siluf_(float x) { return x * sigmoidf_(x); }
DI float geluf_(float x) { float u = 0.7978845608028654f * (x + 0.044715f * x * x * x); return x * sigmoidf_(2.0f * u); }
DI float red4(float v) { v += __shfl_xor(v, 16); v += __shfl_xor(v, 32); return v; }

template <int AT, int BT, class FA, class FB>
DI void wgemm(f32x4 (&acc)[AT][BT], int ksteps, FA fa, FB fb) {
  bf16x8 a0[AT], b0[BT], a1[AT], b1[BT];
  const int k1 = (ksteps > 1) ? 1 : 0;
#pragma unroll
  for (int i = 0; i < AT; ++i) { a0[i] = fa(i, 0); a1[i] = fa(i, k1); }
#pragma unroll
  for (int j = 0; j < BT; ++j) { b0[j] = fb(j, 0); b1[j] = fb(j, k1); }
  for (int ks = 0; ks < ksteps; ++ks) {
    bf16x8 a2[AT], b2[BT];
    const int kn = (ks + 2 < ksteps) ? ks + 2 : ksteps - 1;
#pragma unroll
    for (int i = 0; i < AT; ++i) a2[i] = fa(i, kn);
#pragma unroll
    for (int j = 0; j < BT; ++j) b2[j] = fb(j, kn);
    __builtin_amdgcn_sched_barrier(0);
#pragma unroll
    for (int i = 0; i < AT; ++i)
#pragma unroll
      for (int j = 0; j < BT; ++j) acc[i][j] = mfma16(a0[i], b0[j], acc[i][j]);
    __builtin_amdgcn_sched_barrier(0);
#pragma unroll
    for (int i = 0; i < AT; ++i) { a0[i] = a1[i]; a1[i] = a2[i]; }
#pragma unroll
    for (int j = 0; j < BT; ++j) { b0[j] = b1[j]; b1[j] = b2[j]; }
  }
}

constexpr int GROW = 72;
constexpr int G_TILE_BYTES = 128 * GROW * 2;
constexpr int G_BUF_BYTES = 2 * G_TILE_BYTES;
DI void gemm_block(f32x4 (&acc)[4][4], const u16* Ap, int lda, const u16* Bp, int ldb, int K, char* lds, int tid, bool swap_w1 = false) {
  const int lane = tid & 63, q = lane >> 4, jn = lane & 15;
  const int wave = __builtin_amdgcn_readfirstlane(tid >> 6), wa = wave >> 1, wb = wave & 1;
  uint4 xa0, xa1, xa2, xa3, xb0, xb1, xb2, xb3;
  uint4 ya0, ya1, ya2, ya3, yb0, yb1, yb2, yb3;
  const int srow = tid >> 3, scol = tid & 7;
  const unsigned voa = (unsigned)(srow * lda + scol * 8) * 2u, vob = (unsigned)(srow * ldb + scol * 8) * 2u;
  const char* ag = reinterpret_cast<const char*>(Ap);
  const char* bg = reinterpret_cast<const char*>(Bp);
  char* st0 = lds + (srow * GROW + scol * 8) * 2;
  const bool sw = swap_w1 && (wa == 1);
  const char* a0p = sw ? (lds + G_TILE_BYTES + (wb * 64 + jn) * GROW * 2 + q * 16) : (lds + (wa * 64 + jn) * GROW * 2 + q * 16);
  const char* b0p = sw ? (lds + (wa * 64 + jn) * GROW * 2 + q * 16) : (lds + G_TILE_BYTES + (wb * 64 + jn) * GROW * 2 + q * 16);
#define GL(v, base, ld, vo, i, kt) v = *reinterpret_cast<const uint4*>(base + ((size_t)(32 * (i)) * (ld) + (size_t)(kt) * 64) * 2 + vo)
#define GLOAD0(kt) { GL(xa0, ag, lda, voa, 0, kt); GL(xa1, ag, lda, voa, 1, kt); GL(xa2, ag, lda, voa, 2, kt); GL(xa3, ag, lda, voa, 3, kt); GL(xb0, bg, ldb, vob, 0, kt); GL(xb1, bg, ldb, vob, 1, kt); GL(xb2, bg, ldb, vob, 2, kt); GL(xb3, bg, ldb, vob, 3, kt); }
#define GLOAD1(kt) { GL(ya0, ag, lda, voa, 0, kt); GL(ya1, ag, lda, voa, 1, kt); GL(ya2, ag, lda, voa, 2, kt); GL(ya3, ag, lda, voa, 3, kt); GL(yb0, bg, ldb, vob, 0, kt); GL(yb1, bg, ldb, vob, 1, kt); GL(yb2, bg, ldb, vob, 2, kt); GL(yb3, bg, ldb, vob, 3, kt); }
#define GS(v, off) *reinterpret_cast<uint4*>(st0 + (off)) = v
#define GSTORE0(buf) { GS(xa0, (buf) * G_BUF_BYTES); GS(xa1, (buf) * G_BUF_BYTES + 32 * GROW * 2); GS(xa2, (buf) * G_BUF_BYTES + 64 * GROW * 2); GS(xa3, (buf) * G_BUF_BYTES + 96 * GROW * 2); \
                       GS(xb0, (buf) * G_BUF_BYTES + G_TILE_BYTES); GS(xb1, (buf) * G_BUF_BYTES + G_TILE_BYTES + 32 * GROW * 2); GS(xb2, (buf) * G_BUF_BYTES + G_TILE_BYTES + 64 * GROW * 2); GS(xb3, (buf) * G_BUF_BYTES + G_TILE_BYTES + 96 * GROW * 2); }
#define GSTORE1(buf) { GS(ya0, (buf) * G_BUF_BYTES); GS(ya1, (buf) * G_BUF_BYTES + 32 * GROW * 2); GS(ya2, (buf) * G_BUF_BYTES + 64 * GROW * 2); GS(ya3, (buf) * G_BUF_BYTES + 96 * GROW * 2); \
                       GS(yb0, (buf) * G_BUF_BYTES + G_TILE_BYTES); GS(yb1, (buf) * G_BUF_BYTES + G_TILE_BYTES + 32 * GROW * 2); GS(yb2, (buf) * G_BUF_BYTES + G_TILE_BYTES + 64 * GROW * 2); GS(yb3, (buf) * G_BUF_BYTES + G_TILE_BYTES + 96 * GROW * 2); }
  auto compute = [&](int buf) {
#pragma unroll
    for (int ks = 0; ks < 2; ++ks) {
      bf16x8 a[4], b[4];
#pragma unroll
      for (int i = 0; i < 4; ++i) a[i] = *reinterpret_cast<const bf16x8*>(a0p + buf * G_BUF_BYTES + i * 16 * GROW * 2 + ks * 64);
#pragma unroll
      for (int j = 0; j < 4; ++j) b[j] = *reinterpret_cast<const bf16x8*>(b0p + buf * G_BUF_BYTES + j * 16 * GROW * 2 + ks * 64);
      __builtin_amdgcn_s_setprio(1);
#pragma unroll
      for (int i = 0; i < 4; ++i)
#pragma unroll
        for (int j = 0; j < 4; ++j) acc[i][j] = mfma16(a[i], b[j], acc[i][j]);
      __builtin_amdgcn_s_setprio(0);
    }
  };
  const int nkt = K >> 6;
  GLOAD0(0);
  GLOAD1(1);
  GSTORE0(0);
  __syncthreads();
  for (int kt = 0; kt < nkt; kt += 2) {
    if (kt + 2 < nkt) GLOAD0(kt + 2);
    compute(0);
    GSTORE1(1);
    __syncthreads();
    if (kt + 3 < nkt) GLOAD1(kt + 3);
    compute(1);
    if (kt + 2 < nkt) GSTORE0(0);
    __syncthreads();
  }
#undef GL
#undef GLOAD0
#undef GLOAD1
#undef GS
#undef GSTORE0
#undef GSTORE1
}

template <int A, int B>
DI void zero_acc(f32x4 (&acc)[A][B]) {
#pragma unroll
  for (int i = 0; i < A; ++i)
#pragma unroll
    for (int j = 0; j < B; ++j) acc[i][j] = f32x4{0.f, 0.f, 0.f, 0.f};
}

DI void sincos_d(double a, double& c, double& s) {
  const double TWO_PI = 6.283185307179586476925;
  double n = rint(a / TWO_PI);
  double r = a - n * TWO_PI;
  c = cos(r); s = sin(r);
}

DI void phase_w0(const Params& P, long gtid, long gsz) {
  char* ws = P.ws;
  {
    u16* dst = (u16*)(ws + O_WTIN);
    const float* w = P.in[2]; const float* g = P.in[1];
    for (long idx = gtid; idx < (long)NL * 128 * DINP; idx += gsz) {
      int n = (int)(idx % DINP); long r = idx / DINP; int kb = (int)(r % 128); int l = (int)(r / 128);
      float v[8];
#pragma unroll
      for (int j = 0; j < 8; ++j) { int k = kb * 8 + j; v[j] = (n < DIN) ? w[((size_t)l * DM + k) * DIN + n] * g[l * DM + k] : 0.f; }
      uint4 o; o.x = pack2(v[0], v[1]); o.y = pack2(v[2], v[3]); o.z = pack2(v[4], v[5]); o.w = pack2(v[6], v[7]);
      *reinterpret_cast<uint4*>(dst + ((size_t)l * DINP + n) * DM + kb * 8) = o;
    }
  }
  {
    u16* dst = (u16*)(ws + O_WTOUT);
    const float* w = P.in[20];
    for (long idx = gtid; idx < (long)NL * 128 * DM; idx += gsz) {
      int n = (int)(idx % DM); long r = idx / DM; int kb = (int)(r % 128); int l = (int)(r / 128);
      float v[8];
#pragma unroll
      for (int j = 0; j < 8; ++j) { int k = kb * 8 + j; v[j] = w[((size_t)l * DM + k) * DM + n]; }
      uint4 o; o.x = pack2(v[0], v[1]); o.y = pack2(v[2], v[3]); o.z = pack2(v[4], v[5]); o.w = pack2(v[6], v[7]);
      *reinterpret_cast<uint4*>(dst + ((size_t)l * DM + n) * DM + kb * 8) = o;
    }
  }
  {
    u16* dst = (u16*)(ws + O_WTUQ);
    const float* w = P.in[7]; const float* g = P.in[5];
    for (long idx = gtid; idx < (long)NL * 32 * 768; idx += gsz) {
      int n = (int)(idx % 768); long r = idx / 768; int kb = (int)(r % 32); int l = (int)(r / 32);
      const int h = n >> 7, d = n & 127;
      float v[8];
#pragma unroll
      for (int j = 0; j < 8; ++j) { int k = kb * 8 + j; v[j] = (d < 96) ? w[((size_t)l * 256 + k) * 576 + h * 96 + d] * g[l * 256 + k] : 0.f; }
      uint4 o; o.x = pack2(v[0], v[1]); o.y = pack2(v[2], v[3]); o.z = pack2(v[4], v[5]); o.w = pack2(v[6], v[7]);
      *reinterpret_cast<uint4*>(dst + ((size_t)l * 768 + n) * 256 + kb * 8) = o;
    }
  }
  {
    u16* dst = (u16*)(ws + O_WTUKV);
    const float* w = P.in[8]; const float* g = P.in[6];
    for (long idx = gtid; idx < (long)NL * 16 * 768; idx += gsz) {
      int n = (int)(idx % 768); long r = idx / 768; int kb = (int)(r % 16); int l = (int)(r / 16);
      float v[8];
#pragma unroll
      for (int j = 0; j < 8; ++j) { int k = kb * 8 + j; v[j] = w[((size_t)l * 128 + k) * 768 + n] * g[l * 128 + k]; }
      uint4 o; o.x = pack2(v[0], v[1]); o.y = pack2(v[2], v[3]); o.z = pack2(v[4], v[5]); o.w = pack2(v[6], v[7]);
      *reinterpret_cast<uint4*>(dst + ((size_t)l * 768 + n) * 128 + kb * 8) = o;
    }
  }
  {
    u16* dst = (u16*)(ws + O_WTGLU);
    const float* w = P.in[19];
    for (long idx = gtid; idx < (long)NL * 32 * 256; idx += gsz) {
      int n = (int)(idx % 256); long r = idx / 256; int kb = (int)(r % 32); int l = (int)(r / 32);
      float v[8];
#pragma unroll
      for (int j = 0; j < 8; ++j) { int k = kb * 8 + j; v[j] = w[((size_t)l * 256 + k) * 256 + n]; }
      uint4 o; o.x = pack2(v[0], v[1]); o.y = pack2(v[2], v[3]); o.z = pack2(v[4], v[5]); o.w = pack2(v[6], v[7]);
      *reinterpret_cast<uint4*>(dst + ((size_t)l * 256 + n) * 256 + kb * 8) = o;
    }
  }
  {
    float2* r64 = (float2*)(ws + O_R64);
    for (long idx = gtid; idx < 4096L * 32; idx += gsz) {
      int i = (int)(idx & 31); int pos = (int)(idx >> 5);
      float inv = (float)pow(10000.0, -(double)i / 32.0);
      float ang = (float)pos * inv;
      double c, s; sincos_d((double)ang, c, s);
      r64[idx] = make_float2((float)c, (float)s);
    }
    float2* r32 = (float2*)(ws + O_R32);
    for (long idx = gtid; idx < 4096L * 16; idx += gsz) {
      int i = (int)(idx & 15); int pos = (int)(idx >> 4);
      float inv = (float)pow(10000.0, -(double)i / 16.0);
      float ang = (float)pos * inv;
      double c, s; sincos_d((double)ang, c, s);
      r32[idx] = make_float2((float)c, (float)s);
    }
  }
  {
    float2* pw = (float2*)(ws + O_PW);
    float2* fz = (float2*)(ws + O_FZ);
    const float* a_re = P.in[11]; const float* a_im = P.in[12]; const float* lstep = P.in[18];
    for (long idx = gtid; idx < (long)NL * 16 * 65 * 64; idx += gsz) {
      int p = (int)(idx & 63); long r = idx >> 6; int d = (int)(r % 65); int lg = (int)(r / 65);
      double step = exp((double)lstep[lg]);
      double ar = (double)a_re[lg * 64 + p], ai = (double)a_im[lg * 64 + p];
      double mag = exp((double)d * ar * step);
      double c, s; sincos_d((double)d * ai * step, c, s);
      pw[idx] = make_float2((float)(mag * c), (float)(mag * s));
      if (d == 1) {
        double abr = mag * c, abi = mag * s;
        double den = ar * ar + ai * ai, nr = abr - 1.0;
        double fre = (nr * ar + abi * ai) / den, fim = (abi * ar - nr * ai) / den;
        fz[lg * 64 + p] = make_float2((float)fre, (float)fim);
      }
    }
  }
}

DI void phase_w1(const Params& P, long gtid, long gsz) {
  char* ws = P.ws;
  const float2* pw = (const float2*)(ws + O_PW);
  const float2* fz = (const float2*)(ws + O_FZ);
  const float* b_re = P.in[13]; const float* b_im = P.in[14]; const float* c_re = P.in[15]; const float* c_im = P.in[16];
  {
    u16* w1 = (u16*)(ws + O_W1);
    for (long idx = gtid; idx < (long)NL * 16 * 128 * 128; idx += gsz) {
      int kb = (int)(idx & 127); long r = idx >> 7; int row = (int)(r & 127); int lg = (int)(r >> 7);
      int p = row >> 1, ri = row & 1; int i = kb >> 1, c0 = (kb & 1) * 8;
      float2 e = pw[((size_t)lg * 65 + (63 - i)) * 64 + p]; float2 f = fz[lg * 64 + p];
      float er = e.x * f.x - e.y * f.y, ei = e.x * f.y + e.y * f.x;
      float v[8];
#pragma unroll
      for (int j = 0; j < 8; ++j) {
        float br = b_re[((size_t)lg * 64 + p) * 16 + c0 + j], bi = b_im[((size_t)lg * 64 + p) * 16 + c0 + j];
        v[j] = ri ? (er * bi + ei * br) : (er * br - ei * bi);
      }
      uint4 o; o.x = pack2(v[0], v[1]); o.y = pack2(v[2], v[3]); o.z = pack2(v[4], v[5]); o.w = pack2(v[6], v[7]);
      *reinterpret_cast<uint4*>(w1 + ((size_t)lg * 128 + row) * 1024 + kb * 8) = o;
    }
  }
  {
    u16* w3 = (u16*)(ws + O_W3);
    for (long idx = gtid; idx < (long)NL * 16 * 1024 * 16; idx += gsz) {
      int kb = (int)(idx & 15); long r = idx >> 4; int f = (int)(r & 1023); int lg = (int)(r >> 10);
      int j = f >> 4, c = f & 15;
      float v[8];
#pragma unroll
      for (int jj = 0; jj < 4; ++jj) {
        int p = kb * 4 + jj;
        float2 e = pw[((size_t)lg * 65 + (j + 1)) * 64 + p];
        float cr = c_re[((size_t)lg * 16 + c) * 64 + p], ci = c_im[((size_t)lg * 16 + c) * 64 + p];
        v[2 * jj] = cr * e.x - ci * e.y;
        v[2 * jj + 1] = -(cr * e.y + ci * e.x);
      }
      uint4 o; o.x = pack2(v[0], v[1]); o.y = pack2(v[2], v[3]); o.z = pack2(v[4], v[5]); o.w = pack2(v[6], v[7]);
      *reinterpret_cast<uint4*>(w3 + ((size_t)lg * 1024 + f) * 128 + kb * 8) = o;
    }
  }
  {
    u16* kt = (u16*)(ws + O_KT);
    for (long idx = gtid; idx < (long)NL * 16 * 64 * 16 * 2; idx += gsz) {
      int cb = (int)(idx & 1); long r = idx >> 1; int c = (int)(r & 15); r >>= 4; int d = (int)(r & 63); int lg = (int)(r >> 6);
      float v[8];
#pragma unroll
      for (int j = 0; j < 8; ++j) v[j] = 0.f;
      for (int p = 0; p < 64; ++p) {
        float2 e = pw[((size_t)lg * 65 + d) * 64 + p]; float2 f = fz[lg * 64 + p];
        float er = e.x * f.x - e.y * f.y, ei = e.x * f.y + e.y * f.x;
        float cr = c_re[((size_t)lg * 16 + c) * 64 + p], ci = c_im[((size_t)lg * 16 + c) * 64 + p];
        float gr = cr * er - ci * ei, gi = cr * ei + ci * er;
#pragma unroll
        for (int j = 0; j < 8; ++j) {
          float br = b_re[((size_t)lg * 64 + p) * 16 + cb * 8 + j], bi = b_im[((size_t)lg * 64 + p) * 16 + cb * 8 + j];
          v[j] += gr * br - gi * bi;
        }
      }
      uint4 o; o.x = pack2(v[0], v[1]); o.y = pack2(v[2], v[3]); o.z = pack2(v[4], v[5]); o.w = pack2(v[6], v[7]);
      *reinterpret_cast<uint4*>(kt + (((size_t)lg * 64 + d) * 16 + c) * 16 + cb * 8) = o;
    }
  }
}

DI void phase_p0(const Params& P, int l) {
  const float* x = (l == 0) ? P.in[0] : P.out;
  u16* xb = (u16*)(P.ws + O_XB2);
  const int tid = opaque_tid();
  const int lane = tid & 63;
  const int gw = blockIdx.x * 4 + (tid >> 6), nw = gridDim.x * 4;
  for (int row = gw; row < T; row += nw) {
    const float4* xr = reinterpret_cast<const float4*>(x + (size_t)row * DM);
#pragma unroll
    for (int i = 0; i < 4; ++i) {
      float4 v = xr[i * 64 + lane];
      st4(xb + (size_t)row * DM + (i * 64 + lane) * 4, v.x, v.y, v.z, v.w);
    }
  }
}

DI void prep_mla_q(const Params& P, int l, int tw0, int lane) {
  const int q = lane >> 4, jn = lane & 15;
  const u16* proj = (const u16*)(P.ws + O_PROJ);
  const u16* W = (const u16*)(P.ws + O_WTUQ) + (size_t)l * 576 * 256;
  u16* mq = (u16*)(P.ws + O_MQ);
  const float2* r32 = (const float2*)(P.ws + O_R32);
  const float* gq = P.in[9] + l * 96;
  const u16* bp = proj + (size_t)(tw0 + jn) * DINP + C_CQ + q * 8;
  float rq[2];
#pragma unroll
  for (int t = 0; t < 2; ++t) {
    float ss = 0.f;
    for (int ks = 0; ks < 8; ++ks) {
      bf16x8 v = ld8(bp + (size_t)t * 16 * DINP + ks * 32);
#pragma unroll
      for (int j = 0; j < 8; ++j) { float f = bf2f((u16)v[j]); ss += f * f; }
    }
    ss = red4(ss);
    rq[t] = rsqrtf(ss * (1.0f / 256) + EPS);
  }
  const float qscale = 0.10206207261596577f * LOG2E;
  for (int h = 0; h < 6; ++h) {
    f32x4 acc[6][2]; zero_acc(acc);
    const u16* ap = W + (size_t)(h * 96 + jn) * 256 + q * 8;
    wgemm<6, 2>(acc, 8, [&](int i, int ks) { return ld8(ap + (size_t)i * 16 * 256 + ks * 32); },
                [&](int j, int ks) { return ld8(bp + (size_t)j * 16 * DINP + ks * 32); });
#pragma unroll
    for (int t = 0; t < 2; ++t) {
      const int tok = tw0 + 16 * t + jn, pos = tok & (S - 1);
      float ss = 0.f;
#pragma unroll
      for (int i = 0; i < 6; ++i)
#pragma unroll
        for (int r = 0; r < 4; ++r) { float v = acc[i][t][r] * rq[t]; acc[i][t][r] = v; ss += v * v; }
      ss = red4(ss);
      const float rs = rsqrtf(ss * (1.0f / 96) + EPS);
#pragma unroll
      for (int i = 0; i < 6; ++i)
#pragma unroll
        for (int r = 0; r < 4; ++r) acc[i][t][r] *= rs * gq[16 * i + 4 * q + r];
#pragma unroll
      for (int r = 0; r < 4; ++r) {
        float2 cs = r32[pos * 16 + 4 * q + r];
        float x1 = acc[4][t][r], x2 = acc[5][t][r];
        acc[4][t][r] = x1 * cs.x - x2 * cs.y; acc[5][t][r] = x2 * cs.x + x1 * cs.y;
      }
#pragma unroll
      for (int i = 0; i < 6; ++i)
        st4(mq + (size_t)tok * 576 + h * 96 + 16 * i + 4 * q, acc[i][t][0] * qscale, acc[i][t][1] * qscale, acc[i][t][2] * qscale, acc[i][t][3] * qscale);
    }
  }
}

DI void prep_mla_kv(const Params& P, int l, int tw0, int lane) {
  const int q = lane >> 4, jn = lane & 15;
  const u16* proj = (const u16*)(P.ws + O_PROJ);
  const u16* W = (const u16*)(P.ws + O_WTUKV) + (size_t)l * 768 * 128;
  u16* mk = (u16*)(P.ws + O_MK);
  u16* mvt = (u16*)(P.ws + O_MVT);
  const float2* r32 = (const float2*)(P.ws + O_R32);
  const float* gk = P.in[10] + l * 96;
  const u16* bp = proj + (size_t)(tw0 + jn) * DINP + C_CKV + q * 8;
  const int b = tw0 >> 12, pos0 = tw0 & (S - 1);
  float rkv[2];
#pragma unroll
  for (int t = 0; t < 2; ++t) {
    float ss = 0.f;
    for (int ks = 0; ks < 4; ++ks) {
      bf16x8 v = ld8(bp + (size_t)t * 16 * DINP + ks * 32);
#pragma unroll
      for (int j = 0; j < 8; ++j) { float f = bf2f((u16)v[j]); ss += f * f; }
    }
    ss = red4(ss);
    rkv[t] = rsqrtf(ss * (1.0f / 128) + EPS);
  }
  for (int h = 0; h < 6; ++h) {
    {
      f32x4 acc[4][2]; zero_acc(acc);
      const u16* ap = W + (size_t)(h * 128 + jn) * 128 + q * 8;
      wgemm<4, 2>(acc, 4, [&](int i, int ks) { return ld8(ap + (size_t)i * 16 * 128 + ks * 32); },
                  [&](int j, int ks) { return ld8(bp + (size_t)j * 16 * DINP + ks * 32); });
#pragma unroll
      for (int t = 0; t < 2; ++t) {
        const int tok = tw0 + 16 * t + jn, pos = tok & (S - 1);
        uint2 pl = ld4(proj + (size_t)tok * DINP + C_KPE + 4 * q);
        uint2 ph = ld4(proj + (size_t)tok * DINP + C_KPE + 16 + 4 * q);
        float kl[4] = {lo2f(pl.x), hi2f(pl.x), lo2f(pl.y), hi2f(pl.y)};
        float kh[4] = {lo2f(ph.x), hi2f(ph.x), lo2f(ph.y), hi2f(ph.y)};
        float ss = 0.f;
#pragma unroll
        for (int i = 0; i < 4; ++i)
#pragma unroll
          for (int r = 0; r < 4; ++r) { float v = acc[i][t][r] * rkv[t]; acc[i][t][r] = v; ss += v * v; }
#pragma unroll
        for (int r = 0; r < 4; ++r) ss += kl[r] * kl[r] + kh[r] * kh[r];
        ss = red4(ss);
        const float rs = rsqrtf(ss * (1.0f / 96) + EPS);
#pragma unroll
        for (int i = 0; i < 4; ++i) {
          const int d = 16 * i + 4 * q;
          st4(mk + (size_t)tok * 576 + h * 96 + d, acc[i][t][0] * rs * gk[d], acc[i][t][1] * rs * gk[d + 1], acc[i][t][2] * rs * gk[d + 2], acc[i][t][3] * rs * gk[d + 3]);
        }
        float y1[4], y2[4];
#pragma unroll
        for (int r = 0; r < 4; ++r) {
          float2 cs = r32[pos * 16 + 4 * q + r];
          float x1 = kl[r] * rs * gk[64 + 4 * q + r], x2 = kh[r] * rs * gk[80 + 4 * q + r];
          y1[r] = x1 * cs.x - x2 * cs.y; y2[r] = x2 * cs.x + x1 * cs.y;
        }
        st4(mk + (size_t)tok * 576 + h * 96 + 64 + 4 * q, y1[0], y1[1], y1[2], y1[3]);
        st4(mk + (size_t)tok * 576 + h * 96 + 80 + 4 * q, y2[0], y2[1], y2[2], y2[3]);
      }
    }
    {
      f32x4 acc[2][4]; zero_acc(acc);
      const u16* wp = W + (size_t)(h * 128 + 64 + jn) * 128 + q * 8;
      wgemm<2, 4>(acc, 4, [&](int i, int ks) { return ld8(bp + (size_t)i * 16 * DINP + ks * 32); },
                  [&](int j, int ks) { return ld8(wp + (size_t)j * 16 * 128 + ks * 32); });
#pragma unroll
      for (int i = 0; i < 2; ++i) {
        float rr[4];
#pragma unroll
        for (int r = 0; r < 4; ++r) rr[r] = __shfl(rkv[i], 4 * q + r);
#pragma unroll
        for (int j = 0; j < 4; ++j)
          st4(mvt + ((size_t)(b * 6 + h) * 64 + 16 * j + jn) * S + pos0 + 16 * i + 4 * q,
              acc[i][j][0] * rr[0], acc[i][j][1] * rr[1], acc[i][j][2] * rr[2], acc[i][j][3] * rr[3]);
      }
    }
  }
}

DI void prep_mla_tile(const Params& P, int l, int tt, char* lds, float* s_r, float* s_ss) {
  const int tid = opaque_tid();
  const int wave = __builtin_amdgcn_readfirstlane(tid >> 6), lane = tid & 63, q = lane >> 4, jn = lane & 15;
  const int wa = wave >> 1, wb = wave & 1;
  const int tok0 = tt * 128;
  const u16* proj = (const u16*)(P.ws + O_PROJ);
  const u16* Wq = (const u16*)(P.ws + O_WTUQ) + (size_t)l * 768 * 256;
  const u16* Wkv = (const u16*)(P.ws + O_WTUKV) + (size_t)l * 768 * 128;
  u16* mq = (u16*)(P.ws + O_MQ); u16* mk = (u16*)(P.ws + O_MK); u16* mvt = (u16*)(P.ws + O_MVT);
  const float2* r32 = (const float2*)(P.ws + O_R32);
  const float* gq = P.in[9] + l * 96; const float* gk = P.in[10] + l * 96;
  {
    const int row = tid >> 1, half = tid & 1;
    const u16* pq = proj + (size_t)(tok0 + row) * DINP + C_CQ + half * 128;
    const u16* pk = proj + (size_t)(tok0 + row) * DINP + C_CKV + half * 64;
    bf16x8 vq[16], vk[8];
#pragma unroll
    for (int u = 0; u < 16; ++u) vq[u] = ld8(pq + u * 8);
#pragma unroll
    for (int u = 0; u < 8; ++u) vk[u] = ld8(pk + u * 8);
    float sq = 0.f, sk = 0.f;
#pragma unroll
    for (int u = 0; u < 16; ++u)
#pragma unroll
      for (int j = 0; j < 8; ++j) { const float f = bf2f((u16)vq[u][j]); sq += f * f; }
#pragma unroll
    for (int u = 0; u < 8; ++u)
#pragma unroll
      for (int j = 0; j < 8; ++j) { const float f = bf2f((u16)vk[u][j]); sk += f * f; }
    sq += __shfl_xor(sq, 1); sk += __shfl_xor(sk, 1);
    if (half == 0) { s_r[row] = rsqrtf(sq * (1.0f / 256) + EPS); s_r[128 + row] = rsqrtf(sk * (1.0f / 128) + EPS); }
  }
  __syncthreads();
  const float qscale = 0.10206207261596577f * LOG2E;
#pragma unroll 1
  for (int h0 = 0; h0 < 6; ++h0) {
    int h = h0; asm volatile("" : "+s"(h));
    f32x4 acc[4][4]; zero_acc(acc);
    gemm_block(acc, Wq + (size_t)(h * 128) * 256, 256, proj + (size_t)tok0 * DINP + C_CQ, DINP, 256, lds, tid);
#pragma unroll
    for (int j = 0; j < 4; ++j) {
      const int tl = wb * 64 + 16 * j + jn; const float rq = s_r[tl];
      float ss = 0.f;
#pragma unroll
      for (int i = 0; i < 4; ++i)
#pragma unroll
        for (int r = 0; r < 4; ++r) { const float v = acc[i][j][r] * rq; acc[i][j][r] = v; ss += v * v; }
      ss = red4(ss);
      if (q == 0) s_ss[wa * 128 + tl] = ss;
    }
    __syncthreads();
#pragma unroll
    for (int j = 0; j < 4; ++j) {
      const int tl = wb * 64 + 16 * j + jn, tok = tok0 + tl, pos = tok & (S - 1);
      const float rs = rsqrtf((s_ss[tl] + s_ss[128 + tl]) * (1.0f / 96) + EPS);
      if (wa == 0) {
#pragma unroll
        for (int i = 0; i < 4; ++i) {
          const int d = 16 * i + 4 * q;
          st4(mq + (size_t)tok * 576 + h * 96 + d, acc[i][j][0] * rs * gq[d] * qscale, acc[i][j][1] * rs * gq[d + 1] * qscale,
              acc[i][j][2] * rs * gq[d + 2] * qscale, acc[i][j][3] * rs * gq[d + 3] * qscale);
        }
      } else {
        float y1[4], y2[4];
#pragma unroll
        for (int r = 0; r < 4; ++r) {
          const float2 cs = r32[pos * 16 + 4 * q + r];
          const float x1 = acc[0][j][r] * rs * gq[64 + 4 * q + r], x2 = acc[1][j][r] * rs * gq[80 + 4 * q + r];
          y1[r] = (x1 * cs.x - x2 * cs.y) * qscale; y2[r] = (x2 * cs.x + x1 * cs.y) * qscale;
        }
        st4(mq + (size_t)tok * 576 + h * 96 + 64 + 4 * q, y1[0], y1[1], y1[2], y1[3]);
        st4(mq + (size_t)tok * 576 + h * 96 + 80 + 4 * q, y2[0], y2[1], y2[2], y2[3]);
      }
    }
    __syncthreads();
  }
  const int b = tok0 >> 12, pos0 = tok0 & (S - 1);
#pragma unroll 1
  for (int h0 = 0; h0 < 6; ++h0) {
    int h = h0; asm volatile("" : "+s"(h));
    f32x4 acc[4][4]; zero_acc(acc);
    gemm_block(acc, Wkv + (size_t)(h * 128) * 128, 128, proj + (size_t)tok0 * DINP + C_CKV, DINP, 128, lds, tid, true);
    if (wa == 0) {
#pragma unroll
      for (int j = 0; j < 4; ++j) {
        const int tl = wb * 64 + 16 * j + jn, tok = tok0 + tl, pos = tok & (S - 1);
        const float rkv = s_r[128 + tl];
        const uint2 pl = ld4(proj + (size_t)tok * DINP + C_KPE + 4 * q);
        const uint2 ph = ld4(proj + (size_t)tok * DINP + C_KPE + 16 + 4 * q);
        const float kl[4] = {lo2f(pl.x), hi2f(pl.x), lo2f(pl.y), hi2f(pl.y)};
        const float kh[4] = {lo2f(ph.x), hi2f(ph.x), lo2f(ph.y), hi2f(ph.y)};
        float ss = 0.f;
#pragma unroll
        for (int i = 0; i < 4; ++i)
#pragma unroll
          for (int r = 0; r < 4; ++r) { const float v = acc[i][j][r] * rkv; acc[i][j][r] = v; ss += v * v; }
#pragma unroll
        for (int r = 0; r < 4; ++r) ss += kl[r] * kl[r] + kh[r] * kh[r];
        ss = red4(ss);
        const float rs = rsqrtf(ss * (1.0f / 96) + EPS);
#pragma unroll
        for (int i = 0; i < 4; ++i) {
          const int d = 16 * i + 4 * q;
          st4(mk + (size_t)tok * 576 + h * 96 + d, acc[i][j][0] * rs * gk[d], acc[i][j][1] * rs * gk[d + 1], acc[i][j][2] * rs * gk[d + 2], acc[i][j][3] * rs * gk[d + 3]);
        }
        float y1[4], y2[4];
#pragma unroll
        for (int r = 0; r < 4; ++r) {
          const float2 cs = r32[pos * 16 + 4 * q + r];
          const float x1 = kl[r] * rs * gk[64 + 4 * q + r], x2 = kh[r] * rs * gk[80 + 4 * q + r];
          y1[r] = x1 * cs.x - x2 * cs.y; y2[r] = x2 * cs.x + x1 * cs.y;
        }
        st4(mk + (size_t)tok * 576 + h * 96 + 64 + 4 * q, y1[0], y1[1], y1[2], y1[3]);
        st4(mk + (size_t)tok * 576 + h * 96 + 80 + 4 * q, y2[0], y2[1], y2[2], y2[3]);
      }
    } else {
#pragma unroll
      for (int i = 0; i < 4; ++i) {
        const int tl0 = wb * 64 + 16 * i + 4 * q;
        const float r0 = s_r[128 + tl0], r1 = s_r[128 + tl0 + 1], r2 = s_r[128 + tl0 + 2], r3 = s_r[128 + tl0 + 3];
#pragma unroll
        for (int j = 0; j < 4; ++j)
          st4(mvt + ((size_t)(b * 6 + h) * 64 + 16 * j + jn) * S + pos0 + tl0, acc[i][j][0] * r0, acc[i][j][1] * r1, acc[i][j][2] * r2, acc[i][j][3] * r3);
      }
    }
  }
}

DI void prep_dsa(const Params& P, int l, int tok0) {
  u16* proj = (u16*)(P.ws + O_PROJ);
  u16* avt = (u16*)(P.ws + O_AVT);
  const float2* r64 = (const float2*)(P.ws + O_R64);
  const float2* r32 = (const float2*)(P.ws + O_R32);
  const int tid = opaque_tid();
  for (int task = tid; task < 512; task += 256) {
    const int tok = tok0 + (task >> 2), c = task & 3, pos = tok & (S - 1);
    u16* row = proj + (size_t)tok * DINP;
    bf16x8 lo[7], hi[7];
#pragma unroll
    for (int hh = 0; hh < 7; ++hh) {
      const int base = (hh < 6) ? C_QA + 64 * hh : C_KA;
      lo[hh] = ld8(row + base + 8 * c); hi[hh] = ld8(row + base + 32 + 8 * c);
    }
    float2 cs[8];
    float gql[8], gqh[8], gkl[8], gkh[8];
    const float* gq = P.in[3] + l * 64; const float* gk = P.in[4] + l * 64;
#pragma unroll
    for (int j = 0; j < 8; ++j) {
      cs[j] = r64[pos * 32 + 8 * c + j];
      gql[j] = gq[8 * c + j]; gqh[j] = gq[32 + 8 * c + j]; gkl[j] = gk[8 * c + j]; gkh[j] = gk[32 + 8 * c + j];
    }
#pragma unroll
    for (int hh = 0; hh < 7; ++hh) {
      const int base = (hh < 6) ? C_QA + 64 * hh : C_KA;
      float xl[8], xh[8];
      float ss = 0.f;
#pragma unroll
      for (int j = 0; j < 8; ++j) { xl[j] = bf2f((u16)lo[hh][j]); xh[j] = bf2f((u16)hi[hh][j]); ss += xl[j] * xl[j] + xh[j] * xh[j]; }
      ss += __shfl_xor(ss, 1); ss += __shfl_xor(ss, 2);
      const float rs = rsqrtf(ss * (1.0f / 64) + EPS);
      const float sc = (hh < 6) ? 0.125f * LOG2E : 1.0f;
      float y1[8], y2[8];
#pragma unroll
      for (int j = 0; j < 8; ++j) {
        const float x1 = xl[j] * rs * ((hh < 6) ? gql[j] : gkl[j]), x2 = xh[j] * rs * ((hh < 6) ? gqh[j] : gkh[j]);
        y1[j] = (x1 * cs[j].x - x2 * cs[j].y) * sc; y2[j] = (x2 * cs[j].x + x1 * cs[j].y) * sc;
      }
      uint4 o; o.x = pack2(y1[0], y1[1]); o.y = pack2(y1[2], y1[3]); o.z = pack2(y1[4], y1[5]); o.w = pack2(y1[6], y1[7]);
      *reinterpret_cast<uint4*>(row + base + 8 * c) = o;
      o.x = pack2(y2[0], y2[1]); o.y = pack2(y2[2], y2[3]); o.z = pack2(y2[4], y2[5]); o.w = pack2(y2[6], y2[7]);
      *reinterpret_cast<uint4*>(row + base + 32 + 8 * c) = o;
    }
  }
  {
    const int tok = tok0 + (tid >> 1), c2 = tid & 1, pos = tok & (S - 1);
    u16* row = proj + (size_t)tok * DINP;
    bf16x8 lo[9], hi[9];
#pragma unroll
    for (int hh = 0; hh < 9; ++hh) {
      const int base = (hh < 8) ? C_IQ + 32 * hh : C_IK;
      lo[hh] = ld8(row + base + 8 * c2); hi[hh] = ld8(row + base + 16 + 8 * c2);
    }
    float2 cs[8];
#pragma unroll
    for (int j = 0; j < 8; ++j) cs[j] = r32[pos * 16 + 8 * c2 + j];
#pragma unroll
    for (int hh = 0; hh < 9; ++hh) {
      const int base = (hh < 8) ? C_IQ + 32 * hh : C_IK;
      float y1[8], y2[8];
#pragma unroll
      for (int j = 0; j < 8; ++j) {
        const float x1 = bf2f((u16)lo[hh][j]), x2 = bf2f((u16)hi[hh][j]);
        y1[j] = x1 * cs[j].x - x2 * cs[j].y; y2[j] = x2 * cs[j].x + x1 * cs[j].y;
      }
      uint4 o; o.x = pack2(y1[0], y1[1]); o.y = pack2(y1[2], y1[3]); o.z = pack2(y1[4], y1[5]); o.w = pack2(y1[6], y1[7]);
      *reinterpret_cast<uint4*>(row + base + 8 * c2) = o;
      o.x = pack2(y2[0], y2[1]); o.y = pack2(y2[2], y2[3]); o.z = pack2(y2[4], y2[5]); o.w = pack2(y2[6], y2[7]);
      *reinterpret_cast<uint4*>(row + base + 16 + 8 * c2) = o;
    }
  }
  {
    const int b = tok0 >> 12, pos0 = tok0 & (S - 1);
    const int dim = tid & 63, tg0 = tid >> 6;
    unsigned short v[8][4];
#pragma unroll
    for (int u = 0; u < 8; ++u) {
      const u16* p = proj + (size_t)(tok0 + 4 * (tg0 + 4 * u)) * DINP + C_VA + dim;
#pragma unroll
      for (int k = 0; k < 4; ++k) v[u][k] = p[k * DINP];
    }
#pragma unroll
    for (int u = 0; u < 8; ++u) {
      uint2 o; o.x = (unsigned)v[u][0] | ((unsigned)v[u][1] << 16); o.y = (unsigned)v[u][2] | ((unsigned)v[u][3] << 16);
      *reinterpret_cast<uint2*>(avt + ((size_t)b * 64 + dim) * S + pos0 + 4 * (tg0 + 4 * u)) = o;
    }
  }
}

DI void prep_tile(const Params& P, int l, int tile, char* lds, float* s_r) {
  const int tid = opaque_tid();
  const int wave = __builtin_amdgcn_readfirstlane(tid >> 6), lane = tid & 63;
  const int tok0 = tile * 128;
  prep_mla_tile(P, l, tile, lds, s_r, s_r + 256);
  prep_dsa(P, l, tok0);
}

DI void inproj_tile(const Params& P, int l, int tt, char* lds, float* s_rstd, float* s_prep) {
  const u16* W = (const u16*)(P.ws + O_WTIN) + (size_t)l * DINP * DM;
  const u16* xb = (const u16*)(P.ws + O_XB2);
  u16* proj = (u16*)(P.ws + O_PROJ);
  const int tid = opaque_tid();
  const int wave = __builtin_amdgcn_readfirstlane(tid >> 6), lane = tid & 63, q = lane >> 4, jn = lane & 15;
  {
    {
      const u16* rp = xb + (size_t)(tt * 128 + (tid >> 1)) * DM + (tid & 1) * 512;
      float ss = 0.f;
#pragma unroll 1
      for (int c = 0; c < 8; ++c) {
        bf16x8 v[8];
#pragma unroll
        for (int u = 0; u < 8; ++u) v[u] = ld8(rp + (c * 8 + u) * 8);
#pragma unroll
        for (int u = 0; u < 8; ++u)
#pragma unroll
          for (int j = 0; j < 8; ++j) { const float f = bf2f((u16)v[u][j]); ss += f * f; }
      }
      ss += __shfl_xor(ss, 1);
      if ((tid & 1) == 0) s_rstd[tid >> 1] = rsqrtf(ss * (1.0f / DM) + EPS);
    }
    __syncthreads();
#pragma unroll 1
    for (int ftile0 = 0; ftile0 < 20; ++ftile0) {
      int ftile = ftile0; asm volatile("" : "+s"(ftile));
      const int f0 = ftile * 128 + (wave >> 1) * 64, t0 = tt * 128 + (wave & 1) * 64;
      f32x4 acc[4][4]; zero_acc(acc);
      gemm_block(acc, W + (size_t)(ftile * 128) * DM, DM, xb + (size_t)(tt * 128) * DM, DM, DM, lds, tid);
#pragma unroll
      for (int j = 0; j < 4; ++j) {
        const int tok = t0 + 16 * j + jn; const float rs = s_rstd[(wave & 1) * 64 + 16 * j + jn];
#pragma unroll
        for (int i = 0; i < 4; ++i)
          st4(proj + (size_t)tok * DINP + f0 + 16 * i + 4 * q, acc[i][j][0] * rs, acc[i][j][1] * rs, acc[i][j][2] * rs, acc[i][j][3] * rs);
      }
    }
    asm volatile("s_waitcnt vmcnt(0)" ::: "memory");
    __syncthreads();
    prep_tile(P, l, tt, lds, s_prep);
    __syncthreads();
  }
}

DI void phase_inproj(const Params& P, int l, char* lds, float* s_rstd, float* s_prep) {
  for (int tt = blockIdx.x; tt < 512; tt += gridDim.x) inproj_tile(P, l, tt, lds, s_rstd, s_prep);
}

template <int KS, bool MASK>
DI void attn_block_v1(const u16* Qp, int qstride, const u16* Kp, int kstride, const u16* Vtp, const u64* maskp, int nkt_w, int nkt_max,
                   const u16* gatep, int gstride, u16* outp, int ostride, char* lds, int tid) {
  constexpr int DQK = KS * 32, KROW = DQK + 8, VROW = 72;
  constexpr int KCH = DQK / 8, NKC = 64 * KCH / 256;
  constexpr int K_BYTES = 64 * KROW * 2, BUF_BYTES = K_BYTES + 64 * VROW * 2;
  const int lane = tid & 63, q = lane >> 4, jn = lane & 15;
  const float NEG_INF = -__builtin_inff();
  uint4 kst[NKC], vst[2];
  auto gload = [&](int kt) {
#pragma unroll
    for (int i = 0; i < NKC; ++i) {
      const int c = tid + 256 * i, row = c / KCH, col = c % KCH;
      kst[i] = *reinterpret_cast<const uint4*>(Kp + (size_t)(kt * 64 + row) * kstride + col * 8);
    }
#pragma unroll
    for (int i = 0; i < 2; ++i) {
      const int c = tid + 256 * i, dim = c >> 3, part = c & 7;
      vst[i] = *reinterpret_cast<const uint4*>(Vtp + (size_t)dim * S + kt * 64 + part * 8);
    }
  };
  auto lstore = [&](int buf) {
    char* kb = lds + buf * BUF_BYTES; char* vb = kb + K_BYTES;
#pragma unroll
    for (int i = 0; i < NKC; ++i) {
      const int c = tid + 256 * i, row = c / KCH, col = c % KCH;
      *reinterpret_cast<uint4*>(kb + (row * KROW + col * 8) * 2) = kst[i];
    }
#pragma unroll
    for (int i = 0; i < 2; ++i) {
      const int c = tid + 256 * i, dim = c >> 3, part = c & 7;
      *reinterpret_cast<uint4*>(vb + (dim * VROW + part * 8) * 2) = vst[i];
    }
  };
  bf16x8 qf[2][KS];
#pragma unroll
  for (int c = 0; c < 2; ++c)
#pragma unroll
    for (int ks = 0; ks < KS; ++ks) qf[c][ks] = ld8(Qp + (size_t)(16 * c + jn) * qstride + ks * 32 + q * 8);
  f32x4 o[4][2]; zero_acc(o);
  float m[2] = {NEG_INF, NEG_INF}, lsum[2] = {0.f, 0.f};
  u64 mw[2] = {0ull, 0ull}, mwn[2] = {0ull, 0ull};
  if (MASK) {
#pragma unroll
    for (int c = 0; c < 2; ++c) mw[c] = maskp[(size_t)(16 * c + jn) * 64];
  }
  gload(0);
  lstore(0);
  __syncthreads();
  for (int kt = 0; kt < nkt_max; ++kt) {
    const bool more = kt + 1 < nkt_max;
    if (more) {
      gload(kt + 1);
      if (MASK) {
        if (kt + 1 < nkt_w) {
#pragma unroll
          for (int c = 0; c < 2; ++c) mwn[c] = maskp[(size_t)(16 * c + jn) * 64 + kt + 1];
        }
      }
    }
    if (kt < nkt_w) {
      const char* kb = lds + (kt & 1) * BUF_BYTES; const char* vb = kb + K_BYTES;
      f32x4 s[4][2]; zero_acc(s);
#pragma unroll
      for (int a = 0; a < 4; ++a)
#pragma unroll
        for (int ks = 0; ks < KS; ++ks) {
          const bf16x8 kf = *reinterpret_cast<const bf16x8*>(kb + ((16 * a + jn) * KROW + ks * 32 + q * 8) * 2);
#pragma unroll
          for (int c = 0; c < 2; ++c) s[a][c] = mfma16(kf, qf[c][ks], s[a][c]);
        }
      if (MASK) {
#pragma unroll
        for (int c = 0; c < 2; ++c) {
          const u64 w = mw[c] >> (4 * q);
#pragma unroll
          for (int a = 0; a < 4; ++a)
#pragma unroll
            for (int r = 0; r < 4; ++r)
              if (!((w >> (16 * a + r)) & 1ull)) s[a][c][r] = NEG_INF;
        }
      }
      float alpha[2];
#pragma unroll
      for (int c = 0; c < 2; ++c) {
        float mx = NEG_INF;
#pragma unroll
        for (int a = 0; a < 4; ++a)
#pragma unroll
          for (int r = 0; r < 4; ++r) mx = fmaxf(mx, s[a][c][r]);
        mx = fmaxf(mx, __shfl_xor(mx, 16)); mx = fmaxf(mx, __shfl_xor(mx, 32));
        const float mn = fmaxf(m[c], mx);
        const float mu = (mn == NEG_INF) ? 0.f : mn;
        alpha[c] = fexp2(m[c] - mu);
        m[c] = mn;
        float ps = 0.f;
#pragma unroll
        for (int a = 0; a < 4; ++a)
#pragma unroll
          for (int r = 0; r < 4; ++r) { float p = fexp2(s[a][c][r] - mu); s[a][c][r] = p; ps += p; }
        lsum[c] = lsum[c] * alpha[c] + ps;
      }
      if (__builtin_amdgcn_ballot_w64(alpha[0] != 1.0f || alpha[1] != 1.0f) != 0ull) {
#pragma unroll
        for (int c = 0; c < 2; ++c)
#pragma unroll
          for (int dt = 0; dt < 4; ++dt)
#pragma unroll
            for (int r = 0; r < 4; ++r) o[dt][c][r] *= alpha[c];
      }
#pragma unroll
      for (int kk = 0; kk < 2; ++kk) {
        bf16x8 pf[2];
#pragma unroll
        for (int c = 0; c < 2; ++c) {
          uint4 w; w.x = pack2(s[2 * kk][c][0], s[2 * kk][c][1]); w.y = pack2(s[2 * kk][c][2], s[2 * kk][c][3]);
          w.z = pack2(s[2 * kk + 1][c][0], s[2 * kk + 1][c][1]); w.w = pack2(s[2 * kk + 1][c][2], s[2 * kk + 1][c][3]);
          pf[c] = __builtin_bit_cast(bf16x8, w);
        }
#pragma unroll
        for (int dt = 0; dt < 4; ++dt) {
          const char* vp = vb + ((16 * dt + jn) * VROW + kk * 32 + 4 * q) * 2;
          const uint2 lo = *reinterpret_cast<const uint2*>(vp), hi = *reinterpret_cast<const uint2*>(vp + 32);
          uint4 w; w.x = lo.x; w.y = lo.y; w.z = hi.x; w.w = hi.y;
          const bf16x8 vf = __builtin_bit_cast(bf16x8, w);
#pragma unroll
          for (int c = 0; c < 2; ++c) o[dt][c] = mfma16(vf, pf[c], o[dt][c]);
        }
      }
    }
    if (more) lstore((kt + 1) & 1);
    if (MASK) { mw[0] = mwn[0]; mw[1] = mwn[1]; }
    __syncthreads();
  }
#pragma unroll
  for (int c = 0; c < 2; ++c) {
    const float inv = 1.0f / red4(lsum[c]);
    const int row = 16 * c + jn;
#pragma unroll
    for (int dt = 0; dt < 4; ++dt) {
      uint2 gw = ld4(gatep + (size_t)row * gstride + 16 * dt + 4 * q);
      st4(outp + (size_t)row * ostride + 16 * dt + 4 * q, o[dt][c][0] * inv * siluf_(lo2f(gw.x)), o[dt][c][1] * inv * siluf_(hi2f(gw.x)),
          o[dt][c][2] * inv * siluf_(lo2f(gw.y)), o[dt][c][3] * inv * siluf_(hi2f(gw.y)));
    }
  }
}

template <int KS, bool MASK, int NC, bool SH>
DI void attn_block(const u16* Qp, int qstride, const u16* Kp, int kstride, const u16* Vtp, const u64* maskp, int nkt_w, int nkt_max,
                   const u16* gatep, int gstride, u16* outp, int ostride, char* lds, int tid) {
  constexpr int DQK = KS * 32, KROW = DQK + 8, VROW = 72;
  constexpr int KCH = DQK / 8, NKC = 64 * KCH / 256;
  constexpr int K_BYTES = 64 * KROW * 2, BUF_BYTES = K_BYTES + 64 * VROW * 2;
  const int lane = tid & 63, q = lane >> 4, jn = lane & 15;
  const float NEG_INF = -__builtin_inff();
  uint4 xk0, xk1, xk2, xv0, xv1, yk0, yk1, yk2, yv0, yv1;
  xk2 = yk2 = make_uint4(0, 0, 0, 0);
  const int c0 = tid, c1 = tid + 256, c2 = tid + 512;
  const u16* kg0 = Kp + (size_t)(c0 / KCH) * kstride + (c0 % KCH) * 8;
  const u16* kg1 = Kp + (size_t)(c1 / KCH) * kstride + (c1 % KCH) * 8;
  const u16* kg2 = Kp + (size_t)(c2 / KCH) * kstride + (c2 % KCH) * 8;
  const u16* vg0 = Vtp + (size_t)(c0 >> 3) * S + (c0 & 7) * 8;
  const u16* vg1 = Vtp + (size_t)(c1 >> 3) * S + (c1 & 7) * 8;
  char* ks0 = lds + ((c0 / KCH) * KROW + (c0 % KCH) * 8) * 2;
  char* ks1 = lds + ((c1 / KCH) * KROW + (c1 % KCH) * 8) * 2;
  char* ks2 = lds + ((c2 / KCH) * KROW + (c2 % KCH) * 8) * 2;
  char* vs0 = lds + K_BYTES + ((c0 >> 3) * VROW + (c0 & 7) * 8) * 2;
  char* vs1 = lds + K_BYTES + ((c1 >> 3) * VROW + (c1 & 7) * 8) * 2;
#define A_LOAD(P, kt) { const size_t ko = (size_t)(kt) * 64 * kstride; const int vo = (kt) * 64;                     \
    P##k0 = *reinterpret_cast<const uint4*>(kg0 + ko); P##k1 = *reinterpret_cast<const uint4*>(kg1 + ko);            \
    if (NKC == 3) P##k2 = *reinterpret_cast<const uint4*>(kg2 + ko);                                                 \
    P##v0 = *reinterpret_cast<const uint4*>(vg0 + vo); P##v1 = *reinterpret_cast<const uint4*>(vg1 + vo); }
#define A_STORE(P, buf) { *reinterpret_cast<uint4*>(ks0 + (buf) * BUF_BYTES) = P##k0; *reinterpret_cast<uint4*>(ks1 + (buf) * BUF_BYTES) = P##k1; \
    if (NKC == 3) *reinterpret_cast<uint4*>(ks2 + (buf) * BUF_BYTES) = P##k2;                                        \
    *reinterpret_cast<uint4*>(vs0 + (buf) * BUF_BYTES) = P##v0; *reinterpret_cast<uint4*>(vs1 + (buf) * BUF_BYTES) = P##v1; }
  bf16x8 qf[NC][KS];
#pragma unroll
  for (int c = 0; c < NC; ++c)
#pragma unroll
    for (int ks = 0; ks < KS; ++ks) qf[c][ks] = ld8(Qp + (size_t)((SH ? 0 : 16 * c) + jn) * qstride + (SH ? 64 * c : 0) + ks * 32 + q * 8);
  f32x4 o[4][NC]; zero_acc(o);
  float m[NC], lsum[NC];
#pragma unroll
  for (int c = 0; c < NC; ++c) { m[c] = NEG_INF; lsum[c] = 0.f; }
  u64 mce0 = 0ull, mce1 = 0ull, mco0 = 0ull, mco1 = 0ull, mne0 = 0ull, mne1 = 0ull, mno0 = 0ull, mno1 = 0ull;
  const u64* mrow0 = maskp + (size_t)jn * 64;
  const u64* mrow1 = maskp + (size_t)(16 + jn) * 64;
  if (MASK) {
    mce0 = mrow0[0]; if (!SH) mce1 = mrow1[0];
    if (1 < nkt_w) { mco0 = mrow0[1]; if (!SH) mco1 = mrow1[1]; }
  }
  auto compute = [&](int buf, u64 w0, u64 w1) {
    const char* kb = lds + buf * BUF_BYTES; const char* vb = kb + K_BYTES;
    f32x4 s[4][NC]; zero_acc(s);
#pragma unroll
    for (int a = 0; a < 4; ++a)
#pragma unroll
      for (int ks = 0; ks < KS; ++ks) {
        const bf16x8 kf = *reinterpret_cast<const bf16x8*>(kb + ((16 * a + jn) * KROW + ks * 32 + q * 8) * 2);
#pragma unroll
        for (int c = 0; c < NC; ++c) s[a][c] = mfma16(kf, qf[c][ks], s[a][c]);
      }
    if (MASK) {
#pragma unroll
      for (int c = 0; c < NC; ++c) {
        const u64 w = ((SH || c == 0) ? w0 : w1) >> (4 * q);
#pragma unroll
        for (int a = 0; a < 4; ++a)
#pragma unroll
          for (int r = 0; r < 4; ++r)
            if (!((w >> (16 * a + r)) & 1ull)) s[a][c][r] = NEG_INF;
      }
    }
    float alpha[NC];
#pragma unroll
    for (int c = 0; c < NC; ++c) {
      float mx = NEG_INF;
#pragma unroll
      for (int a = 0; a < 4; ++a)
#pragma unroll
        for (int r = 0; r < 4; ++r) mx = fmaxf(mx, s[a][c][r]);
      mx = fmaxf(mx, __shfl_xor(mx, 16)); mx = fmaxf(mx, __shfl_xor(mx, 32));
      const float mn = fmaxf(m[c], mx);
      const float mu = (mn == NEG_INF) ? 0.f : mn;
      alpha[c] = fexp2(m[c] - mu);
      m[c] = mn;
      float ps = 0.f;
#pragma unroll
      for (int a = 0; a < 4; ++a)
#pragma unroll
        for (int r = 0; r < 4; ++r) { float p = fexp2(s[a][c][r] - mu); s[a][c][r] = p; ps += p; }
      lsum[c] = lsum[c] * alpha[c] + ps;
    }
    bool resc = false;
#pragma unroll
    for (int c = 0; c < NC; ++c) resc = resc || (alpha[c] != 1.0f);
    if (__builtin_amdgcn_ballot_w64(resc) != 0ull) {
#pragma unroll
      for (int c = 0; c < NC; ++c)
#pragma unroll
        for (int dt = 0; dt < 4; ++dt)
#pragma unroll
          for (int r = 0; r < 4; ++r) o[dt][c][r] *= alpha[c];
    }
#pragma unroll
    for (int kk = 0; kk < 2; ++kk) {
      bf16x8 pf[NC];
#pragma unroll
      for (int c = 0; c < NC; ++c) {
        uint4 w; w.x = pack2(s[2 * kk][c][0], s[2 * kk][c][1]); w.y = pack2(s[2 * kk][c][2], s[2 * kk][c][3]);
        w.z = pack2(s[2 * kk + 1][c][0], s[2 * kk + 1][c][1]); w.w = pack2(s[2 * kk + 1][c][2], s[2 * kk + 1][c][3]);
        pf[c] = __builtin_bit_cast(bf16x8, w);
      }
#pragma unroll
      for (int dt = 0; dt < 4; ++dt) {
        const char* vp = vb + ((16 * dt + jn) * VROW + kk * 32 + 4 * q) * 2;
        const uint2 lo = *reinterpret_cast<const uint2*>(vp), hi = *reinterpret_cast<const uint2*>(vp + 32);
        uint4 w; w.x = lo.x; w.y = lo.y; w.z = hi.x; w.w = hi.y;
        const bf16x8 vf = __builtin_bit_cast(bf16x8, w);
#pragma unroll
        for (int c = 0; c < NC; ++c) o[dt][c] = mfma16(vf, pf[c], o[dt][c]);
      }
    }
  };

  A_LOAD(x, 0);
  { const int t1 = (nkt_max > 1) ? 1 : 0; A_LOAD(y, t1); }
  A_STORE(x, 0);
  __syncthreads();
  for (int kt = 0; kt < nkt_max; kt += 2) {
    const bool more = kt + 2 < nkt_max;
    if (more) {
      A_LOAD(x, kt + 2);
      if (MASK) {
        if (kt + 2 < nkt_w) { mne0 = mrow0[kt + 2]; if (!SH) mne1 = mrow1[kt + 2]; }
        if (kt + 3 < nkt_w) { mno0 = mrow0[kt + 3]; if (!SH) mno1 = mrow1[kt + 3]; }
      }
    }
    if (kt < nkt_w) compute(0, mce0, mce1);
    A_STORE(y, 1);
    __syncthreads();
    if (kt + 3 < nkt_max) A_LOAD(y, kt + 3);
    if (kt + 1 < nkt_w) compute(1, mco0, mco1);
    if (more) A_STORE(x, 0);
    if (MASK) { mce0 = mne0; mce1 = mne1; mco0 = mno0; mco1 = mno1; }
    __syncthreads();
  }
#undef A_LOAD
#undef A_STORE
#pragma unroll
  for (int c = 0; c < NC; ++c) {
    const float inv = 1.0f / red4(lsum[c]);
    const int row = (SH ? 0 : 16 * c) + jn;
    const int hc = SH ? 64 * c : 0;
#pragma unroll
    for (int dt = 0; dt < 4; ++dt) {
      uint2 gw = ld4(gatep + (size_t)row * gstride + hc + 16 * dt + 4 * q);
      st4(outp + (size_t)row * ostride + hc + 16 * dt + 4 * q, o[dt][c][0] * inv * siluf_(lo2f(gw.x)), o[dt][c][1] * inv * siluf_(hi2f(gw.x)),
          o[dt][c][2] * inv * siluf_(lo2f(gw.y)), o[dt][c][3] * inv * siluf_(hi2f(gw.y)));
    }
  }
}

DI void mla_attn_item(const Params& P, int it, char* lds, int tid) {
  const int wave = __builtin_amdgcn_readfirstlane(tid >> 6);
  const int qb = 31 - it / 96, bh = it % 96, b = bh / 6, h = bh % 6;
  const int q0 = qb * 128 + wave * 32;
  const int nkt = (q0 >> 6) + 1;
  const u16* mq = (const u16*)(P.ws + O_MQ); const u16* mk = (const u16*)(P.ws + O_MK); const u16* mvt = (const u16*)(P.ws + O_MVT);
  const u16* proj = (const u16*)(P.ws + O_PROJ); u16* mixed = (u16*)(P.ws + O_XB);
  const size_t tok = (size_t)b * S + q0;
  attn_block<3, false, 2, false>(mq + tok * 576 + h * 96, 576, mk + (size_t)b * S * 576 + h * 96, 576, mvt + (size_t)(b * 6 + h) * 64 * S, nullptr, nkt, 2 * qb + 2,
                       proj + tok * DINP + C_GC + h * 64, DINP, mixed + tok * DM + 640 + h * 64, DM, lds, tid);
}

DI void dsa_attn_item(const Params& P, int it, char* lds, int tid) {
  const int wave = __builtin_amdgcn_readfirstlane(tid >> 6);
  const int ch = 63 - it / 32, bh = it % 32, b = bh >> 1, hg = bh & 1;
  const int q0 = ch * 64 + wave * 16;
  const int nkt = ch + 1;
  const u16* proj = (const u16*)(P.ws + O_PROJ); const u16* avt = (const u16*)(P.ws + O_AVT); u16* mixed = (u16*)(P.ws + O_XB);
  const u64* mask = (const u64*)(P.ws + O_MASK);
  const size_t tok = (size_t)b * S + q0;
  attn_block<2, true, 3, true>(proj + tok * DINP + C_QA + hg * 192, DINP, proj + (size_t)b * S * DINP + C_KA, DINP, avt + (size_t)b * 64 * S, mask + tok * 64, nkt, nkt,
                               proj + tok * DINP + C_GA + hg * 192, DINP, mixed + tok * DM + hg * 192, DM, lds, tid);
}

constexpr int SC_STRIDE = 4096 + 16;
DI unsigned fkey(float f) { unsigned u = __float_as_uint(f); return (u & 0x80000000u) ? ~u : (u | 0x80000000u); }
DI float funkey(unsigned k) { return __uint_as_float((k & 0x80000000u) ? (k ^ 0x80000000u) : ~k); }

template <int NR>
DI u64 select_wave(float* scw, int nreg, int lane) {
  unsigned key[NR];
  unsigned kmin = 0xffffffffu, kmax = 0u;
#pragma unroll
  for (int r = 0; r < NR; ++r) {
    const unsigned k = fkey(scw[64 * r + lane]);
    const bool ok = r < nreg;
    key[r] = ok ? k : 0u;
    kmin = min(kmin, ok ? k : 0xffffffffu); kmax = max(kmax, key[r]);
  }
#pragma unroll
  for (int o = 1; o < 64; o <<= 1) { kmin = min(kmin, (unsigned)__shfl_xor((int)kmin, o)); kmax = max(kmax, (unsigned)__shfl_xor((int)kmax, o)); }
  unsigned lo = __builtin_amdgcn_readfirstlane(kmin), hi = __builtin_amdgcn_readfirstlane(kmax);
  int clo = 64 * nreg, chi = 0;
  bool exact = false;
  int iter = 0;
  while (lo < hi && clo - chi > 512) {
    unsigned mid = fkey(0.5f * (funkey(lo) + funkey(hi)));
    if (iter >= 16) mid = lo + ((hi - lo + 1u) >> 1);
    if (mid <= lo) mid = lo + 1;
    if (mid > hi) mid = hi;
    ++iter;
    int cnt = 0;
#pragma unroll
    for (int r = 0; r < NR; ++r) cnt += __builtin_popcountll(__builtin_amdgcn_ballot_w64(key[r] >= mid));
    if (cnt >= 256) { lo = mid; clo = cnt; if (cnt == 256) { exact = true; break; } }
    else { hi = mid - 1; chi = cnt; }
  }
  if (!exact && lo < hi) {
    unsigned* cand = reinterpret_cast<unsigned*>(scw);
    int base = 0;
#pragma unroll
    for (int r = 0; r < NR; ++r) {
      const bool pred = (key[r] >= lo) && (key[r] <= hi);
      const u64 bal = __builtin_amdgcn_ballot_w64(pred);
      const int pos = base + __builtin_amdgcn_mbcnt_hi((unsigned)(bal >> 32), __builtin_amdgcn_mbcnt_lo((unsigned)bal, 0u));
      if (pred) cand[pos] = key[r];
      base += __builtin_popcountll(bal);
    }
    __builtin_amdgcn_fence(__ATOMIC_RELEASE, "wavefront");
    __builtin_amdgcn_fence(__ATOMIC_ACQUIRE, "wavefront");
    unsigned ck[8];
#pragma unroll
    for (int i = 0; i < 8; ++i) { const unsigned v = cand[64 * i + lane]; ck[i] = (64 * i + lane < base) ? v : 0u; }
    const int cabove = chi;
    while (lo < hi) {
      unsigned mid = fkey(0.5f * (funkey(lo) + funkey(hi)));
      if (iter >= 16) mid = lo + ((hi - lo + 1u) >> 1);
      if (mid <= lo) mid = lo + 1;
      if (mid > hi) mid = hi;
      ++iter;
      int cnt = cabove;
#pragma unroll
      for (int i = 0; i < 8; ++i) cnt += __builtin_popcountll(__builtin_amdgcn_ballot_w64(ck[i] >= mid));
      if (cnt >= 256) { lo = mid; if (cnt == 256) { exact = true; break; } }
      else { hi = mid - 1; }
    }
  }
  const unsigned thr = lo;
  u64 myword = 0ull;
  if (exact) {
#pragma unroll
    for (int r = 0; r < NR; ++r) { const u64 bal = __builtin_amdgcn_ballot_w64(key[r] >= thr); if (lane == r) myword = bal; }
  } else {
    int cgt = 0;
#pragma unroll
    for (int r = 0; r < NR; ++r) cgt += __builtin_popcountll(__builtin_amdgcn_ballot_w64(key[r] > thr));
    const int need = 256 - cgt;
    int run = 0;
    const u64 below = (1ull << lane) - 1ull;
#pragma unroll
    for (int r = 0; r < NR; ++r) {
      const u64 eq = __builtin_amdgcn_ballot_w64(key[r] == thr);
      const int rank = run + __builtin_popcountll(eq & below);
      const bool sel = (key[r] > thr) || ((key[r] == thr) && (rank < need));
      const u64 bal = __builtin_amdgcn_ballot_w64(sel);
      run += __builtin_popcountll(eq);
      if (lane == r) myword = bal;
    }
  }
  return myword;
}

DI void dsa_select_item(const Params& P, int it, float* sc, int wave, int lane) {
  const int qd = 1023 - it / 16, b = it % 16;
  const int t0 = qd * 4;
  const int N = ((t0 >> 6) + 1) * 64, nreg = N >> 6;
  const u16* base = (const u16*)(P.ws + O_PROJ) + (size_t)b * S * DINP;
  u64* mask = (u64*)(P.ws + O_MASK);
  const int q = lane >> 4, jn = lane & 15;
  if (N > 256) {
    const bf16x8 a0 = ld8(base + (size_t)(t0 + (jn >> 2)) * DINP + C_IQ + (jn & 3) * 32 + q * 8);
    const bf16x8 a1 = ld8(base + (size_t)(t0 + (jn >> 2)) * DINP + C_IQ + (4 + (jn & 3)) * 32 + q * 8);
    float w[8];
    {
      bf16x8 wv = ld8(base + (size_t)(t0 + q) * DINP + C_IW);
#pragma unroll
      for (int h = 0; h < 8; ++h) w[h] = bf2f((u16)wv[h]) * (0.35355339059327373f * 0.17677669529663687f);
    }
    const int tpw = N >> 6;
    const u16* kbase = base + (size_t)jn * DINP + C_IK + q * 8;
    for (int tl = 0; tl < tpw; tl += 16) {
      bf16x8 bk[16];
#pragma unroll
      for (int u = 0; u < 16; ++u) {
        const int t = (tl + u < tpw) ? tl + u : tpw - 1;
        bk[u] = ld8(kbase + (size_t)((wave * tpw + t) * 16) * DINP);
      }
#pragma unroll
      for (int u = 0; u < 16; ++u) {
        const int t = (tl + u < tpw) ? tl + u : tpw - 1;
        const int key0 = (wave * tpw + t) * 16;
        const f32x4 z = {0.f, 0.f, 0.f, 0.f};
        f32x4 d0 = mfma16(a0, bk[u], z), d1 = mfma16(a1, bk[u], z);
        float sv = 0.f;
#pragma unroll
        for (int r = 0; r < 4; ++r) sv += fmaxf(d0[r], 0.f) * w[r];
#pragma unroll
        for (int r = 0; r < 4; ++r) sv += fmaxf(d1[r], 0.f) * w[4 + r];
        sc[q * SC_STRIDE + key0 + jn] = sv;
      }
    }
  }
  __syncthreads();
  u64 myword = ~0ull;
  if (N > 256) {
    float* scw = sc + wave * SC_STRIDE;
    if (nreg <= 8) myword = select_wave<8>(scw, nreg, lane);
    else if (nreg <= 16) myword = select_wave<16>(scw, nreg, lane);
    else if (nreg <= 24) myword = select_wave<24>(scw, nreg, lane);
    else if (nreg <= 32) myword = select_wave<32>(scw, nreg, lane);
    else if (nreg <= 48) myword = select_wave<48>(scw, nreg, lane);
    else myword = select_wave<64>(scw, nreg, lane);
  }
  if (lane < nreg) mask[((size_t)b * S + t0 + wave) * 64 + lane] = myword;
  __syncthreads();
}

DI void s5_stage1_item(const Params& P, int l, int it, int wave, int lane) {
  const int b = it >> 4, g = it & 15, q = lane >> 4, jn = lane & 15;
  const u16* proj = (const u16*)(P.ws + O_PROJ);
  const u16* W1 = (const u16*)(P.ws + O_W1) + (size_t)(l * 16 + g) * 128 * 1024;
  float* s5s = (float*)(P.ws + O_S5S) + (size_t)it * 64 * 128;
  f32x4 acc[2][4]; zero_acc(acc);
  const u16* ap = W1 + (size_t)(wave * 32 + jn) * 1024 + q * 8;
  const u16* up = proj + ((size_t)b * S + (size_t)jn * 64 + (q >> 1)) * DINP + C_U + g * 16 + (q & 1) * 8;
  wgemm<2, 4>(acc, 32, [&](int i, int ks) { return ld8(ap + (size_t)i * 16 * 1024 + ks * 32); },
              [&](int j, int ks) { return ld8(up + ((size_t)j * 16 * 64 + 2 * ks) * DINP); });
#pragma unroll
  for (int j = 0; j < 4; ++j) {
    const int n = 16 * j + jn;
#pragma unroll
    for (int i = 0; i < 2; ++i)
      *reinterpret_cast<f32x4*>(s5s + (size_t)n * 128 + wave * 32 + 16 * i + 4 * q) = acc[i][j];
  }
}

constexpr int HS_STRIDE = 136;
DI void s5_stage3_item(const Params& P, int l, int it, u16* hs, int wave, int lane) {
  const int b = it >> 4, g = it & 15, q = lane >> 4, jn = lane & 15;
  const u16* proj = (const u16*)(P.ws + O_PROJ);
  const u16* Kt = (const u16*)(P.ws + O_KT) + (size_t)(l * 16 + g) * 64 * 256;
  const u16* W3 = (const u16*)(P.ws + O_W3) + (size_t)(l * 16 + g) * 1024 * 128;
  const float* s5s = (const float*)(P.ws + O_S5S) + (size_t)it * 64 * 128;
  const float2* pw = (const float2*)(P.ws + O_PW);
  u16* yg = (u16*)(P.ws + O_YG);
  const float* dsk = P.in[17] + (l * 16 + g) * 16;
  if (wave == 0) {
    const int p = lane;
    const float2 aL = pw[((size_t)(l * 16 + g) * 65 + 64) * 64 + p];
    float hr = 0.f, hi = 0.f;
#pragma unroll
    for (int half = 0; half < 2; ++half) {
      float2 sv[32];
#pragma unroll
      for (int n = 0; n < 32; ++n) sv[n] = *reinterpret_cast<const float2*>(s5s + (size_t)(half * 32 + n) * 128 + 2 * p);
#pragma unroll
      for (int n = 0; n < 32; ++n) {
        *reinterpret_cast<unsigned*>(hs + (half * 32 + n) * HS_STRIDE + 2 * p) = pack2(hr, hi);
        const float nr = aL.x * hr - aL.y * hi + sv[n].x, ni = aL.x * hi + aL.y * hr + sv[n].y;
        hr = nr; hi = ni;
      }
    }
  }
  __syncthreads();
  const u16* up = proj + ((size_t)b * S + (size_t)jn * 64 + (q >> 1)) * DINP + C_U + g * 16 + (q & 1) * 8;
  const bf16x8 zf = {0, 0, 0, 0, 0, 0, 0, 0};
  for (int gi = 0; gi < 8; ++gi) {
    const int jg = wave + 4 * (gi >> 1);
    const int th = gi & 1;
    f32x4 acc[4][2]; zero_acc(acc);
    wgemm<4, 2>(acc, 2 * jg + 2,
                [&](int i, int ks) { const int j = 4 * jg + i, ii = 2 * ks + (q >> 1); const int d = j - ii;
                                     return (d >= 0) ? ld8(Kt + ((size_t)d * 16 + jn) * 16 + (q & 1) * 8) : zf; },
                [&](int jt, int ks) { return ld8(up + ((size_t)(2 * th + jt) * 16 * 64 + 2 * ks) * DINP); });
    wgemm<4, 2>(acc, 4,
                [&](int i, int ks) { return ld8(W3 + ((size_t)(4 * jg + i) * 16 + jn) * 128 + ks * 32 + q * 8); },
                [&](int jt, int ks) { return *reinterpret_cast<const bf16x8*>(hs + (16 * (2 * th + jt) + jn) * HS_STRIDE + ks * 32 + q * 8); });
#pragma unroll
    for (int jt = 0; jt < 2; ++jt) {
      const int n = 16 * (2 * th + jt) + jn;
#pragma unroll
      for (int i = 0; i < 4; ++i) {
        const size_t tok = (size_t)b * S + n * 64 + 4 * jg + i;
        uint2 uw = ld4(proj + tok * DINP + C_U + g * 16 + 4 * q);
        const float y0 = acc[i][jt][0] + dsk[4 * q] * lo2f(uw.x), y1 = acc[i][jt][1] + dsk[4 * q + 1] * hi2f(uw.x);
        const float y2 = acc[i][jt][2] + dsk[4 * q + 2] * lo2f(uw.y), y3 = acc[i][jt][3] + dsk[4 * q + 3] * hi2f(uw.y);
        st4(yg + tok * 256 + g * 16 + 4 * q, geluf_(y0), geluf_(y1), geluf_(y2), geluf_(y3));
      }
    }
  }
  __syncthreads();
}

DI void glu_tile(const Params& P, int l, int tt, char* lds) {
  const u16* W = (const u16*)(P.ws + O_WTGLU) + (size_t)l * 256 * 256;
  const u16* yg = (const u16*)(P.ws + O_YG);
  const u16* proj = (const u16*)(P.ws + O_PROJ);
  u16* mixed = (u16*)(P.ws + O_XB);
  const int tid = opaque_tid();
  const int wave = __builtin_amdgcn_readfirstlane(tid >> 6), lane = tid & 63, q = lane >> 4, jn = lane & 15;
#pragma unroll 1
  for (int ftile = 0; ftile < 2; ++ftile) {
    const int f0 = ftile * 128 + (wave >> 1) * 64, t0 = tt * 128 + (wave & 1) * 64;
    f32x4 acc[4][4]; zero_acc(acc);
    gemm_block(acc, W + (size_t)(ftile * 128) * 256, 256, yg + (size_t)(tt * 128) * 256, 256, 256, lds, tid);
#pragma unroll
    for (int j = 0; j < 4; ++j) {
      const size_t tok = t0 + 16 * j + jn;
#pragma unroll
      for (int i = 0; i < 4; ++i) {
        const int f = f0 + 16 * i + 4 * q;
        uint2 gw = ld4(yg + tok * 256 + f), bw = ld4(proj + tok * DINP + C_GB + f);
        st4(mixed + tok * DM + 384 + f, lo2f(gw.x) * sigmoidf_(acc[i][j][0]) * siluf_(lo2f(bw.x)), hi2f(gw.x) * sigmoidf_(acc[i][j][1]) * siluf_(hi2f(bw.x)),
            lo2f(gw.y) * sigmoidf_(acc[i][j][2]) * siluf_(lo2f(bw.y)), hi2f(gw.y) * sigmoidf_(acc[i][j][3]) * siluf_(hi2f(bw.y)));
      }
    }
  }
}

DI void outproj_tile(const Params& P, int l, int tt, char* lds) {
  const u16* W = (const u16*)(P.ws + O_WTOUT) + (size_t)l * DM * DM;
  const u16* mixed = (const u16*)(P.ws + O_XB);
  const float* xin = (l == 0) ? P.in[0] : P.out;
  float* xout = P.out;
  u16* xb2 = (u16*)(P.ws + O_XB2);
  const int tid = opaque_tid();
  const int wave = __builtin_amdgcn_readfirstlane(tid >> 6), lane = tid & 63, q = lane >> 4, jn = lane & 15;
#pragma unroll 1
  for (int ftile0 = 0; ftile0 < 8; ++ftile0) {
    int ftile = ftile0; asm volatile("" : "+s"(ftile));
    const int f0 = ftile * 128 + (wave >> 1) * 64, t0 = tt * 128 + (wave & 1) * 64;
    f32x4 acc[4][4]; zero_acc(acc);
    gemm_block(acc, W + (size_t)(ftile * 128) * DM, DM, mixed + (size_t)(tt * 128) * DM, DM, DM, lds, tid);
#pragma unroll
    for (int j = 0; j < 4; ++j) {
      const size_t tok = t0 + 16 * j + jn;
#pragma unroll
      for (int i = 0; i < 4; ++i) {
        const int f = f0 + 16 * i + 4 * q;
        f32x4 xv;
        if (l == 0) xv = *reinterpret_cast<const f32x4*>(xin + tok * DM + f);
        else { const uint2 xw = ld4(xb2 + tok * DM + f); xv = f32x4{lo2f(xw.x), hi2f(xw.x), lo2f(xw.y), hi2f(xw.y)}; }
        const f32x4 xn = xv + acc[i][j];
        if (l == NL - 1) *reinterpret_cast<f32x4*>(xout + tok * DM + f) = xn;
        else st4(xb2 + tok * DM + f, xn[0], xn[1], xn[2], xn[3]);
      }
    }
  }
}

DI void phase_tail(const Params& P, int l, char* lds, float* s_rstd, float* s_prep) {
  for (int tt = blockIdx.x; tt < 512; tt += gridDim.x) {
    glu_tile(P, l, tt, lds);
    asm volatile("s_waitcnt vmcnt(0)" ::: "memory");
    __syncthreads();
    outproj_tile(P, l, tt, lds);
    if (l + 1 < NL) {
      asm volatile("s_waitcnt vmcnt(0)" ::: "memory");
      __syncthreads();
      inproj_tile(P, l + 1, tt, lds, s_rstd, s_prep);
    }
  }
}

DI void gbar(unsigned* ctr, unsigned& epoch) {
  asm volatile("s_waitcnt vmcnt(0)" ::: "memory");
  __syncthreads();
  epoch += gridDim.x;
  if (threadIdx.x == 0) {
    __builtin_amdgcn_fence(__ATOMIC_RELEASE, "agent");
    asm volatile("s_waitcnt vmcnt(0)" ::: "memory");
    __hip_atomic_fetch_add(ctr, 1u, __ATOMIC_RELAXED, __HIP_MEMORY_SCOPE_AGENT);
    while (__hip_atomic_load(ctr, __ATOMIC_RELAXED, __HIP_MEMORY_SCOPE_AGENT) < epoch) __builtin_amdgcn_s_sleep(1);
    __builtin_amdgcn_fence(__ATOMIC_ACQUIRE, "agent");
    asm volatile("s_waitcnt vmcnt(0)" ::: "memory");
  }
  __syncthreads();
}

__global__ void __launch_bounds__(256, 2) fwd_megakernel(Params P) {
  cg::grid_group grid = cg::this_grid();
  __shared__ __attribute__((aligned(16))) float lds_f[2 * G_BUF_BYTES / 4];
  static_assert(2 * G_BUF_BYTES >= 4 * SC_STRIDE * 4, "lds");
  __shared__ int s_item;
  __shared__ float s_rstd[128];
  __shared__ float s_prep[512];
  const long gtid = (long)blockIdx.x * 256 + threadIdx.x, gsz = (long)gridDim.x * 256;

  if (blockIdx.x == 0) { for (int w = threadIdx.x; w < 8192; w += 256) ((unsigned*)(P.ws + O_CTR))[w] = 0u; }
  phase_w0(P, gtid, gsz);
  grid.sync();
  unsigned* bar = (unsigned*)(P.ws + O_CTR) + 6144;
  unsigned epoch = 0u;
  phase_w1(P, gtid, gsz);
#ifdef DUP_W
  phase_w0(P, gtid, gsz);
  phase_w1(P, gtid, gsz);
#endif

  for (int tt = blockIdx.x; tt < 512; tt += gridDim.x) {
    {
      const float* x = P.in[0]; u16* xb = (u16*)(P.ws + O_XB2);
      const int tid = opaque_tid();
#pragma unroll 4
      for (int e = tid; e < 128 * 256; e += 256) {
        const float4 v = *reinterpret_cast<const float4*>(x + (size_t)tt * 128 * DM + (size_t)e * 4);
        st4(xb + (size_t)tt * 128 * DM + (size_t)e * 4, v.x, v.y, v.z, v.w);
      }
    }
    asm volatile("s_waitcnt vmcnt(0)" ::: "memory");
    __syncthreads();
    inproj_tile(P, 0, tt, (char*)lds_f, s_rstd, s_prep);
  }
  gbar(bar, epoch);
  for (int l = 0; l < NL; ++l) {
    {
      const int shard = blockIdx.x & 7;
      unsigned* ctr = (unsigned*)(P.ws + O_CTR) + ((l * 2) * 8 + shard) * 64;
      for (;;) {
        const int tid = opaque_tid();
        if (tid == 0) s_item = (int)atomicAdd(ctr, 1u) * 8 + shard;
        __syncthreads();
        const int it = s_item;
        __syncthreads();
        if (it >= 256 + 3072 + 4096) break;
        const int wave = __builtin_amdgcn_readfirstlane(tid >> 6), lane = tid & 63;
        if (it < 256) s5_stage1_item(P, l, it, wave, lane);
        else if (it < 256 + 3072) mla_attn_item(P, it - 256, (char*)lds_f, tid);
        else {
#pragma unroll 1
          for (int k = 0; k < 4; ++k) dsa_select_item(P, (it - 256 - 3072) * 4 + k, lds_f, wave, lane);
        }
      }
    }
    gbar(bar, epoch);
    {
      const int shard = blockIdx.x & 7;
      unsigned* ctr = (unsigned*)(P.ws + O_CTR) + ((l * 2 + 1) * 8 + shard) * 64;
      for (;;) {
        const int tid = opaque_tid();
        if (tid == 0) s_item = (int)atomicAdd(ctr, 1u) * 8 + shard;
        __syncthreads();
        const int it = s_item;
        __syncthreads();
        if (it >= 256 + 2048) break;
        const int wave = __builtin_amdgcn_readfirstlane(tid >> 6), lane = tid & 63;
        if (it < 256) s5_stage3_item(P, l, it, (u16*)lds_f, wave, lane);
        else dsa_attn_item(P, it - 256, (char*)lds_f, tid);
      }
    }
    gbar(bar, epoch);
    phase_tail(P, l, (char*)lds_f, s_rstd, s_prep);
    if (l + 1 < NL) gbar(bar, epoch);
  }
}

extern "C" void kernel_launch(void* const* d_in, const int* in_sizes, int n_in, void* d_out, int out_size, void* d_ws, size_t ws_size,
                              hipStream_t stream) {
  static int grid_blocks = 0;
  if (!grid_blocks) {
    int dev = 0, cus = 0, per_cu = 0;
    hipGetDevice(&dev);
    hipDeviceGetAttribute(&cus, hipDeviceAttributeMultiprocessorCount, dev);
    hipOccupancyMaxActiveBlocksPerMultiprocessor(&per_cu, fwd_megakernel, 256, 0);
    if (per_cu < 1) per_cu = 1;
    if (per_cu > 2) per_cu = 2;
    grid_blocks = cus * per_cu;
    if (ws_size < O_END) fprintf(stderr, "workspace too small: %zu < %zu\n", ws_size, (size_t)O_END);
  }
  Params p{};
  for (int i = 0; i < 21; ++i) p.in[i] = (const float*)d_in[i];
  p.out = (float*)d_out;
  p.ws = (char*)d_ws;
  void* args[] = {&p};
  hipError_t e = hipLaunchCooperativeKernel((void*)fwd_megakernel, dim3(grid_blocks), dim3(256), args, 0, stream);
  if (e != hipSuccess) fprintf(stderr, "cooperative launch failed: %s (grid %d)\n", hipGetErrorString(e), grid_blocks);
}
```

```cpp
#include <hip/hip_runtime.h>
#include <hip/hip_cooperative_groups.h>
#include <cstdio>
#include <type_traits>
namespace cg = cooperative_groups;

#define DI __device__ __forceinline__
typedef __attribute__((ext_vector_type(8))) short bf16x8;
typedef __attribute__((ext_vector_type(4))) short s16x4;
typedef __attribute__((ext_vector_type(4))) float f32x4;
typedef unsigned short u16;
typedef unsigned long long u64;

constexpr int NB = 16, S = 4096, T = NB * S, DM = 1024, DIN = 2504, DINP = 2560, NL = 4;
constexpr int C_QA = 0, C_KA = 384, C_VA = 448, C_IQ = 512, C_IK = 768, C_IW = 800, C_GA = 808, C_U = 1192,
              C_GB = 1448, C_CQ = 1704, C_CKV = 1960, C_KPE = 2088, C_GC = 2120;
constexpr float EPS = 1e-6f;
constexpr float LOG2E = 1.4426950408889634f;

constexpr size_t O_WTIN = 0;
constexpr size_t O_WTOUT = O_WTIN + (size_t)NL * DINP * DM * 2;
constexpr size_t O_WTUQ = O_WTOUT + (size_t)NL * DM * DM * 2;
constexpr size_t O_WTUKV = O_WTUQ + (size_t)NL * 768 * 256 * 2;
constexpr size_t O_WTGLU = O_WTUKV + (size_t)NL * 768 * 128 * 2;
constexpr size_t O_W1 = O_WTGLU + (size_t)NL * 256 * 256 * 2;
constexpr size_t O_W3 = O_W1 + (size_t)NL * 16 * 128 * 1024 * 2;
constexpr size_t O_KT = O_W3 + (size_t)NL * 16 * 1024 * 128 * 2;
constexpr size_t O_PW = O_KT + (size_t)NL * 16 * 64 * 256 * 2;
constexpr size_t O_FZ = O_PW + (size_t)NL * 16 * 65 * 64 * 8;
constexpr size_t O_R64 = O_FZ + (size_t)NL * 16 * 64 * 8;
constexpr size_t O_R32 = O_R64 + (size_t)4096 * 32 * 8;
constexpr size_t O_XB = O_R32 + (size_t)4096 * 16 * 8;
constexpr size_t O_RSTD = O_XB + (size_t)T * 1024 * 2;
constexpr size_t O_PROJ = O_RSTD + (size_t)T * 4;
constexpr size_t O_MQ = O_PROJ + (size_t)T * DINP * 2;
constexpr size_t O_MK = O_MQ + (size_t)T * 576 * 2;
constexpr size_t O_MVT = O_MK + (size_t)T * 576 * 2;
constexpr size_t O_AVT = O_MVT + (size_t)T * 384 * 2;
constexpr size_t O_MASK = O_AVT + (size_t)T * 64 * 2;
constexpr size_t O_S5S = O_MASK + (size_t)T * 512;
constexpr size_t O_YG = O_S5S + (size_t)16 * 16 * 64 * 128 * 4;
constexpr size_t O_CTR = O_YG + (size_t)T * 256 * 2;
constexpr size_t O_XB2 = O_CTR + 32768;
constexpr size_t O_END = O_XB2 + (size_t)T * 1024 * 2;

struct Params {
  const float* in[21];
  float* out;
  char* ws;
};

DI int opaque_tid() { int t = threadIdx.x; asm volatile("" : "+v"(t)); return t; }
DI u16 f2bf(float f) { unsigned u = __float_as_uint(f); u += 0x7fffu + ((u >> 16) & 1u); return (u16)(u >> 16); }
DI float bf2f(u16 h) { return __uint_as_float(((unsigned)h) << 16); }
typedef __attribute__((ext_vector_type(2))) __bf16 bf16x2_t;
typedef __attribute__((ext_vector_type(2))) float f32x2_t;
DI unsigned pack2(float a, float b) { return __builtin_bit_cast(unsigned, __builtin_convertvector((f32x2_t){a, b}, bf16x2_t)); }
DI float lo2f(unsigned w) { return __uint_as_float(w << 16); }
DI float hi2f(unsigned w) { return __uint_as_float(w & 0xffff0000u); }
DI bf16x8 ld8(const u16* p) { return *reinterpret_cast<const bf16x8*>(p); }
DI uint2 ld4(const u16* p) { return *reinterpret_cast<const uint2*>(p); }
DI void st4(u16* p, float a, float b, float c, float d) { uint2 v; v.x = pack2(a, b); v.y = pack2(c, d); *reinterpret_cast<uint2*>(p) = v; }
DI f32x4 mfma16(bf16x8 a, bf16x8 b, f32x4 c) { return __builtin_amdgcn_mfma_f32_16x16x32_bf16(a, b, c, 0, 0, 0); }
DI float fexp2(float x) { return __builtin_amdgcn_exp2f(x); }
DI float sigmoidf_(float x) { return __builtin_amdgcn_rcpf(1.0f + __expf(-x)); }
DI float siluf_(float x) { return x * sigmoidf_(x); }
DI float geluf_(float x) { float u = 0.7978845608028654f * (x + 0.044715f * x * x * x); return x * sigmoidf_(2.0f * u); }
DI float red4(float v) { v += __shfl_xor(v, 16); v += __shfl_xor(v, 32); return v; }

template <int AT, int BT, class FA, class FB>
DI void wgemm(f32x4 (&acc)[AT][BT], int ksteps, FA fa, FB fb) {
  bf16x8 a0[AT], b0[BT], a1[AT], b1[BT];
  const int k1 = (ksteps > 1) ? 1 : 0;
#pragma unroll
  for (int i = 0; i < AT; ++i) { a0[i] = fa(i, 0); a1[i] = fa(i, k1); }
#pragma unroll
  for (int j = 0; j < BT; ++j) { b0[j] = fb(j, 0); b1[j] = fb(j, k1); }
  for (int ks = 0; ks < ksteps; ++ks) {
    bf16x8 a2[AT], b2[BT];
    const int kn = (ks + 2 < ksteps) ? ks + 2 : ksteps - 1;
#pragma unroll
    for (int i = 0; i < AT; ++i) a2[i] = fa(i, kn);
#pragma unroll
    for (int j = 0; j < BT; ++j) b2[j] = fb(j, kn);
    __builtin_amdgcn_sched_barrier(0);
#pragma unroll
    for (int i = 0; i < AT; ++i)
#pragma unroll
      for (int j = 0; j < BT; ++j) acc[i][j] = mfma16(a0[i], b0[j], acc[i][j]);
    __builtin_amdgcn_sched_barrier(0);
#pragma unroll
    for (int i = 0; i < AT; ++i) { a0[i] = a1[i]; a1[i] = a2[i]; }
#pragma unroll
    for (int j = 0; j < BT; ++j) { b0[j] = b1[j]; b1[j] = b2[j]; }
  }
}

constexpr int GROW = 72;
constexpr int G_TILE_BYTES = 128 * GROW * 2;
constexpr int G_BUF_BYTES = 2 * G_TILE_BYTES;
DI void gemm_block(f32x4 (&acc)[4][4], const u16* Ap, int lda, const u16* Bp, int ldb, int K, char* lds, int tid, bool swap_w1 = false) {
  const int lane = tid & 63, q = lane >> 4, jn = lane & 15;
  const int wave = __builtin_amdgcn_readfirstlane(tid >> 6), wa = wave >> 1, wb = wave & 1;
  uint4 xa0, xa1, xa2, xa3, xb0, xb1, xb2, xb3;
  uint4 ya0, ya1, ya2, ya3, yb0, yb1, yb2, yb3;
  const int srow = tid >> 3, scol = tid & 7;
  const unsigned voa = (unsigned)(srow * lda + scol * 8) * 2u, vob = (unsigned)(srow * ldb + scol * 8) * 2u;
  const char* ag = reinterpret_cast<const char*>(Ap);
  const char* bg = reinterpret_cast<const char*>(Bp);
  char* st0 = lds + (srow * GROW + scol * 8) * 2;
  const bool sw = swap_w1 && (wa == 1);
  const char* a0p = sw ? (lds + G_TILE_BYTES + (wb * 64 + jn) * GROW * 2 + q * 16) : (lds + (wa * 64 + jn) * GROW * 2 + q * 16);
  const char* b0p = sw ? (lds + (wa * 64 + jn) * GROW * 2 + q * 16) : (lds + G_TILE_BYTES + (wb * 64 + jn) * GROW * 2 + q * 16);
#define GL(v, base, ld, vo, i, kt) v = *reinterpret_cast<const uint4*>(base + ((size_t)(32 * (i)) * (ld) + (size_t)(kt) * 64) * 2 + vo)
#define GLOAD0(kt) { GL(xa0, ag, lda, voa, 0, kt); GL(xa1, ag, lda, voa, 1, kt); GL(xa2, ag, lda, voa, 2, kt); GL(xa3, ag, lda, voa, 3, kt); GL(xb0, bg, ldb, vob, 0, kt); GL(xb1, bg, ldb, vob, 1, kt); GL(xb2, bg, ldb, vob, 2, kt); GL(xb3, bg, ldb, vob, 3, kt); }
#define GLOAD1(kt) { GL(ya0, ag, lda, voa, 0, kt); GL(ya1, ag, lda, voa, 1, kt); GL(ya2, ag, lda, voa, 2, kt); GL(ya3, ag, lda, voa, 3, kt); GL(yb0, bg, ldb, vob, 0, kt); GL(yb1, bg, ldb, vob, 1, kt); GL(yb2, bg, ldb, vob, 2, kt); GL(yb3, bg, ldb, vob, 3, kt); }
#define GS(v, off) *reinterpret_cast<uint4*>(st0 + (off)) = v
#define GSTORE0(buf) { GS(xa0, (buf) * G_BUF_BYTES); GS(xa1, (buf) * G_BUF_BYTES + 32 * GROW * 2); GS(xa2, (buf) * G_BUF_BYTES + 64 * GROW * 2); GS(xa3, (buf) * G_BUF_BYTES + 96 * GROW * 2); \
                       GS(xb0, (buf) * G_BUF_BYTES + G_TILE_BYTES); GS(xb1, (buf) * G_BUF_BYTES + G_TILE_BYTES + 32 * GROW * 2); GS(xb2, (buf) * G_BUF_BYTES + G_TILE_BYTES + 64 * GROW * 2); GS(xb3, (buf) * G_BUF_BYTES + G_TILE_BYTES + 96 * GROW * 2); }
#define GSTORE1(buf) { GS(ya0, (buf) * G_BUF_BYTES); GS(ya1, (buf) * G_BUF_BYTES + 32 * GROW * 2); GS(ya2, (buf) * G_BUF_BYTES + 64 * GROW * 2); GS(ya3, (buf) * G_BUF_BYTES + 96 * GROW * 2); \
                       GS(yb0, (buf) * G_BUF_BYTES + G_TILE_BYTES); GS(yb1, (buf) * G_BUF_BYTES + G_TILE_BYTES + 32 * GROW * 2); GS(yb2, (buf) * G_BUF_BYTES + G_TILE_BYTES + 64 * GROW * 2); GS(yb3, (buf) * G_BUF_BYTES + G_TILE_BYTES + 96 * GROW * 2); }
  auto compute = [&](int buf) {
#pragma unroll
    for (int ks = 0; ks < 2; ++ks) {
      bf16x8 a[4], b[4];
#pragma unroll
      for (int i = 0; i < 4; ++i) a[i] = *reinterpret_cast<const bf16x8*>(a0p + buf * G_BUF_BYTES + i * 16 * GROW * 2 + ks * 64);
#pragma unroll
      for (int j = 0; j < 4; ++j) b[j] = *reinterpret_cast<const bf16x8*>(b0p + buf * G_BUF_BYTES + j * 16 * GROW * 2 + ks * 64);
      __builtin_amdgcn_s_setprio(1);
#pragma unroll
      for (int i = 0; i < 4; ++i)
#pragma unroll
        for (int j = 0; j < 4; ++j) acc[i][j] = mfma16(a[i], b[j], acc[i][j]);
      __builtin_amdgcn_s_setprio(0);
    }
  };
  const int nkt = K >> 6;
  GLOAD0(0);
  GLOAD1(1);
  GSTORE0(0);
  __syncthreads();
  for (int kt = 0; kt < nkt; kt += 2) {
    if (kt + 2 < nkt) GLOAD0(kt + 2);
    compute(0);
    GSTORE1(1);
    __syncthreads();
    if (kt + 3 < nkt) GLOAD1(kt + 3);
    compute(1);
    if (kt + 2 < nkt) GSTORE0(0);
    __syncthreads();
  }
#undef GL
#undef GLOAD0
#undef GLOAD1
#undef GS
#undef GSTORE0
#undef GSTORE1
}

template <int A, int B>
DI void zero_acc(f32x4 (&acc)[A][B]) {
#pragma unroll
  for (int i = 0; i < A; ++i)
#pragma unroll
    for (int j = 0; j < B; ++j) acc[i][j] = f32x4{0.f, 0.f, 0.f, 0.f};
}

DI void sincos_d(double a, double& c, double& s) {
  const double TWO_PI = 6.283185307179586476925;
  double n = rint(a / TWO_PI);
  double r = a - n * TWO_PI;
  c = cos(r); s = sin(r);
}

DI void phase_w0(const Params& P, long gtid, long gsz) {
  char* ws = P.ws;
  {
    u16* dst = (u16*)(ws + O_WTIN);
    const float* w = P.in[2]; const float* g = P.in[1];
    for (long idx = gtid; idx < (long)NL * 128 * DINP; idx += gsz) {
      int n = (int)(idx % DINP); long r = idx / DINP; int kb = (int)(r % 128); int l = (int)(r / 128);
      float v[8];
#pragma unroll
      for (int j = 0; j < 8; ++j) { int k = kb * 8 + j; v[j] = (n < DIN) ? w[((size_t)l * DM + k) * DIN + n] * g[l * DM + k] : 0.f; }
      uint4 o; o.x = pack2(v[0], v[1]); o.y = pack2(v[2], v[3]); o.z = pack2(v[4], v[5]); o.w = pack2(v[6], v[7]);
      *reinterpret_cast<uint4*>(dst + ((size_t)l * DINP + n) * DM + kb * 8) = o;
    }
  }
  {
    u16* dst = (u16*)(ws + O_WTOUT);
    const float* w = P.in[20];
    for (long idx = gtid; idx < (long)NL * 128 * DM; idx += gsz) {
      int n = (int)(idx % DM); long r = idx / DM; int kb = (int)(r % 128); int l = (int)(r / 128);
      float v[8];
#pragma unroll
      for (int j = 0; j < 8; ++j) { int k = kb * 8 + j; v[j] = w[((size_t)l * DM + k) * DM + n]; }
      uint4 o; o.x = pack2(v[0], v[1]); o.y = pack2(v[2], v[3]); o.z = pack2(v[4], v[5]); o.w = pack2(v[6], v[7]);
      *reinterpret_cast<uint4*>(dst + ((size_t)l * DM + n) * DM + kb * 8) = o;
    }
  }
  {
    u16* dst = (u16*)(ws + O_WTUQ);
    const float* w = P.in[7]; const float* g = P.in[5];
    for (long idx = gtid; idx < (long)NL * 32 * 768; idx += gsz) {
      int n = (int)(idx % 768); long r = idx / 768; int kb = (int)(r % 32); int l = (int)(r / 32);
      const int h = n >> 7, d = n & 127;
      float v[8];
#pragma unroll
      for (int j = 0; j < 8; ++j) { int k = kb * 8 + j; v[j] = (d < 96) ? w[((size_t)l * 256 + k) * 576 + h * 96 + d] * g[l * 256 + k] : 0.f; }
      uint4 o; o.x = pack2(v[0], v[1]); o.y = pack2(v[2], v[3]); o.z = pack2(v[4], v[5]); o.w = pack2(v[6], v[7]);
      *reinterpret_cast<uint4*>(dst + ((size_t)l * 768 + n) * 256 + kb * 8) = o;
    }
  }
  {
    u16* dst = (u16*)(ws + O_WTUKV);
    const float* w = P.in[8]; const float* g = P.in[6];
    for (long idx = gtid; idx < (long)NL * 16 * 768; idx += gsz) {
      int n = (int)(idx % 768); long r = idx / 768; int kb = (int)(r % 16); int l = (int)(r / 16);
      float v[8];
#pragma unroll
      for (int j = 0; j < 8; ++j) { int k = kb * 8 + j; v[j] = w[((size_t)l * 128 + k) * 768 + n] * g[l * 128 + k]; }
      uint4 o; o.x = pack2(v[0], v[1]); o.y = pack2(v[2], v[3]); o.z = pack2(v[4], v[5]); o.w = pack2(v[6], v[7]);
      *reinterpret_cast<uint4*>(dst + ((size_t)l * 768 + n) * 128 + kb * 8) = o;
    }
  }
  {
    u16* dst = (u16*)(ws + O_WTGLU);
    const float* w = P.in[19];
    for (long idx = gtid; idx < (long)NL * 32 * 256; idx += gsz) {
      int n = (int)(idx % 256); long r = idx / 256; int kb = (int)(r % 32); int l = (int)(r / 32);
      float v[8];
#pragma unroll
      for (int j = 0; j < 8; ++j) { int k = kb * 8 + j; v[j] = w[((size_t)l * 256 + k) * 256 + n]; }
      uint4 o; o.x = pack2(v[0], v[1]); o.y = pack2(v[2], v[3]); o.z = pack2(v[4], v[5]); o.w = pack2(v[6], v[7]);
      *reinterpret_cast<uint4*>(dst + ((size_t)l * 256 + n) * 256 + kb * 8) = o;
    }
  }
  {
    float2* r64 = (float2*)(ws + O_R64);
    for (long idx = gtid; idx < 4096L * 32; idx += gsz) {
      int i = (int)(idx & 31); int pos = (int)(idx >> 5);
      float inv = (float)pow(10000.0, -(double)i / 32.0);
      float ang = (float)pos * inv;
      double c, s; sincos_d((double)ang, c, s);
      r64[idx] = make_float2((float)c, (float)s);
    }
    float2* r32 = (float2*)(ws + O_R32);
    for (long idx = gtid; idx < 4096L * 16; idx += gsz) {
      int i = (int)(idx & 15); int pos = (int)(idx >> 4);
      float inv = (float)pow(10000.0, -(double)i / 16.0);
      float ang = (float)pos * inv;
      double c, s; sincos_d((double)ang, c, s);
      r32[idx] = make_float2((float)c, (float)s);
    }
  }
  {
    float2* pw = (float2*)(ws + O_PW);
    float2* fz = (float2*)(ws + O_FZ);
    const float* a_re = P.in[11]; const float* a_im = P.in[12]; const float* lstep = P.in[18];
    for (long idx = gtid; idx < (long)NL * 16 * 65 * 64; idx += gsz) {
      int p = (int)(idx & 63); long r = idx >> 6; int d = (int)(r % 65); int lg = (int)(r / 65);
      double step = exp((double)lstep[lg]);
      double ar = (double)a_re[lg * 64 + p], ai = (double)a_im[lg * 64 + p];
      double mag = exp((double)d * ar * step);
      double c, s; sincos_d((double)d * ai * step, c, s);
      pw[idx] = make_float2((float)(mag * c), (float)(mag * s));
      if (d == 1) {
        double abr = mag * c, abi = mag * s;
        double den = ar * ar + ai * ai, nr = abr - 1.0;
        double fre = (nr * ar + abi * ai) / den, fim = (abi * ar - nr * ai) / den;
        fz[lg * 64 + p] = make_float2((float)fre, (float)fim);
      }
    }
  }
}

DI void phase_w1(const Params& P, long gtid, long gsz) {
  char* ws = P.ws;
  const float2* pw = (const float2*)(ws + O_PW);
  const float2* fz = (const float2*)(ws + O_FZ);
  const float* b_re = P.in[13]; const float* b_im = P.in[14]; const float* c_re = P.in[15]; const float* c_im = P.in[16];
  {
    u16* w1 = (u16*)(ws + O_W1);
    for (long idx = gtid; idx < (long)NL * 16 * 128 * 128; idx += gsz) {
      int kb = (int)(idx & 127); long r = idx >> 7; int row = (int)(r & 127); int lg = (int)(r >> 7);
      int p = row >> 1, ri = row & 1; int i = kb >> 1, c0 = (kb & 1) * 8;
      float2 e = pw[((size_t)lg * 65 + (63 - i)) * 64 + p]; float2 f = fz[lg * 64 + p];
      float er = e.x * f.x - e.y * f.y, ei = e.x * f.y + e.y * f.x;
      float v[8];
#pragma unroll
      for (int j = 0; j < 8; ++j) {
        float br = b_re[((size_t)lg * 64 + p) * 16 + c0 + j], bi = b_im[((size_t)lg * 64 + p) * 16 + c0 + j];
        v[j] = ri ? (er * bi + ei * br) : (er * br - ei * bi);
      }
      uint4 o; o.x = pack2(v[0], v[1]); o.y = pack2(v[2], v[3]); o.z = pack2(v[4], v[5]); o.w = pack2(v[6], v[7]);
      *reinterpret_cast<uint4*>(w1 + ((size_t)lg * 128 + row) * 1024 + kb * 8) = o;
    }
  }
  {
    u16* w3 = (u16*)(ws + O_W3);
    for (long idx = gtid; idx < (long)NL * 16 * 1024 * 16; idx += gsz) {
      int kb = (int)(idx & 15); long r = idx >> 4; int f = (int)(r & 1023); int lg = (int)(r >> 10);
      int j = f >> 4, c = f & 15;
      float v[8];
#pragma unroll
      for (int jj = 0; jj < 4; ++jj) {
        int p = kb * 4 + jj;
        float2 e = pw[((size_t)lg * 65 + (j + 1)) * 64 + p];
        float cr = c_re[((size_t)lg * 16 + c) * 64 + p], ci = c_im[((size_t)lg * 16 + c) * 64 + p];
        v[2 * jj] = cr * e.x - ci * e.y;
        v[2 * jj + 1] = -(cr * e.y + ci * e.x);
      }
      uint4 o; o.x = pack2(v[0], v[1]); o.y = pack2(v[2], v[3]); o.z = pack2(v[4], v[5]); o.w = pack2(v[6], v[7]);
      *reinterpret_cast<uint4*>(w3 + ((size_t)lg * 1024 + f) * 128 + kb * 8) = o;
    }
  }
  {
    u16* kt = (u16*)(ws + O_KT);
    for (long idx = gtid; idx < (long)NL * 16 * 64 * 16 * 2; idx += gsz) {
      int cb = (int)(idx & 1); long r = idx >> 1; int c = (int)(r & 15); r >>= 4; int d = (int)(r & 63); int lg = (int)(r >> 6);
      float v[8];
#pragma unroll
      for (int j = 0; j < 8; ++j) v[j] = 0.f;
      for (int p = 0; p < 64; ++p) {
        float2 e = pw[((size_t)lg * 65 + d) * 64 + p]; float2 f = fz[lg * 64 + p];
        float er = e.x * f.x - e.y * f.y, ei = e.x * f.y + e.y * f.x;
        float cr = c_re[((size_t)lg * 16 + c) * 64 + p], ci = c_im[((size_t)lg * 16 + c) * 64 + p];
        float gr = cr * er - ci * ei, gi = cr * ei + ci * er;
#pragma unroll
        for (int j = 0; j < 8; ++j) {
          float br = b_re[((size_t)lg * 64 + p) * 16 + cb * 8 + j], bi = b_im[((size_t)lg * 64 + p) * 16 + cb * 8 + j];
          v[j] += gr * br - gi * bi;
        }
      }
      uint4 o; o.x = pack2(v[0], v[1]); o.y = pack2(v[2], v[3]); o.z = pack2(v[4], v[5]); o.w = pack2(v[6], v[7]);
      *reinterpret_cast<uint4*>(kt + (((size_t)lg * 64 + d) * 16 + c) * 16 + cb * 8) = o;
    }
  }
}

DI void phase_p0(const Params& P, int l) {
  const float* x = (l == 0) ? P.in[0] : P.out;
  u16* xb = (u16*)(P.ws + O_XB2);
  const int tid = opaque_tid();
  const int lane = tid & 63;
  const int gw = blockIdx.x * 4 + (tid >> 6), nw = gridDim.x * 4;
  for (int row = gw; row < T; row += nw) {
    const float4* xr = reinterpret_cast<const float4*>(x + (size_t)row * DM);
#pragma unroll
    for (int i = 0; i < 4; ++i) {
      float4 v = xr[i * 64 + lane];
      st4(xb + (size_t)row * DM + (i * 64 + lane) * 4, v.x, v.y, v.z, v.w);
    }
  }
}

DI void prep_mla_q(const Params& P, int l, int tw0, int lane) {
  const int q = lane >> 4, jn = lane & 15;
  const u16* proj = (const u16*)(P.ws + O_PROJ);
  const u16* W = (const u16*)(P.ws + O_WTUQ) + (size_t)l * 576 * 256;
  u16* mq = (u16*)(P.ws + O_MQ);
  const float2* r32 = (const float2*)(P.ws + O_R32);
  const float* gq = P.in[9] + l * 96;
  const u16* bp = proj + (size_t)(tw0 + jn) * DINP + C_CQ + q * 8;
  float rq[2];
#pragma unroll
  for (int t = 0; t < 2; ++t) {
    float ss = 0.f;
    for (int ks = 0; ks < 8; ++ks) {
      bf16x8 v = ld8(bp + (size_t)t * 16 * DINP + ks * 32);
#pragma unroll
      for (int j = 0; j < 8; ++j) { float f = bf2f((u16)v[j]); ss += f * f; }
    }
    ss = red4(ss);
    rq[t] = rsqrtf(ss * (1.0f / 256) + EPS);
  }
  const float qscale = 0.10206207261596577f * LOG2E;
  for (int h = 0; h < 6; ++h) {
    f32x4 acc[6][2]; zero_acc(acc);
    const u16* ap = W + (size_t)(h * 96 + jn) * 256 + q * 8;
    wgemm<6, 2>(acc, 8, [&](int i, int ks) { return ld8(ap + (size_t)i * 16 * 256 + ks * 32); },
                [&](int j, int ks) { return ld8(bp + (size_t)j * 16 * DINP + ks * 32); });
#pragma unroll
    for (int t = 0; t < 2; ++t) {
      const int tok = tw0 + 16 * t + jn, pos = tok & (S - 1);
      float ss = 0.f;
#pragma unroll
      for (int i = 0; i < 6; ++i)
#pragma unroll
        for (int r = 0; r < 4; ++r) { float v = acc[i][t][r] * rq[t]; acc[i][t][r] = v; ss += v * v; }
      ss = red4(ss);
      const float rs = rsqrtf(ss * (1.0f / 96) + EPS);
#pragma unroll
      for (int i = 0; i < 6; ++i)
#pragma unroll
        for (int r = 0; r < 4; ++r) acc[i][t][r] *= rs * gq[16 * i + 4 * q + r];
#pragma unroll
      for (int r = 0; r < 4; ++r) {
        float2 cs = r32[pos * 16 + 4 * q + r];
        float x1 = acc[4][t][r], x2 = acc[5][t][r];
        acc[4][t][r] = x1 * cs.x - x2 * cs.y; acc[5][t][r] = x2 * cs.x + x1 * cs.y;
      }
#pragma unroll
      for (int i = 0; i < 6; ++i)
        st4(mq + (size_t)tok * 576 + h * 96 + 16 * i + 4 * q, acc[i][t][0] * qscale, acc[i][t][1] * qscale, acc[i][t][2] * qscale, acc[i][t][3] * qscale);
    }
  }
}

DI void prep_mla_kv(const Params& P, int l, int tw0, int lane) {
  const int q = lane >> 4, jn = lane & 15;
  const u16* proj = (const u16*)(P.ws + O_PROJ);
  const u16* W = (const u16*)(P.ws + O_WTUKV) + (size_t)l * 768 * 128;
  u16* mk = (u16*)(P.ws + O_MK);
  u16* mvt = (u16*)(P.ws + O_MVT);
  const float2* r32 = (const float2*)(P.ws + O_R32);
  const float* gk = P.in[10] + l * 96;
  const u16* bp = proj + (size_t)(tw0 + jn) * DINP + C_CKV + q * 8;
  const int b = tw0 >> 12, pos0 = tw0 & (S - 1);
  float rkv[2];
#pragma unroll
  for (int t = 0; t < 2; ++t) {
    float ss = 0.f;
    for (int ks = 0; ks < 4; ++ks) {
      bf16x8 v = ld8(bp + (size_t)t * 16 * DINP + ks * 32);
#pragma unroll
      for (int j = 0; j < 8; ++j) { float f = bf2f((u16)v[j]); ss += f * f; }
    }
    ss = red4(ss);
    rkv[t] = rsqrtf(ss * (1.0f / 128) + EPS);
  }
  for (int h = 0; h < 6; ++h) {
    {
      f32x4 acc[4][2]; zero_acc(acc);
      const u16* ap = W + (size_t)(h * 128 + jn) * 128 + q * 8;
      wgemm<4, 2>(acc, 4, [&](int i, int ks) { return ld8(ap + (size_t)i * 16 * 128 + ks * 32); },
                  [&](int j, int ks) { return ld8(bp + (size_t)j * 16 * DINP + ks * 32); });
#pragma unroll
      for (int t = 0; t < 2; ++t) {
        const int tok = tw0 + 16 * t + jn, pos = tok & (S - 1);
        uint2 pl = ld4(proj + (size_t)tok * DINP + C_KPE + 4 * q);
        uint2 ph = ld4(proj + (size_t)tok * DINP + C_KPE + 16 + 4 * q);
        float kl[4] = {lo2f(pl.x), hi2f(pl.x), lo2f(pl.y), hi2f(pl.y)};
        float kh[4] = {lo2f(ph.x), hi2f(ph.x), lo2f(ph.y), hi2f(ph.y)};
        float ss = 0.f;
#pragma unroll
        for (int i = 0; i < 4; ++i)
#pragma unroll
          for (int r = 0; r < 4; ++r) { float v = acc[i][t][r] * rkv[t]; acc[i][t][r] = v; ss += v * v; }
#pragma unroll
        for (int r = 0; r < 4; ++r) ss += kl[r] * kl[r] + kh[r] * kh[r];
        ss = red4(ss);
        const float rs = rsqrtf(ss * (1.0f / 96) + EPS);
#pragma unroll
        for (int i = 0; i < 4; ++i) {
          const int d = 16 * i + 4 * q;
          st4(mk + (size_t)tok * 576 + h * 96 + d, acc[i][t][0] * rs * gk[d], acc[i][t][1] * rs * gk[d + 1], acc[i][t][2] * rs * gk[d + 2], acc[i][t][3] * rs * gk[d + 3]);
        }
        float y1[4], y2[4];
#pragma unroll
        for (int r = 0; r < 4; ++r) {
          float2 cs = r32[pos * 16 + 4 * q + r];
          float x1 = kl[r] * rs * gk[64 + 4 * q + r], x2 = kh[r] * rs * gk[80 + 4 * q + r];
          y1[r] = x1 * cs.x - x2 * cs.y; y2[r] = x2 * cs.x + x1 * cs.y;
        }
        st4(mk + (size_t)tok * 576 + h * 96 + 64 + 4 * q, y1[0], y1[1], y1[2], y1[3]);
        st4(mk + (size_t)tok * 576 + h * 96 + 80 + 4 * q, y2[0], y2[1], y2[2], y2[3]);
      }
    }
    {
      f32x4 acc[2][4]; zero_acc(acc);
      const u16* wp = W + (size_t)(h * 128 + 64 + jn) * 128 + q * 8;
      wgemm<2, 4>(acc, 4, [&](int i, int ks) { return ld8(bp + (size_t)i * 16 * DINP + ks * 32); },
                  [&](int j, int ks) { return ld8(wp + (size_t)j * 16 * 128 + ks * 32); });
#pragma unroll
      for (int i = 0; i < 2; ++i) {
        float rr[4];
#pragma unroll
        for (int r = 0; r < 4; ++r) rr[r] = __shfl(rkv[i], 4 * q + r);
#pragma unroll
        for (int j = 0; j < 4; ++j)
          st4(mvt + ((size_t)(b * 6 + h) * 64 + 16 * j + jn) * S + pos0 + 16 * i + 4 * q,
              acc[i][j][0] * rr[0], acc[i][j][1] * rr[1], acc[i][j][2] * rr[2], acc[i][j][3] * rr[3]);
      }
    }
  }
}

DI void prep_mla_tile(const Params& P, int l, int tt, char* lds, float* s_r, float* s_ss) {
  const int tid = opaque_tid();
  const int wave = __builtin_amdgcn_readfirstlane(tid >> 6), lane = tid & 63, q = lane >> 4, jn = lane & 15;
  const int wa = wave >> 1, wb = wave & 1;
  const int tok0 = tt * 128;
  const u16* proj = (const u16*)(P.ws + O_PROJ);
  const u16* Wq = (const u16*)(P.ws + O_WTUQ) + (size_t)l * 768 * 256;
  const u16* Wkv = (const u16*)(P.ws + O_WTUKV) + (size_t)l * 768 * 128;
  u16* mq = (u16*)(P.ws + O_MQ); u16* mk = (u16*)(P.ws + O_MK); u16* mvt = (u16*)(P.ws + O_MVT);
  const float2* r32 = (const float2*)(P.ws + O_R32);
  const float* gq = P.in[9] + l * 96; const float* gk = P.in[10] + l * 96;
  {
    const int row = tid >> 1, half = tid & 1;
    const u16* pq = proj + (size_t)(tok0 + row) * DINP + C_CQ + half * 128;
    const u16* pk = proj + (size_t)(tok0 + row) * DINP + C_CKV + half * 64;
    bf16x8 vq[16], vk[8];
#pragma unroll
    for (int u = 0; u < 16; ++u) vq[u] = ld8(pq + u * 8);
#pragma unroll
    for (int u = 0; u < 8; ++u) vk[u] = ld8(pk + u * 8);
    float sq = 0.f, sk = 0.f;
#pragma unroll
    for (int u = 0; u < 16; ++u)
#pragma unroll
      for (int j = 0; j < 8; ++j) { const float f = bf2f((u16)vq[u][j]); sq += f * f; }
#pragma unroll
    for (int u = 0; u < 8; ++u)
#pragma unroll
      for (int j = 0; j < 8; ++j) { const float f = bf2f((u16)vk[u][j]); sk += f * f; }
    sq += __shfl_xor(sq, 1); sk += __shfl_xor(sk, 1);
    if (half == 0) { s_r[row] = rsqrtf(sq * (1.0f / 256) + EPS); s_r[128 + row] = rsqrtf(sk * (1.0f / 128) + EPS); }
  }
  __syncthreads();
  const float qscale = 0.10206207261596577f * LOG2E;
#pragma unroll 1
  for (int h0 = 0; h0 < 6; ++h0) {
    int h = h0; asm volatile("" : "+s"(h));
    f32x4 acc[4][4]; zero_acc(acc);
    gemm_block(acc, Wq + (size_t)(h * 128) * 256, 256, proj + (size_t)tok0 * DINP + C_CQ, DINP, 256, lds, tid);
#pragma unroll
    for (int j = 0; j < 4; ++j) {
      const int tl = wb * 64 + 16 * j + jn; const float rq = s_r[tl];
      float ss = 0.f;
#pragma unroll
      for (int i = 0; i < 4; ++i)
#pragma unroll
        for (int r = 0; r < 4; ++r) { const float v = acc[i][j][r] * rq; acc[i][j][r] = v; ss += v * v; }
      ss = red4(ss);
      if (q == 0) s_ss[wa * 128 + tl] = ss;
    }
    __syncthreads();
#pragma unroll
    for (int j = 0; j < 4; ++j) {
      const int tl = wb * 64 + 16 * j + jn, tok = tok0 + tl, pos = tok & (S - 1);
      const float rs = rsqrtf((s_ss[tl] + s_ss[128 + tl]) * (1.0f / 96) + EPS);
      if (wa == 0) {
#pragma unroll
        for (int i = 0; i < 4; ++i) {
          const int d = 16 * i + 4 * q;
          st4(mq + (size_t)tok * 576 + h * 96 + d, acc[i][j][0] * rs * gq[d] * qscale, acc[i][j][1] * rs * gq[d + 1] * qscale,
              acc[i][j][2] * rs * gq[d + 2] * qscale, acc[i][j][3] * rs * gq[d + 3] * qscale);
        }
      } else {
        float y1[4], y2[4];
#pragma unroll
        for (int r = 0; r < 4; ++r) {
          const float2 cs = r32[pos * 16 + 4 * q + r];
          const float x1 = acc[0][j][r] * rs * gq[64 + 4 * q + r], x2 = acc[1][j][r] * rs * gq[80 + 4 * q + r];
          y1[r] = (x1 * cs.x - x2 * cs.y) * qscale; y2[r] = (x2 * cs.x + x1 * cs.y) * qscale;
        }
        st4(mq + (size_t)tok * 576 + h * 96 + 64 + 4 * q, y1[0], y1[1], y1[2], y1[3]);
        st4(mq + (size_t)tok * 576 + h * 96 + 80 + 4 * q, y2[0], y2[1], y2[2], y2[3]);
      }
    }
    __syncthreads();
  }
  const int b = tok0 >> 12, pos0 = tok0 & (S - 1);
#pragma unroll 1
  for (int h0 = 0; h0 < 6; ++h0) {
    int h = h0; asm volatile("" : "+s"(h));
    f32x4 acc[4][4]; zero_acc(acc);
    gemm_block(acc, Wkv + (size_t)(h * 128) * 128, 128, proj + (size_t)tok0 * DINP + C_CKV, DINP, 128, lds, tid, true);
    if (wa == 0) {
#pragma unroll
      for (int j = 0; j < 4; ++j) {
        const int tl = wb * 64 + 16 * j + jn, tok = tok0 + tl, pos = tok & (S - 1);
        const float rkv = s_r[128 + tl];
        const uint2 pl = ld4(proj + (size_t)tok * DINP + C_KPE + 4 * q);
        const uint2 ph = ld4(proj + (size_t)tok * DINP + C_KPE + 16 + 4 * q);
        const float kl[4] = {lo2f(pl.x), hi2f(pl.x), lo2f(pl.y), hi2f(pl.y)};
        const float kh[4] = {lo2f(ph.x), hi2f(ph.x), lo2f(ph.y), hi2f(ph.y)};
        float ss = 0.f;
#pragma unroll
        for (int i = 0; i < 4; ++i)
#pragma unroll
          for (int r = 0; r < 4; ++r) { const float v = acc[i][j][r] * rkv; acc[i][j][r] = v; ss += v * v; }
#pragma unroll
        for (int r = 0; r < 4; ++r) ss += kl[r] * kl[r] + kh[r] * kh[r];
        ss = red4(ss);
        const float rs = rsqrtf(ss * (1.0f / 96) + EPS);
#pragma unroll
        for (int i = 0; i < 4; ++i) {
          const int d = 16 * i + 4 * q;
          st4(mk + (size_t)tok * 576 + h * 96 + d, acc[i][j][0] * rs * gk[d], acc[i][j][1] * rs * gk[d + 1], acc[i][j][2] * rs * gk[d + 2], acc[i][j][3] * rs * gk[d + 3]);
        }
        float y1[4], y2[4];
#pragma unroll
        for (int r = 0; r < 4; ++r) {
          const float2 cs = r32[pos * 16 + 4 * q + r];
          const float x1 = kl[r] * rs * gk[64 + 4 * q + r], x2 = kh[r] * rs * gk[80 + 4 * q + r];
          y1[r] = x1 * cs.x - x2 * cs.y; y2[r] = x2 * cs.x + x1 * cs.y;
        }
        st4(mk + (size_t)tok * 576 + h * 96 + 64 + 4 * q, y1[0], y1[1], y1[2], y1[3]);
        st4(mk + (size_t)tok * 576 + h * 96 + 80 + 4 * q, y2[0], y2[1], y2[2], y2[3]);
      }
    } else {
#pragma unroll
      for (int i = 0; i < 4; ++i) {
        const int tl0 = wb * 64 + 16 * i + 4 * q;
        const float r0 = s_r[128 + tl0], r1 = s_r[128 + tl0 + 1], r2 = s_r[128 + tl0 + 2], r3 = s_r[128 + tl0 + 3];
#pragma unroll
        for (int j = 0; j < 4; ++j)
          st4(mvt + ((size_t)(b * 6 + h) * 64 + 16 * j + jn) * S + pos0 + tl0, acc[i][j][0] * r0, acc[i][j][1] * r1, acc[i][j][2] * r2, acc[i][j][3] * r3);
      }
    }
  }
}

DI void prep_dsa(const Params& P, int l, int tok0) {
  u16* proj = (u16*)(P.ws + O_PROJ);
  u16* avt = (u16*)(P.ws + O_AVT);
  const float2* r64 = (const float2*)(P.ws + O_R64);
  const float2* r32 = (const float2*)(P.ws + O_R32);
  const int tid = opaque_tid();
  for (int task = tid; task < 512; task += 256) {
    const int tok = tok0 + (task >> 2), c = task & 3, pos = tok & (S - 1);
    u16* row = proj + (size_t)tok * DINP;
    bf16x8 lo[7], hi[7];
#pragma unroll
    for (int hh = 0; hh < 7; ++hh) {
      const int base = (hh < 6) ? C_QA + 64 * hh : C_KA;
      lo[hh] = ld8(row + base + 8 * c); hi[hh] = ld8(row + base + 32 + 8 * c);
    }
    float2 cs[8];
    float gql[8], gqh[8], gkl[8], gkh[8];
    const float* gq = P.in[3] + l * 64; const float* gk = P.in[4] + l * 64;
#pragma unroll
    for (int j = 0; j < 8; ++j) {
      cs[j] = r64[pos * 32 + 8 * c + j];
      gql[j] = gq[8 * c + j]; gqh[j] = gq[32 + 8 * c + j]; gkl[j] = gk[8 * c + j]; gkh[j] = gk[32 + 8 * c + j];
    }
#pragma unroll
    for (int hh = 0; hh < 7; ++hh) {
      const int base = (hh < 6) ? C_QA + 64 * hh : C_KA;
      float xl[8], xh[8];
      float ss = 0.f;
#pragma unroll
      for (int j = 0; j < 8; ++j) { xl[j] = bf2f((u16)lo[hh][j]); xh[j] = bf2f((u16)hi[hh][j]); ss += xl[j] * xl[j] + xh[j] * xh[j]; }
      ss += __shfl_xor(ss, 1); ss += __shfl_xor(ss, 2);
      const float rs = rsqrtf(ss * (1.0f / 64) + EPS);
      const float sc = (hh < 6) ? 0.125f * LOG2E : 1.0f;
      float y1[8], y2[8];
#pragma unroll
      for (int j = 0; j < 8; ++j) {
        const float x1 = xl[j] * rs * ((hh < 6) ? gql[j] : gkl[j]), x2 = xh[j] * rs * ((hh < 6) ? gqh[j] : gkh[j]);
        y1[j] = (x1 * cs[j].x - x2 * cs[j].y) * sc; y2[j] = (x2 * cs[j].x + x1 * cs[j].y) * sc;
      }
      uint4 o; o.x = pack2(y1[0], y1[1]); o.y = pack2(y1[2], y1[3]); o.z = pack2(y1[4], y1[5]); o.w = pack2(y1[6], y1[7]);
      *reinterpret_cast<uint4*>(row + base + 8 * c) = o;
      o.x = pack2(y2[0], y2[1]); o.y = pack2(y2[2], y2[3]); o.z = pack2(y2[4], y2[5]); o.w = pack2(y2[6], y2[7]);
      *reinterpret_cast<uint4*>(row + base + 32 + 8 * c) = o;
    }
  }
  {
    const int tok = tok0 + (tid >> 1), c2 = tid & 1, pos = tok & (S - 1);
    u16* row = proj + (size_t)tok * DINP;
    bf16x8 lo[9], hi[9];
#pragma unroll
    for (int hh = 0; hh < 9; ++hh) {
      const int base = (hh < 8) ? C_IQ + 32 * hh : C_IK;
      lo[hh] = ld8(row + base + 8 * c2); hi[hh] = ld8(row + base + 16 + 8 * c2);
    }
    float2 cs[8];
#pragma unroll
    for (int j = 0; j < 8; ++j) cs[j] = r32[pos * 16 + 8 * c2 + j];
#pragma unroll
    for (int hh = 0; hh < 9; ++hh) {
      const int base = (hh < 8) ? C_IQ + 32 * hh : C_IK;
      float y1[8], y2[8];
#pragma unroll
      for (int j = 0; j < 8; ++j) {
        const float x1 = bf2f((u16)lo[hh][j]), x2 = bf2f((u16)hi[hh][j]);
        y1[j] = x1 * cs[j].x - x2 * cs[j].y; y2[j] = x2 * cs[j].x + x1 * cs[j].y;
      }
      uint4 o; o.x = pack2(y1[0], y1[1]); o.y = pack2(y1[2], y1[3]); o.z = pack2(y1[4], y1[5]); o.w = pack2(y1[6], y1[7]);
      *reinterpret_cast<uint4*>(row + base + 8 * c2) = o;
      o.x = pack2(y2[0], y2[1]); o.y = pack2(y2[2], y2[3]); o.z = pack2(y2[4], y2[5]); o.w = pack2(y2[6], y2[7]);
      *reinterpret_cast<uint4*>(row + base + 16 + 8 * c2) = o;
    }
  }
  {
    const int b = tok0 >> 12, pos0 = tok0 & (S - 1);
    const int dim = tid & 63, tg0 = tid >> 6;
    unsigned short v[8][4];
#pragma unroll
    for (int u = 0; u < 8; ++u) {
      const u16* p = proj + (size_t)(tok0 + 4 * (tg0 + 4 * u)) * DINP + C_VA + dim;
#pragma unroll
      for (int k = 0; k < 4; ++k) v[u][k] = p[k * DINP];
    }
#pragma unroll
    for (int u = 0; u < 8; ++u) {
      uint2 o; o.x = (unsigned)v[u][0] | ((unsigned)v[u][1] << 16); o.y = (unsigned)v[u][2] | ((unsigned)v[u][3] << 16);
      *reinterpret_cast<uint2*>(avt + ((size_t)b * 64 + dim) * S + pos0 + 4 * (tg0 + 4 * u)) = o;
    }
  }
}

DI void prep_tile(const Params& P, int l, int tile, char* lds, float* s_r) {
  const int tid = opaque_tid();
  const int wave = __builtin_amdgcn_readfirstlane(tid >> 6), lane = tid & 63;
  const int tok0 = tile * 128;
  prep_mla_tile(P, l, tile, lds, s_r, s_r + 256);
  prep_dsa(P, l, tok0);
}

DI void inproj_tile(const Params& P, int l, int tt, char* lds, float* s_rstd, float* s_prep) {
  const u16* W = (const u16*)(P.ws + O_WTIN) + (size_t)l * DINP * DM;
  const u16* xb = (const u16*)(P.ws + O_XB2);
  u16* proj = (u16*)(P.ws + O_PROJ);
  const int tid = opaque_tid();
  const int wave = __builtin_amdgcn_readfirstlane(tid >> 6), lane = tid & 63, q = lane >> 4, jn = lane & 15;
  {
    {
      const u16* rp = xb + (size_t)(tt * 128 + (tid >> 1)) * DM + (tid & 1) * 512;
      float ss = 0.f;
#pragma unroll 1
      for (int c = 0; c < 8; ++c) {
        bf16x8 v[8];
#pragma unroll
        for (int u = 0; u < 8; ++u) v[u] = ld8(rp + (c * 8 + u) * 8);
#pragma unroll
        for (int u = 0; u < 8; ++u)
#pragma unroll
          for (int j = 0; j < 8; ++j) { const float f = bf2f((u16)v[u][j]); ss += f * f; }
      }
      ss += __shfl_xor(ss, 1);
      if ((tid & 1) == 0) s_rstd[tid >> 1] = rsqrtf(ss * (1.0f / DM) + EPS);
    }
    __syncthreads();
#pragma unroll 1
    for (int ftile0 = 0; ftile0 < 20; ++ftile0) {
      int ftile = ftile0; asm volatile("" : "+s"(ftile));
      const int f0 = ftile * 128 + (wave >> 1) * 64, t0 = tt * 128 + (wave & 1) * 64;
      f32x4 acc[4][4]; zero_acc(acc);
      gemm_block(acc, W + (size_t)(ftile * 128) * DM, DM, xb + (size_t)(tt * 128) * DM, DM, DM, lds, tid);
#pragma unroll
      for (int j = 0; j < 4; ++j) {
        const int tok = t0 + 16 * j + jn; const float rs = s_rstd[(wave & 1) * 64 + 16 * j + jn];
#pragma unroll
        for (int i = 0; i < 4; ++i)
          st4(proj + (size_t)tok * DINP + f0 + 16 * i + 4 * q, acc[i][j][0] * rs, acc[i][j][1] * rs, acc[i][j][2] * rs, acc[i][j][3] * rs);
      }
    }
    asm volatile("s_waitcnt vmcnt(0)" ::: "memory");
    __syncthreads();
    prep_tile(P, l, tt, lds, s_prep);
    __syncthreads();
  }
}

DI void phase_inproj(const Params& P, int l, char* lds, float* s_rstd, float* s_prep) {
  for (int tt = blockIdx.x; tt < 512; tt += gridDim.x) inproj_tile(P, l, tt, lds, s_rstd, s_prep);
}

template <int KS, bool MASK>
DI void attn_block_v1(const u16* Qp, int qstride, const u16* Kp, int kstride, const u16* Vtp, const u64* maskp, int nkt_w, int nkt_max,
                   const u16* gatep, int gstride, u16* outp, int ostride, char* lds, int tid) {
  constexpr int DQK = KS * 32, KROW = DQK + 8, VROW = 72;
  constexpr int KCH = DQK / 8, NKC = 64 * KCH / 256;
  constexpr int K_BYTES = 64 * KROW * 2, BUF_BYTES = K_BYTES + 64 * VROW * 2;
  const int lane = tid & 63, q = lane >> 4, jn = lane & 15;
  const float NEG_INF = -__builtin_inff();
  uint4 kst[NKC], vst[2];
  auto gload = [&](int kt) {
#pragma unroll
    for (int i = 0; i < NKC; ++i) {
      const int c = tid + 256 * i, row = c / KCH, col = c % KCH;
      kst[i] = *reinterpret_cast<const uint4*>(Kp + (size_t)(kt * 64 + row) * kstride + col * 8);
    }
#pragma unroll
    for (int i = 0; i < 2; ++i) {
      const int c = tid + 256 * i, dim = c >> 3, part = c & 7;
      vst[i] = *reinterpret_cast<const uint4*>(Vtp + (size_t)dim * S + kt * 64 + part * 8);
    }
  };
  auto lstore = [&](int buf) {
    char* kb = lds + buf * BUF_BYTES; char* vb = kb + K_BYTES;
#pragma unroll
    for (int i = 0; i < NKC; ++i) {
      const int c = tid + 256 * i, row = c / KCH, col = c % KCH;
      *reinterpret_cast<uint4*>(kb + (row * KROW + col * 8) * 2) = kst[i];
    }
#pragma unroll
    for (int i = 0; i < 2; ++i) {
      const int c = tid + 256 * i, dim = c >> 3, part = c & 7;
      *reinterpret_cast<uint4*>(vb + (dim * VROW + part * 8) * 2) = vst[i];
    }
  };
  bf16x8 qf[2][KS];
#pragma unroll
  for (int c = 0; c < 2; ++c)
#pragma unroll
    for (int ks = 0; ks < KS; ++ks) qf[c][ks] = ld8(Qp + (size_t)(16 * c + jn) * qstride + ks * 32 + q * 8);
  f32x4 o[4][2]; zero_acc(o);
  float m[2] = {NEG_INF, NEG_INF}, lsum[2] = {0.f, 0.f};
  u64 mw[2] = {0ull, 0ull}, mwn[2] = {0ull, 0ull};
  if (MASK) {
#pragma unroll
    for (int c = 0; c < 2; ++c) mw[c] = maskp[(size_t)(16 * c + jn) * 64];
  }
  gload(0);
  lstore(0);
  __syncthreads();
  for (int kt = 0; kt < nkt_max; ++kt) {
    const bool more = kt + 1 < nkt_max;
    if (more) {
      gload(kt + 1);
      if (MASK) {
        if (kt + 1 < nkt_w) {
#pragma unroll
          for (int c = 0; c < 2; ++c) mwn[c] = maskp[(size_t)(16 * c + jn) * 64 + kt + 1];
        }
      }
    }
    if (kt < nkt_w) {
      const char* kb = lds + (kt & 1) * BUF_BYTES; const char* vb = kb + K_BYTES;
      f32x4 s[4][2]; zero_acc(s);
#pragma unroll
      for (int a = 0; a < 4; ++a)
#pragma unroll
        for (int ks = 0; ks < KS; ++ks) {
          const bf16x8 kf = *reinterpret_cast<const bf16x8*>(kb + ((16 * a + jn) * KROW + ks * 32 + q * 8) * 2);
#pragma unroll
          for (int c = 0; c < 2; ++c) s[a][c] = mfma16(kf, qf[c][ks], s[a][c]);
        }
      if (MASK) {
#pragma unroll
        for (int c = 0; c < 2; ++c) {
          const u64 w = mw[c] >> (4 * q);
#pragma unroll
          for (int a = 0; a < 4; ++a)
#pragma unroll
            for (int r = 0; r < 4; ++r)
              if (!((w >> (16 * a + r)) & 1ull)) s[a][c][r] = NEG_INF;
        }
      }
      float alpha[2];
#pragma unroll
      for (int c = 0; c < 2; ++c) {
        float mx = NEG_INF;
#pragma unroll
        for (int a = 0; a < 4; ++a)
#pragma unroll
          for (int r = 0; r < 4; ++r) mx = fmaxf(mx, s[a][c][r]);
        mx = fmaxf(mx, __shfl_xor(mx, 16)); mx = fmaxf(mx, __shfl_xor(mx, 32));
        const float mn = fmaxf(m[c], mx);
        const float mu = (mn == NEG_INF) ? 0.f : mn;
        alpha[c] = fexp2(m[c] - mu);
        m[c] = mn;
        float ps = 0.f;
#pragma unroll
        for (int a = 0; a < 4; ++a)
#pragma unroll
          for (int r = 0; r < 4; ++r) { float p = fexp2(s[a][c][r] - mu); s[a][c][r] = p; ps += p; }
        lsum[c] = lsum[c] * alpha[c] + ps;
      }
      if (__builtin_amdgcn_ballot_w64(alpha[0] != 1.0f || alpha[1] != 1.0f) != 0ull) {
#pragma unroll
        for (int c = 0; c < 2; ++c)
#pragma unroll
          for (int dt = 0; dt < 4; ++dt)
#pragma unroll
            for (int r = 0; r < 4; ++r) o[dt][c][r] *= alpha[c];
      }
#pragma unroll
      for (int kk = 0; kk < 2; ++kk) {
        bf16x8 pf[2];
#pragma unroll
        for (int c = 0; c < 2; ++c) {
          uint4 w; w.x = pack2(s[2 * kk][c][0], s[2 * kk][c][1]); w.y = pack2(s[2 * kk][c][2], s[2 * kk][c][3]);
          w.z = pack2(s[2 * kk + 1][c][0], s[2 * kk + 1][c][1]); w.w = pack2(s[2 * kk + 1][c][2], s[2 * kk + 1][c][3]);
          pf[c] = __builtin_bit_cast(bf16x8, w);
        }
#pragma unroll
        for (int dt = 0; dt < 4; ++dt) {
          const char* vp = vb + ((16 * dt + jn) * VROW + kk * 32 + 4 * q) * 2;
          const uint2 lo = *reinterpret_cast<const uint2*>(vp), hi = *reinterpret_cast<const uint2*>(vp + 32);
          uint4 w; w.x = lo.x; w.y = lo.y; w.z = hi.x; w.w = hi.y;
          const bf16x8 vf = __builtin_bit_cast(bf16x8, w);
#pragma unroll
          for (int c = 0; c < 2; ++c) o[dt][c] = mfma16(vf, pf[c], o[dt][c]);
        }
      }
    }
    if (more) lstore((kt + 1) & 1);
    if (MASK) { mw[0] = mwn[0]; mw[1] = mwn[1]; }
    __syncthreads();
  }
#pragma unroll
  for (int c = 0; c < 2; ++c) {
    const float inv = 1.0f / red4(lsum[c]);
    const int row = 16 * c + jn;
#pragma unroll
    for (int dt = 0; dt < 4; ++dt) {
      uint2 gw = ld4(gatep + (size_t)row * gstride + 16 * dt + 4 * q);
      st4(outp + (size_t)row * ostride + 16 * dt + 4 * q, o[dt][c][0] * inv * siluf_(lo2f(gw.x)), o[dt][c][1] * inv * siluf_(hi2f(gw.x)),
          o[dt][c][2] * inv * siluf_(lo2f(gw.y)), o[dt][c][3] * inv * siluf_(hi2f(gw.y)));
    }
  }
}

template <int KS, bool MASK, int NC, bool SH>
DI void attn_block(const u16* Qp, int qstride, const u16* Kp, int kstride, const u16* Vtp, const u64* maskp, int nkt_w, int nkt_max,
                   const u16* gatep, int gstride, u16* outp, int ostride, char* lds, int tid) {
  constexpr int DQK = KS * 32, KROW = DQK + 8, VROW = 72;
  constexpr int KCH = DQK / 8, NKC = 64 * KCH / 256;
  constexpr int K_BYTES = 64 * KROW * 2, BUF_BYTES = K_BYTES + 64 * VROW * 2;
  const int lane = tid & 63, q = lane >> 4, jn = lane & 15;
  const float NEG_INF = -__builtin_inff();
  uint4 xk0, xk1, xk2, xv0, xv1, yk0, yk1, yk2, yv0, yv1;
  xk2 = yk2 = make_uint4(0, 0, 0, 0);
  const int c0 = tid, c1 = tid + 256, c2 = tid + 512;
  const u16* kg0 = Kp + (size_t)(c0 / KCH) * kstride + (c0 % KCH) * 8;
  const u16* kg1 = Kp + (size_t)(c1 / KCH) * kstride + (c1 % KCH) * 8;
  const u16* kg2 = Kp + (size_t)(c2 / KCH) * kstride + (c2 % KCH) * 8;
  const u16* vg0 = Vtp + (size_t)(c0 >> 3) * S + (c0 & 7) * 8;
  const u16* vg1 = Vtp + (size_t)(c1 >> 3) * S + (c1 & 7) * 8;
  char* ks0 = lds + ((c0 / KCH) * KROW + (c0 % KCH) * 8) * 2;
  char* ks1 = lds + ((c1 / KCH) * KROW + (c1 % KCH) * 8) * 2;
  char* ks2 = lds + ((c2 / KCH) * KROW + (c2 % KCH) * 8) * 2;
  char* vs0 = lds + K_BYTES + ((c0 >> 3) * VROW + (c0 & 7) * 8) * 2;
  char* vs1 = lds + K_BYTES + ((c1 >> 3) * VROW + (c1 & 7) * 8) * 2;
#define A_LOAD(P, kt) { const size_t ko = (size_t)(kt) * 64 * kstride; const int vo = (kt) * 64;                     \
    P##k0 = *reinterpret_cast<const uint4*>(kg0 + ko); P##k1 = *reinterpret_cast<const uint4*>(kg1 + ko);            \
    if (NKC == 3) P##k2 = *reinterpret_cast<const uint4*>(kg2 + ko);                                                 \
    P##v0 = *reinterpret_cast<const uint4*>(vg0 + vo); P##v1 = *reinterpret_cast<const uint4*>(vg1 + vo); }
#define A_STORE(P, buf) { *reinterpret_cast<uint4*>(ks0 + (buf) * BUF_BYTES) = P##k0; *reinterpret_cast<uint4*>(ks1 + (buf) * BUF_BYTES) = P##k1; \
    if (NKC == 3) *reinterpret_cast<uint4*>(ks2 + (buf) * BUF_BYTES) = P##k2;                                        \
    *reinterpret_cast<uint4*>(vs0 + (buf) * BUF_BYTES) = P##v0; *reinterpret_cast<uint4*>(vs1 + (buf) * BUF_BYTES) = P##v1; }
  bf16x8 qf[NC][KS];
#pragma unroll
  for (int c = 0; c < NC; ++c)
#pragma unroll
    for (int ks = 0; ks < KS; ++ks) qf[c][ks] = ld8(Qp + (size_t)((SH ? 0 : 16 * c) + jn) * qstride + (SH ? 64 * c : 0) + ks * 32 + q * 8);
  f32x4 o[4][NC]; zero_acc(o);
  float m[NC], lsum[NC];
#pragma unroll
  for (int c = 0; c < NC; ++c) { m[c] = NEG_INF; lsum[c] = 0.f; }
  u64 mce0 = 0ull, mce1 = 0ull, mco0 = 0ull, mco1 = 0ull, mne0 = 0ull, mne1 = 0ull, mno0 = 0ull, mno1 = 0ull;
  const u64* mrow0 = maskp + (size_t)jn * 64;
  const u64* mrow1 = maskp + (size_t)(16 + jn) * 64;
  if (MASK) {
    mce0 = mrow0[0]; if (!SH) mce1 = mrow1[0];
    if (1 < nkt_w) { mco0 = mrow0[1]; if (!SH) mco1 = mrow1[1]; }
  }
  auto compute = [&](int buf, u64 w0, u64 w1) {
    const char* kb = lds + buf * BUF_BYTES; const char* vb = kb + K_BYTES;
    f32x4 s[4][NC]; zero_acc(s);
#pragma unroll
    for (int a = 0; a < 4; ++a)
#pragma unroll
      for (int ks = 0; ks < KS; ++ks) {
        const bf16x8 kf = *reinterpret_cast<const bf16x8*>(kb + ((16 * a + jn) * KROW + ks * 32 + q * 8) * 2);
#pragma unroll
        for (int c = 0; c < NC; ++c) s[a][c] = mfma16(kf, qf[c][ks], s[a][c]);
      }
    if (MASK) {
#pragma unroll
      for (int c = 0; c < NC; ++c) {
        const u64 w = ((SH || c == 0) ? w0 : w1) >> (4 * q);
#pragma unroll
        for (int a = 0; a < 4; ++a)
#pragma unroll
          for (int r = 0; r < 4; ++r)
            if (!((w >> (16 * a + r)) & 1ull)) s[a][c][r] = NEG_INF;
      }
    }
    float alpha[NC];
#pragma unroll
    for (int c = 0; c < NC; ++c) {
      float mx = NEG_INF;
#pragma unroll
      for (int a = 0; a < 4; ++a)
#pragma unroll
        for (int r = 0; r < 4; ++r) mx = fmaxf(mx, s[a][c][r]);
      mx = fmaxf(mx, __shfl_xor(mx, 16)); mx = fmaxf(mx, __shfl_xor(mx, 32));
      const float mn = fmaxf(m[c], mx);
      const float mu = (mn == NEG_INF) ? 0.f : mn;
      alpha[c] = fexp2(m[c] - mu);
      m[c] = mn;
      float ps = 0.f;
#pragma unroll
      for (int a = 0; a < 4; ++a)
#pragma unroll
        for (int r = 0; r < 4; ++r) { float p = fexp2(s[a][c][r] - mu); s[a][c][r] = p; ps += p; }
      lsum[c] = lsum[c] * alpha[c] + ps;
    }
    bool resc = false;
#pragma unroll
    for (int c = 0; c < NC; ++c) resc = resc || (alpha[c] != 1.0f);
    if (__builtin_amdgcn_ballot_w64(resc) != 0ull) {
#pragma unroll
      for (int c = 0; c < NC; ++c)
#pragma unroll
        for (int dt = 0; dt < 4; ++dt)
#pragma unroll
          for (int r = 0; r < 4; ++r) o[dt][c][r] *= alpha[c];
    }
#pragma unroll
    for (int kk = 0; kk < 2; ++kk) {
      bf16x8 pf[NC];
#pragma unroll
      for (int c = 0; c < NC; ++c) {
        uint4 w; w.x = pack2(s[2 * kk][c][0], s[2 * kk][c][1]); w.y = pack2(s[2 * kk][c][2], s[2 * kk][c][3]);
        w.z = pack2(s[2 * kk + 1][c][0], s[2 * kk + 1][c][1]); w.w = pack2(s[2 * kk + 1][c][2], s[2 * kk + 1][c][3]);
        pf[c] = __builtin_bit_cast(bf16x8, w);
      }
#pragma unroll
      for (int dt = 0; dt < 4; ++dt) {
        const char* vp = vb + ((16 * dt + jn) * VROW + kk * 32 + 4 * q) * 2;
        const uint2 lo = *reinterpret_cast<const uint2*>(vp), hi = *reinterpret_cast<const uint2*>(vp + 32);
        uint4 w; w.x = lo.x; w.y = lo.y; w.z = hi.x; w.w = hi.y;
        const bf16x8 vf = __builtin_bit_cast(bf16x8, w);
#pragma unroll
        for (int c = 0; c < NC; ++c) o[dt][c] = mfma16(vf, pf[c], o[dt][c]);
      }
    }
  };

  A_LOAD(x, 0);
  { const int t1 = (nkt_max > 1) ? 1 : 0; A_LOAD(y, t1); }
  A_STORE(x, 0);
  __syncthreads();
  for (int kt = 0; kt < nkt_max; kt += 2) {
    const bool more = kt + 2 < nkt_max;
    if (more) {
      A_LOAD(x, kt + 2);
      if (MASK) {
        if (kt + 2 < nkt_w) { mne0 = mrow0[kt + 2]; if (!SH) mne1 = mrow1[kt + 2]; }
        if (kt + 3 < nkt_w) { mno0 = mrow0[kt + 3]; if (!SH) mno1 = mrow1[kt + 3]; }
      }
    }
    if (kt < nkt_w) compute(0, mce0, mce1);
    A_STORE(y, 1);
    __syncthreads();
    if (kt + 3 < nkt_max) A_LOAD(y, kt + 3);
    if (kt + 1 < nkt_w) compute(1, mco0, mco1);
    if (more) A_STORE(x, 0);
    if (MASK) { mce0 = mne0; mce1 = mne1; mco0 = mno0; mco1 = mno1; }
    __syncthreads();
  }
#undef A_LOAD
#undef A_STORE
#pragma unroll
  for (int c = 0; c < NC; ++c) {
    const float inv = 1.0f / red4(lsum[c]);
    const int row = (SH ? 0 : 16 * c) + jn;
    const int hc = SH ? 64 * c : 0;
#pragma unroll
    for (int dt = 0; dt < 4; ++dt) {
      uint2 gw = ld4(gatep + (size_t)row * gstride + hc + 16 * dt + 4 * q);
      st4(outp + (size_t)row * ostride + hc + 16 * dt + 4 * q, o[dt][c][0] * inv * siluf_(lo2f(gw.x)), o[dt][c][1] * inv * siluf_(hi2f(gw.x)),
          o[dt][c][2] * inv * siluf_(lo2f(gw.y)), o[dt][c][3] * inv * siluf_(hi2f(gw.y)));
    }
  }
}

DI void mla_attn_item(const Params& P, int it, char* lds, int tid) {
  const int wave = __builtin_amdgcn_readfirstlane(tid >> 6);
  const int sh = it & 7, mloc = it >> 3;
  const int qb = 31 - (mloc & 31), bh = sh + 8 * (mloc >> 5), b = bh / 6, h = bh % 6;
  const int q0 = qb * 128 + wave * 32;
  const int nkt = (q0 >> 6) + 1;
  const u16* mq = (const u16*)(P.ws + O_MQ); const u16* mk = (const u16*)(P.ws + O_MK); const u16* mvt = (const u16*)(P.ws + O_MVT);
  const u16* proj = (const u16*)(P.ws + O_PROJ); u16* mixed = (u16*)(P.ws + O_XB);
  const size_t tok = (size_t)b * S + q0;
  attn_block<3, false, 2, false>(mq + tok * 576 + h * 96, 576, mk + (size_t)b * S * 576 + h * 96, 576, mvt + (size_t)(b * 6 + h) * 64 * S, nullptr, nkt, 2 * qb + 2,
                       proj + tok * DINP + C_GC + h * 64, DINP, mixed + tok * DM + 640 + h * 64, DM, lds, tid);
}

DI void dsa_attn_item(const Params& P, int it, char* lds, int tid) {
  const int wave = __builtin_amdgcn_readfirstlane(tid >> 6);
  const int ch = 63 - it / 32, bh = it % 32, b = bh >> 1, hg = bh & 1;
  const int q0 = ch * 64 + wave * 16;
  const int nkt = ch + 1;
  const u16* proj = (const u16*)(P.ws + O_PROJ); const u16* avt = (const u16*)(P.ws + O_AVT); u16* mixed = (u16*)(P.ws + O_XB);
  const u64* mask = (const u64*)(P.ws + O_MASK);
  const size_t tok = (size_t)b * S + q0;
  attn_block<2, true, 3, true>(proj + tok * DINP + C_QA + hg * 192, DINP, proj + (size_t)b * S * DINP + C_KA, DINP, avt + (size_t)b * 64 * S, mask + tok * 64, nkt, nkt,
                               proj + tok * DINP + C_GA + hg * 192, DINP, mixed + tok * DM + hg * 192, DM, lds, tid);
}

constexpr int SC_STRIDE = 4096 + 16;
DI unsigned fkey(float f) { unsigned u = __float_as_uint(f); return (u & 0x80000000u) ? ~u : (u | 0x80000000u); }
DI float funkey(unsigned k) { return __uint_as_float((k & 0x80000000u) ? (k ^ 0x80000000u) : ~k); }

template <int NR>
DI u64 select_wave(float* scw, int nreg, int lane) {
  unsigned key[NR];
  unsigned kmin = 0xffffffffu, kmax = 0u;
#pragma unroll
  for (int r = 0; r < NR; ++r) {
    const unsigned k = fkey(scw[64 * r + lane]);
    const bool ok = r < nreg;
    key[r] = ok ? k : 0u;
    kmin = min(kmin, ok ? k : 0xffffffffu); kmax = max(kmax, key[r]);
  }
#pragma unroll
  for (int o = 1; o < 64; o <<= 1) { kmin = min(kmin, (unsigned)__shfl_xor((int)kmin, o)); kmax = max(kmax, (unsigned)__shfl_xor((int)kmax, o)); }
  unsigned lo = __builtin_amdgcn_readfirstlane(kmin), hi = __builtin_amdgcn_readfirstlane(kmax);
  int clo = 64 * nreg, chi = 0;
  bool exact = false;
  int iter = 0;
  while (lo < hi && clo - chi > 512) {
    unsigned mid = fkey(0.5f * (funkey(lo) + funkey(hi)));
    if (iter >= 16) mid = lo + ((hi - lo + 1u) >> 1);
    if (mid <= lo) mid = lo + 1;
    if (mid > hi) mid = hi;
    ++iter;
    int cnt = 0;
#pragma unroll
    for (int r = 0; r < NR; ++r) cnt += __builtin_popcountll(__builtin_amdgcn_ballot_w64(key[r] >= mid));
    if (cnt >= 256) { lo = mid; clo = cnt; if (cnt == 256) { exact = true; break; } }
    else { hi = mid - 1; chi = cnt; }
  }
  if (!exact && lo < hi) {
    unsigned* cand = reinterpret_cast<unsigned*>(scw);
    int base = 0;
#pragma unroll
    for (int r = 0; r < NR; ++r) {
      const bool pred = (key[r] >= lo) && (key[r] <= hi);
      const u64 bal = __builtin_amdgcn_ballot_w64(pred);
      const int pos = base + __builtin_amdgcn_mbcnt_hi((unsigned)(bal >> 32), __builtin_amdgcn_mbcnt_lo((unsigned)bal, 0u));
      if (pred) cand[pos] = key[r];
      base += __builtin_popcountll(bal);
    }
    __builtin_amdgcn_fence(__ATOMIC_RELEASE, "wavefront");
    __builtin_amdgcn_fence(__ATOMIC_ACQUIRE, "wavefront");
    unsigned ck[8];
#pragma unroll
    for (int i = 0; i < 8; ++i) { const unsigned v = cand[64 * i + lane]; ck[i] = (64 * i + lane < base) ? v : 0u; }
    const int cabove = chi;
    while (lo < hi) {
      unsigned mid = fkey(0.5f * (funkey(lo) + funkey(hi)));
      if (iter >= 16) mid = lo + ((hi - lo + 1u) >> 1);
      if (mid <= lo) mid = lo + 1;
      if (mid > hi) mid = hi;
      ++iter;
      int cnt = cabove;
#pragma unroll
      for (int i = 0; i < 8; ++i) cnt += __builtin_popcountll(__builtin_amdgcn_ballot_w64(ck[i] >= mid));
      if (cnt >= 256) { lo = mid; if (cnt == 256) { exact = true; break; } }
      else { hi = mid - 1; }
    }
  }
  const unsigned thr = lo;
  u64 myword = 0ull;
  if (exact) {
#pragma unroll
    for (int r = 0; r < NR; ++r) { const u64 bal = __builtin_amdgcn_ballot_w64(key[r] >= thr); if (lane == r) myword = bal; }
  } else {
    int cgt = 0;
#pragma unroll
    for (int r = 0; r < NR; ++r) cgt += __builtin_popcountll(__builtin_amdgcn_ballot_w64(key[r] > thr));
    const int need = 256 - cgt;
    int run = 0;
    const u64 below = (1ull << lane) - 1ull;
#pragma unroll
    for (int r = 0; r < NR; ++r) {
      const u64 eq = __builtin_amdgcn_ballot_w64(key[r] == thr);
      const int rank = run + __builtin_popcountll(eq & below);
      const bool sel = (key[r] > thr) || ((key[r] == thr) && (rank < need));
      const u64 bal = __builtin_amdgcn_ballot_w64(sel);
      run += __builtin_popcountll(eq);
      if (lane == r) myword = bal;
    }
  }
  return myword;
}

DI void dsa_select_item(const Params& P, int it, float* sc, int wave, int lane) {
  const int qd = 1023 - it / 16, b = it % 16;
  const int t0 = qd * 4;
  const int N = ((t0 >> 6) + 1) * 64, nreg = N >> 6;
  const u16* base = (const u16*)(P.ws + O_PROJ) + (size_t)b * S * DINP;
  u64* mask = (u64*)(P.ws + O_MASK);
  const int q = lane >> 4, jn = lane & 15;
  if (N > 256) {
    const bf16x8 a0 = ld8(base + (size_t)(t0 + (jn >> 2)) * DINP + C_IQ + (jn & 3) * 32 + q * 8);
    const bf16x8 a1 = ld8(base + (size_t)(t0 + (jn >> 2)) * DINP + C_IQ + (4 + (jn & 3)) * 32 + q * 8);
    float w[8];
    {
      bf16x8 wv = ld8(base + (size_t)(t0 + q) * DINP + C_IW);
#pragma unroll
      for (int h = 0; h < 8; ++h) w[h] = bf2f((u16)wv[h]) * (0.35355339059327373f * 0.17677669529663687f);
    }
    const int tpw = N >> 6;
    const u16* kbase = base + (size_t)jn * DINP + C_IK + q * 8;
    for (int tl = 0; tl < tpw; tl += 16) {
      bf16x8 bk[16];
#pragma unroll
      for (int u = 0; u < 16; ++u) {
        const int t = (tl + u < tpw) ? tl + u : tpw - 1;
        bk[u] = ld8(kbase + (size_t)((wave * tpw + t) * 16) * DINP);
      }
#pragma unroll
      for (int u = 0; u < 16; ++u) {
        const int t = (tl + u < tpw) ? tl + u : tpw - 1;
        const int key0 = (wave * tpw + t) * 16;
        const f32x4 z = {0.f, 0.f, 0.f, 0.f};
        f32x4 d0 = mfma16(a0, bk[u], z), d1 = mfma16(a1, bk[u], z);
        float sv = 0.f;
#pragma unroll
        for (int r = 0; r < 4; ++r) sv += fmaxf(d0[r], 0.f) * w[r];
#pragma unroll
        for (int r = 0; r < 4; ++r) sv += fmaxf(d1[r], 0.f) * w[4 + r];
        sc[q * SC_STRIDE + key0 + jn] = sv;
      }
    }
  }
  __syncthreads();
  u64 myword = ~0ull;
  if (N > 256) {
    float* scw = sc + wave * SC_STRIDE;
    if (nreg <= 8) myword = select_wave<8>(scw, nreg, lane);
    else if (nreg <= 16) myword = select_wave<16>(scw, nreg, lane);
    else if (nreg <= 24) myword = select_wave<24>(scw, nreg, lane);
    else if (nreg <= 32) myword = select_wave<32>(scw, nreg, lane);
    else if (nreg <= 48) myword = select_wave<48>(scw, nreg, lane);
    else myword = select_wave<64>(scw, nreg, lane);
  }
  if (lane < nreg) mask[((size_t)b * S + t0 + wave) * 64 + lane] = myword;
  __syncthreads();
}

DI void s5_stage1_item(const Params& P, int l, int it, int wave, int lane) {
  const int b = it >> 4, g = it & 15, q = lane >> 4, jn = lane & 15;
  const u16* proj = (const u16*)(P.ws + O_PROJ);
  const u16* W1 = (const u16*)(P.ws + O_W1) + (size_t)(l * 16 + g) * 128 * 1024;
  float* s5s = (float*)(P.ws + O_S5S) + (size_t)it * 64 * 128;
  f32x4 acc[2][4]; zero_acc(acc);
  const u16* ap = W1 + (size_t)(wave * 32 + jn) * 1024 + q * 8;
  const u16* up = proj + ((size_t)b * S + (size_t)jn * 64 + (q >> 1)) * DINP + C_U + g * 16 + (q & 1) * 8;
  wgemm<2, 4>(acc, 32, [&](int i, int ks) { return ld8(ap + (size_t)i * 16 * 1024 + ks * 32); },
              [&](int j, int ks) { return ld8(up + ((size_t)j * 16 * 64 + 2 * ks) * DINP); });
#pragma unroll
  for (int j = 0; j < 4; ++j) {
    const int n = 16 * j + jn;
#pragma unroll
    for (int i = 0; i < 2; ++i)
      *reinterpret_cast<f32x4*>(s5s + (size_t)n * 128 + wave * 32 + 16 * i + 4 * q) = acc[i][j];
  }
}

constexpr int HS_STRIDE = 136;
DI void s5_stage3_item(const Params& P, int l, int it, u16* hs, int wave, int lane) {
  const int b = it >> 4, g = it & 15, q = lane >> 4, jn = lane & 15;
  const u16* proj = (const u16*)(P.ws + O_PROJ);
  const u16* Kt = (const u16*)(P.ws + O_KT) + (size_t)(l * 16 + g) * 64 * 256;
  const u16* W3 = (const u16*)(P.ws + O_W3) + (size_t)(l * 16 + g) * 1024 * 128;
  const float* s5s = (const float*)(P.ws + O_S5S) + (size_t)it * 64 * 128;
  const float2* pw = (const float2*)(P.ws + O_PW);
  u16* yg = (u16*)(P.ws + O_YG);
  const float* dsk = P.in[17] + (l * 16 + g) * 16;
  if (wave == 0) {
    const int p = lane;
    const float2 aL = pw[((size_t)(l * 16 + g) * 65 + 64) * 64 + p];
    float hr = 0.f, hi = 0.f;
#pragma unroll
    for (int half = 0; half < 2; ++half) {
      float2 sv[32];
#pragma unroll
      for (int n = 0; n < 32; ++n) sv[n] = *reinterpret_cast<const float2*>(s5s + (size_t)(half * 32 + n) * 128 + 2 * p);
#pragma unroll
      for (int n = 0; n < 32; ++n) {
        *reinterpret_cast<unsigned*>(hs + (half * 32 + n) * HS_STRIDE + 2 * p) = pack2(hr, hi);
        const float nr = aL.x * hr - aL.y * hi + sv[n].x, ni = aL.x * hi + aL.y * hr + sv[n].y;
        hr = nr; hi = ni;
      }
    }
  }
  __syncthreads();
  const u16* up = proj + ((size_t)b * S + (size_t)jn * 64 + (q >> 1)) * DINP + C_U + g * 16 + (q & 1) * 8;
  const bf16x8 zf = {0, 0, 0, 0, 0, 0, 0, 0};
  for (int gi = 0; gi < 8; ++gi) {
    const int jg = wave + 4 * (gi >> 1);
    const int th = gi & 1;
    f32x4 acc[4][2]; zero_acc(acc);
    wgemm<4, 2>(acc, 2 * jg + 2,
                [&](int i, int ks) { const int j = 4 * jg + i, ii = 2 * ks + (q >> 1); const int d = j - ii;
                                     return (d >= 0) ? ld8(Kt + ((size_t)d * 16 + jn) * 16 + (q & 1) * 8) : zf; },
                [&](int jt, int ks) { return ld8(up + ((size_t)(2 * th + jt) * 16 * 64 + 2 * ks) * DINP); });
    wgemm<4, 2>(acc, 4,
                [&](int i, int ks) { return ld8(W3 + ((size_t)(4 * jg + i) * 16 + jn) * 128 + ks * 32 + q * 8); },
                [&](int jt, int ks) { return *reinterpret_cast<const bf16x8*>(hs + (16 * (2 * th + jt) + jn) * HS_STRIDE + ks * 32 + q * 8); });
#pragma unroll
    for (int jt = 0; jt < 2; ++jt) {
      const int n = 16 * (2 * th + jt) + jn;
#pragma unroll
      for (int i = 0; i < 4; ++i) {
        const size_t tok = (size_t)b * S + n * 64 + 4 * jg + i;
        uint2 uw = ld4(proj + tok * DINP + C_U + g * 16 + 4 * q);
        const float y0 = acc[i][jt][0] + dsk[4 * q] * lo2f(uw.x), y1 = acc[i][jt][1] + dsk[4 * q + 1] * hi2f(uw.x);
        const float y2 = acc[i][jt][2] + dsk[4 * q + 2] * lo2f(uw.y), y3 = acc[i][jt][3] + dsk[4 * q + 3] * hi2f(uw.y);
        st4(yg + tok * 256 + g * 16 + 4 * q, geluf_(y0), geluf_(y1), geluf_(y2), geluf_(y3));
      }
    }
  }
  __syncthreads();
}

DI void glu_tile(const Params& P, int l, int tt, char* lds) {
  const u16* W = (const u16*)(P.ws + O_WTGLU) + (size_t)l * 256 * 256;
  const u16* yg = (const u16*)(P.ws + O_YG);
  const u16* proj = (const u16*)(P.ws + O_PROJ);
  u16* mixed = (u16*)(P.ws + O_XB);
  const int tid = opaque_tid();
  const int wave = __builtin_amdgcn_readfirstlane(tid >> 6), lane = tid & 63, q = lane >> 4, jn = lane & 15;
#pragma unroll 1
  for (int ftile = 0; ftile < 2; ++ftile) {
    const int f0 = ftile * 128 + (wave >> 1) * 64, t0 = tt * 128 + (wave & 1) * 64;
    f32x4 acc[4][4]; zero_acc(acc);
    gemm_block(acc, W + (size_t)(ftile * 128) * 256, 256, yg + (size_t)(tt * 128) * 256, 256, 256, lds, tid);
#pragma unroll
    for (int j = 0; j < 4; ++j) {
      const size_t tok = t0 + 16 * j + jn;
#pragma unroll
      for (int i = 0; i < 4; ++i) {
        const int f = f0 + 16 * i + 4 * q;
        uint2 gw = ld4(yg + tok * 256 + f), bw = ld4(proj + tok * DINP + C_GB + f);
        st4(mixed + tok * DM + 384 + f, lo2f(gw.x) * sigmoidf_(acc[i][j][0]) * siluf_(lo2f(bw.x)), hi2f(gw.x) * sigmoidf_(acc[i][j][1]) * siluf_(hi2f(bw.x)),
            lo2f(gw.y) * sigmoidf_(acc[i][j][2]) * siluf_(lo2f(bw.y)), hi2f(gw.y) * sigmoidf_(acc[i][j][3]) * siluf_(hi2f(bw.y)));
      }
    }
  }
}

DI void outproj_tile(const Params& P, int l, int tt, char* lds) {
  const u16* W = (const u16*)(P.ws + O_WTOUT) + (size_t)l * DM * DM;
  const u16* mixed = (const u16*)(P.ws + O_XB);
  const float* xin = (l == 0) ? P.in[0] : P.out;
  float* xout = P.out;
  u16* xb2 = (u16*)(P.ws + O_XB2);
  const int tid = opaque_tid();
  const int wave = __builtin_amdgcn_readfirstlane(tid >> 6), lane = tid & 63, q = lane >> 4, jn = lane & 15;
#pragma unroll 1
  for (int ftile0 = 0; ftile0 < 8; ++ftile0) {
    int ftile = ftile0; asm volatile("" : "+s"(ftile));
    const int f0 = ftile * 128 + (wave >> 1) * 64, t0 = tt * 128 + (wave & 1) * 64;
    f32x4 acc[4][4]; zero_acc(acc);
    gemm_block(acc, W + (size_t)(ftile * 128) * DM, DM, mixed + (size_t)(tt * 128) * DM, DM, DM, lds, tid);
#pragma unroll
    for (int j = 0; j < 4; ++j) {
      const size_t tok = t0 + 16 * j + jn;
#pragma unroll
      for (int i = 0; i < 4; ++i) {
        const int f = f0 + 16 * i + 4 * q;
        f32x4 xv;
        if (l == 0) xv = *reinterpret_cast<const f32x4*>(xin + tok * DM + f);
        else { const uint2 xw = ld4(xb2 + tok * DM + f); xv = f32x4{lo2f(xw.x), hi2f(xw.x), lo2f(xw.y), hi2f(xw.y)}; }
        const f32x4 xn = xv + acc[i][j];
        if (l == NL - 1) *reinterpret_cast<f32x4*>(xout + tok * DM + f) = xn;
        else st4(xb2 + tok * DM + f, xn[0], xn[1], xn[2], xn[3]);
      }
    }
  }
}

DI void phase_tail(const Params& P, int l, char* lds, float* s_rstd, float* s_prep) {
  for (int tt = blockIdx.x; tt < 512; tt += gridDim.x) {
    glu_tile(P, l, tt, lds);
    asm volatile("s_waitcnt vmcnt(0)" ::: "memory");
    __syncthreads();
    outproj_tile(P, l, tt, lds);
    if (l + 1 < NL) {
      asm volatile("s_waitcnt vmcnt(0)" ::: "memory");
      __syncthreads();
      inproj_tile(P, l + 1, tt, lds, s_rstd, s_prep);
    }
  }
}

DI void gbar(unsigned* ctr, unsigned& epoch) {
  asm volatile("s_waitcnt vmcnt(0)" ::: "memory");
  __syncthreads();
  epoch += gridDim.x;
  if (threadIdx.x == 0) {
    __builtin_amdgcn_fence(__ATOMIC_RELEASE, "agent");
    asm volatile("s_waitcnt vmcnt(0)" ::: "memory");
    __hip_atomic_fetch_add(ctr, 1u, __ATOMIC_RELAXED, __HIP_MEMORY_SCOPE_AGENT);
    while (__hip_atomic_load(ctr, __ATOMIC_RELAXED, __HIP_MEMORY_SCOPE_AGENT) < epoch) __builtin_amdgcn_s_sleep(1);
    __builtin_amdgcn_fence(__ATOMIC_ACQUIRE, "agent");
    asm volatile("s_waitcnt vmcnt(0)" ::: "memory");
  }
  __syncthreads();
}

__global__ void __launch_bounds__(256, 2) fwd_megakernel(Params P) {
  cg::grid_group grid = cg::this_grid();
  __shared__ __attribute__((aligned(16))) float lds_f[2 * G_BUF_BYTES / 4];
  static_assert(2 * G_BUF_BYTES >= 4 * SC_STRIDE * 4, "lds");
  __shared__ int s_item;
  __shared__ float s_rstd[128];
  __shared__ float s_prep[512];
  const long gtid = (long)blockIdx.x * 256 + threadIdx.x, gsz = (long)gridDim.x * 256;

  if (blockIdx.x == 0) { for (int w = threadIdx.x; w < 8192; w += 256) ((unsigned*)(P.ws + O_CTR))[w] = 0u; }
  phase_w0(P, gtid, gsz);
  grid.sync();
  unsigned* bar = (unsigned*)(P.ws + O_CTR) + 6144;
  unsigned epoch = 0u;
  phase_w1(P, gtid, gsz);
#ifdef DUP_W
  phase_w0(P, gtid, gsz);
  phase_w1(P, gtid, gsz);
#endif

  for (int tt = blockIdx.x; tt < 512; tt += gridDim.x) {
    {
      const float* x = P.in[0]; u16* xb = (u16*)(P.ws + O_XB2);
      const int tid = opaque_tid();
#pragma unroll 4
      for (int e = tid; e < 128 * 256; e += 256) {
        const float4 v = *reinterpret_cast<const float4*>(x + (size_t)tt * 128 * DM + (size_t)e * 4);
        st4(xb + (size_t)tt * 128 * DM + (size_t)e * 4, v.x, v.y, v.z, v.w);
      }
    }
    asm volatile("s_waitcnt vmcnt(0)" ::: "memory");
    __syncthreads();
    inproj_tile(P, 0, tt, (char*)lds_f, s_rstd, s_prep);
  }
  gbar(bar, epoch);
  for (int l = 0; l < NL; ++l) {
    {
      const int shard = blockIdx.x & 7;
      unsigned* ctr = (unsigned*)(P.ws + O_CTR) + ((l * 2) * 8 + shard) * 64;
      for (;;) {
        const int tid = opaque_tid();
        if (tid == 0) s_item = (int)atomicAdd(ctr, 1u) * 8 + shard;
        __syncthreads();
        const int it = s_item;
        __syncthreads();
        if (it >= 256 + 3072 + 4096) break;
        const int wave = __builtin_amdgcn_readfirstlane(tid >> 6), lane = tid & 63;
        if (it < 256) s5_stage1_item(P, l, it, wave, lane);
        else if (it < 256 + 3072) mla_attn_item(P, it - 256, (char*)lds_f, tid);
        else {
#pragma unroll 1
          for (int k = 0; k < 4; ++k) dsa_select_item(P, (it - 256 - 3072) * 4 + k, lds_f, wave, lane);
        }
      }
    }
    gbar(bar, epoch);
    {
      const int shard = blockIdx.x & 7;
      unsigned* ctr = (unsigned*)(P.ws + O_CTR) + ((l * 2 + 1) * 8 + shard) * 64;
      for (;;) {
        const int tid = opaque_tid();
        if (tid == 0) s_item = (int)atomicAdd(ctr, 1u) * 8 + shard;
        __syncthreads();
        const int it = s_item;
        __syncthreads();
        if (it >= 256 + 2048) break;
        const int wave = __builtin_amdgcn_readfirstlane(tid >> 6), lane = tid & 63;
        if (it < 256) s5_stage3_item(P, l, it, (u16*)lds_f, wave, lane);
        else dsa_attn_item(P, it - 256, (char*)lds_f, tid);
      }
    }
    gbar(bar, epoch);
    phase_tail(P, l, (char*)lds_f, s_rstd, s_prep);
    if (l + 1 < NL) gbar(bar, epoch);
  }
}

extern "C" void kernel_launch(void* const* d_in, const int* in_sizes, int n_in, void* d_out, int out_size, void* d_ws, size_t ws_size,
                              hipStream_t stream) {
  static int grid_blocks = 0;
  if (!grid_blocks) {
    int dev = 0, cus = 0, per_cu = 0;
    hipGetDevice(&dev);
    hipDeviceGetAttribute(&cus, hipDeviceAttributeMultiprocessorCount, dev);
    hipOccupancyMaxActiveBlocksPerMultiprocessor(&per_cu, fwd_megakernel, 256, 0);
    if (per_cu < 1) per_cu = 1;
    if (per_cu > 2) per_cu = 2;
    grid_blocks = cus * per_cu;
    if (ws_size < O_END) fprintf(stderr, "workspace too small: %zu < %zu\n", ws_size, (size_t)O_END);
  }
  Params p{};
  for (int i = 0; i < 21; ++i) p.in[i] = (const float*)d_in[i];
  p.out = (float*)d_out;
  p.ws = (char*)d_ws;
  void* args[] = {&p};
  hipError_t e = hipLaunchCooperativeKernel((void*)fwd_megakernel, dim3(grid_blocks), dim3(256), args, 0, stream);
  if (e != hipSuccess) fprintf(stderr, "cooperative launch failed: %s (grid %d)\n", hipGetErrorString(e), grid_blocks);
}
```

```cpp
#include <hip/hip_runtime.h>
#include <hip/hip_cooperative_groups.h>
#include <cstdio>
#include <type_traits>
namespace cg = cooperative_groups;

#define DI __device__ __forceinline__
typedef __attribute__((ext_vector_type(8))) short bf16x8;
typedef __attribute__((ext_vector_type(4))) short s16x4;
typedef __attribute__((ext_vector_type(4))) float f32x4;
typedef unsigned short u16;
typedef unsigned long long u64;

constexpr int NB = 16, S = 4096, T = NB * S, DM = 1024, DIN = 2504, DINP = 2560, NL = 4;
constexpr int C_QA = 0, C_KA = 384, C_VA = 448, C_IQ = 512, C_IK = 768, C_IW = 800, C_GA = 808, C_U = 1192,
              C_GB = 1448, C_CQ = 1704, C_CKV = 1960, C_KPE = 2088, C_GC = 2120;
constexpr float EPS = 1e-6f;
constexpr float LOG2E = 1.4426950408889634f;

constexpr size_t O_WTIN = 0;
constexpr size_t O_WTOUT = O_WTIN + (size_t)NL * DINP * DM * 2;
constexpr size_t O_WTUQ = O_WTOUT + (size_t)NL * DM * DM * 2;
constexpr size_t O_WTUKV = O_WTUQ + (size_t)NL * 768 * 256 * 2;
constexpr size_t O_WTGLU = O_WTUKV + (size_t)NL * 768 * 128 * 2;
constexpr size_t O_W1 = O_WTGLU + (size_t)NL * 256 * 256 * 2;
constexpr size_t O_W3 = O_W1 + (size_t)NL * 16 * 128 * 1024 * 2;
constexpr size_t O_KT = O_W3 + (size_t)NL * 16 * 1024 * 128 * 2;
constexpr size_t O_PW = O_KT + (size_t)NL * 16 * 64 * 256 * 2;
constexpr size_t O_FZ = O_PW + (size_t)NL * 16 * 65 * 64 * 8;
constexpr size_t O_R64 = O_FZ + (size_t)NL * 16 * 64 * 8;
constexpr size_t O_R32 = O_R64 + (size_t)4096 * 32 * 8;
constexpr size_t O_XB = O_R32 + (size_t)4096 * 16 * 8;
constexpr size_t O_RSTD = O_XB + (size_t)T * 1024 * 2;
constexpr size_t O_PROJ = O_RSTD + (size_t)T * 4;
constexpr size_t O_MQ = O_PROJ + (size_t)T * DINP * 2;
constexpr size_t O_MK = O_MQ + (size_t)T * 576 * 2;
constexpr size_t O_MVT = O_MK + (size_t)T * 576 * 2;
constexpr size_t O_AVT = O_MVT + (size_t)T * 384 * 2;
constexpr size_t O_MASK = O_AVT + (size_t)T * 64 * 2;
constexpr size_t O_S5S = O_MASK + (size_t)T * 512;
constexpr size_t O_YG = O_S5S + (size_t)16 * 16 * 64 * 128 * 4;
constexpr size_t O_CTR = O_YG + (size_t)T * 256 * 2;
constexpr size_t O_XB2 = O_CTR + 32768;
constexpr size_t O_END = O_XB2 + (size_t)T * 1024 * 2;

struct Params {
  const float* in[21];
  float* out;
  char* ws;
};

DI int opaque_tid() { int t = threadIdx.x; asm volatile("" : "+v"(t)); return t; }
DI u16 f2bf(float f) { unsigned u = __float_as_uint(f); u += 0x7fffu + ((u >> 16) & 1u); return (u16)(u >> 16); }
DI float bf2f(u16 h) { return __uint_as_float(((unsigned)h) << 16); }
typedef __attribute__((ext_vector_type(2))) __bf16 bf16x2_t;
typedef __attribute__((ext_vector_type(2))) float f32x2_t;
DI unsigned pack2(float a, float b) { return __builtin_bit_cast(unsigned, __builtin_convertvector((f32x2_t){a, b}, bf16x2_t)); }
DI float lo2f(unsigned w) { return __uint_as_float(w << 16); }
DI float hi2f(unsigned w) { return __uint_as_float(w & 0xffff0000u); }
DI bf16x8 ld8(const u16* p) { return *reinterpret_cast<const bf16x8*>(p); }
DI uint2 ld4(const u16* p) { return *reinterpret_cast<const uint2*>(p); }
DI void st4(u16* p, float a, float b, float c, float d) { uint2 v; v.x = pack2(a, b); v.y = pack2(c, d); *reinterpret_cast<uint2*>(p) = v; }
DI f32x4 mfma16(bf16x8 a, bf16x8 b, f32x4 c) { return __builtin_amdgcn_mfma_f32_16x16x32_bf16(a, b, c, 0, 0, 0); }
DI float fexp2(float x) { return __builtin_amdgcn_exp2f(x); }
DI float sigmoidf_(float x) { return __builtin_amdgcn_rcpf(1.0f + __expf(-x)); }
DI float siluf_(float x) { return x * sigmoidf_(x); }
DI float geluf_(float x) { float u = 0.7978845608028654f * (x + 0.044715f * x * x * x); return x * sigmoidf_(2.0f * u); }
DI float red4(float v) { v += __shfl_xor(v, 16); v += __shfl_xor(v, 32); return v; }

template <int AT, int BT, class FA, class FB>
DI void wgemm(f32x4 (&acc)[AT][BT], int ksteps, FA fa, FB fb) {
  bf16x8 a0[AT], b0[BT], a1[AT], b1[BT];
  const int k1 = (ksteps > 1) ? 1 : 0;
#pragma unroll
  for (int i = 0; i < AT; ++i) { a0[i] = fa(i, 0); a1[i] = fa(i, k1); }
#pragma unroll
  for (int j = 0; j < BT; ++j) { b0[j] = fb(j, 0); b1[j] = fb(j, k1); }
  for (int ks = 0; ks < ksteps; ++ks) {
    bf16x8 a2[AT], b2[BT];
    const int kn = (ks + 2 < ksteps) ? ks + 2 : ksteps - 1;
#pragma unroll
    for (int i = 0; i < AT; ++i) a2[i] = fa(i, kn);
#pragma unroll
    for (int j = 0; j < BT; ++j) b2[j] = fb(j, kn);
    __builtin_amdgcn_sched_barrier(0);
#pragma unroll
    for (int i = 0; i < AT; ++i)
#pragma unroll
      for (int j = 0; j < BT; ++j) acc[i][j] = mfma16(a0[i], b0[j], acc[i][j]);
    __builtin_amdgcn_sched_barrier(0);
#pragma unroll
    for (int i = 0; i < AT; ++i) { a0[i] = a1[i]; a1[i] = a2[i]; }
#pragma unroll
    for (int j = 0; j < BT; ++j) { b0[j] = b1[j]; b1[j] = b2[j]; }
  }
}

constexpr int GROW = 72;
constexpr int G_TILE_BYTES = 128 * GROW * 2;
constexpr int G_BUF_BYTES = 2 * G_TILE_BYTES;
DI void gemm_block(f32x4 (&acc)[4][4], const u16* Ap, int lda, const u16* Bp, int ldb, int K, char* lds, int tid, bool swap_w1 = false) {
  const int lane = tid & 63, q = lane >> 4, jn = lane & 15;
  const int wave = __builtin_amdgcn_readfirstlane(tid >> 6), wa = wave >> 1, wb = wave & 1;
  uint4 xa0, xa1, xa2, xa3, xb0, xb1, xb2, xb3;
  uint4 ya0, ya1, ya2, ya3, yb0, yb1, yb2, yb3;
  const int srow = tid >> 3, scol = tid & 7;
  const unsigned voa = (unsigned)(srow * lda + scol * 8) * 2u, vob = (unsigned)(srow * ldb + scol * 8) * 2u;
  const char* ag = reinterpret_cast<const char*>(Ap);
  const char* bg = reinterpret_cast<const char*>(Bp);
  char* st0 = lds + (srow * GROW + scol * 8) * 2;
  const bool sw = swap_w1 && (wa == 1);
  const char* a0p = sw ? (lds + G_TILE_BYTES + (wb * 64 + jn) * GROW * 2 + q * 16) : (lds + (wa * 64 + jn) * GROW * 2 + q * 16);
  const char* b0p = sw ? (lds + (wa * 64 + jn) * GROW * 2 + q * 16) : (lds + G_TILE_BYTES + (wb * 64 + jn) * GROW * 2 + q * 16);
#define GL(v, base, ld, vo, i, kt) v = *reinterpret_cast<const uint4*>(base + ((size_t)(32 * (i)) * (ld) + (size_t)(kt) * 64) * 2 + vo)
#define GLOAD0(kt) { GL(xa0, ag, lda, voa, 0, kt); GL(xa1, ag, lda, voa, 1, kt); GL(xa2, ag, lda, voa, 2, kt); GL(xa3, ag, lda, voa, 3, kt); GL(xb0, bg, ldb, vob, 0, kt); GL(xb1, bg, ldb, vob, 1, kt); GL(xb2, bg, ldb, vob, 2, kt); GL(xb3, bg, ldb, vob, 3, kt); }
#define GLOAD1(kt) { GL(ya0, ag, lda, voa, 0, kt); GL(ya1, ag, lda, voa, 1, kt); GL(ya2, ag, lda, voa, 2, kt); GL(ya3, ag, lda, voa, 3, kt); GL(yb0, bg, ldb, vob, 0, kt); GL(yb1, bg, ldb, vob, 1, kt); GL(yb2, bg, ldb, vob, 2, kt); GL(yb3, bg, ldb, vob, 3, kt); }
#define GS(v, off) *reinterpret_cast<uint4*>(st0 + (off)) = v
#define GSTORE0(buf) { GS(xa0, (buf) * G_BUF_BYTES); GS(xa1, (buf) * G_BUF_BYTES + 32 * GROW * 2); GS(xa2, (buf) * G_BUF_BYTES + 64 * GROW * 2); GS(xa3, (buf) * G_BUF_BYTES + 96 * GROW * 2); \
                       GS(xb0, (buf) * G_BUF_BYTES + G_TILE_BYTES); GS(xb1, (buf) * G_BUF_BYTES + G_TILE_BYTES + 32 * GROW * 2); GS(xb2, (buf) * G_BUF_BYTES + G_TILE_BYTES + 64 * GROW * 2); GS(xb3, (buf) * G_BUF_BYTES + G_TILE_BYTES + 96 * GROW * 2); }
#define GSTORE1(buf) { GS(ya0, (buf) * G_BUF_BYTES); GS(ya1, (buf) * G_BUF_BYTES + 32 * GROW * 2); GS(ya2, (buf) * G_BUF_BYTES + 64 * GROW * 2); GS(ya3, (buf) * G_BUF_BYTES + 96 * GROW * 2); \
                       GS(yb0, (buf) * G_BUF_BYTES + G_TILE_BYTES); GS(yb1, (buf) * G_BUF_BYTES + G_TILE_BYTES + 32 * GROW * 2); GS(yb2, (buf) * G_BUF_BYTES + G_TILE_BYTES + 64 * GROW * 2); GS(yb3, (buf) * G_BUF_BYTES + G_TILE_BYTES + 96 * GROW * 2); }
  auto compute = [&](int buf) {
#pragma unroll
    for (int ks = 0; ks < 2; ++ks) {
      bf16x8 a[4], b[4];
#pragma unroll
      for (int i = 0; i < 4; ++i) a[i] = *reinterpret_cast<const bf16x8*>(a0p + buf * G_BUF_BYTES + i * 16 * GROW * 2 + ks * 64);
#pragma unroll
      for (int j = 0; j < 4; ++j) b[j] = *reinterpret_cast<const bf16x8*>(b0p + buf * G_BUF_BYTES + j * 16 * GROW * 2 + ks * 64);
      __builtin_amdgcn_s_setprio(1);
#pragma unroll
      for (int i = 0; i < 4; ++i)
#pragma unroll
        for (int j = 0; j < 4; ++j) acc[i][j] = mfma16(a[i], b[j], acc[i][j]);
      __builtin_amdgcn_s_setprio(0);
    }
  };
  const int nkt = K >> 6;
  GLOAD0(0);
  GLOAD1(1);
  GSTORE0(0);
  __syncthreads();
  for (int kt = 0; kt < nkt; kt += 2) {
    if (kt + 2 < nkt) GLOAD0(kt + 2);
    compute(0);
    GSTORE1(1);
    __syncthreads();
    if (kt + 3 < nkt) GLOAD1(kt + 3);
    compute(1);
    if (kt + 2 < nkt) GSTORE0(0);
    __syncthreads();
  }
#undef GL
#undef GLOAD0
#undef GLOAD1
#undef GS
#undef GSTORE0
#undef GSTORE1
}

template <int A, int B>
DI void zero_acc(f32x4 (&acc)[A][B]) {
#pragma unroll
  for (int i = 0; i < A; ++i)
#pragma unroll
    for (int j = 0; j < B; ++j) acc[i][j] = f32x4{0.f, 0.f, 0.f, 0.f};
}

DI void sincos_d(double a, double& c, double& s) {
  const double TWO_PI = 6.283185307179586476925;
  double n = rint(a / TWO_PI);
  double r = a - n * TWO_PI;
  c = cos(r); s = sin(r);
}

DI void phase_w0(const Params& P, long gtid, long gsz) {
  char* ws = P.ws;
  {
    u16* dst = (u16*)(ws + O_WTIN);
    const float* w = P.in[2]; const float* g = P.in[1];
    for (long idx = gtid; idx < (long)NL * 128 * DINP; idx += gsz) {
      int n = (int)(idx % DINP); long r = idx / DINP; int kb = (int)(r % 128); int l = (int)(r / 128);
      float v[8];
#pragma unroll
      for (int j = 0; j < 8; ++j) { int k = kb * 8 + j; v[j] = (n < DIN) ? w[((size_t)l * DM + k) * DIN + n] * g[l * DM + k] : 0.f; }
      uint4 o; o.x = pack2(v[0], v[1]); o.y = pack2(v[2], v[3]); o.z = pack2(v[4], v[5]); o.w = pack2(v[6], v[7]);
      *reinterpret_cast<uint4*>(dst + ((size_t)l * DINP + n) * DM + kb * 8) = o;
    }
  }
  {
    u16* dst = (u16*)(ws + O_WTOUT);
    const float* w = P.in[20];
    for (long idx = gtid; idx < (long)NL * 128 * DM; idx += gsz) {
      int n = (int)(idx % DM); long r = idx / DM; int kb = (int)(r % 128); int l = (int)(r / 128);
      float v[8];
#pragma unroll
      for (int j = 0; j < 8; ++j) { int k = kb * 8 + j; v[j] = w[((size_t)l * DM + k) * DM + n]; }
      uint4 o; o.x = pack2(v[0], v[1]); o.y = pack2(v[2], v[3]); o.z = pack2(v[4], v[5]); o.w = pack2(v[6], v[7]);
      *reinterpret_cast<uint4*>(dst + ((size_t)l * DM + n) * DM + kb * 8) = o;
    }
  }
  {
    u16* dst = (u16*)(ws + O_WTUQ);
    const float* w = P.in[7]; const float* g = P.in[5];
    for (long idx = gtid; idx < (long)NL * 32 * 768; idx += gsz) {
      int n = (int)(idx % 768); long r = idx / 768; int kb = (int)(r % 32); int l = (int)(r / 32);
      const int h = n >> 7, d = n & 127;
      float v[8];
#pragma unroll
      for (int j = 0; j < 8; ++j) { int k = kb * 8 + j; v[j] = (d < 96) ? w[((size_t)l * 256 + k) * 576 + h * 96 + d] * g[l * 256 + k] : 0.f; }
      uint4 o; o.x = pack2(v[0], v[1]); o.y = pack2(v[2], v[3]); o.z = pack2(v[4], v[5]); o.w = pack2(v[6], v[7]);
      *reinterpret_cast<uint4*>(dst + ((size_t)l * 768 + n) * 256 + kb * 8) = o;
    }
  }
  {
    u16* dst = (u16*)(ws + O_WTUKV);
    const float* w = P.in[8]; const float* g = P.in[6];
    for (long idx = gtid; idx < (long)NL * 16 * 768; idx += gsz) {
      int n = (int)(idx % 768); long r = idx / 768; int kb = (int)(r % 16); int l = (int)(r / 16);
      float v[8];
#pragma unroll
      for (int j = 0; j < 8; ++j) { int k = kb * 8 + j; v[j] = w[((size_t)l * 128 + k) * 768 + n] * g[l * 128 + k]; }
      uint4 o; o.x = pack2(v[0], v[1]); o.y = pack2(v[2], v[3]); o.z = pack2(v[4], v[5]); o.w = pack2(v[6], v[7]);
      *reinterpret_cast<uint4*>(dst + ((size_t)l * 768 + n) * 128 + kb * 8) = o;
    }
  }
  {
    u16* dst = (u16*)(ws + O_WTGLU);
    const float* w = P.in[19];
    for (long idx = gtid; idx < (long)NL * 32 * 256; idx += gsz) {
      int n = (int)(idx % 256); long r = idx / 256; int kb = (int)(r % 32); int l = (int)(r / 32);
      float v[8];
#pragma unroll
      for (int j = 0; j < 8; ++j) { int k = kb * 8 + j; v[j] = w[((size_t)l * 256 + k) * 256 + n]; }
      uint4 o; o.x = pack2(v[0], v[1]); o.y = pack2(v[2], v[3]); o.z = pack2(v[4], v[5]); o.w = pack2(v[6], v[7]);
      *reinterpret_cast<uint4*>(dst + ((size_t)l * 256 + n) * 256 + kb * 8) = o;
    }
  }
  {
    float2* r64 = (float2*)(ws + O_R64);
    for (long idx = gtid; idx < 4096L * 32; idx += gsz) {
      int i = (int)(idx & 31); int pos = (int)(idx >> 5);
      float inv = (float)pow(10000.0, -(double)i / 32.0);
      float ang = (float)pos * inv;
      double c, s; sincos_d((double)ang, c, s);
      r64[idx] = make_float2((float)c, (float)s);
    }
    float2* r32 = (float2*)(ws + O_R32);
    for (long idx = gtid; idx < 4096L * 16; idx += gsz) {
      int i = (int)(idx & 15); int pos = (int)(idx >> 4);
      float inv = (float)pow(10000.0, -(double)i / 16.0);
      float ang = (float)pos * inv;
      double c, s; sincos_d((double)ang, c, s);
      r32[idx] = make_float2((float)c, (float)s);
    }
  }
  {
    float2* pw = (float2*)(ws + O_PW);
    float2* fz = (float2*)(ws + O_FZ);
    const float* a_re = P.in[11]; const float* a_im = P.in[12]; const float* lstep = P.in[18];
    for (long idx = gtid; idx < (long)NL * 16 * 65 * 64; idx += gsz) {
      int p = (int)(idx & 63); long r = idx >> 6; int d = (int)(r % 65); int lg = (int)(r / 65);
      double step = exp((double)lstep[lg]);
      double ar = (double)a_re[lg * 64 + p], ai = (double)a_im[lg * 64 + p];
      double mag = exp((double)d * ar * step);
      double c, s; sincos_d((double)d * ai * step, c, s);
      pw[idx] = make_float2((float)(mag * c), (float)(mag * s));
      if (d == 1) {
        double abr = mag * c, abi = mag * s;
        double den = ar * ar + ai * ai, nr = abr - 1.0;
        double fre = (nr * ar + abi * ai) / den, fim = (abi * ar - nr * ai) / den;
        fz[lg * 64 + p] = make_float2((float)fre, (float)fim);
      }
    }
  }
}

DI void phase_w1(const Params& P, long gtid, long gsz) {
  char* ws = P.ws;
  const float2* pw = (const float2*)(ws + O_PW);
  const float2* fz = (const float2*)(ws + O_FZ);
  const float* b_re = P.in[13]; const float* b_im = P.in[14]; const float* c_re = P.in[15]; const float* c_im = P.in[16];
  {
    u16* w1 = (u16*)(ws + O_W1);
    for (long idx = gtid; idx < (long)NL * 16 * 128 * 128; idx += gsz) {
      int kb = (int)(idx & 127); long r = idx >> 7; int row = (int)(r & 127); int lg = (int)(r >> 7);
      int p = row >> 1, ri = row & 1; int i = kb >> 1, c0 = (kb & 1) * 8;
      float2 e = pw[((size_t)lg * 65 + (63 - i)) * 64 + p]; float2 f = fz[lg * 64 + p];
      float er = e.x * f.x - e.y * f.y, ei = e.x * f.y + e.y * f.x;
      float v[8];
#pragma unroll
      for (int j = 0; j < 8; ++j) {
        float br = b_re[((size_t)lg * 64 + p) * 16 + c0 + j], bi = b_im[((size_t)lg * 64 + p) * 16 + c0 + j];
        v[j] = ri ? (er * bi + ei * br) : (er * br - ei * bi);
      }
      uint4 o; o.x = pack2(v[0], v[1]); o.y = pack2(v[2], v[3]); o.z = pack2(v[4], v[5]); o.w = pack2(v[6], v[7]);
      *reinterpret_cast<uint4*>(w1 + ((size_t)lg * 128 + row) * 1024 + kb * 8) = o;
    }
  }
  {
    u16* w3 = (u16*)(ws + O_W3);
    for (long idx = gtid; idx < (long)NL * 16 * 1024 * 16; idx += gsz) {
      int kb = (int)(idx & 15); long r = idx >> 4; int f = (int)(r & 1023); int lg = (int)(r >> 10);
      int j = f >> 4, c = f & 15;
      float v[8];
#pragma unroll
      for (int jj = 0; jj < 4; ++jj) {
        int p = kb * 4 + jj;
        float2 e = pw[((size_t)lg * 65 + (j + 1)) * 64 + p];
        float cr = c_re[((size_t)lg * 16 + c) * 64 + p], ci = c_im[((size_t)lg * 16 + c) * 64 + p];
        v[2 * jj] = cr * e.x - ci * e.y;
        v[2 * jj + 1] = -(cr * e.y + ci * e.x);
      }
      uint4 o; o.x = pack2(v[0], v[1]); o.y = pack2(v[2], v[3]); o.z = pack2(v[4], v[5]); o.w = pack2(v[6], v[7]);
      *reinterpret_cast<uint4*>(w3 + ((size_t)lg * 1024 + f) * 128 + kb * 8) = o;
    }
  }
  {
    u16* kt = (u16*)(ws + O_KT);
    for (long idx = gtid; idx < (long)NL * 16 * 64 * 16 * 2; idx += gsz) {
      int cb = (int)(idx & 1); long r = idx >> 1; int c = (int)(r & 15); r >>= 4; int d = (int)(r & 63); int lg = (int)(r >> 6);
      float v[8];
#pragma unroll
      for (int j = 0; j < 8; ++j) v[j] = 0.f;
      for (int p = 0; p < 64; ++p) {
        float2 e = pw[((size_t)lg * 65 + d) * 64 + p]; float2 f = fz[lg * 64 + p];
        float er = e.x * f.x - e.y * f.y, ei = e.x * f.y + e.y * f.x;
        float cr = c_re[((size_t)lg * 16 + c) * 64 + p], ci = c_im[((size_t)lg * 16 + c) * 64 + p];
        float gr = cr * er - ci * ei, gi = cr * ei + ci * er;
#pragma unroll
        for (int j = 0; j < 8; ++j) {
          float br = b_re[((size_t)lg * 64 + p) * 16 + cb * 8 + j], bi = b_im[((size_t)lg * 64 + p) * 16 + cb * 8 + j];
          v[j] += gr * br - gi * bi;
        }
      }
      uint4 o; o.x = pack2(v[0], v[1]); o.y = pack2(v[2], v[3]); o.z = pack2(v[4], v[5]); o.w = pack2(v[6], v[7]);
      *reinterpret_cast<uint4*>(kt + (((size_t)lg * 64 + d) * 16 + c) * 16 + cb * 8) = o;
    }
  }
}

DI void phase_p0(const Params& P, int l) {
  const float* x = (l == 0) ? P.in[0] : P.out;
  u16* xb = (u16*)(P.ws + O_XB2);
  const int tid = opaque_tid();
  const int lane = tid & 63;
  const int gw = blockIdx.x * 4 + (tid >> 6), nw = gridDim.x * 4;
  for (int row = gw; row < T; row += nw) {
    const float4* xr = reinterpret_cast<const float4*>(x + (size_t)row * DM);
#pragma unroll
    for (int i = 0; i < 4; ++i) {
      float4 v = xr[i * 64 + lane];
      st4(xb + (size_t)row * DM + (i * 64 + lane) * 4, v.x, v.y, v.z, v.w);
    }
  }
}

DI void prep_mla_q(const Params& P, int l, int tw0, int lane) {
  const int q = lane >> 4, jn = lane & 15;
  const u16* proj = (const u16*)(P.ws + O_PROJ);
  const u16* W = (const u16*)(P.ws + O_WTUQ) + (size_t)l * 576 * 256;
  u16* mq = (u16*)(P.ws + O_MQ);
  const float2* r32 = (const float2*)(P.ws + O_R32);
  const float* gq = P.in[9] + l * 96;
  const u16* bp = proj + (size_t)(tw0 + jn) * DINP + C_CQ + q * 8;
  float rq[2];
#pragma unroll
  for (int t = 0; t < 2; ++t) {
    float ss = 0.f;
    for (int ks = 0; ks < 8; ++ks) {
      bf16x8 v = ld8(bp + (size_t)t * 16 * DINP + ks * 32);
#pragma unroll
      for (int j = 0; j < 8; ++j) { float f = bf2f((u16)v[j]); ss += f * f; }
    }
    ss = red4(ss);
    rq[t] = rsqrtf(ss * (1.0f / 256) + EPS);
  }
  const float qscale = 0.10206207261596577f * LOG2E;
  for (int h = 0; h < 6; ++h) {
    f32x4 acc[6][2]; zero_acc(acc);
    const u16* ap = W + (size_t)(h * 96 + jn) * 256 + q * 8;
    wgemm<6, 2>(acc, 8, [&](int i, int ks) { return ld8(ap + (size_t)i * 16 * 256 + ks * 32); },
                [&](int j, int ks) { return ld8(bp + (size_t)j * 16 * DINP + ks * 32); });
#pragma unroll
    for (int t = 0; t < 2; ++t) {
      const int tok = tw0 + 16 * t + jn, pos = tok & (S - 1);
      float ss = 0.f;
#pragma unroll
      for (int i = 0; i < 6; ++i)
#pragma unroll
        for (int r = 0; r < 4; ++r) { float v = acc[i][t][r] * rq[t]; acc[i][t][r] = v; ss += v * v; }
      ss = red4(ss);
      const float rs = rsqrtf(ss * (1.0f / 96) + EPS);
#pragma unroll
      for (int i = 0; i < 6; ++i)
#pragma unroll
        for (int r = 0; r < 4; ++r) acc[i][t][r] *= rs * gq[16 * i + 4 * q + r];
#pragma unroll
      for (int r = 0; r < 4; ++r) {
        float2 cs = r32[pos * 16 + 4 * q + r];
        float x1 = acc[4][t][r], x2 = acc[5][t][r];
        acc[4][t][r] = x1 * cs.x - x2 * cs.y; acc[5][t][r] = x2 * cs.x + x1 * cs.y;
      }
#pragma unroll
      for (int i = 0; i < 6; ++i)
        st4(mq + (size_t)tok * 576 + h * 96 + 16 * i + 4 * q, acc[i][t][0] * qscale, acc[i][t][1] * qscale, acc[i][t][2] * qscale, acc[i][t][3] * qscale);
    }
  }
}

DI void prep_mla_kv(const Params& P, int l, int tw0, int lane) {
  const int q = lane >> 4, jn = lane & 15;
  const u16* proj = (const u16*)(P.ws + O_PROJ);
  const u16* W = (const u16*)(P.ws + O_WTUKV) + (size_t)l * 768 * 128;
  u16* mk = (u16*)(P.ws + O_MK);
  u16* mvt = (u16*)(P.ws + O_MVT);
  const float2* r32 = (const float2*)(P.ws + O_R32);
  const float* gk = P.in[10] + l * 96;
  const u16* bp = proj + (size_t)(tw0 + jn) * DINP + C_CKV + q * 8;
  const int b = tw0 >> 12, pos0 = tw0 & (S - 1);
  float rkv[2];
#pragma unroll
  for (int t = 0; t < 2; ++t) {
    float ss = 0.f;
    for (int ks = 0; ks < 4; ++ks) {
      bf16x8 v = ld8(bp + (size_t)t * 16 * DINP + ks * 32);
#pragma unroll
      for (int j = 0; j < 8; ++j) { float f = bf2f((u16)v[j]); ss += f * f; }
    }
    ss = red4(ss);
    rkv[t] = rsqrtf(ss * (1.0f / 128) + EPS);
  }
  for (int h = 0; h < 6; ++h) {
    {
      f32x4 acc[4][2]; zero_acc(acc);
      const u16* ap = W + (size_t)(h * 128 + jn) * 128 + q * 8;
      wgemm<4, 2>(acc, 4, [&](int i, int ks) { return ld8(ap + (size_t)i * 16 * 128 + ks * 32); },
                  [&](int j, int ks) { return ld8(bp + (size_t)j * 16 * DINP + ks * 32); });
#pragma unroll
      for (int t = 0; t < 2; ++t) {
        const int tok = tw0 + 16 * t + jn, pos = tok & (S - 1);
        uint2 pl = ld4(proj + (size_t)tok * DINP + C_KPE + 4 * q);
        uint2 ph = ld4(proj + (size_t)tok * DINP + C_KPE + 16 + 4 * q);
        float kl[4] = {lo2f(pl.x), hi2f(pl.x), lo2f(pl.y), hi2f(pl.y)};
        float kh[4] = {lo2f(ph.x), hi2f(ph.x), lo2f(ph.y), hi2f(ph.y)};
        float ss = 0.f;
#pragma unroll
        for (int i = 0; i < 4; ++i)
#pragma unroll
          for (int r = 0; r < 4; ++r) { float v = acc[i][t][r] * rkv[t]; acc[i][t][r] = v; ss += v * v; }
#pragma unroll
        for (int r = 0; r < 4; ++r) ss += kl[r] * kl[r] + kh[r] * kh[r];
        ss = red4(ss);
        const float rs = rsqrtf(ss * (1.0f / 96) + EPS);
#pragma unroll
        for (int i = 0; i < 4; ++i) {
          const int d = 16 * i + 4 * q;
          st4(mk + (size_t)tok * 576 + h * 96 + d, acc[i][t][0] * rs * gk[d], acc[i][t][1] * rs * gk[d + 1], acc[i][t][2] * rs * gk[d + 2], acc[i][t][3] * rs * gk[d + 3]);
        }
        float y1[4], y2[4];
#pragma unroll
        for (int r = 0; r < 4; ++r) {
          float2 cs = r32[pos * 16 + 4 * q + r];
          float x1 = kl[r] * rs * gk[64 + 4 * q + r], x2 = kh[r] * rs * gk[80 + 4 * q + r];
          y1[r] = x1 * cs.x - x2 * cs.y; y2[r] = x2 * cs.x + x1 * cs.y;
        }
        st4(mk + (size_t)tok * 576 + h * 96 + 64 + 4 * q, y1[0], y1[1], y1[2], y1[3]);
        st4(mk + (size_t)tok * 576 + h * 96 + 80 + 4 * q, y2[0], y2[1], y2[2], y2[3]);
      }
    }
    {
      f32x4 acc[2][4]; zero_acc(acc);
      const u16* wp = W + (size_t)(h * 128 + 64 + jn) * 128 + q * 8;
      wgemm<2, 4>(acc, 4, [&](int i, int ks) { return ld8(bp + (size_t)i * 16 * DINP + ks * 32); },
                  [&](int j, int ks) { return ld8(wp + (size_t)j * 16 * 128 + ks * 32); });
#pragma unroll
      for (int i = 0; i < 2; ++i) {
        float rr[4];
#pragma unroll
        for (int r = 0; r < 4; ++r) rr[r] = __shfl(rkv[i], 4 * q + r);
#pragma unroll
        for (int j = 0; j < 4; ++j)
          st4(mvt + ((size_t)(b * 6 + h) * 64 + 16 * j + jn) * S + pos0 + 16 * i + 4 * q,
              acc[i][j][0] * rr[0], acc[i][j][1] * rr[1], acc[i][j][2] * rr[2], acc[i][j][3] * rr[3]);
      }
    }
  }
}

DI void prep_mla_tile(const Params& P, int l, int tt, char* lds, float* s_r, float* s_ss) {
  const int tid = opaque_tid();
  const int wave = __builtin_amdgcn_readfirstlane(tid >> 6), lane = tid & 63, q = lane >> 4, jn = lane & 15;
  const int wa = wave >> 1, wb = wave & 1;
  const int tok0 = tt * 128;
  const u16* proj = (const u16*)(P.ws + O_PROJ);
  const u16* Wq = (const u16*)(P.ws + O_WTUQ) + (size_t)l * 768 * 256;
  const u16* Wkv = (const u16*)(P.ws + O_WTUKV) + (size_t)l * 768 * 128;
  u16* mq = (u16*)(P.ws + O_MQ); u16* mk = (u16*)(P.ws + O_MK); u16* mvt = (u16*)(P.ws + O_MVT);
  const float2* r32 = (const float2*)(P.ws + O_R32);
  const float* gq = P.in[9] + l * 96; const float* gk = P.in[10] + l * 96;
  {
    const int row = tid >> 1, half = tid & 1;
    const u16* pq = proj + (size_t)(tok0 + row) * DINP + C_CQ + half * 128;
    const u16* pk = proj + (size_t)(tok0 + row) * DINP + C_CKV + half * 64;
    bf16x8 vq[16], vk[8];
#pragma unroll
    for (int u = 0; u < 16; ++u) vq[u] = ld8(pq + u * 8);
#pragma unroll
    for (int u = 0; u < 8; ++u) vk[u] = ld8(pk + u * 8);
    float sq = 0.f, sk = 0.f;
#pragma unroll
    for (int u = 0; u < 16; ++u)
#pragma unroll
      for (int j = 0; j < 8; ++j) { const float f = bf2f((u16)vq[u][j]); sq += f * f; }
#pragma unroll
    for (int u = 0; u < 8; ++u)
#pragma unroll
      for (int j = 0; j < 8; ++j) { const float f = bf2f((u16)vk[u][j]); sk += f * f; }
    sq += __shfl_xor(sq, 1); sk += __shfl_xor(sk, 1);
    if (half == 0) { s_r[row] = rsqrtf(sq * (1.0f / 256) + EPS); s_r[128 + row] = rsqrtf(sk * (1.0f / 128) + EPS); }
  }
  __syncthreads();
  const float qscale = 0.10206207261596577f * LOG2E;
#pragma unroll 1
  for (int h0 = 0; h0 < 6; ++h0) {
    int h = h0; asm volatile("" : "+s"(h));
    f32x4 acc[4][4]; zero_acc(acc);
    gemm_block(acc, Wq + (size_t)(h * 128) * 256, 256, proj + (size_t)tok0 * DINP + C_CQ, DINP, 256, lds, tid);
#pragma unroll
    for (int j = 0; j < 4; ++j) {
      const int tl = wb * 64 + 16 * j + jn; const float rq = s_r[tl];
      float ss = 0.f;
#pragma unroll
      for (int i = 0; i < 4; ++i)
#pragma unroll
        for (int r = 0; r < 4; ++r) { const float v = acc[i][j][r] * rq; acc[i][j][r] = v; ss += v * v; }
      ss = red4(ss);
      if (q == 0) s_ss[wa * 128 + tl] = ss;
    }
    __syncthreads();
#pragma unroll
    for (int j = 0; j < 4; ++j) {
      const int tl = wb * 64 + 16 * j + jn, tok = tok0 + tl, pos = tok & (S - 1);
      const float rs = rsqrtf((s_ss[tl] + s_ss[128 + tl]) * (1.0f / 96) + EPS);
      if (wa == 0) {
#pragma unroll
        for (int i = 0; i < 4; ++i) {
          const int d = 16 * i + 4 * q;
          st4(mq + (size_t)tok * 576 + h * 96 + d, acc[i][j][0] * rs * gq[d] * qscale, acc[i][j][1] * rs * gq[d + 1] * qscale,
              acc[i][j][2] * rs * gq[d + 2] * qscale, acc[i][j][3] * rs * gq[d + 3] * qscale);
        }
      } else {
        float y1[4], y2[4];
#pragma unroll
        for (int r = 0; r < 4; ++r) {
          const float2 cs = r32[pos * 16 + 4 * q + r];
          const float x1 = acc[0][j][r] * rs * gq[64 + 4 * q + r], x2 = acc[1][j][r] * rs * gq[80 + 4 * q + r];
          y1[r] = (x1 * cs.x - x2 * cs.y) * qscale; y2[r] = (x2 * cs.x + x1 * cs.y) * qscale;
        }
        st4(mq + (size_t)tok * 576 + h * 96 + 64 + 4 * q, y1[0], y1[1], y1[2], y1[3]);
        st4(mq + (size_t)tok * 576 + h * 96 + 80 + 4 * q, y2[0], y2[1], y2[2], y2[3]);
      }
    }
    __syncthreads();
  }
  const int b = tok0 >> 12, pos0 = tok0 & (S - 1);
#pragma unroll 1
  for (int h0 = 0; h0 < 6; ++h0) {
    int h = h0; asm volatile("" : "+s"(h));
    f32x4 acc[4][4]; zero_acc(acc);
    gemm_block(acc, Wkv + (size_t)(h * 128) * 128, 128, proj + (size_t)tok0 * DINP + C_CKV, DINP, 128, lds, tid, true);
    if (wa == 0) {
#pragma unroll
      for (int j = 0; j < 4; ++j) {
        const int tl = wb * 64 + 16 * j + jn, tok = tok0 + tl, pos = tok & (S - 1);
        const float rkv = s_r[128 + tl];
        const uint2 pl = ld4(proj + (size_t)tok * DINP + C_KPE + 4 * q);
        const uint2 ph = ld4(proj + (size_t)tok * DINP + C_KPE + 16 + 4 * q);
        const float kl[4] = {lo2f(pl.x), hi2f(pl.x), lo2f(pl.y), hi2f(pl.y)};
        const float kh[4] = {lo2f(ph.x), hi2f(ph.x), lo2f(ph.y), hi2f(ph.y)};
        float ss = 0.f;
#pragma unroll
        for (int i = 0; i < 4; ++i)
#pragma unroll
          for (int r = 0; r < 4; ++r) { const float v = acc[i][j][r] * rkv; acc[i][j][r] = v; ss += v * v; }
#pragma unroll
        for (int r = 0; r < 4; ++r) ss += kl[r] * kl[r] + kh[r] * kh[r];
        ss = red4(ss);
        const float rs = rsqrtf(ss * (1.0f / 96) + EPS);
#pragma unroll
        for (int i = 0; i < 4; ++i) {
          const int d = 16 * i + 4 * q;
          st4(mk + (size_t)tok * 576 + h * 96 + d, acc[i][j][0] * rs * gk[d], acc[i][j][1] * rs * gk[d + 1], acc[i][j][2] * rs * gk[d + 2], acc[i][j][3] * rs * gk[d + 3]);
        }
        float y1[4], y2[4];
#pragma unroll
        for (int r = 0; r < 4; ++r) {
          const float2 cs = r32[pos * 16 + 4 * q + r];
          const float x1 = kl[r] * rs * gk[64 + 4 * q + r], x2 = kh[r] * rs * gk[80 + 4 * q + r];
          y1[r] = x1 * cs.x - x2 * cs.y; y2[r] = x2 * cs.x + x1 * cs.y;
        }
        st4(mk + (size_t)tok * 576 + h * 96 + 64 + 4 * q, y1[0], y1[1], y1[2], y1[3]);
        st4(mk + (size_t)tok * 576 + h * 96 + 80 + 4 * q, y2[0], y2[1], y2[2], y2[3]);
      }
    } else {
#pragma unroll
      for (int i = 0; i < 4; ++i) {
        const int tl0 = wb * 64 + 16 * i + 4 * q;
        const float r0 = s_r[128 + tl0], r1 = s_r[128 + tl0 + 1], r2 = s_r[128 + tl0 + 2], r3 = s_r[128 + tl0 + 3];
#pragma unroll
        for (int j = 0; j < 4; ++j)
          st4(mvt + ((size_t)(b * 6 + h) * 64 + 16 * j + jn) * S + pos0 + tl0, acc[i][j][0] * r0, acc[i][j][1] * r1, acc[i][j][2] * r2, acc[i][j][3] * r3);
      }
    }
  }
}

DI void prep_dsa(const Params& P, int l, int tok0) {
  u16* proj = (u16*)(P.ws + O_PROJ);
  u16* avt = (u16*)(P.ws + O_AVT);
  const float2* r64 = (const float2*)(P.ws + O_R64);
  const float2* r32 = (const float2*)(P.ws + O_R32);
  const int tid = opaque_tid();
  for (int task = tid; task < 512; task += 256) {
    const int tok = tok0 + (task >> 2), c = task & 3, pos = tok & (S - 1);
    u16* row = proj + (size_t)tok * DINP;
    bf16x8 lo[7], hi[7];
#pragma unroll
    for (int hh = 0; hh < 7; ++hh) {
      const int base = (hh < 6) ? C_QA + 64 * hh : C_KA;
      lo[hh] = ld8(row + base + 8 * c); hi[hh] = ld8(row + base + 32 + 8 * c);
    }
    float2 cs[8];
    float gql[8], gqh[8], gkl[8], gkh[8];
    const float* gq = P.in[3] + l * 64; const float* gk = P.in[4] + l * 64;
#pragma unroll
    for (int j = 0; j < 8; ++j) {
      cs[j] = r64[pos * 32 + 8 * c + j];
      gql[j] = gq[8 * c + j]; gqh[j] = gq[32 + 8 * c + j]; gkl[j] = gk[8 * c + j]; gkh[j] = gk[32 + 8 * c + j];
    }
#pragma unroll
    for (int hh = 0; hh < 7; ++hh) {
      const int base = (hh < 6) ? C_QA + 64 * hh : C_KA;
      float xl[8], xh[8];
      float ss = 0.f;
#pragma unroll
      for (int j = 0; j < 8; ++j) { xl[j] = bf2f((u16)lo[hh][j]); xh[j] = bf2f((u16)hi[hh][j]); ss += xl[j] * xl[j] + xh[j] * xh[j]; }
      ss += __shfl_xor(ss, 1); ss += __shfl_xor(ss, 2);
      const float rs = rsqrtf(ss * (1.0f / 64) + EPS);
      const float sc = (hh < 6) ? 0.125f * LOG2E : 1.0f;
      float y1[8], y2[8];
#pragma unroll
      for (int j = 0; j < 8; ++j) {
        const float x1 = xl[j] * rs * ((hh < 6) ? gql[j] : gkl[j]), x2 = xh[j] * rs * ((hh < 6) ? gqh[j] : gkh[j]);
        y1[j] = (x1 * cs[j].x - x2 * cs[j].y) * sc; y2[j] = (x2 * cs[j].x + x1 * cs[j].y) * sc;
      }
      uint4 o; o.x = pack2(y1[0], y1[1]); o.y = pack2(y1[2], y1[3]); o.z = pack2(y1[4], y1[5]); o.w = pack2(y1[6], y1[7]);
      *reinterpret_cast<uint4*>(row + base + 8 * c) = o;
      o.x = pack2(y2[0], y2[1]); o.y = pack2(y2[2], y2[3]); o.z = pack2(y2[4], y2[5]); o.w = pack2(y2[6], y2[7]);
      *reinterpret_cast<uint4*>(row + base + 32 + 8 * c) = o;
    }
  }
  {
    const int tok = tok0 + (tid >> 1), c2 = tid & 1, pos = tok & (S - 1);
    u16* row = proj + (size_t)tok * DINP;
    bf16x8 lo[9], hi[9];
#pragma unroll
    for (int hh = 0; hh < 9; ++hh) {
      const int base = (hh < 8) ? C_IQ + 32 * hh : C_IK;
      lo[hh] = ld8(row + base + 8 * c2); hi[hh] = ld8(row + base + 16 + 8 * c2);
    }
    float2 cs[8];
#pragma unroll
    for (int j = 0; j < 8; ++j) cs[j] = r32[pos * 16 + 8 * c2 + j];
#pragma unroll
    for (int hh = 0; hh < 9; ++hh) {
      const int base = (hh < 8) ? C_IQ + 32 * hh : C_IK;
      float y1[8], y2[8];
#pragma unroll
      for (int j = 0; j < 8; ++j) {
        const float x1 = bf2f((u16)lo[hh][j]), x2 = bf2f((u16)hi[hh][j]);
        y1[j] = x1 * cs[j].x - x2 * cs[j].y; y2[j] = x2 * cs[j].x + x1 * cs[j].y;
      }
      uint4 o; o.x = pack2(y1[0], y1[1]); o.y = pack2(y1[2], y1[3]); o.z = pack2(y1[4], y1[5]); o.w = pack2(y1[6], y1[7]);
      *reinterpret_cast<uint4*>(row + base + 8 * c2) = o;
      o.x = pack2(y2[0], y2[1]); o.y = pack2(y2[2], y2[3]); o.z = pack2(y2[4], y2[5]); o.w = pack2(y2[6], y2[7]);
      *reinterpret_cast<uint4*>(row + base + 16 + 8 * c2) = o;
    }
  }
  {
    const int b = tok0 >> 12, pos0 = tok0 & (S - 1);
    const int dim = tid & 63, tg0 = tid >> 6;
    unsigned short v[8][4];
#pragma unroll
    for (int u = 0; u < 8; ++u) {
      const u16* p = proj + (size_t)(tok0 + 4 * (tg0 + 4 * u)) * DINP + C_VA + dim;
#pragma unroll
      for (int k = 0; k < 4; ++k) v[u][k] = p[k * DINP];
    }
#pragma unroll
    for (int u = 0; u < 8; ++u) {
      uint2 o; o.x = (unsigned)v[u][0] | ((unsigned)v[u][1] << 16); o.y = (unsigned)v[u][2] | ((unsigned)v[u][3] << 16);
      *reinterpret_cast<uint2*>(avt + ((size_t)b * 64 + dim) * S + pos0 + 4 * (tg0 + 4 * u)) = o;
    }
  }
}

DI void prep_tile(const Params& P, int l, int tile, char* lds, float* s_r) {
  const int tid = opaque_tid();
  const int wave = __builtin_amdgcn_readfirstlane(tid >> 6), lane = tid & 63;
  const int tok0 = tile * 128;
  prep_mla_tile(P, l, tile, lds, s_r, s_r + 256);
  prep_dsa(P, l, tok0);
}

DI void inproj_tile(const Params& P, int l, int tt, char* lds, float* s_rstd, float* s_prep) {
  const u16* W = (const u16*)(P.ws + O_WTIN) + (size_t)l * DINP * DM;
  const u16* xb = (const u16*)(P.ws + O_XB2);
  u16* proj = (u16*)(P.ws + O_PROJ);
  const int tid = opaque_tid();
  const int wave = __builtin_amdgcn_readfirstlane(tid >> 6), lane = tid & 63, q = lane >> 4, jn = lane & 15;
  {
    {
      const u16* rp = xb + (size_t)(tt * 128 + (tid >> 1)) * DM + (tid & 1) * 512;
      float ss = 0.f;
#pragma unroll 1
      for (int c = 0; c < 8; ++c) {
        bf16x8 v[8];
#pragma unroll
        for (int u = 0; u < 8; ++u) v[u] = ld8(rp + (c * 8 + u) * 8);
#pragma unroll
        for (int u = 0; u < 8; ++u)
#pragma unroll
          for (int j = 0; j < 8; ++j) { const float f = bf2f((u16)v[u][j]); ss += f * f; }
      }
      ss += __shfl_xor(ss, 1);
      if ((tid & 1) == 0) s_rstd[tid >> 1] = rsqrtf(ss * (1.0f / DM) + EPS);
    }
    __syncthreads();
#pragma unroll 1
    for (int ftile0 = 0; ftile0 < 20; ++ftile0) {
      int ftile = ftile0; asm volatile("" : "+s"(ftile));
      const int f0 = ftile * 128 + (wave >> 1) * 64, t0 = tt * 128 + (wave & 1) * 64;
      f32x4 acc[4][4]; zero_acc(acc);
      gemm_block(acc, W + (size_t)(ftile * 128) * DM, DM, xb + (size_t)(tt * 128) * DM, DM, DM, lds, tid);
#pragma unroll
      for (int j = 0; j < 4; ++j) {
        const int tok = t0 + 16 * j + jn; const float rs = s_rstd[(wave & 1) * 64 + 16 * j + jn];
#pragma unroll
        for (int i = 0; i < 4; ++i)
          st4(proj + (size_t)tok * DINP + f0 + 16 * i + 4 * q, acc[i][j][0] * rs, acc[i][j][1] * rs, acc[i][j][2] * rs, acc[i][j][3] * rs);
      }
    }
    asm volatile("s_waitcnt vmcnt(0)" ::: "memory");
    __syncthreads();
    prep_tile(P, l, tt, lds, s_prep);
    __syncthreads();
  }
}

DI void phase_inproj(const Params& P, int l, char* lds, float* s_rstd, float* s_prep) {
  for (int tt = blockIdx.x; tt < 512; tt += gridDim.x) inproj_tile(P, l, tt, lds, s_rstd, s_prep);
}

template <int KS, bool MASK>
DI void attn_block_v1(const u16* Qp, int qstride, const u16* Kp, int kstride, const u16* Vtp, const u64* maskp, int nkt_w, int nkt_max,
                   const u16* gatep, int gstride, u16* outp, int ostride, char* lds, int tid) {
  constexpr int DQK = KS * 32, KROW = DQK + 8, VROW = 72;
  constexpr int KCH = DQK / 8, NKC = 64 * KCH / 256;
  constexpr int K_BYTES = 64 * KROW * 2, BUF_BYTES = K_BYTES + 64 * VROW * 2;
  const int lane = tid & 63, q = lane >> 4, jn = lane & 15;
  const float NEG_INF = -__builtin_inff();
  uint4 kst[NKC], vst[2];
  auto gload = [&](int kt) {
#pragma unroll
    for (int i = 0; i < NKC; ++i) {
      const int c = tid + 256 * i, row = c / KCH, col = c % KCH;
      kst[i] = *reinterpret_cast<const uint4*>(Kp + (size_t)(kt * 64 + row) * kstride + col * 8);
    }
#pragma unroll
    for (int i = 0; i < 2; ++i) {
      const int c = tid + 256 * i, dim = c >> 3, part = c & 7;
      vst[i] = *reinterpret_cast<const uint4*>(Vtp + (size_t)dim * S + kt * 64 + part * 8);
    }
  };
  auto lstore = [&](int buf) {
    char* kb = lds + buf * BUF_BYTES; char* vb = kb + K_BYTES;
#pragma unroll
    for (int i = 0; i < NKC; ++i) {
      const int c = tid + 256 * i, row = c / KCH, col = c % KCH;
      *reinterpret_cast<uint4*>(kb + (row * KROW + col * 8) * 2) = kst[i];
    }
#pragma unroll
    for (int i = 0; i < 2; ++i) {
      const int c = tid + 256 * i, dim = c >> 3, part = c & 7;
      *reinterpret_cast<uint4*>(vb + (dim * VROW + part * 8) * 2) = vst[i];
    }
  };
  bf16x8 qf[2][KS];
#pragma unroll
  for (int c = 0; c < 2; ++c)
#pragma unroll
    for (int ks = 0; ks < KS; ++ks) qf[c][ks] = ld8(Qp + (size_t)(16 * c + jn) * qstride + ks * 32 + q * 8);
  f32x4 o[4][2]; zero_acc(o);
  float m[2] = {NEG_INF, NEG_INF}, lsum[2] = {0.f, 0.f};
  u64 mw[2] = {0ull, 0ull}, mwn[2] = {0ull, 0ull};
  if (MASK) {
#pragma unroll
    for (int c = 0; c < 2; ++c) mw[c] = maskp[(size_t)(16 * c + jn) * 64];
  }
  gload(0);
  lstore(0);
  __syncthreads();
  for (int kt = 0; kt < nkt_max; ++kt) {
    const bool more = kt + 1 < nkt_max;
    if (more) {
      gload(kt + 1);
      if (MASK) {
        if (kt + 1 < nkt_w) {
#pragma unroll
          for (int c = 0; c < 2; ++c) mwn[c] = maskp[(size_t)(16 * c + jn) * 64 + kt + 1];
        }
      }
    }
    if (kt < nkt_w) {
      const char* kb = lds + (kt & 1) * BUF_BYTES; const char* vb = kb + K_BYTES;
      f32x4 s[4][2]; zero_acc(s);
#pragma unroll
      for (int a = 0; a < 4; ++a)
#pragma unroll
        for (int ks = 0; ks < KS; ++ks) {
          const bf16x8 kf = *reinterpret_cast<const bf16x8*>(kb + ((16 * a + jn) * KROW + ks * 32 + q * 8) * 2);
#pragma unroll
          for (int c = 0; c < 2; ++c) s[a][c] = mfma16(kf, qf[c][ks], s[a][c]);
        }
      if (MASK) {
#pragma unroll
        for (int c = 0; c < 2; ++c) {
          const u64 w = mw[c] >> (4 * q);
#pragma unroll
          for (int a = 0; a < 4; ++a)
#pragma unroll
            for (int r = 0; r < 4; ++r)
              if (!((w >> (16 * a + r)) & 1ull)) s[a][c][r] = NEG_INF;
        }
      }
      float alpha[2];
#pragma unroll
      for (int c = 0; c < 2; ++c) {
        float mx = NEG_INF;
#pragma unroll
        for (int a = 0; a < 4; ++a)
#pragma unroll
          for (int r = 0; r < 4; ++r) mx = fmaxf(mx, s[a][c][r]);
        mx = fmaxf(mx, __shfl_xor(mx, 16)); mx = fmaxf(mx, __shfl_xor(mx, 32));
        const float mn = fmaxf(m[c], mx);
        const float mu = (mn == NEG_INF) ? 0.f : mn;
        alpha[c] = fexp2(m[c] - mu);
        m[c] = mn;
        float ps = 0.f;
#pragma unroll
        for (int a = 0; a < 4; ++a)
#pragma unroll
          for (int r = 0; r < 4; ++r) { float p = fexp2(s[a][c][r] - mu); s[a][c][r] = p; ps += p; }
        lsum[c] = lsum[c] * alpha[c] + ps;
      }
      if (__builtin_amdgcn_ballot_w64(alpha[0] != 1.0f || alpha[1] != 1.0f) != 0ull) {
#pragma unroll
        for (int c = 0; c < 2; ++c)
#pragma unroll
          for (int dt = 0; dt < 4; ++dt)
#pragma unroll
            for (int r = 0; r < 4; ++r) o[dt][c][r] *= alpha[c];
      }
#pragma unroll
      for (int kk = 0; kk < 2; ++kk) {
        bf16x8 pf[2];
#pragma unroll
        for (int c = 0; c < 2; ++c) {
          uint4 w; w.x = pack2(s[2 * kk][c][0], s[2 * kk][c][1]); w.y = pack2(s[2 * kk][c][2], s[2 * kk][c][3]);
          w.z = pack2(s[2 * kk + 1][c][0], s[2 * kk + 1][c][1]); w.w = pack2(s[2 * kk + 1][c][2], s[2 * kk + 1][c][3]);
          pf[c] = __builtin_bit_cast(bf16x8, w);
        }
#pragma unroll
        for (int dt = 0; dt < 4; ++dt) {
          const char* vp = vb + ((16 * dt + jn) * VROW + kk * 32 + 4 * q) * 2;
          const uint2 lo = *reinterpret_cast<const uint2*>(vp), hi = *reinterpret_cast<const uint2*>(vp + 32);
          uint4 w; w.x = lo.x; w.y = lo.y; w.z = hi.x; w.w = hi.y;
          const bf16x8 vf = __builtin_bit_cast(bf16x8, w);
#pragma unroll
          for (int c = 0; c < 2; ++c) o[dt][c] = mfma16(vf, pf[c], o[dt][c]);
        }
      }
    }
    if (more) lstore((kt + 1) & 1);
    if (MASK) { mw[0] = mwn[0]; mw[1] = mwn[1]; }
    __syncthreads();
  }
#pragma unroll
  for (int c = 0; c < 2; ++c) {
    const float inv = 1.0f / red4(lsum[c]);
    const int row = 16 * c + jn;
#pragma unroll
    for (int dt = 0; dt < 4; ++dt) {
      uint2 gw = ld4(gatep + (size_t)row * gstride + 16 * dt + 4 * q);
      st4(outp + (size_t)row * ostride + 16 * dt + 4 * q, o[dt][c][0] * inv * siluf_(lo2f(gw.x)), o[dt][c][1] * inv * siluf_(hi2f(gw.x)),
          o[dt][c][2] * inv * siluf_(lo2f(gw.y)), o[dt][c][3] * inv * siluf_(hi2f(gw.y)));
    }
  }
}

template <int KS, bool MASK, int NC, bool SH>
DI void attn_block(const u16* Qp, int qstride, const u16* Kp, int kstride, const u16* Vtp, const u64* maskp, int nkt_w, int nkt_max,
                   const u16* gatep, int gstride, u16* outp, int ostride, char* lds, int tid) {
  constexpr int DQK = KS * 32, KROW = DQK + 8, VROW = 72;
  constexpr int KCH = DQK / 8, NKC = 64 * KCH / 256;
  constexpr int K_BYTES = 64 * KROW * 2, BUF_BYTES = K_BYTES + 64 * VROW * 2;
  const int lane = tid & 63, q = lane >> 4, jn = lane & 15;
  const float NEG_INF = -__builtin_inff();
  uint4 xk0, xk1, xk2, xv0, xv1, yk0, yk1, yk2, yv0, yv1;
  xk2 = yk2 = make_uint4(0, 0, 0, 0);
  const int c0 = tid, c1 = tid + 256, c2 = tid + 512;
  const u16* kg0 = Kp + (size_t)(c0 / KCH) * kstride + (c0 % KCH) * 8;
  const u16* kg1 = Kp + (size_t)(c1 / KCH) * kstride + (c1 % KCH) * 8;
  const u16* kg2 = Kp + (size_t)(c2 / KCH) * kstride + (c2 % KCH) * 8;
  const u16* vg0 = Vtp + (size_t)(c0 >> 3) * S + (c0 & 7) * 8;
  const u16* vg1 = Vtp + (size_t)(c1 >> 3) * S + (c1 & 7) * 8;
  char* ks0 = lds + ((c0 / KCH) * KROW + (c0 % KCH) * 8) * 2;
  char* ks1 = lds + ((c1 / KCH) * KROW + (c1 % KCH) * 8) * 2;
  char* ks2 = lds + ((c2 / KCH) * KROW + (c2 % KCH) * 8) * 2;
  char* vs0 = lds + K_BYTES + ((c0 >> 3) * VROW + (c0 & 7) * 8) * 2;
  char* vs1 = lds + K_BYTES + ((c1 >> 3) * VROW + (c1 & 7) * 8) * 2;
#define A_LOAD(P, kt) { const size_t ko = (size_t)(kt) * 64 * kstride; const int vo = (kt) * 64;                     \
    P##k0 = *reinterpret_cast<const uint4*>(kg0 + ko); P##k1 = *reinterpret_cast<const uint4*>(kg1 + ko);            \
    if (NKC == 3) P##k2 = *reinterpret_cast<const uint4*>(kg2 + ko);                                                 \
    P##v0 = *reinterpret_cast<const uint4*>(vg0 + vo); P##v1 = *reinterpret_cast<const uint4*>(vg1 + vo); }
#define A_STORE(P, buf) { *reinterpret_cast<uint4*>(ks0 + (buf) * BUF_BYTES) = P##k0; *reinterpret_cast<uint4*>(ks1 + (buf) * BUF_BYTES) = P##k1; \
    if (NKC == 3) *reinterpret_cast<uint4*>(ks2 + (buf) * BUF_BYTES) = P##k2;                                        \
    *reinterpret_cast<uint4*>(vs0 + (buf) * BUF_BYTES) = P##v0; *reinterpret_cast<uint4*>(vs1 + (buf) * BUF_BYTES) = P##v1; }
  bf16x8 qf[NC][KS];
#pragma unroll
  for (int c = 0; c < NC; ++c)
#pragma unroll
    for (int ks = 0; ks < KS; ++ks) qf[c][ks] = ld8(Qp + (size_t)((SH ? 0 : 16 * c) + jn) * qstride + (SH ? 64 * c : 0) + ks * 32 + q * 8);
  f32x4 o[4][NC]; zero_acc(o);
  float m[NC], lsum[NC];
#pragma unroll
  for (int c = 0; c < NC; ++c) { m[c] = NEG_INF; lsum[c] = 0.f; }
  u64 mce0 = 0ull, mce1 = 0ull, mco0 = 0ull, mco1 = 0ull, mne0 = 0ull, mne1 = 0ull, mno0 = 0ull, mno1 = 0ull;
  const u64* mrow0 = maskp + (size_t)jn * 64;
  const u64* mrow1 = maskp + (size_t)(16 + jn) * 64;
  if (MASK) {
    mce0 = mrow0[0]; if (!SH) mce1 = mrow1[0];
    if (1 < nkt_w) { mco0 = mrow0[1]; if (!SH) mco1 = mrow1[1]; }
  }
  auto compute = [&](int buf, u64 w0, u64 w1) {
    const char* kb = lds + buf * BUF_BYTES; const char* vb = kb + K_BYTES;
    f32x4 s[4][NC]; zero_acc(s);
#pragma unroll
    for (int a = 0; a < 4; ++a)
#pragma unroll
      for (int ks = 0; ks < KS; ++ks) {
        const bf16x8 kf = *reinterpret_cast<const bf16x8*>(kb + ((16 * a + jn) * KROW + ks * 32 + q * 8) * 2);
#pragma unroll
        for (int c = 0; c < NC; ++c) s[a][c] = mfma16(kf, qf[c][ks], s[a][c]);
      }
    if (MASK) {
#pragma unroll
      for (int c = 0; c < NC; ++c) {
        const u64 w = ((SH || c == 0) ? w0 : w1) >> (4 * q);
#pragma unroll
        for (int a = 0; a < 4; ++a)
#pragma unroll
          for (int r = 0; r < 4; ++r)
            if (!((w >> (16 * a + r)) & 1ull)) s[a][c][r] = NEG_INF;
      }
    }
    float alpha[NC];
#pragma unroll
    for (int c = 0; c < NC; ++c) {
      float mx = NEG_INF;
#pragma unroll
      for (int a = 0; a < 4; ++a)
#pragma unroll
        for (int r = 0; r < 4; ++r) mx = fmaxf(mx, s[a][c][r]);
      mx = fmaxf(mx, __shfl_xor(mx, 16)); mx = fmaxf(mx, __shfl_xor(mx, 32));
      const float mn = fmaxf(m[c], mx);
      const float mu = (mn == NEG_INF) ? 0.f : mn;
      alpha[c] = fexp2(m[c] - mu);
      m[c] = mn;
      float ps = 0.f;
#pragma unroll
      for (int a = 0; a < 4; ++a)
#pragma unroll
        for (int r = 0; r < 4; ++r) { float p = fexp2(s[a][c][r] - mu); s[a][c][r] = p; ps += p; }
      lsum[c] = lsum[c] * alpha[c] + ps;
    }
    bool resc = false;
#pragma unroll
    for (int c = 0; c < NC; ++c) resc = resc || (alpha[c] != 1.0f);
    if (__builtin_amdgcn_ballot_w64(resc) != 0ull) {
#pragma unroll
      for (int c = 0; c < NC; ++c)
#pragma unroll
        for (int dt = 0; dt < 4; ++dt)
#pragma unroll
          for (int r = 0; r < 4; ++r) o[dt][c][r] *= alpha[c];
    }
#pragma unroll
    for (int kk = 0; kk < 2; ++kk) {
      bf16x8 pf[NC];
#pragma unroll
      for (int c = 0; c < NC; ++c) {
        uint4 w; w.x = pack2(s[2 * kk][c][0], s[2 * kk][c][1]); w.y = pack2(s[2 * kk][c][2], s[2 * kk][c][3]);
        w.z = pack2(s[2 * kk + 1][c][0], s[2 * kk + 1][c][1]); w.w = pack2(s[2 * kk + 1][c][2], s[2 * kk + 1][c][3]);
        pf[c] = __builtin_bit_cast(bf16x8, w);
      }
#pragma unroll
      for (int dt = 0; dt < 4; ++dt) {
        const char* vp = vb + ((16 * dt + jn) * VROW + kk * 32 + 4 * q) * 2;
        const uint2 lo = *reinterpret_cast<const uint2*>(vp), hi = *reinterpret_cast<const uint2*>(vp + 32);
        uint4 w; w.x = lo.x; w.y = lo.y; w.z = hi.x; w.w = hi.y;
        const bf16x8 vf = __builtin_bit_cast(bf16x8, w);
#pragma unroll
        for (int c = 0; c < NC; ++c) o[dt][c] = mfma16(vf, pf[c], o[dt][c]);
      }
    }
  };

  A_LOAD(x, 0);
  { const int t1 = (nkt_max > 1) ? 1 : 0; A_LOAD(y, t1); }
  A_STORE(x, 0);
  __syncthreads();
  for (int kt = 0; kt < nkt_max; kt += 2) {
    const bool more = kt + 2 < nkt_max;
    if (more) {
      A_LOAD(x, kt + 2);
      if (MASK) {
        if (kt + 2 < nkt_w) { mne0 = mrow0[kt + 2]; if (!SH) mne1 = mrow1[kt + 2]; }
        if (kt + 3 < nkt_w) { mno0 = mrow0[kt + 3]; if (!SH) mno1 = mrow1[kt + 3]; }
      }
    }
    if (kt < nkt_w) compute(0, mce0, mce1);
    A_STORE(y, 1);
    __syncthreads();
    if (kt + 3 < nkt_max) A_LOAD(y, kt + 3);
    if (kt + 1 < nkt_w) compute(1, mco0, mco1);
    if (more) A_STORE(x, 0);
    if (MASK) { mce0 = mne0; mce1 = mne1; mco0 = mno0; mco1 = mno1; }
    __syncthreads();
  }
#undef A_LOAD
#undef A_STORE
#pragma unroll
  for (int c = 0; c < NC; ++c) {
    const float inv = 1.0f / red4(lsum[c]);
    const int row = (SH ? 0 : 16 * c) + jn;
    const int hc = SH ? 64 * c : 0;
#pragma unroll
    for (int dt = 0; dt < 4; ++dt) {
      uint2 gw = ld4(gatep + (size_t)row * gstride + hc + 16 * dt + 4 * q);
      st4(outp + (size_t)row * ostride + hc + 16 * dt + 4 * q, o[dt][c][0] * inv * siluf_(lo2f(gw.x)), o[dt][c][1] * inv * siluf_(hi2f(gw.x)),
          o[dt][c][2] * inv * siluf_(lo2f(gw.y)), o[dt][c][3] * inv * siluf_(hi2f(gw.y)));
    }
  }
}

DI void mla_attn_item(const Params& P, int it, char* lds, int tid) {
  const int wave = __builtin_amdgcn_readfirstlane(tid >> 6);
  const int sh = it & 7, mloc = it >> 3;
  const int qb = 31 - (mloc & 31), bh = sh + 8 * (mloc >> 5), b = bh / 6, h = bh % 6;
  const int q0 = qb * 128 + wave * 32;
  const int nkt = (q0 >> 6) + 1;
  const u16* mq = (const u16*)(P.ws + O_MQ); const u16* mk = (const u16*)(P.ws + O_MK); const u16* mvt = (const u16*)(P.ws + O_MVT);
  const u16* proj = (const u16*)(P.ws + O_PROJ); u16* mixed = (u16*)(P.ws + O_XB);
  const size_t tok = (size_t)b * S + q0;
  attn_block<3, false, 2, false>(mq + tok * 576 + h * 96, 576, mk + (size_t)b * S * 576 + h * 96, 576, mvt + (size_t)(b * 6 + h) * 64 * S, nullptr, nkt, 2 * qb + 2,
                       proj + tok * DINP + C_GC + h * 64, DINP, mixed + tok * DM + 640 + h * 64, DM, lds, tid);
}

DI void dsa_attn_item(const Params& P, int it, char* lds, int tid) {
  const int wave = __builtin_amdgcn_readfirstlane(tid >> 6);
  const int ch = 63 - it / 32, bh = it % 32, b = bh >> 1, hg = bh & 1;
  const int q0 = ch * 64 + wave * 16;
  const int nkt = ch + 1;
  const u16* proj = (const u16*)(P.ws + O_PROJ); const u16* avt = (const u16*)(P.ws + O_AVT); u16* mixed = (u16*)(P.ws + O_XB);
  const u64* mask = (const u64*)(P.ws + O_MASK);
  const size_t tok = (size_t)b * S + q0;
  attn_block<2, true, 3, true>(proj + tok * DINP + C_QA + hg * 192, DINP, proj + (size_t)b * S * DINP + C_KA, DINP, avt + (size_t)b * 64 * S, mask + tok * 64, nkt, nkt,
                               proj + tok * DINP + C_GA + hg * 192, DINP, mixed + tok * DM + hg * 192, DM, lds, tid);
}

constexpr int SC_STRIDE = 4096 + 16;
DI unsigned fkey(float f) { unsigned u = __float_as_uint(f); return (u & 0x80000000u) ? ~u : (u | 0x80000000u); }
DI float funkey(unsigned k) { return __uint_as_float((k & 0x80000000u) ? (k ^ 0x80000000u) : ~k); }

template <int NR>
DI u64 select_wave(float* scw, int nreg, int lane) {
  unsigned key[NR];
  unsigned kmin = 0xffffffffu, kmax = 0u;
#pragma unroll
  for (int r = 0; r < NR; ++r) {
    const unsigned k = fkey(scw[64 * r + lane]);
    const bool ok = r < nreg;
    key[r] = ok ? k : 0u;
    kmin = min(kmin, ok ? k : 0xffffffffu); kmax = max(kmax, key[r]);
  }
#pragma unroll
  for (int o = 1; o < 64; o <<= 1) { kmin = min(kmin, (unsigned)__shfl_xor((int)kmin, o)); kmax = max(kmax, (unsigned)__shfl_xor((int)kmax, o)); }
  unsigned lo = __builtin_amdgcn_readfirstlane(kmin), hi = __builtin_amdgcn_readfirstlane(kmax);
  int clo = 64 * nreg, chi = 0;
  bool exact = false;
  int iter = 0;
  while (lo < hi && clo - chi > 512) {
    unsigned mid = fkey(0.5f * (funkey(lo) + funkey(hi)));
    if (iter >= 16) mid = lo + ((hi - lo + 1u) >> 1);
    if (mid <= lo) mid = lo + 1;
    if (mid > hi) mid = hi;
    ++iter;
    int cnt = 0;
#pragma unroll
    for (int r = 0; r < NR; ++r) cnt += __builtin_popcountll(__builtin_amdgcn_ballot_w64(key[r] >= mid));
    if (cnt >= 256) { lo = mid; clo = cnt; if (cnt == 256) { exact = true; break; } }
    else { hi = mid - 1; chi = cnt; }
  }
  if (!exact && lo < hi) {
    unsigned* cand = reinterpret_cast<unsigned*>(scw);
    int base = 0;
#pragma unroll
    for (int r = 0; r < NR; ++r) {
      const bool pred = (key[r] >= lo) && (key[r] <= hi);
      const u64 bal = __builtin_amdgcn_ballot_w64(pred);
      const int pos = base + __builtin_amdgcn_mbcnt_hi((unsigned)(bal >> 32), __builtin_amdgcn_mbcnt_lo((unsigned)bal, 0u));
      if (pred) cand[pos] = key[r];
      base += __builtin_popcountll(bal);
    }
    __builtin_amdgcn_fence(__ATOMIC_RELEASE, "wavefront");
    __builtin_amdgcn_fence(__ATOMIC_ACQUIRE, "wavefront");
    unsigned ck[8];
#pragma unroll
    for (int i = 0; i < 8; ++i) { const unsigned v = cand[64 * i + lane]; ck[i] = (64 * i + lane < base) ? v : 0u; }
    const int cabove = chi;
    while (lo < hi) {
      unsigned mid = fkey(0.5f * (funkey(lo) + funkey(hi)));
      if (iter >= 16) mid = lo + ((hi - lo + 1u) >> 1);
      if (mid <= lo) mid = lo + 1;
      if (mid > hi) mid = hi;
      ++iter;
      int cnt = cabove;
#pragma unroll
      for (int i = 0; i < 8; ++i) cnt += __builtin_popcountll(__builtin_amdgcn_ballot_w64(ck[i] >= mid));
      if (cnt >= 256) { lo = mid; if (cnt == 256) { exact = true; break; } }
      else { hi = mid - 1; }
    }
  }
  const unsigned thr = lo;
  u64 myword = 0ull;
  if (exact) {
#pragma unroll
    for (int r = 0; r < NR; ++r) { const u64 bal = __builtin_amdgcn_ballot_w64(key[r] >= thr); if (lane == r) myword = bal; }
  } else {
    int cgt = 0;
#pragma unroll
    for (int r = 0; r < NR; ++r) cgt += __builtin_popcountll(__builtin_amdgcn_ballot_w64(key[r] > thr));
    const int need = 256 - cgt;
    int run = 0;
    const u64 below = (1ull << lane) - 1ull;
#pragma unroll
    for (int r = 0; r < NR; ++r) {
      const u64 eq = __builtin_amdgcn_ballot_w64(key[r] == thr);
      const int rank = run + __builtin_popcountll(eq & below);
      const bool sel = (key[r] > thr) || ((key[r] == thr) && (rank < need));
      const u64 bal = __builtin_amdgcn_ballot_w64(sel);
      run += __builtin_popcountll(eq);
      if (lane == r) myword = bal;
    }
  }
  return myword;
}

DI void dsa_select_item(const Params& P, int it, float* sc, int wave, int lane) {
  const int qd = 1023 - it / 16, b = it % 16;
  const int t0 = qd * 4;
  const int N = ((t0 >> 6) + 1) * 64, nreg = N >> 6;
  const u16* base = (const u16*)(P.ws + O_PROJ) + (size_t)b * S * DINP;
  u64* mask = (u64*)(P.ws + O_MASK);
  const int q = lane >> 4, jn = lane & 15;
  if (N > 256) {
    const bf16x8 a0 = ld8(base + (size_t)(t0 + (jn >> 2)) * DINP + C_IQ + (jn & 3) * 32 + q * 8);
    const bf16x8 a1 = ld8(base + (size_t)(t0 + (jn >> 2)) * DINP + C_IQ + (4 + (jn & 3)) * 32 + q * 8);
    float w[8];
    {
      bf16x8 wv = ld8(base + (size_t)(t0 + q) * DINP + C_IW);
#pragma unroll
      for (int h = 0; h < 8; ++h) w[h] = bf2f((u16)wv[h]) * (0.35355339059327373f * 0.17677669529663687f);
    }
    const int tpw = N >> 6;
    const u16* kbase = base + (size_t)jn * DINP + C_IK + q * 8;
    for (int tl = 0; tl < tpw; tl += 16) {
      bf16x8 bk[16];
#pragma unroll
      for (int u = 0; u < 16; ++u) {
        const int t = (tl + u < tpw) ? tl + u : tpw - 1;
        bk[u] = ld8(kbase + (size_t)((wave * tpw + t) * 16) * DINP);
      }
#pragma unroll
      for (int u = 0; u < 16; ++u) {
        const int t = (tl + u < tpw) ? tl + u : tpw - 1;
        const int key0 = (wave * tpw + t) * 16;
        const f32x4 z = {0.f, 0.f, 0.f, 0.f};
        f32x4 d0 = mfma16(a0, bk[u], z), d1 = mfma16(a1, bk[u], z);
        float sv = 0.f;
#pragma unroll
        for (int r = 0; r < 4; ++r) sv += fmaxf(d0[r], 0.f) * w[r];
#pragma unroll
        for (int r = 0; r < 4; ++r) sv += fmaxf(d1[r], 0.f) * w[4 + r];
        sc[q * SC_STRIDE + key0 + jn] = sv;
      }
    }
  }
  __syncthreads();
  u64 myword = ~0ull;
  if (N > 256) {
    float* scw = sc + wave * SC_STRIDE;
    if (nreg <= 8) myword = select_wave<8>(scw, nreg, lane);
    else if (nreg <= 16) myword = select_wave<16>(scw, nreg, lane);
    else if (nreg <= 24) myword = select_wave<24>(scw, nreg, lane);
    else if (nreg <= 32) myword = select_wave<32>(scw, nreg, lane);
    else if (nreg <= 48) myword = select_wave<48>(scw, nreg, lane);
    else myword = select_wave<64>(scw, nreg, lane);
  }
  if (lane < nreg) mask[((size_t)b * S + t0 + wave) * 64 + lane] = myword;
  __syncthreads();
}

DI void s5_stage1_item(const Params& P, int l, int it, int wave, int lane) {
  const int b = it >> 4, g = it & 15, q = lane >> 4, jn = lane & 15;
  const u16* proj = (const u16*)(P.ws + O_PROJ);
  const u16* W1 = (const u16*)(P.ws + O_W1) + (size_t)(l * 16 + g) * 128 * 1024;
  float* s5s = (float*)(P.ws + O_S5S) + (size_t)it * 64 * 128;
  f32x4 acc[2][4]; zero_acc(acc);
  const u16* ap = W1 + (size_t)(wave * 32 + jn) * 1024 + q * 8;
  const u16* up = proj + ((size_t)b * S + (size_t)jn * 64 + (q >> 1)) * DINP + C_U + g * 16 + (q & 1) * 8;
  wgemm<2, 4>(acc, 32, [&](int i, int ks) { return ld8(ap + (size_t)i * 16 * 1024 + ks * 32); },
              [&](int j, int ks) { return ld8(up + ((size_t)j * 16 * 64 + 2 * ks) * DINP); });
#pragma unroll
  for (int j = 0; j < 4; ++j) {
    const int n = 16 * j + jn;
#pragma unroll
    for (int i = 0; i < 2; ++i)
      *reinterpret_cast<f32x4*>(s5s + (size_t)n * 128 + wave * 32 + 16 * i + 4 * q) = acc[i][j];
  }
}

constexpr int HS_STRIDE = 136;
DI void s5_stage3_item(const Params& P, int l, int it, u16* hs, int wave, int lane) {
  const int b = it >> 4, g = it & 15, q = lane >> 4, jn = lane & 15;
  const u16* proj = (const u16*)(P.ws + O_PROJ);
  const u16* Kt = (const u16*)(P.ws + O_KT) + (size_t)(l * 16 + g) * 64 * 256;
  const u16* W3 = (const u16*)(P.ws + O_W3) + (size_t)(l * 16 + g) * 1024 * 128;
  const float* s5s = (const float*)(P.ws + O_S5S) + (size_t)it * 64 * 128;
  const float2* pw = (const float2*)(P.ws + O_PW);
  u16* yg = (u16*)(P.ws + O_YG);
  const float* dsk = P.in[17] + (l * 16 + g) * 16;
  if (wave == 0) {
    const int p = lane;
    const float2 aL = pw[((size_t)(l * 16 + g) * 65 + 64) * 64 + p];
    float hr = 0.f, hi = 0.f;
#pragma unroll
    for (int half = 0; half < 2; ++half) {
      float2 sv[32];
#pragma unroll
      for (int n = 0; n < 32; ++n) sv[n] = *reinterpret_cast<const float2*>(s5s + (size_t)(half * 32 + n) * 128 + 2 * p);
#pragma unroll
      for (int n = 0; n < 32; ++n) {
        *reinterpret_cast<unsigned*>(hs + (half * 32 + n) * HS_STRIDE + 2 * p) = pack2(hr, hi);
        const float nr = aL.x * hr - aL.y * hi + sv[n].x, ni = aL.x * hi + aL.y * hr + sv[n].y;
        hr = nr; hi = ni;
      }
    }
  }
  __syncthreads();
  const u16* up = proj + ((size_t)b * S + (size_t)jn * 64 + (q >> 1)) * DINP + C_U + g * 16 + (q & 1) * 8;
  const bf16x8 zf = {0, 0, 0, 0, 0, 0, 0, 0};
  for (int gi = 0; gi < 8; ++gi) {
    const int jg = wave + 4 * (gi >> 1);
    const int th = gi & 1;
    f32x4 acc[4][2]; zero_acc(acc);
    wgemm<4, 2>(acc, 2 * jg + 2,
                [&](int i, int ks) { const int j = 4 * jg + i, ii = 2 * ks + (q >> 1); const int d = j - ii;
                                     return (d >= 0) ? ld8(Kt + ((size_t)d * 16 + jn) * 16 + (q & 1) * 8) : zf; },
                [&](int jt, int ks) { return ld8(up + ((size_t)(2 * th + jt) * 16 * 64 + 2 * ks) * DINP); });
    wgemm<4, 2>(acc, 4,
                [&](int i, int ks) { return ld8(W3 + ((size_t)(4 * jg + i) * 16 + jn) * 128 + ks * 32 + q * 8); },
                [&](int jt, int ks) { return *reinterpret_cast<const bf16x8*>(hs + (16 * (2 * th + jt) + jn) * HS_STRIDE + ks * 32 + q * 8); });
#pragma unroll
    for (int jt = 0; jt < 2; ++jt) {
      const int n = 16 * (2 * th + jt) + jn;
#pragma unroll
      for (int i = 0; i < 4; ++i) {
        const size_t tok = (size_t)b * S + n * 64 + 4 * jg + i;
        uint2 uw = ld4(proj + tok * DINP + C_U + g * 16 + 4 * q);
        const float y0 = acc[i][jt][0] + dsk[4 * q] * lo2f(uw.x), y1 = acc[i][jt][1] + dsk[4 * q + 1] * hi2f(uw.x);
        const float y2 = acc[i][jt][2] + dsk[4 * q + 2] * lo2f(uw.y), y3 = acc[i][jt][3] + dsk[4 * q + 3] * hi2f(uw.y);
        st4(yg + tok * 256 + g * 16 + 4 * q, geluf_(y0), geluf_(y1), geluf_(y2), geluf_(y3));
      }
    }
  }
  __syncthreads();
}

DI void glu_tile(const Params& P, int l, int tt, char* lds) {
  const u16* W = (const u16*)(P.ws + O_WTGLU) + (size_t)l * 256 * 256;
  const u16* yg = (const u16*)(P.ws + O_YG);
  const u16* proj = (const u16*)(P.ws + O_PROJ);
  u16* mixed = (u16*)(P.ws + O_XB);
  const int tid = opaque_tid();
  const int wave = __builtin_amdgcn_readfirstlane(tid >> 6), lane = tid & 63, q = lane >> 4, jn = lane & 15;
#pragma unroll 1
  for (int ftile = 0; ftile < 2; ++ftile) {
    const int f0 = ftile * 128 + (wave >> 1) * 64, t0 = tt * 128 + (wave & 1) * 64;
    f32x4 acc[4][4]; zero_acc(acc);
    gemm_block(acc, W + (size_t)(ftile * 128) * 256, 256, yg + (size_t)(tt * 128) * 256, 256, 256, lds, tid);
#pragma unroll
    for (int j = 0; j < 4; ++j) {
      const size_t tok = t0 + 16 * j + jn;
#pragma unroll
      for (int i = 0; i < 4; ++i) {
        const int f = f0 + 16 * i + 4 * q;
        uint2 gw = ld4(yg + tok * 256 + f), bw = ld4(proj + tok * DINP + C_GB + f);
        st4(mixed + tok * DM + 384 + f, lo2f(gw.x) * sigmoidf_(acc[i][j][0]) * siluf_(lo2f(bw.x)), hi2f(gw.x) * sigmoidf_(acc[i][j][1]) * siluf_(hi2f(bw.x)),
            lo2f(gw.y) * sigmoidf_(acc[i][j][2]) * siluf_(lo2f(bw.y)), hi2f(gw.y) * sigmoidf_(acc[i][j][3]) * siluf_(hi2f(bw.y)));
      }
    }
  }
}

DI void outproj_tile(const Params& P, int l, int tt, char* lds) {
  const u16* W = (const u16*)(P.ws + O_WTOUT) + (size_t)l * DM * DM;
  const u16* mixed = (const u16*)(P.ws + O_XB);
  const float* xin = (l == 0) ? P.in[0] : P.out;
  float* xout = P.out;
  u16* xb2 = (u16*)(P.ws + O_XB2);
  const int tid = opaque_tid();
  const int wave = __builtin_amdgcn_readfirstlane(tid >> 6), lane = tid & 63, q = lane >> 4, jn = lane & 15;
#pragma unroll 1
  for (int ftile0 = 0; ftile0 < 8; ++ftile0) {
    int ftile = ftile0; asm volatile("" : "+s"(ftile));
    const int f0 = ftile * 128 + (wave >> 1) * 64, t0 = tt * 128 + (wave & 1) * 64;
    f32x4 acc[4][4]; zero_acc(acc);
    gemm_block(acc, W + (size_t)(ftile * 128) * DM, DM, mixed + (size_t)(tt * 128) * DM, DM, DM, lds, tid);
#pragma unroll
    for (int j = 0; j < 4; ++j) {
      const size_t tok = t0 + 16 * j + jn;
#pragma unroll
      for (int i = 0; i < 4; ++i) {
        const int f = f0 + 16 * i + 4 * q;
        f32x4 xv;
        if (l == 0) xv = *reinterpret_cast<const f32x4*>(xin + tok * DM + f);
        else { const uint2 xw = ld4(xb2 + tok * DM + f); xv = f32x4{lo2f(xw.x), hi2f(xw.x), lo2f(xw.y), hi2f(xw.y)}; }
        const f32x4 xn = xv + acc[i][j];
        if (l == NL - 1) *reinterpret_cast<f32x4*>(xout + tok * DM + f) = xn;
        else st4(xb2 + tok * DM + f, xn[0], xn[1], xn[2], xn[3]);
      }
    }
  }
}

DI void phase_tail(const Params& P, int l, char* lds, float* s_rstd, float* s_prep) {
  for (int tt = blockIdx.x; tt < 512; tt += gridDim.x) {
    glu_tile(P, l, tt, lds);
    asm volatile("s_waitcnt vmcnt(0)" ::: "memory");
    __syncthreads();
    outproj_tile(P, l, tt, lds);
    if (l + 1 < NL) {
      asm volatile("s_waitcnt vmcnt(0)" ::: "memory");
      __syncthreads();
      inproj_tile(P, l + 1, tt, lds, s_rstd, s_prep);
    }
  }
}

DI void gbar(unsigned* ctr, unsigned& epoch) {
  asm volatile("s_waitcnt vmcnt(0)" ::: "memory");
  __syncthreads();
  epoch += gridDim.x;
  if (threadIdx.x == 0) {
    __builtin_amdgcn_fence(__ATOMIC_RELEASE, "agent");
    asm volatile("s_waitcnt vmcnt(0)" ::: "memory");
    __hip_atomic_fetch_add(ctr, 1u, __ATOMIC_RELAXED, __HIP_MEMORY_SCOPE_AGENT);
    while (__hip_atomic_load(ctr, __ATOMIC_RELAXED, __HIP_MEMORY_SCOPE_AGENT) < epoch) __builtin_amdgcn_s_sleep(1);
    __builtin_amdgcn_fence(__ATOMIC_ACQUIRE, "agent");
    asm volatile("s_waitcnt vmcnt(0)" ::: "memory");
  }
  __syncthreads();
}

__global__ void __launch_bounds__(256, 2) fwd_megakernel(Params P) {
  cg::grid_group grid = cg::this_grid();
  __shared__ __attribute__((aligned(16))) float lds_f[2 * G_BUF_BYTES / 4];
  static_assert(2 * G_BUF_BYTES >= 4 * SC_STRIDE * 4, "lds");
  __shared__ int s_item;
  __shared__ float s_rstd[128];
  __shared__ float s_prep[512];
  const long gtid = (long)blockIdx.x * 256 + threadIdx.x, gsz = (long)gridDim.x * 256;

  if (blockIdx.x == 0) { for (int w = threadIdx.x; w < 8192; w += 256) ((unsigned*)(P.ws + O_CTR))[w] = 0u; }
  phase_w0(P, gtid, gsz);
  grid.sync();
  unsigned* bar = (unsigned*)(P.ws + O_CTR) + 6144;
  unsigned epoch = 0u;
  phase_w1(P, gtid, gsz);
#ifdef DUP_W
  phase_w0(P, gtid, gsz);
  phase_w1(P, gtid, gsz);
#endif

  for (int tt = blockIdx.x; tt < 512; tt += gridDim.x) {
    {
      const float* x = P.in[0]; u16* xb = (u16*)(P.ws + O_XB2);
      const int tid = opaque_tid();
#pragma unroll 4
      for (int e = tid; e < 128 * 256; e += 256) {
        const float4 v = *reinterpret_cast<const float4*>(x + (size_t)tt * 128 * DM + (size_t)e * 4);
        st4(xb + (size_t)tt * 128 * DM + (size_t)e * 4, v.x, v.y, v.z, v.w);
      }
    }
    asm volatile("s_waitcnt vmcnt(0)" ::: "memory");
    __syncthreads();
    inproj_tile(P, 0, tt, (char*)lds_f, s_rstd, s_prep);
  }
  gbar(bar, epoch);
  for (int l = 0; l < NL; ++l) {
    {
      const int shard = blockIdx.x & 7;
      unsigned* ctr = (unsigned*)(P.ws + O_CTR) + ((l * 2) * 8 + shard) * 64;
      for (;;) {
        const int tid = opaque_tid();
        if (tid == 0) s_item = (int)atomicAdd(ctr, 1u) * 8 + shard;
        __syncthreads();
        const int it = s_item;
        __syncthreads();
        if (it >= 256 + 3072 + 4096) break;
        const int wave = __builtin_amdgcn_readfirstlane(tid >> 6), lane = tid & 63;
        if (it < 256) s5_stage1_item(P, l, it, wave, lane);
        else if (it < 256 + 3072) mla_attn_item(P, it - 256, (char*)lds_f, tid);
        else {
#pragma unroll 1
          for (int k = 0; k < 4; ++k) dsa_select_item(P, (it - 256 - 3072) * 4 + k, lds_f, wave, lane);
        }
      }
    }
    gbar(bar, epoch);
    {
      const int shard = blockIdx.x & 7;
      unsigned* ctr = (unsigned*)(P.ws + O_CTR) + ((l * 2 + 1) * 8 + shard) * 64;
      for (;;) {
        const int tid = opaque_tid();
        if (tid == 0) s_item = (int)atomicAdd(ctr, 1u) * 8 + shard;
        __syncthreads();
        const int it = s_item;
        __syncthreads();
        if (it >= 256 + 2048) break;
        const int wave = __builtin_amdgcn_readfirstlane(tid >> 6), lane = tid & 63;
        if (it < 256) s5_stage3_item(P, l, it, (u16*)lds_f, wave, lane);
        else {
          const int iu = __builtin_amdgcn_readfirstlane(it - 256), ml = iu >> 3;
          dsa_attn_item(P, (ml & 63) * 32 + (iu & 7) + 8 * (ml >> 6), (char*)lds_f, tid);
        }
      }
    }
    gbar(bar, epoch);
    phase_tail(P, l, (char*)lds_f, s_rstd, s_prep);
    if (l + 1 < NL) gbar(bar, epoch);
  }
}

extern "C" void kernel_launch(void* const* d_in, const int* in_sizes, int n_in, void* d_out, int out_size, void* d_ws, size_t ws_size,
                              hipStream_t stream) {
  static int grid_blocks = 0;
  if (!grid_blocks) {
    int dev = 0, cus = 0, per_cu = 0;
    hipGetDevice(&dev);
    hipDeviceGetAttribute(&cus, hipDeviceAttributeMultiprocessorCount, dev);
    hipOccupancyMaxActiveBlocksPerMultiprocessor(&per_cu, fwd_megakernel, 256, 0);
    if (per_cu < 1) per_cu = 1;
    if (per_cu > 2) per_cu = 2;
    grid_blocks = cus * per_cu;
    if (ws_size < O_END) fprintf(stderr, "workspace too small: %zu < %zu\n", ws_size, (size_t)O_END);
  }
  Params p{};
  for (int i = 0; i < 21; ++i) p.in[i] = (const float*)d_in[i];
  p.out = (float*)d_out;
  p.ws = (char*)d_ws;
  void* args[] = {&p};
  hipError_t e = hipLaunchCooperativeKernel((void*)fwd_megakernel, dim3(grid_blocks), dim3(256), args, 0, stream);
  if (e != hipSuccess) fprintf(stderr, "cooperative launch failed: %s (grid %d)\n", hipGetErrorString(e), grid_blocks);
}
```

```cpp
#include <hip/hip_runtime.h>
#include <hip/hip_cooperative_groups.h>
#include <cstdio>
#include <type_traits>
namespace cg = cooperative_groups;

#define DI __device__ __forceinline__
typedef __attribute__((ext_vector_type(8))) short bf16x8;
typedef __attribute__((ext_vector_type(4))) short s16x4;
typedef __attribute__((ext_vector_type(4))) float f32x4;
typedef unsigned short u16;
typedef unsigned long long u64;

constexpr int NB = 16, S = 4096, T = NB * S, DM = 1024, DIN = 2504, DINP = 2560, NL = 4;
constexpr int C_QA = 0, C_KA = 384, C_VA = 448, C_IQ = 512, C_IK = 768, C_IW = 800, C_GA = 808, C_U = 1192,
              C_GB = 1448, C_CQ = 1704, C_CKV = 1960, C_KPE = 2088, C_GC = 2120;
constexpr float EPS = 1e-6f;
constexpr float LOG2E = 1.4426950408889634f;

constexpr size_t O_WTIN = 0;
constexpr size_t O_WTOUT = O_WTIN + (size_t)NL * DINP * DM * 2;
constexpr size_t O_WTUQ = O_WTOUT + (size_t)NL * DM * DM * 2;
constexpr size_t O_WTUKV = O_WTUQ + (size_t)NL * 768 * 256 * 2;
constexpr size_t O_WTGLU = O_WTUKV + (size_t)NL * 768 * 128 * 2;
constexpr size_t O_W1 = O_WTGLU + (size_t)NL * 256 * 256 * 2;
constexpr size_t O_W3 = O_W1 + (size_t)NL * 16 * 128 * 1024 * 2;
constexpr size_t O_KT = O_W3 + (size_t)NL * 16 * 1024 * 128 * 2;
constexpr size_t O_PW = O_KT + (size_t)NL * 16 * 64 * 256 * 2;
constexpr size_t O_FZ = O_PW + (size_t)NL * 16 * 65 * 64 * 8;
constexpr size_t O_R64 = O_FZ + (size_t)NL * 16 * 64 * 8;
constexpr size_t O_R32 = O_R64 + (size_t)4096 * 32 * 8;
constexpr size_t O_XB = O_R32 + (size_t)4096 * 16 * 8;
constexpr size_t O_RSTD = O_XB + (size_t)T * 1024 * 2;
constexpr size_t O_PROJ = O_RSTD + (size_t)T * 4;
constexpr size_t O_MQ = O_PROJ + (size_t)T * DINP * 2;
constexpr size_t O_MK = O_MQ + (size_t)T * 576 * 2;
constexpr size_t O_MVT = O_MK + (size_t)T * 576 * 2;
constexpr size_t O_AVT = O_MVT + (size_t)T * 384 * 2;
constexpr size_t O_MASK = O_AVT + (size_t)T * 64 * 2;
constexpr size_t O_S5S = O_MASK + (size_t)T * 512;
constexpr size_t O_YG = O_S5S + (size_t)16 * 16 * 64 * 128 * 4;
constexpr size_t O_CTR = O_YG + (size_t)T * 256 * 2;
constexpr size_t O_XB2 = O_CTR + 32768;
constexpr size_t O_END = O_XB2 + (size_t)T * 1024 * 2;

struct Params {
  const float* in[21];
  float* out;
  char* ws;
};

DI int opaque_tid() { int t = threadIdx.x; asm volatile("" : "+v"(t)); return t; }
DI u16 f2bf(float f) { unsigned u = __float_as_uint(f); u += 0x7fffu + ((u >> 16) & 1u); return (u16)(u >> 16); }
DI float bf2f(u16 h) { return __uint_as_float(((unsigned)h) << 16); }
typedef __attribute__((ext_vector_type(2))) __bf16 bf16x2_t;
typedef __attribute__((ext_vector_type(2))) float f32x2_t;
DI unsigned pack2(float a, float b) { return __builtin_bit_cast(unsigned, __builtin_convertvector((f32x2_t){a, b}, bf16x2_t)); }
DI float lo2f(unsigned w) { return __uint_as_float(w << 16); }
DI float hi2f(unsigned w) { return __uint_as_float(w & 0xffff0000u); }
DI bf16x8 ld8(const u16* p) { return *reinterpret_cast<const bf16x8*>(p); }
DI uint2 ld4(const u16* p) { return *reinterpret_cast<const uint2*>(p); }
DI void st4(u16* p, float a, float b, float c, float d) { uint2 v; v.x = pack2(a, b); v.y = pack2(c, d); *reinterpret_cast<uint2*>(p) = v; }
DI f32x4 mfma16(bf16x8 a, bf16x8 b, f32x4 c) { return __builtin_amdgcn_mfma_f32_16x16x32_bf16(a, b, c, 0, 0, 0); }
DI float fexp2(float x) { return __builtin_amdgcn_exp2f(x); }
DI float sigmoidf_(float x) { return __builtin_amdgcn_rcpf(1.0f + __expf(-x)); }
DI float siluf_(float x) { return x * sigmoidf_(x); }
DI float geluf_(float x) { float u = 0.7978845608028654f * (x + 0.044715f * x * x * x); return x * sigmoidf_(2.0f * u); }
DI float red4(float v) { v += __shfl_xor(v, 16); v += __shfl_xor(v, 32); return v; }

template <int AT, int BT, class FA, class FB>
DI void wgemm(f32x4 (&acc)[AT][BT], int ksteps, FA fa, FB fb) {
  bf16x8 a0[AT], b0[BT], a1[AT], b1[BT];
  const int k1 = (ksteps > 1) ? 1 : 0;
#pragma unroll
  for (int i = 0; i < AT; ++i) { a0[i] = fa(i, 0); a1[i] = fa(i, k1); }
#pragma unroll
  for (int j = 0; j < BT; ++j) { b0[j] = fb(j, 0); b1[j] = fb(j, k1); }
  for (int ks = 0; ks < ksteps; ++ks) {
    bf16x8 a2[AT], b2[BT];
    const int kn = (ks + 2 < ksteps) ? ks + 2 : ksteps - 1;
#pragma unroll
    for (int i = 0; i < AT; ++i) a2[i] = fa(i, kn);
#pragma unroll
    for (int j = 0; j < BT; ++j) b2[j] = fb(j, kn);
    __builtin_amdgcn_sched_barrier(0);
#pragma unroll
    for (int i = 0; i < AT; ++i)
#pragma unroll
      for (int j = 0; j < BT; ++j) acc[i][j] = mfma16(a0[i], b0[j], acc[i][j]);
    __builtin_amdgcn_sched_barrier(0);
#pragma unroll
    for (int i = 0; i < AT; ++i) { a0[i] = a1[i]; a1[i] = a2[i]; }
#pragma unroll
    for (int j = 0; j < BT; ++j) { b0[j] = b1[j]; b1[j] = b2[j]; }
  }
}

constexpr int GROW = 72;
constexpr int G_TILE_BYTES = 128 * GROW * 2;
constexpr int G_BUF_BYTES = 2 * G_TILE_BYTES;
DI void gemm_block(f32x4 (&acc)[4][4], const u16* Ap, int lda, const u16* Bp, int ldb, int K, char* lds, int tid, bool swap_w1 = false) {
  const int lane = tid & 63, q = lane >> 4, jn = lane & 15;
  const int wave = __builtin_amdgcn_readfirstlane(tid >> 6), wa = wave >> 1, wb = wave & 1;
  uint4 xa0, xa1, xa2, xa3, xb0, xb1, xb2, xb3;
  uint4 ya0, ya1, ya2, ya3, yb0, yb1, yb2, yb3;
  const int srow = tid >> 3, scol = tid & 7;
  const unsigned voa = (unsigned)(srow * lda + scol * 8) * 2u, vob = (unsigned)(srow * ldb + scol * 8) * 2u;
  const char* ag = reinterpret_cast<const char*>(Ap);
  const char* bg = reinterpret_cast<const char*>(Bp);
  char* st0 = lds + (srow * GROW + scol * 8) * 2;
  const bool sw = swap_w1 && (wa == 1);
  const char* a0p = sw ? (lds + G_TILE_BYTES + (wb * 64 + jn) * GROW * 2 + q * 16) : (lds + (wa * 64 + jn) * GROW * 2 + q * 16);
  const char* b0p = sw ? (lds + (wa * 64 + jn) * GROW * 2 + q * 16) : (lds + G_TILE_BYTES + (wb * 64 + jn) * GROW * 2 + q * 16);
#define GL(v, base, ld, vo, i, kt) v = *reinterpret_cast<const uint4*>(base + ((size_t)(32 * (i)) * (ld) + (size_t)(kt) * 64) * 2 + vo)
#define GLOAD0(kt) { GL(xa0, ag, lda, voa, 0, kt); GL(xa1, ag, lda, voa, 1, kt); GL(xa2, ag, lda, voa, 2, kt); GL(xa3, ag, lda, voa, 3, kt); GL(xb0, bg, ldb, vob, 0, kt); GL(xb1, bg, ldb, vob, 1, kt); GL(xb2, bg, ldb, vob, 2, kt); GL(xb3, bg, ldb, vob, 3, kt); }
#define GLOAD1(kt) { GL(ya0, ag, lda, voa, 0, kt); GL(ya1, ag, lda, voa, 1, kt); GL(ya2, ag, lda, voa, 2, kt); GL(ya3, ag, lda, voa, 3, kt); GL(yb0, bg, ldb, vob, 0, kt); GL(yb1, bg, ldb, vob, 1, kt); GL(yb2, bg, ldb, vob, 2, kt); GL(yb3, bg, ldb, vob, 3, kt); }
#define GS(v, off) *reinterpret_cast<uint4*>(st0 + (off)) = v
#define GSTORE0(buf) { GS(xa0, (buf) * G_BUF_BYTES); GS(xa1, (buf) * G_BUF_BYTES + 32 * GROW * 2); GS(xa2, (buf) * G_BUF_BYTES + 64 * GROW * 2); GS(xa3, (buf) * G_BUF_BYTES + 96 * GROW * 2); \
                       GS(xb0, (buf) * G_BUF_BYTES + G_TILE_BYTES); GS(xb1, (buf) * G_BUF_BYTES + G_TILE_BYTES + 32 * GROW * 2); GS(xb2, (buf) * G_BUF_BYTES + G_TILE_BYTES + 64 * GROW * 2); GS(xb3, (buf) * G_BUF_BYTES + G_TILE_BYTES + 96 * GROW * 2); }
#define GSTORE1(buf) { GS(ya0, (buf) * G_BUF_BYTES); GS(ya1, (buf) * G_BUF_BYTES + 32 * GROW * 2); GS(ya2, (buf) * G_BUF_BYTES + 64 * GROW * 2); GS(ya3, (buf) * G_BUF_BYTES + 96 * GROW * 2); \
                       GS(yb0, (buf) * G_BUF_BYTES + G_TILE_BYTES); GS(yb1, (buf) * G_BUF_BYTES + G_TILE_BYTES + 32 * GROW * 2); GS(yb2, (buf) * G_BUF_BYTES + G_TILE_BYTES + 64 * GROW * 2); GS(yb3, (buf) * G_BUF_BYTES + G_TILE_BYTES + 96 * GROW * 2); }
  auto compute = [&](int buf) {
#pragma unroll
    for (int ks = 0; ks < 2; ++ks) {
      bf16x8 a[4], b[4];
#pragma unroll
      for (int i = 0; i < 4; ++i) a[i] = *reinterpret_cast<const bf16x8*>(a0p + buf * G_BUF_BYTES + i * 16 * GROW * 2 + ks * 64);
#pragma unroll
      for (int j = 0; j < 4; ++j) b[j] = *reinterpret_cast<const bf16x8*>(b0p + buf * G_BUF_BYTES + j * 16 * GROW * 2 + ks * 64);
      __builtin_amdgcn_s_setprio(1);
#pragma unroll
      for (int i = 0; i < 4; ++i)
#pragma unroll
        for (int j = 0; j < 4; ++j) acc[i][j] = mfma16(a[i], b[j], acc[i][j]);
      __builtin_amdgcn_s_setprio(0);
    }
  };
  const int nkt = K >> 6;
  GLOAD0(0);
  GLOAD1(1);
  GSTORE0(0);
  __syncthreads();
  for (int kt = 0; kt < nkt; kt += 2) {
    if (kt + 2 < nkt) GLOAD0(kt + 2);
    compute(0);
    GSTORE1(1);
    __syncthreads();
    if (kt + 3 < nkt) GLOAD1(kt + 3);
    compute(1);
    if (kt + 2 < nkt) GSTORE0(0);
    __syncthreads();
  }
#undef GL
#undef GLOAD0
#undef GLOAD1
#undef GS
#undef GSTORE0
#undef GSTORE1
}

template <int A, int B>
DI void zero_acc(f32x4 (&acc)[A][B]) {
#pragma unroll
  for (int i = 0; i < A; ++i)
#pragma unroll
    for (int j = 0; j < B; ++j) acc[i][j] = f32x4{0.f, 0.f, 0.f, 0.f};
}

DI void sincos_d(double a, double& c, double& s) {
  const double TWO_PI = 6.283185307179586476925;
  double n = rint(a / TWO_PI);
  double r = a - n * TWO_PI;
  c = cos(r); s = sin(r);
}

DI void phase_w0(const Params& P, long gtid, long gsz) {
  char* ws = P.ws;
  {
    u16* dst = (u16*)(ws + O_WTIN);
    const float* w = P.in[2]; const float* g = P.in[1];
    for (long idx = gtid; idx < (long)NL * 128 * DINP; idx += gsz) {
      int n = (int)(idx % DINP); long r = idx / DINP; int kb = (int)(r % 128); int l = (int)(r / 128);
      float v[8];
#pragma unroll
      for (int j = 0; j < 8; ++j) { int k = kb * 8 + j; v[j] = (n < DIN) ? w[((size_t)l * DM + k) * DIN + n] * g[l * DM + k] : 0.f; }
      uint4 o; o.x = pack2(v[0], v[1]); o.y = pack2(v[2], v[3]); o.z = pack2(v[4], v[5]); o.w = pack2(v[6], v[7]);
      *reinterpret_cast<uint4*>(dst + ((size_t)l * DINP + n) * DM + kb * 8) = o;
    }
  }
  {
    u16* dst = (u16*)(ws + O_WTOUT);
    const float* w = P.in[20];
    for (long idx = gtid; idx < (long)NL * 128 * DM; idx += gsz) {
      int n = (int)(idx % DM); long r = idx / DM; int kb = (int)(r % 128); int l = (int)(r / 128);
      float v[8];
#pragma unroll
      for (int j = 0; j < 8; ++j) { int k = kb * 8 + j; v[j] = w[((size_t)l * DM + k) * DM + n]; }
      uint4 o; o.x = pack2(v[0], v[1]); o.y = pack2(v[2], v[3]); o.z = pack2(v[4], v[5]); o.w = pack2(v[6], v[7]);
      *reinterpret_cast<uint4*>(dst + ((size_t)l * DM + n) * DM + kb * 8) = o;
    }
  }
  {
    u16* dst = (u16*)(ws + O_WTUQ);
    const float* w = P.in[7]; const float* g = P.in[5];
    for (long idx = gtid; idx < (long)NL * 32 * 768; idx += gsz) {
      int n = (int)(idx % 768); long r = idx / 768; int kb = (int)(r % 32); int l = (int)(r / 32);
      const int h = n >> 7, d = n & 127;
      float v[8];
#pragma unroll
      for (int j = 0; j < 8; ++j) { int k = kb * 8 + j; v[j] = (d < 96) ? w[((size_t)l * 256 + k) * 576 + h * 96 + d] * g[l * 256 + k] : 0.f; }
      uint4 o; o.x = pack2(v[0], v[1]); o.y = pack2(v[2], v[3]); o.z = pack2(v[4], v[5]); o.w = pack2(v[6], v[7]);
      *reinterpret_cast<uint4*>(dst + ((size_t)l * 768 + n) * 256 + kb * 8) = o;
    }
  }
  {
    u16* dst = (u16*)(ws + O_WTUKV);
    const float* w = P.in[8]; const float* g = P.in[6];
    for (long idx = gtid; idx < (long)NL * 16 * 768; idx += gsz) {
      int n = (int)(idx % 768); long r = idx / 768; int kb = (int)(r % 16); int l = (int)(r / 16);
      float v[8];
#pragma unroll
      for (int j = 0; j < 8; ++j) { int k = kb * 8 + j; v[j] = w[((size_t)l * 128 + k) * 768 + n] * g[l * 128 + k]; }
      uint4 o; o.x = pack2(v[0], v[1]); o.y = pack2(v[2], v[3]); o.z = pack2(v[4], v[5]); o.w = pack2(v[6], v[7]);
      *reinterpret_cast<uint4*>(dst + ((size_t)l * 768 + n) * 128 + kb * 8) = o;
    }
  }
  {
    u16* dst = (u16*)(ws + O_WTGLU);
    const float* w = P.in[19];
    for (long idx = gtid; idx < (long)NL * 32 * 256; idx += gsz) {
      int n = (int)(idx % 256); long r = idx / 256; int kb = (int)(r % 32); int l = (int)(r / 32);
      float v[8];
#pragma unroll
      for (int j = 0; j < 8; ++j) { int k = kb * 8 + j; v[j] = w[((size_t)l * 256 + k) * 256 + n]; }
      uint4 o; o.x = pack2(v[0], v[1]); o.y = pack2(v[2], v[3]); o.z = pack2(v[4], v[5]); o.w = pack2(v[6], v[7]);
      *reinterpret_cast<uint4*>(dst + ((size_t)l * 256 + n) * 256 + kb * 8) = o;
    }
  }
  {
    float2* r64 = (float2*)(ws + O_R64);
    for (long idx = gtid; idx < 4096L * 32; idx += gsz) {
      int i = (int)(idx & 31); int pos = (int)(idx >> 5);
      float inv = (float)pow(10000.0, -(double)i / 32.0);
      float ang = (float)pos * inv;
      double c, s; sincos_d((double)ang, c, s);
      r64[idx] = make_float2((float)c, (float)s);
    }
    float2* r32 = (float2*)(ws + O_R32);
    for (long idx = gtid; idx < 4096L * 16; idx += gsz) {
      int i = (int)(idx & 15); int pos = (int)(idx >> 4);
      float inv = (float)pow(10000.0, -(double)i / 16.0);
      float ang = (float)pos * inv;
      double c, s; sincos_d((double)ang, c, s);
      r32[idx] = make_float2((float)c, (float)s);
    }
  }
  {
    float2* pw = (float2*)(ws + O_PW);
    float2* fz = (float2*)(ws + O_FZ);
    const float* a_re = P.in[11]; const float* a_im = P.in[12]; const float* lstep = P.in[18];
    for (long idx = gtid; idx < (long)NL * 16 * 65 * 64; idx += gsz) {
      int p = (int)(idx & 63); long r = idx >> 6; int d = (int)(r % 65); int lg = (int)(r / 65);
      double step = exp((double)lstep[lg]);
      double ar = (double)a_re[lg * 64 + p], ai = (double)a_im[lg * 64 + p];
      double mag = exp((double)d * ar * step);
      double c, s; sincos_d((double)d * ai * step, c, s);
      pw[idx] = make_float2((float)(mag * c), (float)(mag * s));
      if (d == 1) {
        double abr = mag * c, abi = mag * s;
        double den = ar * ar + ai * ai, nr = abr - 1.0;
        double fre = (nr * ar + abi * ai) / den, fim = (abi * ar - nr * ai) / den;
        fz[lg * 64 + p] = make_float2((float)fre, (float)fim);
      }
    }
  }
}

DI void phase_w1(const Params& P, long gtid, long gsz) {
  char* ws = P.ws;
  const float2* pw = (const float2*)(ws + O_PW);
  const float2* fz = (const float2*)(ws + O_FZ);
  const float* b_re = P.in[13]; const float* b_im = P.in[14]; const float* c_re = P.in[15]; const float* c_im = P.in[16];
  {
    u16* w1 = (u16*)(ws + O_W1);
    for (long idx = gtid; idx < (long)NL * 16 * 128 * 128; idx += gsz) {
      int kb = (int)(idx & 127); long r = idx >> 7; int row = (int)(r & 127); int lg = (int)(r >> 7);
      int p = row >> 1, ri = row & 1; int i = kb >> 1, c0 = (kb & 1) * 8;
      float2 e = pw[((size_t)lg * 65 + (63 - i)) * 64 + p]; float2 f = fz[lg * 64 + p];
      float er = e.x * f.x - e.y * f.y, ei = e.x * f.y + e.y * f.x;
      float v[8];
#pragma unroll
      for (int j = 0; j < 8; ++j) {
        float br = b_re[((size_t)lg * 64 + p) * 16 + c0 + j], bi = b_im[((size_t)lg * 64 + p) * 16 + c0 + j];
        v[j] = ri ? (er * bi + ei * br) : (er * br - ei * bi);
      }
      uint4 o; o.x = pack2(v[0], v[1]); o.y = pack2(v[2], v[3]); o.z = pack2(v[4], v[5]); o.w = pack2(v[6], v[7]);
      *reinterpret_cast<uint4*>(w1 + ((size_t)lg * 128 + row) * 1024 + kb * 8) = o;
    }
  }
  {
    u16* w3 = (u16*)(ws + O_W3);
    for (long idx = gtid; idx < (long)NL * 16 * 1024 * 16; idx += gsz) {
      int kb = (int)(idx & 15); long r = idx >> 4; int f = (int)(r & 1023); int lg = (int)(r >> 10);
      int j = f >> 4, c = f & 15;
      float v[8];
#pragma unroll
      for (int jj = 0; jj < 4; ++jj) {
        int p = kb * 4 + jj;
        float2 e = pw[((size_t)lg * 65 + (j + 1)) * 64 + p];
        float cr = c_re[((size_t)lg * 16 + c) * 64 + p], ci = c_im[((size_t)lg * 16 + c) * 64 + p];
        v[2 * jj] = cr * e.x - ci * e.y;
        v[2 * jj + 1] = -(cr * e.y + ci * e.x);
      }
      uint4 o; o.x = pack2(v[0], v[1]); o.y = pack2(v[2], v[3]); o.z = pack2(v[4], v[5]); o.w = pack2(v[6], v[7]);
      *reinterpret_cast<uint4*>(w3 + ((size_t)lg * 1024 + f) * 128 + kb * 8) = o;
    }
  }
  {
    u16* kt = (u16*)(ws + O_KT);
    for (long idx = gtid; idx < (long)NL * 16 * 64 * 16 * 2; idx += gsz) {
      int cb = (int)(idx & 1); long r = idx >> 1; int c = (int)(r & 15); r >>= 4; int d = (int)(r & 63); int lg = (int)(r >> 6);
      float v[8];
#pragma unroll
      for (int j = 0; j < 8; ++j) v[j] = 0.f;
      for (int p = 0; p < 64; ++p) {
        float2 e = pw[((size_t)lg * 65 + d) * 64 + p]; float2 f = fz[lg * 64 + p];
        float er = e.x * f.x - e.y * f.y, ei = e.x * f.y + e.y * f.x;
        float cr = c_re[((size_t)lg * 16 + c) * 64 + p], ci = c_im[((size_t)lg * 16 + c) * 64 + p];
        float gr = cr * er - ci * ei, gi = cr * ei + ci * er;
#pragma unroll
        for (int j = 0; j < 8; ++j) {
          float br = b_re[((size_t)lg * 64 + p) * 16 + cb * 8 + j], bi = b_im[((size_t)lg * 64 + p) * 16 + cb * 8 + j];
          v[j] += gr * br - gi * bi;
        }
      }
      uint4 o; o.x = pack2(v[0], v[1]); o.y = pack2(v[2], v[3]); o.z = pack2(v[4], v[5]); o.w = pack2(v[6], v[7]);
      *reinterpret_cast<uint4*>(kt + (((size_t)lg * 64 + d) * 16 + c) * 16 + cb * 8) = o;
    }
  }
}

DI void phase_p0(const Params& P, int l) {
  const float* x = (l == 0) ? P.in[0] : P.out;
  u16* xb = (u16*)(P.ws + O_XB2);
  const int tid = opaque_tid();
  const int lane = tid & 63;
  const int gw = blockIdx.x * 4 + (tid >> 6), nw = gridDim.x * 4;
  for (int row = gw; row < T; row += nw) {
    const float4* xr = reinterpret_cast<const float4*>(x + (size_t)row * DM);
#pragma unroll
    for (int i = 0; i < 4; ++i) {
      float4 v = xr[i * 64 + lane];
      st4(xb + (size_t)row * DM + (i * 64 + lane) * 4, v.x, v.y, v.z, v.w);
    }
  }
}

DI void prep_mla_q(const Params& P, int l, int tw0, int lane) {
  const int q = lane >> 4, jn = lane & 15;
  const u16* proj = (const u16*)(P.ws + O_PROJ);
  const u16* W = (const u16*)(P.ws + O_WTUQ) + (size_t)l * 576 * 256;
  u16* mq = (u16*)(P.ws + O_MQ);
  const float2* r32 = (const float2*)(P.ws + O_R32);
  const float* gq = P.in[9] + l * 96;
  const u16* bp = proj + (size_t)(tw0 + jn) * DINP + C_CQ + q * 8;
  float rq[2];
#pragma unroll
  for (int t = 0; t < 2; ++t) {
    float ss = 0.f;
    for (int ks = 0; ks < 8; ++ks) {
      bf16x8 v = ld8(bp + (size_t)t * 16 * DINP + ks * 32);
#pragma unroll
      for (int j = 0; j < 8; ++j) { float f = bf2f((u16)v[j]); ss += f * f; }
    }
    ss = red4(ss);
    rq[t] = rsqrtf(ss * (1.0f / 256) + EPS);
  }
  const float qscale = 0.10206207261596577f * LOG2E;
  for (int h = 0; h < 6; ++h) {
    f32x4 acc[6][2]; zero_acc(acc);
    const u16* ap = W + (size_t)(h * 96 + jn) * 256 + q * 8;
    wgemm<6, 2>(acc, 8, [&](int i, int ks) { return ld8(ap + (size_t)i * 16 * 256 + ks * 32); },
                [&](int j, int ks) { return ld8(bp + (size_t)j * 16 * DINP + ks * 32); });
#pragma unroll
    for (int t = 0; t < 2; ++t) {
      const int tok = tw0 + 16 * t + jn, pos = tok & (S - 1);
      float ss = 0.f;
#pragma unroll
      for (int i = 0; i < 6; ++i)
#pragma unroll
        for (int r = 0; r < 4; ++r) { float v = acc[i][t][r] * rq[t]; acc[i][t][r] = v; ss += v * v; }
      ss = red4(ss);
      const float rs = rsqrtf(ss * (1.0f / 96) + EPS);
#pragma unroll
      for (int i = 0; i < 6; ++i)
#pragma unroll
        for (int r = 0; r < 4; ++r) acc[i][t][r] *= rs * gq[16 * i + 4 * q + r];
#pragma unroll
      for (int r = 0; r < 4; ++r) {
        float2 cs = r32[pos * 16 + 4 * q + r];
        float x1 = acc[4][t][r], x2 = acc[5][t][r];
        acc[4][t][r] = x1 * cs.x - x2 * cs.y; acc[5][t][r] = x2 * cs.x + x1 * cs.y;
      }
#pragma unroll
      for (int i = 0; i < 6; ++i)
        st4(mq + (size_t)tok * 576 + h * 96 + 16 * i + 4 * q, acc[i][t][0] * qscale, acc[i][t][1] * qscale, acc[i][t][2] * qscale, acc[i][t][3] * qscale);
    }
  }
}

DI void prep_mla_kv(const Params& P, int l, int tw0, int lane) {
  const int q = lane >> 4, jn = lane & 15;
  const u16* proj = (const u16*)(P.ws + O_PROJ);
  const u16* W = (const u16*)(P.ws + O_WTUKV) + (size_t)l * 768 * 128;
  u16* mk = (u16*)(P.ws + O_MK);
  u16* mvt = (u16*)(P.ws + O_MVT);
  const float2* r32 = (const float2*)(P.ws + O_R32);
  const float* gk = P.in[10] + l * 96;
  const u16* bp = proj + (size_t)(tw0 + jn) * DINP + C_CKV + q * 8;
  const int b = tw0 >> 12, pos0 = tw0 & (S - 1);
  float rkv[2];
#pragma unroll
  for (int t = 0; t < 2; ++t) {
    float ss = 0.f;
    for (int ks = 0; ks < 4; ++ks) {
      bf16x8 v = ld8(bp + (size_t)t * 16 * DINP + ks * 32);
#pragma unroll
      for (int j = 0; j < 8; ++j) { float f = bf2f((u16)v[j]); ss += f * f; }
    }
    ss = red4(ss);
    rkv[t] = rsqrtf(ss * (1.0f / 128) + EPS);
  }
  for (int h = 0; h < 6; ++h) {
    {
      f32x4 acc[4][2]; zero_acc(acc);
      const u16* ap = W + (size_t)(h * 128 + jn) * 128 + q * 8;
      wgemm<4, 2>(acc, 4, [&](int i, int ks) { return ld8(ap + (size_t)i * 16 * 128 + ks * 32); },
                  [&](int j, int ks) { return ld8(bp + (size_t)j * 16 * DINP + ks * 32); });
#pragma unroll
      for (int t = 0; t < 2; ++t) {
        const int tok = tw0 + 16 * t + jn, pos = tok & (S - 1);
        uint2 pl = ld4(proj + (size_t)tok * DINP + C_KPE + 4 * q);
        uint2 ph = ld4(proj + (size_t)tok * DINP + C_KPE + 16 + 4 * q);
        float kl[4] = {lo2f(pl.x), hi2f(pl.x), lo2f(pl.y), hi2f(pl.y)};
        float kh[4] = {lo2f(ph.x), hi2f(ph.x), lo2f(ph.y), hi2f(ph.y)};
        float ss = 0.f;
#pragma unroll
        for (int i = 0; i < 4; ++i)
#pragma unroll
          for (int r = 0; r < 4; ++r) { float v = acc[i][t][r] * rkv[t]; acc[i][t][r] = v; ss += v * v; }
#pragma unroll
        for (int r = 0; r < 4; ++r) ss += kl[r] * kl[r] + kh[r] * kh[r];
        ss = red4(ss);
        const float rs = rsqrtf(ss * (1.0f / 96) + EPS);
#pragma unroll
        for (int i = 0; i < 4; ++i) {
          const int d = 16 * i + 4 * q;
          st4(mk + (size_t)tok * 576 + h * 96 + d, acc[i][t][0] * rs * gk[d], acc[i][t][1] * rs * gk[d + 1], acc[i][t][2] * rs * gk[d + 2], acc[i][t][3] * rs * gk[d + 3]);
        }
        float y1[4], y2[4];
#pragma unroll
        for (int r = 0; r < 4; ++r) {
          float2 cs = r32[pos * 16 + 4 * q + r];
          float x1 = kl[r] * rs * gk[64 + 4 * q + r], x2 = kh[r] * rs * gk[80 + 4 * q + r];
          y1[r] = x1 * cs.x - x2 * cs.y; y2[r] = x2 * cs.x + x1 * cs.y;
        }
        st4(mk + (size_t)tok * 576 + h * 96 + 64 + 4 * q, y1[0], y1[1], y1[2], y1[3]);
        st4(mk + (size_t)tok * 576 + h * 96 + 80 + 4 * q, y2[0], y2[1], y2[2], y2[3]);
      }
    }
    {
      f32x4 acc[2][4]; zero_acc(acc);
      const u16* wp = W + (size_t)(h * 128 + 64 + jn) * 128 + q * 8;
      wgemm<2, 4>(acc, 4, [&](int i, int ks) { return ld8(bp + (size_t)i * 16 * DINP + ks * 32); },
                  [&](int j, int ks) { return ld8(wp + (size_t)j * 16 * 128 + ks * 32); });
#pragma unroll
      for (int i = 0; i < 2; ++i) {
        float rr[4];
#pragma unroll
        for (int r = 0; r < 4; ++r) rr[r] = __shfl(rkv[i], 4 * q + r);
#pragma unroll
        for (int j = 0; j < 4; ++j)
          st4(mvt + ((size_t)(b * 6 + h) * 64 + 16 * j + jn) * S + pos0 + 16 * i + 4 * q,
              acc[i][j][0] * rr[0], acc[i][j][1] * rr[1], acc[i][j][2] * rr[2], acc[i][j][3] * rr[3]);
      }
    }
  }
}

DI void prep_mla_tile(const Params& P, int l, int tt, char* lds, float* s_r, float* s_ss) {
  const int tid = opaque_tid();
  const int wave = __builtin_amdgcn_readfirstlane(tid >> 6), lane = tid & 63, q = lane >> 4, jn = lane & 15;
  const int wa = wave >> 1, wb = wave & 1;
  const int tok0 = tt * 128;
  const u16* proj = (const u16*)(P.ws + O_PROJ);
  const u16* Wq = (const u16*)(P.ws + O_WTUQ) + (size_t)l * 768 * 256;
  const u16* Wkv = (const u16*)(P.ws + O_WTUKV) + (size_t)l * 768 * 128;
  u16* mq = (u16*)(P.ws + O_MQ); u16* mk = (u16*)(P.ws + O_MK); u16* mvt = (u16*)(P.ws + O_MVT);
  const float2* r32 = (const float2*)(P.ws + O_R32);
  const float* gq = P.in[9] + l * 96; const float* gk = P.in[10] + l * 96;
  {
    const int row = tid >> 1, half = tid & 1;
    const u16* pq = proj + (size_t)(tok0 + row) * DINP + C_CQ + half * 128;
    const u16* pk = proj + (size_t)(tok0 + row) * DINP + C_CKV + half * 64;
    bf16x8 vq[16], vk[8];
#pragma unroll
    for (int u = 0; u < 16; ++u) vq[u] = ld8(pq + u * 8);
#pragma unroll
    for (int u = 0; u < 8; ++u) vk[u] = ld8(pk + u * 8);
    float sq = 0.f, sk = 0.f;
#pragma unroll
    for (int u = 0; u < 16; ++u)
#pragma unroll
      for (int j = 0; j < 8; ++j) { const float f = bf2f((u16)vq[u][j]); sq += f * f; }
#pragma unroll
    for (int u = 0; u < 8; ++u)
#pragma unroll
      for (int j = 0; j < 8; ++j) { const float f = bf2f((u16)vk[u][j]); sk += f * f; }
    sq += __shfl_xor(sq, 1); sk += __shfl_xor(sk, 1);
    if (half == 0) { s_r[row] = rsqrtf(sq * (1.0f / 256) + EPS); s_r[128 + row] = rsqrtf(sk * (1.0f / 128) + EPS); }
  }
  __syncthreads();
  const float qscale = 0.10206207261596577f * LOG2E;
#pragma unroll 1
  for (int h0 = 0; h0 < 6; ++h0) {
    int h = h0; asm volatile("" : "+s"(h));
    f32x4 acc[4][4]; zero_acc(acc);
    gemm_block(acc, Wq + (size_t)(h * 128) * 256, 256, proj + (size_t)tok0 * DINP + C_CQ, DINP, 256, lds, tid);
#pragma unroll
    for (int j = 0; j < 4; ++j) {
      const int tl = wb * 64 + 16 * j + jn; const float rq = s_r[tl];
      float ss = 0.f;
#pragma unroll
      for (int i = 0; i < 4; ++i)
#pragma unroll
        for (int r = 0; r < 4; ++r) { const float v = acc[i][j][r] * rq; acc[i][j][r] = v; ss += v * v; }
      ss = red4(ss);
      if (q == 0) s_ss[wa * 128 + tl] = ss;
    }
    __syncthreads();
#pragma unroll
    for (int j = 0; j < 4; ++j) {
      const int tl = wb * 64 + 16 * j + jn, tok = tok0 + tl, pos = tok & (S - 1);
      const float rs = rsqrtf((s_ss[tl] + s_ss[128 + tl]) * (1.0f / 96) + EPS);
      if (wa == 0) {
#pragma unroll
        for (int i = 0; i < 4; ++i) {
          const int d = 16 * i + 4 * q;
          st4(mq + (size_t)tok * 576 + h * 96 + d, acc[i][j][0] * rs * gq[d] * qscale, acc[i][j][1] * rs * gq[d + 1] * qscale,
              acc[i][j][2] * rs * gq[d + 2] * qscale, acc[i][j][3] * rs * gq[d + 3] * qscale);
        }
      } else {
        float y1[4], y2[4];
#pragma unroll
        for (int r = 0; r < 4; ++r) {
          const float2 cs = r32[pos * 16 + 4 * q + r];
          const float x1 = acc[0][j][r] * rs * gq[64 + 4 * q + r], x2 = acc[1][j][r] * rs * gq[80 + 4 * q + r];
          y1[r] = (x1 * cs.x - x2 * cs.y) * qscale; y2[r] = (x2 * cs.x + x1 * cs.y) * qscale;
        }
        st4(mq + (size_t)tok * 576 + h * 96 + 64 + 4 * q, y1[0], y1[1], y1[2], y1[3]);
        st4(mq + (size_t)tok * 576 + h * 96 + 80 + 4 * q, y2[0], y2[1], y2[2], y2[3]);
      }
    }
    __syncthreads();
  }
  const int b = tok0 >> 12, pos0 = tok0 & (S - 1);
#pragma unroll 1
  for (int h0 = 0; h0 < 6; ++h0) {
    int h = h0; asm volatile("" : "+s"(h));
    f32x4 acc[4][4]; zero_acc(acc);
    gemm_block(acc, Wkv + (size_t)(h * 128) * 128, 128, proj + (size_t)tok0 * DINP + C_CKV, DINP, 128, lds, tid, true);
    if (wa == 0) {
#pragma unroll
      for (int j = 0; j < 4; ++j) {
        const int tl = wb * 64 + 16 * j + jn, tok = tok0 + tl, pos = tok & (S - 1);
        const float rkv = s_r[128 + tl];
        const uint2 pl = ld4(proj + (size_t)tok * DINP + C_KPE + 4 * q);
        const uint2 ph = ld4(proj + (size_t)tok * DINP + C_KPE + 16 + 4 * q);
        const float kl[4] = {lo2f(pl.x), hi2f(pl.x), lo2f(pl.y), hi2f(pl.y)};
        const float kh[4] = {lo2f(ph.x), hi2f(ph.x), lo2f(ph.y), hi2f(ph.y)};
        float ss = 0.f;
#pragma unroll
        for (int i = 0; i < 4; ++i)
#pragma unroll
          for (int r = 0; r < 4; ++r) { const float v = acc[i][j][r] * rkv; acc[i][j][r] = v; ss += v * v; }
#pragma unroll
        for (int r = 0; r < 4; ++r) ss += kl[r] * kl[r] + kh[r] * kh[r];
        ss = red4(ss);
        const float rs = rsqrtf(ss * (1.0f / 96) + EPS);
#pragma unroll
        for (int i = 0; i < 4; ++i) {
          const int d = 16 * i + 4 * q;
          st4(mk + (size_t)tok * 576 + h * 96 + d, acc[i][j][0] * rs * gk[d], acc[i][j][1] * rs * gk[d + 1], acc[i][j][2] * rs * gk[d + 2], acc[i][j][3] * rs * gk[d + 3]);
        }
        float y1[4], y2[4];
#pragma unroll
        for (int r = 0; r < 4; ++r) {
          const float2 cs = r32[pos * 16 + 4 * q + r];
          const float x1 = kl[r] * rs * gk[64 + 4 * q + r], x2 = kh[r] * rs * gk[80 + 4 * q + r];
          y1[r] = x1 * cs.x - x2 * cs.y; y2[r] = x2 * cs.x + x1 * cs.y;
        }
        st4(mk + (size_t)tok * 576 + h * 96 + 64 + 4 * q, y1[0], y1[1], y1[2], y1[3]);
        st4(mk + (size_t)tok * 576 + h * 96 + 80 + 4 * q, y2[0], y2[1], y2[2], y2[3]);
      }
    } else {
#pragma unroll
      for (int i = 0; i < 4; ++i) {
        const int tl0 = wb * 64 + 16 * i + 4 * q;
        const float r0 = s_r[128 + tl0], r1 = s_r[128 + tl0 + 1], r2 = s_r[128 + tl0 + 2], r3 = s_r[128 + tl0 + 3];
#pragma unroll
        for (int j = 0; j < 4; ++j)
          st4(mvt + ((size_t)(b * 6 + h) * 64 + 16 * j + jn) * S + pos0 + tl0, acc[i][j][0] * r0, acc[i][j][1] * r1, acc[i][j][2] * r2, acc[i][j][3] * r3);
      }
    }
  }
}

DI void prep_dsa(const Params& P, int l, int tok0) {
  u16* proj = (u16*)(P.ws + O_PROJ);
  u16* avt = (u16*)(P.ws + O_AVT);
  const float2* r64 = (const float2*)(P.ws + O_R64);
  const float2* r32 = (const float2*)(P.ws + O_R32);
  const int tid = opaque_tid();
  for (int task = tid; task < 512; task += 256) {
    const int tok = tok0 + (task >> 2), c = task & 3, pos = tok & (S - 1);
    u16* row = proj + (size_t)tok * DINP;
    bf16x8 lo[7], hi[7];
#pragma unroll
    for (int hh = 0; hh < 7; ++hh) {
      const int base = (hh < 6) ? C_QA + 64 * hh : C_KA;
      lo[hh] = ld8(row + base + 8 * c); hi[hh] = ld8(row + base + 32 + 8 * c);
    }
    float2 cs[8];
    float gql[8], gqh[8], gkl[8], gkh[8];
    const float* gq = P.in[3] + l * 64; const float* gk = P.in[4] + l * 64;
#pragma unroll
    for (int j = 0; j < 8; ++j) {
      cs[j] = r64[pos * 32 + 8 * c + j];
      gql[j] = gq[8 * c + j]; gqh[j] = gq[32 + 8 * c + j]; gkl[j] = gk[8 * c + j]; gkh[j] = gk[32 + 8 * c + j];
    }
#pragma unroll
    for (int hh = 0; hh < 7; ++hh) {
      const int base = (hh < 6) ? C_QA + 64 * hh : C_KA;
      float xl[8], xh[8];
      float ss = 0.f;
#pragma unroll
      for (int j = 0; j < 8; ++j) { xl[j] = bf2f((u16)lo[hh][j]); xh[j] = bf2f((u16)hi[hh][j]); ss += xl[j] * xl[j] + xh[j] * xh[j]; }
      ss += __shfl_xor(ss, 1); ss += __shfl_xor(ss, 2);
      const float rs = rsqrtf(ss * (1.0f / 64) + EPS);
      const float sc = (hh < 6) ? 0.125f * LOG2E : 1.0f;
      float y1[8], y2[8];
#pragma unroll
      for (int j = 0; j < 8; ++j) {
        const float x1 = xl[j] * rs * ((hh < 6) ? gql[j] : gkl[j]), x2 = xh[j] * rs * ((hh < 6) ? gqh[j] : gkh[j]);
        y1[j] = (x1 * cs[j].x - x2 * cs[j].y) * sc; y2[j] = (x2 * cs[j].x + x1 * cs[j].y) * sc;
      }
      uint4 o; o.x = pack2(y1[0], y1[1]); o.y = pack2(y1[2], y1[3]); o.z = pack2(y1[4], y1[5]); o.w = pack2(y1[6], y1[7]);
      *reinterpret_cast<uint4*>(row + base + 8 * c) = o;
      o.x = pack2(y2[0], y2[1]); o.y = pack2(y2[2], y2[3]); o.z = pack2(y2[4], y2[5]); o.w = pack2(y2[6], y2[7]);
      *reinterpret_cast<uint4*>(row + base + 32 + 8 * c) = o;
    }
  }
  {
    const int tok = tok0 + (tid >> 1), c2 = tid & 1, pos = tok & (S - 1);
    u16* row = proj + (size_t)tok * DINP;
    bf16x8 lo[9], hi[9];
#pragma unroll
    for (int hh = 0; hh < 9; ++hh) {
      const int base = (hh < 8) ? C_IQ + 32 * hh : C_IK;
      lo[hh] = ld8(row + base + 8 * c2); hi[hh] = ld8(row + base + 16 + 8 * c2);
    }
    float2 cs[8];
#pragma unroll
    for (int j = 0; j < 8; ++j) cs[j] = r32[pos * 16 + 8 * c2 + j];
#pragma unroll
    for (int hh = 0; hh < 9; ++hh) {
      const int base = (hh < 8) ? C_IQ + 32 * hh : C_IK;
      float y1[8], y2[8];
#pragma unroll
      for (int j = 0; j < 8; ++j) {
        const float x1 = bf2f((u16)lo[hh][j]), x2 = bf2f((u16)hi[hh][j]);
        y1[j] = x1 * cs[j].x - x2 * cs[j].y; y2[j] = x2 * cs[j].x + x1 * cs[j].y;
      }
      uint4 o; o.x = pack2(y1[0], y1[1]); o.y = pack2(y1[2], y1[3]); o.z = pack2(y1[4], y1[5]); o.w = pack2(y1[6], y1[7]);
      *reinterpret_cast<uint4*>(row + base + 8 * c2) = o;
      o.x = pack2(y2[0], y2[1]); o.y = pack2(y2[2], y2[3]); o.z = pack2(y2[4], y2[5]); o.w = pack2(y2[6], y2[7]);
      *reinterpret_cast<uint4*>(row + base + 16 + 8 * c2) = o;
    }
  }
  {
    const int b = tok0 >> 12, pos0 = tok0 & (S - 1);
    const int dim = tid & 63, tg0 = tid >> 6;
    unsigned short v[8][4];
#pragma unroll
    for (int u = 0; u < 8; ++u) {
      const u16* p = proj + (size_t)(tok0 + 4 * (tg0 + 4 * u)) * DINP + C_VA + dim;
#pragma unroll
      for (int k = 0; k < 4; ++k) v[u][k] = p[k * DINP];
    }
#pragma unroll
    for (int u = 0; u < 8; ++u) {
      uint2 o; o.x = (unsigned)v[u][0] | ((unsigned)v[u][1] << 16); o.y = (unsigned)v[u][2] | ((unsigned)v[u][3] << 16);
      *reinterpret_cast<uint2*>(avt + ((size_t)b * 64 + dim) * S + pos0 + 4 * (tg0 + 4 * u)) = o;
    }
  }
}

DI void prep_tile(const Params& P, int l, int tile, char* lds, float* s_r) {
  const int tid = opaque_tid();
  const int wave = __builtin_amdgcn_readfirstlane(tid >> 6), lane = tid & 63;
  const int tok0 = tile * 128;
  prep_mla_tile(P, l, tile, lds, s_r, s_r + 256);
  prep_dsa(P, l, tok0);
}

DI void inproj_tile(const Params& P, int l, int tt, char* lds, float* s_rstd, float* s_prep) {
  const u16* W = (const u16*)(P.ws + O_WTIN) + (size_t)l * DINP * DM;
  const u16* xb = (const u16*)(P.ws + O_XB2);
  u16* proj = (u16*)(P.ws + O_PROJ);
  const int tid = opaque_tid();
  const int wave = __builtin_amdgcn_readfirstlane(tid >> 6), lane = tid & 63, q = lane >> 4, jn = lane & 15;
  {
    {
      const u16* rp = xb + (size_t)(tt * 128 + (tid >> 1)) * DM + (tid & 1) * 512;
      float ss = 0.f;
#pragma unroll 1
      for (int c = 0; c < 8; ++c) {
        bf16x8 v[8];
#pragma unroll
        for (int u = 0; u < 8; ++u) v[u] = ld8(rp + (c * 8 + u) * 8);
#pragma unroll
        for (int u = 0; u < 8; ++u)
#pragma unroll
          for (int j = 0; j < 8; ++j) { const float f = bf2f((u16)v[u][j]); ss += f * f; }
      }
      ss += __shfl_xor(ss, 1);
      if ((tid & 1) == 0) s_rstd[tid >> 1] = rsqrtf(ss * (1.0f / DM) + EPS);
    }
    __syncthreads();
#pragma unroll 1
    for (int ftile0 = 0; ftile0 < 20; ++ftile0) {
      int ftile = ftile0; asm volatile("" : "+s"(ftile));
      const int f0 = ftile * 128 + (wave >> 1) * 64, t0 = tt * 128 + (wave & 1) * 64;
      f32x4 acc[4][4]; zero_acc(acc);
      gemm_block(acc, W + (size_t)(ftile * 128) * DM, DM, xb + (size_t)(tt * 128) * DM, DM, DM, lds, tid);
#pragma unroll
      for (int j = 0; j < 4; ++j) {
        const int tok = t0 + 16 * j + jn; const float rs = s_rstd[(wave & 1) * 64 + 16 * j + jn];
#pragma unroll
        for (int i = 0; i < 4; ++i)
          st4(proj + (size_t)tok * DINP + f0 + 16 * i + 4 * q, acc[i][j][0] * rs, acc[i][j][1] * rs, acc[i][j][2] * rs, acc[i][j][3] * rs);
      }
    }
    asm volatile("s_waitcnt vmcnt(0)" ::: "memory");
    __syncthreads();
    prep_tile(P, l, tt, lds, s_prep);
    __syncthreads();
  }
}

DI void phase_inproj(const Params& P, int l, char* lds, float* s_rstd, float* s_prep) {
  for (int tt = blockIdx.x; tt < 512; tt += gridDim.x) inproj_tile(P, l, tt, lds, s_rstd, s_prep);
}

template <int KS, bool MASK>
DI void attn_block_v1(const u16* Qp, int qstride, const u16* Kp, int kstride, const u16* Vtp, const u64* maskp, int nkt_w, int nkt_max,
                   const u16* gatep, int gstride, u16* outp, int ostride, char* lds, int tid) {
  constexpr int DQK = KS * 32, KROW = DQK + 8, VROW = 72;
  constexpr int KCH = DQK / 8, NKC = 64 * KCH / 256;
  constexpr int K_BYTES = 64 * KROW * 2, BUF_BYTES = K_BYTES + 64 * VROW * 2;
  const int lane = tid & 63, q = lane >> 4, jn = lane & 15;
  const float NEG_INF = -__builtin_inff();
  uint4 kst[NKC], vst[2];
  auto gload = [&](int kt) {
#pragma unroll
    for (int i = 0; i < NKC; ++i) {
      const int c = tid + 256 * i, row = c / KCH, col = c % KCH;
      kst[i] = *reinterpret_cast<const uint4*>(Kp + (size_t)(kt * 64 + row) * kstride + col * 8);
    }
#pragma unroll
    for (int i = 0; i < 2; ++i) {
      const int c = tid + 256 * i, dim = c >> 3, part = c & 7;
      vst[i] = *reinterpret_cast<const uint4*>(Vtp + (size_t)dim * S + kt * 64 + part * 8);
    }
  };
  auto lstore = [&](int buf) {
    char* kb = lds + buf * BUF_BYTES; char* vb = kb + K_BYTES;
#pragma unroll
    for (int i = 0; i < NKC; ++i) {
      const int c = tid + 256 * i, row = c / KCH, col = c % KCH;
      *reinterpret_cast<uint4*>(kb + (row * KROW + col * 8) * 2) = kst[i];
    }
#pragma unroll
    for (int i = 0; i < 2; ++i) {
      const int c = tid + 256 * i, dim = c >> 3, part = c & 7;
      *reinterpret_cast<uint4*>(vb + (dim * VROW + part * 8) * 2) = vst[i];
    }
  };
  bf16x8 qf[2][KS];
#pragma unroll
  for (int c = 0; c < 2; ++c)
#pragma unroll
    for (int ks = 0; ks < KS; ++ks) qf[c][ks] = ld8(Qp + (size_t)(16 * c + jn) * qstride + ks * 32 + q * 8);
  f32x4 o[4][2]; zero_acc(o);
  float m[2] = {NEG_INF, NEG_INF}, lsum[2] = {0.f, 0.f};
  u64 mw[2] = {0ull, 0ull}, mwn[2] = {0ull, 0ull};
  if (MASK) {
#pragma unroll
    for (int c = 0; c < 2; ++c) mw[c] = maskp[(size_t)(16 * c + jn) * 64];
  }
  gload(0);
  lstore(0);
  __syncthreads();
  for (int kt = 0; kt < nkt_max; ++kt) {
    const bool more = kt + 1 < nkt_max;
    if (more) {
      gload(kt + 1);
      if (MASK) {
        if (kt + 1 < nkt_w) {
#pragma unroll
          for (int c = 0; c < 2; ++c) mwn[c] = maskp[(size_t)(16 * c + jn) * 64 + kt + 1];
        }
      }
    }
    if (kt < nkt_w) {
      const char* kb = lds + (kt & 1) * BUF_BYTES; const char* vb = kb + K_BYTES;
      f32x4 s[4][2]; zero_acc(s);
#pragma unroll
      for (int a = 0; a < 4; ++a)
#pragma unroll
        for (int ks = 0; ks < KS; ++ks) {
          const bf16x8 kf = *reinterpret_cast<const bf16x8*>(kb + ((16 * a + jn) * KROW + ks * 32 + q * 8) * 2);
#pragma unroll
          for (int c = 0; c < 2; ++c) s[a][c] = mfma16(kf, qf[c][ks], s[a][c]);
        }
      if (MASK) {
#pragma unroll
        for (int c = 0; c < 2; ++c) {
          const u64 w = mw[c] >> (4 * q);
#pragma unroll
          for (int a = 0; a < 4; ++a)
#pragma unroll
            for (int r = 0; r < 4; ++r)
              if (!((w >> (16 * a + r)) & 1ull)) s[a][c][r] = NEG_INF;
        }
      }
      float alpha[2];
#pragma unroll
      for (int c = 0; c < 2; ++c) {
        float mx = NEG_INF;
#pragma unroll
        for (int a = 0; a < 4; ++a)
#pragma unroll
          for (int r = 0; r < 4; ++r) mx = fmaxf(mx, s[a][c][r]);
        mx = fmaxf(mx, __shfl_xor(mx, 16)); mx = fmaxf(mx, __shfl_xor(mx, 32));
        const float mn = fmaxf(m[c], mx);
        const float mu = (mn == NEG_INF) ? 0.f : mn;
        alpha[c] = fexp2(m[c] - mu);
        m[c] = mn;
        float ps = 0.f;
#pragma unroll
        for (int a = 0; a < 4; ++a)
#pragma unroll
          for (int r = 0; r < 4; ++r) { float p = fexp2(s[a][c][r] - mu); s[a][c][r] = p; ps += p; }
        lsum[c] = lsum[c] * alpha[c] + ps;
      }
      if (__builtin_amdgcn_ballot_w64(alpha[0] != 1.0f || alpha[1] != 1.0f) != 0ull) {
#pragma unroll
        for (int c = 0; c < 2; ++c)
#pragma unroll
          for (int dt = 0; dt < 4; ++dt)
#pragma unroll
            for (int r = 0; r < 4; ++r) o[dt][c][r] *= alpha[c];
      }
#pragma unroll
      for (int kk = 0; kk < 2; ++kk) {
        bf16x8 pf[2];
#pragma unroll
        for (int c = 0; c < 2; ++c) {
          uint4 w; w.x = pack2(s[2 * kk][c][0], s[2 * kk][c][1]); w.y = pack2(s[2 * kk][c][2], s[2 * kk][c][3]);
          w.z = pack2(s[2 * kk + 1][c][0], s[2 * kk + 1][c][1]); w.w = pack2(s[2 * kk + 1][c][2], s[2 * kk + 1][c][3]);
          pf[c] = __builtin_bit_cast(bf16x8, w);
        }
#pragma unroll
        for (int dt = 0; dt < 4; ++dt) {
          const char* vp = vb + ((16 * dt + jn) * VROW + kk * 32 + 4 * q) * 2;
          const uint2 lo = *reinterpret_cast<const uint2*>(vp), hi = *reinterpret_cast<const uint2*>(vp + 32);
          uint4 w; w.x = lo.x; w.y = lo.y; w.z = hi.x; w.w = hi.y;
          const bf16x8 vf = __builtin_bit_cast(bf16x8, w);
#pragma unroll
          for (int c = 0; c < 2; ++c) o[dt][c] = mfma16(vf, pf[c], o[dt][c]);
        }
      }
    }
    if (more) lstore((kt + 1) & 1);
    if (MASK) { mw[0] = mwn[0]; mw[1] = mwn[1]; }
    __syncthreads();
  }
#pragma unroll
  for (int c = 0; c < 2; ++c) {
    const float inv = 1.0f / red4(lsum[c]);
    const int row = 16 * c + jn;
#pragma unroll
    for (int dt = 0; dt < 4; ++dt) {
      uint2 gw = ld4(gatep + (size_t)row * gstride + 16 * dt + 4 * q);
      st4(outp + (size_t)row * ostride + 16 * dt + 4 * q, o[dt][c][0] * inv * siluf_(lo2f(gw.x)), o[dt][c][1] * inv * siluf_(hi2f(gw.x)),
          o[dt][c][2] * inv * siluf_(lo2f(gw.y)), o[dt][c][3] * inv * siluf_(hi2f(gw.y)));
    }
  }
}

template <int KS, bool MASK, int NC, bool SH>
DI void attn_block(const u16* Qp, int qstride, const u16* Kp, int kstride, const u16* Vtp, const u64* maskp, int nkt_w, int nkt_max,
                   const u16* gatep, int gstride, u16* outp, int ostride, char* lds, int tid) {
  constexpr int DQK = KS * 32, KROW = DQK + 8, VROW = 72;
  constexpr int KCH = DQK / 8, NKC = 64 * KCH / 256;
  constexpr int K_BYTES = 64 * KROW * 2, BUF_BYTES = K_BYTES + 64 * VROW * 2;
  const int lane = tid & 63, q = lane >> 4, jn = lane & 15;
  const float NEG_INF = -__builtin_inff();
  uint4 xk0, xk1, xk2, xv0, xv1, yk0, yk1, yk2, yv0, yv1;
  xk2 = yk2 = make_uint4(0, 0, 0, 0);
  const int c0 = tid, c1 = tid + 256, c2 = tid + 512;
  const u16* kg0 = Kp + (size_t)(c0 / KCH) * kstride + (c0 % KCH) * 8;
  const u16* kg1 = Kp + (size_t)(c1 / KCH) * kstride + (c1 % KCH) * 8;
  const u16* kg2 = Kp + (size_t)(c2 / KCH) * kstride + (c2 % KCH) * 8;
  const u16* vg0 = Vtp + (size_t)(c0 >> 3) * S + (c0 & 7) * 8;
  const u16* vg1 = Vtp + (size_t)(c1 >> 3) * S + (c1 & 7) * 8;
  char* ks0 = lds + ((c0 / KCH) * KROW + (c0 % KCH) * 8) * 2;
  char* ks1 = lds + ((c1 / KCH) * KROW + (c1 % KCH) * 8) * 2;
  char* ks2 = lds + ((c2 / KCH) * KROW + (c2 % KCH) * 8) * 2;
  char* vs0 = lds + K_BYTES + ((c0 >> 3) * VROW + (c0 & 7) * 8) * 2;
  char* vs1 = lds + K_BYTES + ((c1 >> 3) * VROW + (c1 & 7) * 8) * 2;
#define A_LOAD(P, kt) { const size_t ko = (size_t)(kt) * 64 * kstride; const int vo = (kt) * 64;                     \
    P##k0 = *reinterpret_cast<const uint4*>(kg0 + ko); P##k1 = *reinterpret_cast<const uint4*>(kg1 + ko);            \
    if (NKC == 3) P##k2 = *reinterpret_cast<const uint4*>(kg2 + ko);                                                 \
    P##v0 = *reinterpret_cast<const uint4*>(vg0 + vo); P##v1 = *reinterpret_cast<const uint4*>(vg1 + vo); }
#define A_STORE(P, buf) { *reinterpret_cast<uint4*>(ks0 + (buf) * BUF_BYTES) = P##k0; *reinterpret_cast<uint4*>(ks1 + (buf) * BUF_BYTES) = P##k1; \
    if (NKC == 3) *reinterpret_cast<uint4*>(ks2 + (buf) * BUF_BYTES) = P##k2;                                        \
    *reinterpret_cast<uint4*>(vs0 + (buf) * BUF_BYTES) = P##v0; *reinterpret_cast<uint4*>(vs1 + (buf) * BUF_BYTES) = P##v1; }
  bf16x8 qf[NC][KS];
#pragma unroll
  for (int c = 0; c < NC; ++c)
#pragma unroll
    for (int ks = 0; ks < KS; ++ks) qf[c][ks] = ld8(Qp + (size_t)((SH ? 0 : 16 * c) + jn) * qstride + (SH ? 64 * c : 0) + ks * 32 + q * 8);
  f32x4 o[4][NC]; zero_acc(o);
  float m[NC], lsum[NC];
#pragma unroll
  for (int c = 0; c < NC; ++c) { m[c] = NEG_INF; lsum[c] = 0.f; }
  u64 mce0 = 0ull, mce1 = 0ull, mco0 = 0ull, mco1 = 0ull, mne0 = 0ull, mne1 = 0ull, mno0 = 0ull, mno1 = 0ull;
  const u64* mrow0 = maskp + (size_t)jn * 64;
  const u64* mrow1 = maskp + (size_t)(16 + jn) * 64;
  if (MASK) {
    mce0 = mrow0[0]; if (!SH) mce1 = mrow1[0];
    if (1 < nkt_w) { mco0 = mrow0[1]; if (!SH) mco1 = mrow1[1]; }
  }
  auto compute = [&](int buf, u64 w0, u64 w1) {
    const char* kb = lds + buf * BUF_BYTES; const char* vb = kb + K_BYTES;
    f32x4 s[4][NC]; zero_acc(s);
#pragma unroll
    for (int a = 0; a < 4; ++a)
#pragma unroll
      for (int ks = 0; ks < KS; ++ks) {
        const bf16x8 kf = *reinterpret_cast<const bf16x8*>(kb + ((16 * a + jn) * KROW + ks * 32 + q * 8) * 2);
#pragma unroll
        for (int c = 0; c < NC; ++c) s[a][c] = mfma16(kf, qf[c][ks], s[a][c]);
      }
    if (MASK) {
#pragma unroll
      for (int c = 0; c < NC; ++c) {
        const u64 w = ((SH || c == 0) ? w0 : w1) >> (4 * q);
#pragma unroll
        for (int a = 0; a < 4; ++a)
#pragma unroll
          for (int r = 0; r < 4; ++r)
            if (!((w >> (16 * a + r)) & 1ull)) s[a][c][r] = NEG_INF;
      }
    }
    float alpha[NC];
#pragma unroll
    for (int c = 0; c < NC; ++c) {
      float mx = NEG_INF;
#pragma unroll
      for (int a = 0; a < 4; ++a)
#pragma unroll
        for (int r = 0; r < 4; ++r) mx = fmaxf(mx, s[a][c][r]);
      mx = fmaxf(mx, __shfl_xor(mx, 16)); mx = fmaxf(mx, __shfl_xor(mx, 32));
      const float mn = fmaxf(m[c], mx);
      const float mu = (mn == NEG_INF) ? 0.f : mn;
      alpha[c] = fexp2(m[c] - mu);
      m[c] = mn;
      float ps = 0.f;
#pragma unroll
      for (int a = 0; a < 4; ++a)
#pragma unroll
        for (int r = 0; r < 4; ++r) { float p = fexp2(s[a][c][r] - mu); s[a][c][r] = p; ps += p; }
      lsum[c] = lsum[c] * alpha[c] + ps;
    }
    bool resc = false;
#pragma unroll
    for (int c = 0; c < NC; ++c) resc = resc || (alpha[c] != 1.0f);
    if (__builtin_amdgcn_ballot_w64(resc) != 0ull) {
#pragma unroll
      for (int c = 0; c < NC; ++c)
#pragma unroll
        for (int dt = 0; dt < 4; ++dt)
#pragma unroll
          for (int r = 0; r < 4; ++r) o[dt][c][r] *= alpha[c];
    }
#pragma unroll
    for (int kk = 0; kk < 2; ++kk) {
      bf16x8 pf[NC];
#pragma unroll
      for (int c = 0; c < NC; ++c) {
        uint4 w; w.x = pack2(s[2 * kk][c][0], s[2 * kk][c][1]); w.y = pack2(s[2 * kk][c][2], s[2 * kk][c][3]);
        w.z = pack2(s[2 * kk + 1][c][0], s[2 * kk + 1][c][1]); w.w = pack2(s[2 * kk + 1][c][2], s[2 * kk + 1][c][3]);
        pf[c] = __builtin_bit_cast(bf16x8, w);
      }
#pragma unroll
      for (int dt = 0; dt < 4; ++dt) {
        const char* vp = vb + ((16 * dt + jn) * VROW + kk * 32 + 4 * q) * 2;
        const uint2 lo = *reinterpret_cast<const uint2*>(vp), hi = *reinterpret_cast<const uint2*>(vp + 32);
        uint4 w; w.x = lo.x; w.y = lo.y; w.z = hi.x; w.w = hi.y;
        const bf16x8 vf = __builtin_bit_cast(bf16x8, w);
#pragma unroll
        for (int c = 0; c < NC; ++c) o[dt][c] = mfma16(vf, pf[c], o[dt][c]);
      }
    }
  };

  A_LOAD(x, 0);
  { const int t1 = (nkt_max > 1) ? 1 : 0; A_LOAD(y, t1); }
  A_STORE(x, 0);
  __syncthreads();
  for (int kt = 0; kt < nkt_max; kt += 2) {
    const bool more = kt + 2 < nkt_max;
    if (more) {
      A_LOAD(x, kt + 2);
      if (MASK) {
        if (kt + 2 < nkt_w) { mne0 = mrow0[kt + 2]; if (!SH) mne1 = mrow1[kt + 2]; }
        if (kt + 3 < nkt_w) { mno0 = mrow0[kt + 3]; if (!SH) mno1 = mrow1[kt + 3]; }
      }
    }
    if (kt < nkt_w) compute(0, mce0, mce1);
    A_STORE(y, 1);
    __syncthreads();
    if (kt + 3 < nkt_max) A_LOAD(y, kt + 3);
    if (kt + 1 < nkt_w) compute(1, mco0, mco1);
    if (more) A_STORE(x, 0);
    if (MASK) { mce0 = mne0; mce1 = mne1; mco0 = mno0; mco1 = mno1; }
    __syncthreads();
  }
#undef A_LOAD
#undef A_STORE
#pragma unroll
  for (int c = 0; c < NC; ++c) {
    const float inv = 1.0f / red4(lsum[c]);
    const int row = (SH ? 0 : 16 * c) + jn;
    const int hc = SH ? 64 * c : 0;
#pragma unroll
    for (int dt = 0; dt < 4; ++dt) {
      uint2 gw = ld4(gatep + (size_t)row * gstride + hc + 16 * dt + 4 * q);
      st4(outp + (size_t)row * ostride + hc + 16 * dt + 4 * q, o[dt][c][0] * inv * siluf_(lo2f(gw.x)), o[dt][c][1] * inv * siluf_(hi2f(gw.x)),
          o[dt][c][2] * inv * siluf_(lo2f(gw.y)), o[dt][c][3] * inv * siluf_(hi2f(gw.y)));
    }
  }
}

DI void mla_attn_item(const Params& P, int it, char* lds, int tid) {
  const int wave = __builtin_amdgcn_readfirstlane(tid >> 6);
  const int sh = it & 7, mloc = it >> 3;
  const int qb = 31 - (mloc & 31), bh = sh + 8 * (mloc >> 5), b = bh / 6, h = bh % 6;
  const int q0 = qb * 128 + wave * 32;
  const int nkt = (q0 >> 6) + 1;
  const u16* mq = (const u16*)(P.ws + O_MQ); const u16* mk = (const u16*)(P.ws + O_MK); const u16* mvt = (const u16*)(P.ws + O_MVT);
  const u16* proj = (const u16*)(P.ws + O_PROJ); u16* mixed = (u16*)(P.ws + O_XB);
  const size_t tok = (size_t)b * S + q0;
  attn_block<3, false, 2, false>(mq + tok * 576 + h * 96, 576, mk + (size_t)b * S * 576 + h * 96, 576, mvt + (size_t)(b * 6 + h) * 64 * S, nullptr, nkt, 2 * qb + 2,
                       proj + tok * DINP + C_GC + h * 64, DINP, mixed + tok * DM + 640 + h * 64, DM, lds, tid);
}

DI void dsa_attn_item(const Params& P, int it, char* lds, int tid) {
  const int wave = __builtin_amdgcn_readfirstlane(tid >> 6);
  const int ch = 63 - it / 32, bh = it % 32, b = bh >> 1, hg = bh & 1;
  const int q0 = ch * 64 + wave * 16;
  const int nkt = ch + 1;
  const u16* proj = (const u16*)(P.ws + O_PROJ); const u16* avt = (const u16*)(P.ws + O_AVT); u16* mixed = (u16*)(P.ws + O_XB);
  const u64* mask = (const u64*)(P.ws + O_MASK);
  const size_t tok = (size_t)b * S + q0;
  attn_block<2, true, 3, true>(proj + tok * DINP + C_QA + hg * 192, DINP, proj + (size_t)b * S * DINP + C_KA, DINP, avt + (size_t)b * 64 * S, mask + tok * 64, nkt, nkt,
                               proj + tok * DINP + C_GA + hg * 192, DINP, mixed + tok * DM + hg * 192, DM, lds, tid);
}

constexpr int SC_STRIDE = 4096 + 16;
DI unsigned fkey(float f) { unsigned u = __float_as_uint(f); return (u & 0x80000000u) ? ~u : (u | 0x80000000u); }
DI float funkey(unsigned k) { return __uint_as_float((k & 0x80000000u) ? (k ^ 0x80000000u) : ~k); }

template <int NR>
DI u64 select_wave(float* scw, int nreg, int lane) {
  unsigned key[NR];
  unsigned kmin = 0xffffffffu, kmax = 0u;
#pragma unroll
  for (int r = 0; r < NR; ++r) {
    const unsigned k = fkey(scw[64 * r + lane]);
    const bool ok = r < nreg;
    key[r] = ok ? k : 0u;
    kmin = min(kmin, ok ? k : 0xffffffffu); kmax = max(kmax, key[r]);
  }
#pragma unroll
  for (int o = 1; o < 64; o <<= 1) { kmin = min(kmin, (unsigned)__shfl_xor((int)kmin, o)); kmax = max(kmax, (unsigned)__shfl_xor((int)kmax, o)); }
  unsigned lo = __builtin_amdgcn_readfirstlane(kmin), hi = __builtin_amdgcn_readfirstlane(kmax);
  int clo = 64 * nreg, chi = 0;
  bool exact = false;
  int iter = 0;
  while (lo < hi && clo - chi > 512) {
    unsigned mid = fkey(0.5f * (funkey(lo) + funkey(hi)));
    if (iter >= 16) mid = lo + ((hi - lo + 1u) >> 1);
    if (mid <= lo) mid = lo + 1;
    if (mid > hi) mid = hi;
    ++iter;
    int cnt = 0;
#pragma unroll
    for (int r = 0; r < NR; ++r) cnt += __builtin_popcountll(__builtin_amdgcn_ballot_w64(key[r] >= mid));
    if (cnt >= 256) { lo = mid; clo = cnt; if (cnt == 256) { exact = true; break; } }
    else { hi = mid - 1; chi = cnt; }
  }
  if (!exact && lo < hi) {
    unsigned* cand = reinterpret_cast<unsigned*>(scw);
    int base = 0;
#pragma unroll
    for (int r = 0; r < NR; ++r) {
      const bool pred = (key[r] >= lo) && (key[r] <= hi);
      const u64 bal = __builtin_amdgcn_ballot_w64(pred);
      const int pos = base + __builtin_amdgcn_mbcnt_hi((unsigned)(bal >> 32), __builtin_amdgcn_mbcnt_lo((unsigned)bal, 0u));
      if (pred) cand[pos] = key[r];
      base += __builtin_popcountll(bal);
    }
    __builtin_amdgcn_fence(__ATOMIC_RELEASE, "wavefront");
    __builtin_amdgcn_fence(__ATOMIC_ACQUIRE, "wavefront");
    unsigned ck[8];
#pragma unroll
    for (int i = 0; i < 8; ++i) { const unsigned v = cand[64 * i + lane]; ck[i] = (64 * i + lane < base) ? v : 0u; }
    const int cabove = chi;
    while (lo < hi) {
      unsigned mid = fkey(0.5f * (funkey(lo) + funkey(hi)));
      if (iter >= 16) mid = lo + ((hi - lo + 1u) >> 1);
      if (mid <= lo) mid = lo + 1;
      if (mid > hi) mid = hi;
      ++iter;
      int cnt = cabove;
#pragma unroll
      for (int i = 0; i < 8; ++i) cnt += __builtin_popcountll(__builtin_amdgcn_ballot_w64(ck[i] >= mid));
      if (cnt >= 256) { lo = mid; if (cnt == 256) { exact = true; break; } }
      else { hi = mid - 1; }
    }
  }
  const unsigned thr = lo;
  u64 myword = 0ull;
  if (exact) {
#pragma unroll
    for (int r = 0; r < NR; ++r) { const u64 bal = __builtin_amdgcn_ballot_w64(key[r] >= thr); if (lane == r) myword = bal; }
  } else {
    int cgt = 0;
#pragma unroll
    for (int r = 0; r < NR; ++r) cgt += __builtin_popcountll(__builtin_amdgcn_ballot_w64(key[r] > thr));
    const int need = 256 - cgt;
    int run = 0;
    const u64 below = (1ull << lane) - 1ull;
#pragma unroll
    for (int r = 0; r < NR; ++r) {
      const u64 eq = __builtin_amdgcn_ballot_w64(key[r] == thr);
      const int rank = run + __builtin_popcountll(eq & below);
      const bool sel = (key[r] > thr) || ((key[r] == thr) && (rank < need));
      const u64 bal = __builtin_amdgcn_ballot_w64(sel);
      run += __builtin_popcountll(eq);
      if (lane == r) myword = bal;
    }
  }
  return myword;
}

DI void dsa_select_item(const Params& P, int it, float* sc, int wave, int lane) {
  const int qd = 1023 - it / 16, b = it % 16;
  const int t0 = qd * 4;
  const int N = ((t0 >> 6) + 1) * 64, nreg = N >> 6;
  const u16* base = (const u16*)(P.ws + O_PROJ) + (size_t)b * S * DINP;
  u64* mask = (u64*)(P.ws + O_MASK);
  const int q = lane >> 4, jn = lane & 15;
  if (N > 256) {
    const bf16x8 a0 = ld8(base + (size_t)(t0 + (jn >> 2)) * DINP + C_IQ + (jn & 3) * 32 + q * 8);
    const bf16x8 a1 = ld8(base + (size_t)(t0 + (jn >> 2)) * DINP + C_IQ + (4 + (jn & 3)) * 32 + q * 8);
    float w[8];
    {
      bf16x8 wv = ld8(base + (size_t)(t0 + q) * DINP + C_IW);
#pragma unroll
      for (int h = 0; h < 8; ++h) w[h] = bf2f((u16)wv[h]) * (0.35355339059327373f * 0.17677669529663687f);
    }
    const int tpw = N >> 6;
    const u16* kbase = base + (size_t)jn * DINP + C_IK + q * 8;
    for (int tl = 0; tl < tpw; tl += 16) {
      bf16x8 bk[16];
#pragma unroll
      for (int u = 0; u < 16; ++u) {
        const int t = (tl + u < tpw) ? tl + u : tpw - 1;
        bk[u] = ld8(kbase + (size_t)((wave * tpw + t) * 16) * DINP);
      }
#pragma unroll
      for (int u = 0; u < 16; ++u) {
        const int t = (tl + u < tpw) ? tl + u : tpw - 1;
        const int key0 = (wave * tpw + t) * 16;
        const f32x4 z = {0.f, 0.f, 0.f, 0.f};
        f32x4 d0 = mfma16(a0, bk[u], z), d1 = mfma16(a1, bk[u], z);
        float sv = 0.f;
#pragma unroll
        for (int r = 0; r < 4; ++r) sv += fmaxf(d0[r], 0.f) * w[r];
#pragma unroll
        for (int r = 0; r < 4; ++r) sv += fmaxf(d1[r], 0.f) * w[4 + r];
        sc[q * SC_STRIDE + key0 + jn] = sv;
      }
    }
  }
  __syncthreads();
  u64 myword = ~0ull;
  if (N > 256) {
    float* scw = sc + wave * SC_STRIDE;
    if (nreg <= 8) myword = select_wave<8>(scw, nreg, lane);
    else if (nreg <= 16) myword = select_wave<16>(scw, nreg, lane);
    else if (nreg <= 24) myword = select_wave<24>(scw, nreg, lane);
    else if (nreg <= 32) myword = select_wave<32>(scw, nreg, lane);
    else if (nreg <= 48) myword = select_wave<48>(scw, nreg, lane);
    else myword = select_wave<64>(scw, nreg, lane);
  }
  if (lane < nreg) mask[((size_t)b * S + t0 + wave) * 64 + lane] = myword;
  __syncthreads();
}

DI void s5_stage1_item(const Params& P, int l, int it, int wave, int lane) {
  const int b = it >> 4, g = it & 15, q = lane >> 4, jn = lane & 15;
  const u16* proj = (const u16*)(P.ws + O_PROJ);
  const u16* W1 = (const u16*)(P.ws + O_W1) + (size_t)(l * 16 + g) * 128 * 1024;
  float* s5s = (float*)(P.ws + O_S5S) + (size_t)it * 64 * 128;
  f32x4 acc[2][4]; zero_acc(acc);
  const u16* ap = W1 + (size_t)(wave * 32 + jn) * 1024 + q * 8;
  const u16* up = proj + ((size_t)b * S + (size_t)jn * 64 + (q >> 1)) * DINP + C_U + g * 16 + (q & 1) * 8;
  wgemm<2, 4>(acc, 32, [&](int i, int ks) { return ld8(ap + (size_t)i * 16 * 1024 + ks * 32); },
              [&](int j, int ks) { return ld8(up + ((size_t)j * 16 * 64 + 2 * ks) * DINP); });
#pragma unroll
  for (int j = 0; j < 4; ++j) {
    const int n = 16 * j + jn;
#pragma unroll
    for (int i = 0; i < 2; ++i)
      *reinterpret_cast<f32x4*>(s5s + (size_t)n * 128 + wave * 32 + 16 * i + 4 * q) = acc[i][j];
  }
}

constexpr int HS_STRIDE = 136;
DI void s5_stage3_item(const Params& P, int l, int it, u16* hs, int wave, int lane) {
  const int b = it >> 4, g = it & 15, q = lane >> 4, jn = lane & 15;
  const u16* proj = (const u16*)(P.ws + O_PROJ);
  const u16* Kt = (const u16*)(P.ws + O_KT) + (size_t)(l * 16 + g) * 64 * 256;
  const u16* W3 = (const u16*)(P.ws + O_W3) + (size_t)(l * 16 + g) * 1024 * 128;
  const float* s5s = (const float*)(P.ws + O_S5S) + (size_t)it * 64 * 128;
  const float2* pw = (const float2*)(P.ws + O_PW);
  u16* yg = (u16*)(P.ws + O_YG);
  const float* dsk = P.in[17] + (l * 16 + g) * 16;
  if (wave == 0) {
    const int p = lane;
    const float2 aL = pw[((size_t)(l * 16 + g) * 65 + 64) * 64 + p];
    float hr = 0.f, hi = 0.f;
#pragma unroll
    for (int half = 0; half < 2; ++half) {
      float2 sv[32];
#pragma unroll
      for (int n = 0; n < 32; ++n) sv[n] = *reinterpret_cast<const float2*>(s5s + (size_t)(half * 32 + n) * 128 + 2 * p);
#pragma unroll
      for (int n = 0; n < 32; ++n) {
        *reinterpret_cast<unsigned*>(hs + (half * 32 + n) * HS_STRIDE + 2 * p) = pack2(hr, hi);
        const float nr = aL.x * hr - aL.y * hi + sv[n].x, ni = aL.x * hi + aL.y * hr + sv[n].y;
        hr = nr; hi = ni;
      }
    }
  }
  __syncthreads();
  const u16* up = proj + ((size_t)b * S + (size_t)jn * 64 + (q >> 1)) * DINP + C_U + g * 16 + (q & 1) * 8;
  const bf16x8 zf = {0, 0, 0, 0, 0, 0, 0, 0};
  for (int gi = 0; gi < 8; ++gi) {
    const int jg = wave + 4 * (gi >> 1);
    const int th = gi & 1;
    f32x4 acc[4][2]; zero_acc(acc);
    wgemm<4, 2>(acc, 2 * jg + 2,
                [&](int i, int ks) { const int j = 4 * jg + i, ii = 2 * ks + (q >> 1); const int d = j - ii;
                                     return (d >= 0) ? ld8(Kt + ((size_t)d * 16 + jn) * 16 + (q & 1) * 8) : zf; },
                [&](int jt, int ks) { return ld8(up + ((size_t)(2 * th + jt) * 16 * 64 + 2 * ks) * DINP); });
    wgemm<4, 2>(acc, 4,
                [&](int i, int ks) { return ld8(W3 + ((size_t)(4 * jg + i) * 16 + jn) * 128 + ks * 32 + q * 8); },
                [&](int jt, int ks) { return *reinterpret_cast<const bf16x8*>(hs + (16 * (2 * th + jt) + jn) * HS_STRIDE + ks * 32 + q * 8); });
#pragma unroll
    for (int jt = 0; jt < 2; ++jt) {
      const int n = 16 * (2 * th + jt) + jn;
#pragma unroll
      for (int i = 0; i < 4; ++i) {
        const size_t tok = (size_t)b * S + n * 64 + 4 * jg + i;
        uint2 uw = ld4(proj + tok * DINP + C_U + g * 16 + 4 * q);
        const float y0 = acc[i][jt][0] + dsk[4 * q] * lo2f(uw.x), y1 = acc[i][jt][1] + dsk[4 * q + 1] * hi2f(uw.x);
        const float y2 = acc[i][jt][2] + dsk[4 * q + 2] * lo2f(uw.y), y3 = acc[i][jt][3] + dsk[4 * q + 3] * hi2f(uw.y);
        st4(yg + tok * 256 + g * 16 + 4 * q, geluf_(y0), geluf_(y1), geluf_(y2), geluf_(y3));
      }
    }
  }
  __syncthreads();
}

DI void glu_tile(const Params& P, int l, int tt, char* lds) {
  const u16* W = (const u16*)(P.ws + O_WTGLU) + (size_t)l * 256 * 256;
  const u16* yg = (const u16*)(P.ws + O_YG);
  const u16* proj = (const u16*)(P.ws + O_PROJ);
  u16* mixed = (u16*)(P.ws + O_XB);
  const int tid = opaque_tid();
  const int wave = __builtin_amdgcn_readfirstlane(tid >> 6), lane = tid & 63, q = lane >> 4, jn = lane & 15;
#pragma unroll 1
  for (int ftile = 0; ftile < 2; ++ftile) {
    const int f0 = ftile * 128 + (wave >> 1) * 64, t0 = tt * 128 + (wave & 1) * 64;
    f32x4 acc[4][4]; zero_acc(acc);
    gemm_block(acc, W + (size_t)(ftile * 128) * 256, 256, yg + (size_t)(tt * 128) * 256, 256, 256, lds, tid);
#pragma unroll
    for (int j = 0; j < 4; ++j) {
      const size_t tok = t0 + 16 * j + jn;
#pragma unroll
      for (int i = 0; i < 4; ++i) {
        const int f = f0 + 16 * i + 4 * q;
        uint2 gw = ld4(yg + tok * 256 + f), bw = ld4(proj + tok * DINP + C_GB + f);
        st4(mixed + tok * DM + 384 + f, lo2f(gw.x) * sigmoidf_(acc[i][j][0]) * siluf_(lo2f(bw.x)), hi2f(gw.x) * sigmoidf_(acc[i][j][1]) * siluf_(hi2f(bw.x)),
            lo2f(gw.y) * sigmoidf_(acc[i][j][2]) * siluf_(lo2f(bw.y)), hi2f(gw.y) * sigmoidf_(acc[i][j][3]) * siluf_(hi2f(bw.y)));
      }
    }
  }
}

DI void outproj_tile(const Params& P, int l, int tt, char* lds) {
  const u16* W = (const u16*)(P.ws + O_WTOUT) + (size_t)l * DM * DM;
  const u16* mixed = (const u16*)(P.ws + O_XB);
  float* xout = P.out;
  u16* xb2 = (u16*)(P.ws + O_XB2);
  const int tid = opaque_tid();
  const int wave = __builtin_amdgcn_readfirstlane(tid >> 6), lane = tid & 63, q = lane >> 4, jn = lane & 15;
#pragma unroll 1
  for (int ftile0 = 0; ftile0 < 8; ++ftile0) {
    int ftile = ftile0; asm volatile("" : "+s"(ftile));
    const int f0 = ftile * 128 + (wave >> 1) * 64, t0 = tt * 128 + (wave & 1) * 64;
    f32x4 acc[4][4]; zero_acc(acc);
    gemm_block(acc, W + (size_t)(ftile * 128) * DM, DM, mixed + (size_t)(tt * 128) * DM, DM, DM, lds, tid);
#pragma unroll
    for (int j = 0; j < 4; ++j) {
      const size_t tok = t0 + 16 * j + jn;
#pragma unroll
      for (int i = 0; i < 4; ++i) {
        const int f = f0 + 16 * i + 4 * q;
        const uint2 xw = ld4(xb2 + tok * DM + f);
        const f32x4 xv = f32x4{lo2f(xw.x), hi2f(xw.x), lo2f(xw.y), hi2f(xw.y)};
        const f32x4 xn = xv + acc[i][j];
        if (l == NL - 1) *reinterpret_cast<f32x4*>(xout + tok * DM + f) = xn;
        else st4(xb2 + tok * DM + f, xn[0], xn[1], xn[2], xn[3]);
      }
    }
  }
}

DI void phase_tail(const Params& P, int l, char* lds, float* s_rstd, float* s_prep) {
  for (int tt = blockIdx.x; tt < 512; tt += gridDim.x) {
    glu_tile(P, l, tt, lds);
    asm volatile("s_waitcnt vmcnt(0)" ::: "memory");
    __syncthreads();
    outproj_tile(P, l, tt, lds);
    if (l + 1 < NL) {
      asm volatile("s_waitcnt vmcnt(0)" ::: "memory");
      __syncthreads();
      inproj_tile(P, l + 1, tt, lds, s_rstd, s_prep);
    }
  }
}

DI void gbar(unsigned* ctr, unsigned& epoch) {
  asm volatile("s_waitcnt vmcnt(0)" ::: "memory");
  __syncthreads();
  epoch += gridDim.x;
  if (threadIdx.x == 0) {
    __builtin_amdgcn_fence(__ATOMIC_RELEASE, "agent");
    asm volatile("s_waitcnt vmcnt(0)" ::: "memory");
    __hip_atomic_fetch_add(ctr, 1u, __ATOMIC_RELAXED, __HIP_MEMORY_SCOPE_AGENT);
    while (__hip_atomic_load(ctr, __ATOMIC_RELAXED, __HIP_MEMORY_SCOPE_AGENT) < epoch) __builtin_amdgcn_s_sleep(1);
    __builtin_amdgcn_fence(__ATOMIC_ACQUIRE, "agent");
    asm volatile("s_waitcnt vmcnt(0)" ::: "memory");
  }
  __syncthreads();
}

__global__ void __launch_bounds__(256, 2) fwd_megakernel(Params P) {
  cg::grid_group grid = cg::this_grid();
  __shared__ __attribute__((aligned(16))) float lds_f[2 * G_BUF_BYTES / 4];
  static_assert(2 * G_BUF_BYTES >= 4 * SC_STRIDE * 4, "lds");
  __shared__ int s_item;
  __shared__ float s_rstd[128];
  __shared__ float s_prep[512];
  const long gtid = (long)blockIdx.x * 256 + threadIdx.x, gsz = (long)gridDim.x * 256;

  if (blockIdx.x == 0) { for (int w = threadIdx.x; w < 8192; w += 256) ((unsigned*)(P.ws + O_CTR))[w] = 0u; }
  phase_w0(P, gtid, gsz);
  grid.sync();
  unsigned* bar = (unsigned*)(P.ws + O_CTR) + 6144;
  unsigned epoch = 0u;
  phase_w1(P, gtid, gsz);
#ifdef DUP_W
  phase_w0(P, gtid, gsz);
  phase_w1(P, gtid, gsz);
#endif

  for (int tt = blockIdx.x; tt < 512; tt += gridDim.x) {
    {
      const float* x = P.in[0]; u16* xb = (u16*)(P.ws + O_XB2);
      const int tid = opaque_tid();
#pragma unroll 4
      for (int e = tid; e < 128 * 256; e += 256) {
        const float4 v = *reinterpret_cast<const float4*>(x + (size_t)tt * 128 * DM + (size_t)e * 4);
        st4(xb + (size_t)tt * 128 * DM + (size_t)e * 4, v.x, v.y, v.z, v.w);
      }
    }
    asm volatile("s_waitcnt vmcnt(0)" ::: "memory");
    __syncthreads();
    inproj_tile(P, 0, tt, (char*)lds_f, s_rstd, s_prep);
  }
  gbar(bar, epoch);
  for (int l = 0; l < NL; ++l) {
    {
      const int shard = blockIdx.x & 7;
      unsigned* ctr = (unsigned*)(P.ws + O_CTR) + ((l * 2) * 8 + shard) * 64;
      for (;;) {
        const int tid = opaque_tid();
        if (tid == 0) s_item = (int)atomicAdd(ctr, 1u) * 8 + shard;
        __syncthreads();
        const int it = s_item;
        __syncthreads();
        if (it >= 256 + 3072 + 4096) break;
        const int wave = __builtin_amdgcn_readfirstlane(tid >> 6), lane = tid & 63;
        if (it < 256) s5_stage1_item(P, l, it, wave, lane);
        else if (it < 256 + 3072) mla_attn_item(P, it - 256, (char*)lds_f, tid);
        else {
#pragma unroll 1
          for (int k = 0; k < 4; ++k) dsa_select_item(P, (it - 256 - 3072) * 4 + k, lds_f, wave, lane);
        }
      }
    }
    gbar(bar, epoch);
    {
      const int shard = blockIdx.x & 7;
      unsigned* ctr = (unsigned*)(P.ws + O_CTR) + ((l * 2 + 1) * 8 + shard) * 64;
      for (;;) {
        const int tid = opaque_tid();
        if (tid == 0) s_item = (int)atomicAdd(ctr, 1u) * 8 + shard;
        __syncthreads();
        const int it = s_item;
        __syncthreads();
        if (it >= 256 + 2048) break;
        const int wave = __builtin_amdgcn_readfirstlane(tid >> 6), lane = tid & 63;
        if (it < 256) s5_stage3_item(P, l, it, (u16*)lds_f, wave, lane);
        else {
          const int iu = __builtin_amdgcn_readfirstlane(it - 256), ml = iu >> 3;
          dsa_attn_item(P, (ml & 63) * 32 + (iu & 7) + 8 * (ml >> 6), (char*)lds_f, tid);
        }
      }
    }
    gbar(bar, epoch);
    phase_tail(P, l, (char*)lds_f, s_rstd, s_prep);
    if (l + 1 < NL) gbar(bar, epoch);
  }
}

extern "C" void kernel_launch(void* const* d_in, const int* in_sizes, int n_in, void* d_out, int out_size, void* d_ws, size_t ws_size,
                              hipStream_t stream) {
  static int grid_blocks = 0;
  if (!grid_blocks) {
    int dev = 0, cus = 0, per_cu = 0;
    hipGetDevice(&dev);
    hipDeviceGetAttribute(&cus, hipDeviceAttributeMultiprocessorCount, dev);
    hipOccupancyMaxActiveBlocksPerMultiprocessor(&per_cu, fwd_megakernel, 256, 0);
    if (per_cu < 1) per_cu = 1;
    if (per_cu > 2) per_cu = 2;
    grid_blocks = cus * per_cu;
    if (ws_size < O_END) fprintf(stderr, "workspace too small: %zu < %zu\n", ws_size, (size_t)O_END);
  }
  Params p{};
  for (int i = 0; i < 21; ++i) p.in[i] = (const float*)d_in[i];
  p.out = (float*)d_out;
  p.ws = (char*)d_ws;
  void* args[] = {&p};
  hipError_t e = hipLaunchCooperativeKernel((void*)fwd_megakernel, dim3(grid_blocks), dim3(256), args, 0, stream);
  if (e != hipSuccess) fprintf(stderr, "cooperative launch failed: %s (grid %d)\n", hipGetErrorString(e), grid_blocks);
}
```

```cpp
#include <hip/hip_runtime.h>
#include <hip/hip_cooperative_groups.h>
#include <cstdio>
#include <type_traits>
namespace cg = cooperative_groups;

#define DI __device__ __forceinline__
typedef __attribute__((ext_vector_type(8))) short bf16x8;
typedef __attribute__((ext_vector_type(4))) short s16x4;
typedef __attribute__((ext_vector_type(4))) float f32x4;
typedef unsigned short u16;
typedef unsigned long long u64;

constexpr int NB = 16, S = 4096, T = NB * S, DM = 1024, DIN = 2504, DINP = 2560, NL = 4;
constexpr int C_QA = 0, C_KA = 384, C_VA = 448, C_IQ = 512, C_IK = 768, C_IW = 800, C_GA = 808, C_U = 1192,
              C_GB = 1448, C_CQ = 1704, C_CKV = 1960, C_KPE = 2088, C_GC = 2120;
constexpr float EPS = 1e-6f;
constexpr float LOG2E = 1.4426950408889634f;

constexpr size_t O_WTIN = 0;
constexpr size_t O_WTOUT = O_WTIN + (size_t)NL * DINP * DM * 2;
constexpr size_t O_WTUQ = O_WTOUT + (size_t)NL * DM * DM * 2;
constexpr size_t O_WTUKV = O_WTUQ + (size_t)NL * 768 * 256 * 2;
constexpr size_t O_WTGLU = O_WTUKV + (size_t)NL * 768 * 128 * 2;
constexpr size_t O_W1 = O_WTGLU + (size_t)NL * 256 * 256 * 2;
constexpr size_t O_W3 = O_W1 + (size_t)NL * 16 * 128 * 1024 * 2;
constexpr size_t O_KT = O_W3 + (size_t)NL * 16 * 1024 * 128 * 2;
constexpr size_t O_PW = O_KT + (size_t)NL * 16 * 64 * 256 * 2;
constexpr size_t O_FZ = O_PW + (size_t)NL * 16 * 65 * 64 * 8;
constexpr size_t O_R64 = O_FZ + (size_t)NL * 16 * 64 * 8;
constexpr size_t O_R32 = O_R64 + (size_t)4096 * 32 * 8;
constexpr size_t O_XB = O_R32 + (size_t)4096 * 16 * 8;
constexpr size_t O_RSTD = O_XB + (size_t)T * 1024 * 2;
constexpr size_t O_PROJ = O_RSTD + (size_t)T * 4;
constexpr size_t O_MQ = O_PROJ + (size_t)T * DINP * 2;
constexpr size_t O_MK = O_MQ + (size_t)T * 576 * 2;
constexpr size_t O_MVT = O_MK + (size_t)T * 576 * 2;
constexpr size_t O_AVT = O_MVT + (size_t)T * 384 * 2;
constexpr size_t O_MASK = O_AVT + (size_t)T * 64 * 2;
constexpr size_t O_S5S = O_MASK + (size_t)T * 512;
constexpr size_t O_YG = O_S5S + (size_t)16 * 16 * 64 * 128 * 4;
constexpr size_t O_CTR = O_YG + (size_t)T * 256 * 2;
constexpr size_t O_XB2 = O_CTR + 32768;
constexpr size_t O_END = O_XB2 + (size_t)T * 1024 * 2;

struct Params {
  const float* in[21];
  float* out;
  char* ws;
};

DI int opaque_tid() { int t = threadIdx.x; asm volatile("" : "+v"(t)); return t; }
DI u16 f2bf(float f) { unsigned u = __float_as_uint(f); u += 0x7fffu + ((u >> 16) & 1u); return (u16)(u >> 16); }
DI float bf2f(u16 h) { return __uint_as_float(((unsigned)h) << 16); }
typedef __attribute__((ext_vector_type(2))) __bf16 bf16x2_t;
typedef __attribute__((ext_vector_type(2))) float f32x2_t;
DI unsigned pack2(float a, float b) { return __builtin_bit_cast(unsigned, __builtin_convertvector((f32x2_t){a, b}, bf16x2_t)); }
DI float lo2f(unsigned w) { return __uint_as_float(w << 16); }
DI float hi2f(unsigned w) { return __uint_as_float(w & 0xffff0000u); }
DI bf16x8 ld8(const u16* p) { return *reinterpret_cast<const bf16x8*>(p); }
DI uint2 ld4(const u16* p) { return *reinterpret_cast<const uint2*>(p); }
DI void st4(u16* p, float a, float b, float c, float d) { uint2 v; v.x = pack2(a, b); v.y = pack2(c, d); *reinterpret_cast<uint2*>(p) = v; }
DI f32x4 mfma16(bf16x8 a, bf16x8 b, f32x4 c) { return __builtin_amdgcn_mfma_f32_16x16x32_bf16(a, b, c, 0, 0, 0); }
DI float fexp2(float x) { return __builtin_amdgcn_exp2f(x); }
DI float sigmoidf_(float x) { return __builtin_amdgcn_rcpf(1.0f + __expf(-x)); }
DI float siluf_(float x) { return x * sigmoidf_(x); }
DI float geluf_(float x) { float u = 0.7978845608028654f * (x + 0.044715f * x * x * x); return x * sigmoidf_(2.0f * u); }
DI float red4(float v) { v += __shfl_xor(v, 16); v += __shfl_xor(v, 32); return v; }

template <int AT, int BT, class FA, class FB>
DI void wgemm(f32x4 (&acc)[AT][BT], int ksteps, FA fa, FB fb) {
  bf16x8 a0[AT], b0[BT], a1[AT], b1[BT];
  const int k1 = (ksteps > 1) ? 1 : 0;
#pragma unroll
  for (int i = 0; i < AT; ++i) { a0[i] = fa(i, 0); a1[i] = fa(i, k1); }
#pragma unroll
  for (int j = 0; j < BT; ++j) { b0[j] = fb(j, 0); b1[j] = fb(j, k1); }
  for (int ks = 0; ks < ksteps; ++ks) {
    bf16x8 a2[AT], b2[BT];
    const int kn = (ks + 2 < ksteps) ? ks + 2 : ksteps - 1;
#pragma unroll
    for (int i = 0; i < AT; ++i) a2[i] = fa(i, kn);
#pragma unroll
    for (int j = 0; j < BT; ++j) b2[j] = fb(j, kn);
    __builtin_amdgcn_sched_barrier(0);
#pragma unroll
    for (int i = 0; i < AT; ++i)
#pragma unroll
      for (int j = 0; j < BT; ++j) acc[i][j] = mfma16(a0[i], b0[j], acc[i][j]);
    __builtin_amdgcn_sched_barrier(0);
#pragma unroll
    for (int i = 0; i < AT; ++i) { a0[i] = a1[i]; a1[i] = a2[i]; }
#pragma unroll
    for (int j = 0; j < BT; ++j) { b0[j] = b1[j]; b1[j] = b2[j]; }
  }
}

constexpr int GROW = 72;
constexpr int G_TILE_BYTES = 128 * GROW * 2;
constexpr int G_BUF_BYTES = 2 * G_TILE_BYTES;
DI void gemm_block(f32x4 (&acc)[4][4], const u16* Ap, int lda, const u16* Bp, int ldb, int K, char* lds, int tid, bool swap_w1 = false) {
  const int lane = tid & 63, q = lane >> 4, jn = lane & 15;
  const int wave = __builtin_amdgcn_readfirstlane(tid >> 6), wa = wave >> 1, wb = wave & 1;
  uint4 xa0, xa1, xa2, xa3, xb0, xb1, xb2, xb3;
  uint4 ya0, ya1, ya2, ya3, yb0, yb1, yb2, yb3;
  const int srow = tid >> 3, scol = tid & 7;
  const unsigned voa = (unsigned)(srow * lda + scol * 8) * 2u, vob = (unsigned)(srow * ldb + scol * 8) * 2u;
  const char* ag = reinterpret_cast<const char*>(Ap);
  const char* bg = reinterpret_cast<const char*>(Bp);
  char* st0 = lds + (srow * GROW + scol * 8) * 2;
  const bool sw = swap_w1 && (wa == 1);
  const char* a0p = sw ? (lds + G_TILE_BYTES + (wb * 64 + jn) * GROW * 2 + q * 16) : (lds + (wa * 64 + jn) * GROW * 2 + q * 16);
  const char* b0p = sw ? (lds + (wa * 64 + jn) * GROW * 2 + q * 16) : (lds + G_TILE_BYTES + (wb * 64 + jn) * GROW * 2 + q * 16);
#define GL(v, base, ld, vo, i, kt) v = *reinterpret_cast<const uint4*>(base + ((size_t)(32 * (i)) * (ld) + (size_t)(kt) * 64) * 2 + vo)
#define GLOAD0(kt) { GL(xa0, ag, lda, voa, 0, kt); GL(xa1, ag, lda, voa, 1, kt); GL(xa2, ag, lda, voa, 2, kt); GL(xa3, ag, lda, voa, 3, kt); GL(xb0, bg, ldb, vob, 0, kt); GL(xb1, bg, ldb, vob, 1, kt); GL(xb2, bg, ldb, vob, 2, kt); GL(xb3, bg, ldb, vob, 3, kt); }
#define GLOAD1(kt) { GL(ya0, ag, lda, voa, 0, kt); GL(ya1, ag, lda, voa, 1, kt); GL(ya2, ag, lda, voa, 2, kt); GL(ya3, ag, lda, voa, 3, kt); GL(yb0, bg, ldb, vob, 0, kt); GL(yb1, bg, ldb, vob, 1, kt); GL(yb2, bg, ldb, vob, 2, kt); GL(yb3, bg, ldb, vob, 3, kt); }
#define GS(v, off) *reinterpret_cast<uint4*>(st0 + (off)) = v
#define GSTORE0(buf) { GS(xa0, (buf) * G_BUF_BYTES); GS(xa1, (buf) * G_BUF_BYTES + 32 * GROW * 2); GS(xa2, (buf) * G_BUF_BYTES + 64 * GROW * 2); GS(xa3, (buf) * G_BUF_BYTES + 96 * GROW * 2); \
                       GS(xb0, (buf) * G_BUF_BYTES + G_TILE_BYTES); GS(xb1, (buf) * G_BUF_BYTES + G_TILE_BYTES + 32 * GROW * 2); GS(xb2, (buf) * G_BUF_BYTES + G_TILE_BYTES + 64 * GROW * 2); GS(xb3, (buf) * G_BUF_BYTES + G_TILE_BYTES + 96 * GROW * 2); }
#define GSTORE1(buf) { GS(ya0, (buf) * G_BUF_BYTES); GS(ya1, (buf) * G_BUF_BYTES + 32 * GROW * 2); GS(ya2, (buf) * G_BUF_BYTES + 64 * GROW * 2); GS(ya3, (buf) * G_BUF_BYTES + 96 * GROW * 2); \
                       GS(yb0, (buf) * G_BUF_BYTES + G_TILE_BYTES); GS(yb1, (buf) * G_BUF_BYTES + G_TILE_BYTES + 32 * GROW * 2); GS(yb2, (buf) * G_BUF_BYTES + G_TILE_BYTES + 64 * GROW * 2); GS(yb3, (buf) * G_BUF_BYTES + G_TILE_BYTES + 96 * GROW * 2); }
  auto compute = [&](int buf) {
#pragma unroll
    for (int ks = 0; ks < 2; ++ks) {
      bf16x8 a[4], b[4];
#pragma unroll
      for (int i = 0; i < 4; ++i) a[i] = *reinterpret_cast<const bf16x8*>(a0p + buf * G_BUF_BYTES + i * 16 * GROW * 2 + ks * 64);
#pragma unroll
      for (int j = 0; j < 4; ++j) b[j] = *reinterpret_cast<const bf16x8*>(b0p + buf * G_BUF_BYTES + j * 16 * GROW * 2 + ks * 64);
      __builtin_amdgcn_s_setprio(1);
#pragma unroll
      for (int i = 0; i < 4; ++i)
#pragma unroll
        for (int j = 0; j < 4; ++j) acc[i][j] = mfma16(a[i], b[j], acc[i][j]);
      __builtin_amdgcn_s_setprio(0);
    }
  };
  const int nkt = K >> 6;
  GLOAD0(0);
  GLOAD1(1);
  GSTORE0(0);
  __syncthreads();
  for (int kt = 0; kt < nkt; kt += 2) {
    if (kt + 2 < nkt) GLOAD0(kt + 2);
    compute(0);
    GSTORE1(1);
    __syncthreads();
    if (kt + 3 < nkt) GLOAD1(kt + 3);
    compute(1);
    if (kt + 2 < nkt) GSTORE0(0);
    __syncthreads();
  }
#undef GL
#undef GLOAD0
#undef GLOAD1
#undef GS
#undef GSTORE0
#undef GSTORE1
}

template <int A, int B>
DI void zero_acc(f32x4 (&acc)[A][B]) {
#pragma unroll
  for (int i = 0; i < A; ++i)
#pragma unroll
    for (int j = 0; j < B; ++j) acc[i][j] = f32x4{0.f, 0.f, 0.f, 0.f};
}

DI void sincos_d(double a, double& c, double& s) {
  const double TWO_PI = 6.283185307179586476925;
  double n = rint(a / TWO_PI);
  double r = a - n * TWO_PI;
  c = cos(r); s = sin(r);
}

DI void phase_w0(const Params& P, long gtid, long gsz) {
  char* ws = P.ws;
  {
    u16* dst = (u16*)(ws + O_WTIN);
    const float* w = P.in[2]; const float* g = P.in[1];
    for (long idx = gtid; idx < (long)NL * 128 * DINP; idx += gsz) {
      int n = (int)(idx % DINP); long r = idx / DINP; int kb = (int)(r % 128); int l = (int)(r / 128);
      float v[8];
#pragma unroll
      for (int j = 0; j < 8; ++j) { int k = kb * 8 + j; v[j] = (n < DIN) ? w[((size_t)l * DM + k) * DIN + n] * g[l * DM + k] : 0.f; }
      uint4 o; o.x = pack2(v[0], v[1]); o.y = pack2(v[2], v[3]); o.z = pack2(v[4], v[5]); o.w = pack2(v[6], v[7]);
      *reinterpret_cast<uint4*>(dst + ((size_t)l * DINP + n) * DM + kb * 8) = o;
    }
  }
  {
    u16* dst = (u16*)(ws + O_WTOUT);
    const float* w = P.in[20];
    for (long idx = gtid; idx < (long)NL * 128 * DM; idx += gsz) {
      int n = (int)(idx % DM); long r = idx / DM; int kb = (int)(r % 128); int l = (int)(r / 128);
      float v[8];
#pragma unroll
      for (int j = 0; j < 8; ++j) { int k = kb * 8 + j; v[j] = w[((size_t)l * DM + k) * DM + n]; }
      uint4 o; o.x = pack2(v[0], v[1]); o.y = pack2(v[2], v[3]); o.z = pack2(v[4], v[5]); o.w = pack2(v[6], v[7]);
      *reinterpret_cast<uint4*>(dst + ((size_t)l * DM + n) * DM + kb * 8) = o;
    }
  }
  {
    u16* dst = (u16*)(ws + O_WTUQ);
    const float* w = P.in[7]; const float* g = P.in[5];
    for (long idx = gtid; idx < (long)NL * 32 * 768; idx += gsz) {
      int n = (int)(idx % 768); long r = idx / 768; int kb = (int)(r % 32); int l = (int)(r / 32);
      const int h = n >> 7, d = n & 127;
      float v[8];
#pragma unroll
      for (int j = 0; j < 8; ++j) { int k = kb * 8 + j; v[j] = (d < 96) ? w[((size_t)l * 256 + k) * 576 + h * 96 + d] * g[l * 256 + k] : 0.f; }
      uint4 o; o.x = pack2(v[0], v[1]); o.y = pack2(v[2], v[3]); o.z = pack2(v[4], v[5]); o.w = pack2(v[6], v[7]);
      *reinterpret_cast<uint4*>(dst + ((size_t)l * 768 + n) * 256 + kb * 8) = o;
    }
  }
  {
    u16* dst = (u16*)(ws + O_WTUKV);
    const float* w = P.in[8]; const float* g = P.in[6];
    for (long idx = gtid; idx < (long)NL * 16 * 768; idx += gsz) {
      int n = (int)(idx % 768); long r = idx / 768; int kb = (int)(r % 16); int l = (int)(r / 16);
      float v[8];
#pragma unroll
      for (int j = 0; j < 8; ++j) { int k = kb * 8 + j; v[j] = w[((size_t)l * 128 + k) * 768 + n] * g[l * 128 + k]; }
      uint4 o; o.x = pack2(v[0], v[1]); o.y = pack2(v[2], v[3]); o.z = pack2(v[4], v[5]); o.w = pack2(v[6], v[7]);
      *reinterpret_cast<uint4*>(dst + ((size_t)l * 768 + n) * 128 + kb * 8) = o;
    }
  }
  {
    u16* dst = (u16*)(ws + O_WTGLU);
    const float* w = P.in[19];
    for (long idx = gtid; idx < (long)NL * 32 * 256; idx += gsz) {
      int n = (int)(idx % 256); long r = idx / 256; int kb = (int)(r % 32); int l = (int)(r / 32);
      float v[8];
#pragma unroll
      for (int j = 0; j < 8; ++j) { int k = kb * 8 + j; v[j] = w[((size_t)l * 256 + k) * 256 + n]; }
      uint4 o; o.x = pack2(v[0], v[1]); o.y = pack2(v[2], v[3]); o.z = pack2(v[4], v[5]); o.w = pack2(v[6], v[7]);
      *reinterpret_cast<uint4*>(dst + ((size_t)l * 256 + n) * 256 + kb * 8) = o;
    }
  }
  {
    float2* r64 = (float2*)(ws + O_R64);
    for (long idx = gtid; idx < 4096L * 32; idx += gsz) {
      int i = (int)(idx & 31); int pos = (int)(idx >> 5);
      float inv = (float)pow(10000.0, -(double)i / 32.0);
      float ang = (float)pos * inv;
      double c, s; sincos_d((double)ang, c, s);
      r64[idx] = make_float2((float)c, (float)s);
    }
    float2* r32 = (float2*)(ws + O_R32);
    for (long idx = gtid; idx < 4096L * 16; idx += gsz) {
      int i = (int)(idx & 15); int pos = (int)(idx >> 4);
      float inv = (float)pow(10000.0, -(double)i / 16.0);
      float ang = (float)pos * inv;
      double c, s; sincos_d((double)ang, c, s);
      r32[idx] = make_float2((float)c, (float)s);
    }
  }
  {
    float2* pw = (float2*)(ws + O_PW);
    float2* fz = (float2*)(ws + O_FZ);
    const float* a_re = P.in[11]; const float* a_im = P.in[12]; const float* lstep = P.in[18];
    for (long idx = gtid; idx < (long)NL * 16 * 65 * 64; idx += gsz) {
      int p = (int)(idx & 63); long r = idx >> 6; int d = (int)(r % 65); int lg = (int)(r / 65);
      double step = exp((double)lstep[lg]);
      double ar = (double)a_re[lg * 64 + p], ai = (double)a_im[lg * 64 + p];
      double mag = exp((double)d * ar * step);
      double c, s; sincos_d((double)d * ai * step, c, s);
      pw[idx] = make_float2((float)(mag * c), (float)(mag * s));
      if (d == 1) {
        double abr = mag * c, abi = mag * s;
        double den = ar * ar + ai * ai, nr = abr - 1.0;
        double fre = (nr * ar + abi * ai) / den, fim = (abi * ar - nr * ai) / den;
        fz[lg * 64 + p] = make_float2((float)fre, (float)fim);
      }
    }
  }
}

DI void phase_w1(const Params& P, long gtid, long gsz) {
  char* ws = P.ws;
  const float2* pw = (const float2*)(ws + O_PW);
  const float2* fz = (const float2*)(ws + O_FZ);
  const float* b_re = P.in[13]; const float* b_im = P.in[14]; const float* c_re = P.in[15]; const float* c_im = P.in[16];
  {
    u16* w1 = (u16*)(ws + O_W1);
    for (long idx = gtid; idx < (long)NL * 16 * 128 * 128; idx += gsz) {
      int kb = (int)(idx & 127); long r = idx >> 7; int row = (int)(r & 127); int lg = (int)(r >> 7);
      int p = row >> 1, ri = row & 1; int i = kb >> 1, c0 = (kb & 1) * 8;
      float2 e = pw[((size_t)lg * 65 + (63 - i)) * 64 + p]; float2 f = fz[lg * 64 + p];
      float er = e.x * f.x - e.y * f.y, ei = e.x * f.y + e.y * f.x;
      float v[8];
#pragma unroll
      for (int j = 0; j < 8; ++j) {
        float br = b_re[((size_t)lg * 64 + p) * 16 + c0 + j], bi = b_im[((size_t)lg * 64 + p) * 16 + c0 + j];
        v[j] = ri ? (er * bi + ei * br) : (er * br - ei * bi);
      }
      uint4 o; o.x = pack2(v[0], v[1]); o.y = pack2(v[2], v[3]); o.z = pack2(v[4], v[5]); o.w = pack2(v[6], v[7]);
      *reinterpret_cast<uint4*>(w1 + ((size_t)lg * 128 + row) * 1024 + kb * 8) = o;
    }
  }
  {
    u16* w3 = (u16*)(ws + O_W3);
    for (long idx = gtid; idx < (long)NL * 16 * 1024 * 16; idx += gsz) {
      int kb = (int)(idx & 15); long r = idx >> 4; int f = (int)(r & 1023); int lg = (int)(r >> 10);
      int j = f >> 4, c = f & 15;
      float v[8];
#pragma unroll
      for (int jj = 0; jj < 4; ++jj) {
        int p = kb * 4 + jj;
        float2 e = pw[((size_t)lg * 65 + (j + 1)) * 64 + p];
        float cr = c_re[((size_t)lg * 16 + c) * 64 + p], ci = c_im[((size_t)lg * 16 + c) * 64 + p];
        v[2 * jj] = cr * e.x - ci * e.y;
        v[2 * jj + 1] = -(cr * e.y + ci * e.x);
      }
      uint4 o; o.x = pack2(v[0], v[1]); o.y = pack2(v[2], v[3]); o.z = pack2(v[4], v[5]); o.w = pack2(v[6], v[7]);
      *reinterpret_cast<uint4*>(w3 + ((size_t)lg * 1024 + f) * 128 + kb * 8) = o;
    }
  }
  {
    u16* kt = (u16*)(ws + O_KT);
    for (long idx = gtid; idx < (long)NL * 16 * 64 * 16 * 2; idx += gsz) {
      int cb = (int)(idx & 1); long r = idx >> 1; int c = (int)(r & 15); r >>= 4; int d = (int)(r & 63); int lg = (int)(r >> 6);
      float v[8];
#pragma unroll
      for (int j = 0; j < 8; ++j) v[j] = 0.f;
      for (int p = 0; p < 64; ++p) {
        float2 e = pw[((size_t)lg * 65 + d) * 64 + p]; float2 f = fz[lg * 64 + p];
        float er = e.x * f.x - e.y * f.y, ei = e.x * f.y + e.y * f.x;
        float cr = c_re[((size_t)lg * 16 + c) * 64 + p], ci = c_im[((size_t)lg * 16 + c) * 64 + p];
        float gr = cr * er - ci * ei, gi = cr * ei + ci * er;
#pragma unroll
        for (int j = 0; j < 8; ++j) {
          float br = b_re[((size_t)lg * 64 + p) * 16 + cb * 8 + j], bi = b_im[((size_t)lg * 64 + p) * 16 + cb * 8 + j];
          v[j] += gr * br - gi * bi;
        }
      }
      uint4 o; o.x = pack2(v[0], v[1]); o.y = pack2(v[2], v[3]); o.z = pack2(v[4], v[5]); o.w = pack2(v[6], v[7]);
      *reinterpret_cast<uint4*>(kt + (((size_t)lg * 64 + d) * 16 + c) * 16 + cb * 8) = o;
    }
  }
}

DI void phase_p0(const Params& P, int l) {
  const float* x = (l == 0) ? P.in[0] : P.out;
  u16* xb = (u16*)(P.ws + O_XB2);
  const int tid = opaque_tid();
  const int lane = tid & 63;
  const int gw = blockIdx.x * 4 + (tid >> 6), nw = gridDim.x * 4;
  for (int row = gw; row < T; row += nw) {
    const float4* xr = reinterpret_cast<const float4*>(x + (size_t)row * DM);
#pragma unroll
    for (int i = 0; i < 4; ++i) {
      float4 v = xr[i * 64 + lane];
      st4(xb + (size_t)row * DM + (i * 64 + lane) * 4, v.x, v.y, v.z, v.w);
    }
  }
}

DI void prep_mla_q(const Params& P, int l, int tw0, int lane) {
  const int q = lane >> 4, jn = lane & 15;
  const u16* proj = (const u16*)(P.ws + O_PROJ);
  const u16* W = (const u16*)(P.ws + O_WTUQ) + (size_t)l * 576 * 256;
  u16* mq = (u16*)(P.ws + O_MQ);
  const float2* r32 = (const float2*)(P.ws + O_R32);
  const float* gq = P.in[9] + l * 96;
  const u16* bp = proj + (size_t)(tw0 + jn) * DINP + C_CQ + q * 8;
  float rq[2];
#pragma unroll
  for (int t = 0; t < 2; ++t) {
    float ss = 0.f;
    for (int ks = 0; ks < 8; ++ks) {
      bf16x8 v = ld8(bp + (size_t)t * 16 * DINP + ks * 32);
#pragma unroll
      for (int j = 0; j < 8; ++j) { float f = bf2f((u16)v[j]); ss += f * f; }
    }
    ss = red4(ss);
    rq[t] = rsqrtf(ss * (1.0f / 256) + EPS);
  }
  const float qscale = 0.10206207261596577f * LOG2E;
  for (int h = 0; h < 6; ++h) {
    f32x4 acc[6][2]; zero_acc(acc);
    const u16* ap = W + (size_t)(h * 96 + jn) * 256 + q * 8;
    wgemm<6, 2>(acc, 8, [&](int i, int ks) { return ld8(ap + (size_t)i * 16 * 256 + ks * 32); },
                [&](int j, int ks) { return ld8(bp + (size_t)j * 16 * DINP + ks * 32); });
#pragma unroll
    for (int t = 0; t < 2; ++t) {
      const int tok = tw0 + 16 * t + jn, pos = tok & (S - 1);
      float ss = 0.f;
#pragma unroll
      for (int i = 0; i < 6; ++i)
#pragma unroll
        for (int r = 0; r < 4; ++r) { float v = acc[i][t][r] * rq[t]; acc[i][t][r] = v; ss += v * v; }
      ss = red4(ss);
      const float rs = rsqrtf(ss * (1.0f / 96) + EPS);
#pragma unroll
      for (int i = 0; i < 6; ++i)
#pragma unroll
        for (int r = 0; r < 4; ++r) acc[i][t][r] *= rs * gq[16 * i + 4 * q + r];
#pragma unroll
      for (int r = 0; r < 4; ++r) {
        float2 cs = r32[pos * 16 + 4 * q + r];
        float x1 = acc[4][t][r], x2 = acc[5][t][r];
        acc[4][t][r] = x1 * cs.x - x2 * cs.y; acc[5][t][r] = x2 * cs.x + x1 * cs.y;
      }
#pragma unroll
      for (int i = 0; i < 6; ++i)
        st4(mq + (size_t)tok * 576 + h * 96 + 16 * i + 4 * q, acc[i][t][0] * qscale, acc[i][t][1] * qscale, acc[i][t][2] * qscale, acc[i][t][3] * qscale);
    }
  }
}

DI void prep_mla_kv(const Params& P, int l, int tw0, int lane) {
  const int q = lane >> 4, jn = lane & 15;
  const u16* proj = (const u16*)(P.ws + O_PROJ);
  const u16* W = (const u16*)(P.ws + O_WTUKV) + (size_t)l * 768 * 128;
  u16* mk = (u16*)(P.ws + O_MK);
  u16* mvt = (u16*)(P.ws + O_MVT);
  const float2* r32 = (const float2*)(P.ws + O_R32);
  const float* gk = P.in[10] + l * 96;
  const u16* bp = proj + (size_t)(tw0 + jn) * DINP + C_CKV + q * 8;
  const int b = tw0 >> 12, pos0 = tw0 & (S - 1);
  float rkv[2];
#pragma unroll
  for (int t = 0; t < 2; ++t) {
    float ss = 0.f;
    for (int ks = 0; ks < 4; ++ks) {
      bf16x8 v = ld8(bp + (size_t)t * 16 * DINP + ks * 32);
#pragma unroll
      for (int j = 0; j < 8; ++j) { float f = bf2f((u16)v[j]); ss += f * f; }
    }
    ss = red4(ss);
    rkv[t] = rsqrtf(ss * (1.0f / 128) + EPS);
  }
  for (int h = 0; h < 6; ++h) {
    {
      f32x4 acc[4][2]; zero_acc(acc);
      const u16* ap = W + (size_t)(h * 128 + jn) * 128 + q * 8;
      wgemm<4, 2>(acc, 4, [&](int i, int ks) { return ld8(ap + (size_t)i * 16 * 128 + ks * 32); },
                  [&](int j, int ks) { return ld8(bp + (size_t)j * 16 * DINP + ks * 32); });
#pragma unroll
      for (int t = 0; t < 2; ++t) {
        const int tok = tw0 + 16 * t + jn, pos = tok & (S - 1);
        uint2 pl = ld4(proj + (size_t)tok * DINP + C_KPE + 4 * q);
        uint2 ph = ld4(proj + (size_t)tok * DINP + C_KPE + 16 + 4 * q);
        float kl[4] = {lo2f(pl.x), hi2f(pl.x), lo2f(pl.y), hi2f(pl.y)};
        float kh[4] = {lo2f(ph.x), hi2f(ph.x), lo2f(ph.y), hi2f(ph.y)};
        float ss = 0.f;
#pragma unroll
        for (int i = 0; i < 4; ++i)
#pragma unroll
          for (int r = 0; r < 4; ++r) { float v = acc[i][t][r] * rkv[t]; acc[i][t][r] = v; ss += v * v; }
#pragma unroll
        for (int r = 0; r < 4; ++r) ss += kl[r] * kl[r] + kh[r] * kh[r];
        ss = red4(ss);
        const float rs = rsqrtf(ss * (1.0f / 96) + EPS);
#pragma unroll
        for (int i = 0; i < 4; ++i) {
          const int d = 16 * i + 4 * q;
          st4(mk + (size_t)tok * 576 + h * 96 + d, acc[i][t][0] * rs * gk[d], acc[i][t][1] * rs * gk[d + 1], acc[i][t][2] * rs * gk[d + 2], acc[i][t][3] * rs * gk[d + 3]);
        }
        float y1[4], y2[4];
#pragma unroll
        for (int r = 0; r < 4; ++r) {
          float2 cs = r32[pos * 16 + 4 * q + r];
          float x1 = kl[r] * rs * gk[64 + 4 * q + r], x2 = kh[r] * rs * gk[80 + 4 * q + r];
          y1[r] = x1 * cs.x - x2 * cs.y; y2[r] = x2 * cs.x + x1 * cs.y;
        }
        st4(mk + (size_t)tok * 576 + h * 96 + 64 + 4 * q, y1[0], y1[1], y1[2], y1[3]);
        st4(mk + (size_t)tok * 576 + h * 96 + 80 + 4 * q, y2[0], y2[1], y2[2], y2[3]);
      }
    }
    {
      f32x4 acc[2][4]; zero_acc(acc);
      const u16* wp = W + (size_t)(h * 128 + 64 + jn) * 128 + q * 8;
      wgemm<2, 4>(acc, 4, [&](int i, int ks) { return ld8(bp + (size_t)i * 16 * DINP + ks * 32); },
                  [&](int j, int ks) { return ld8(wp + (size_t)j * 16 * 128 + ks * 32); });
#pragma unroll
      for (int i = 0; i < 2; ++i) {
        float rr[4];
#pragma unroll
        for (int r = 0; r < 4; ++r) rr[r] = __shfl(rkv[i], 4 * q + r);
#pragma unroll
        for (int j = 0; j < 4; ++j)
          st4(mvt + ((size_t)(b * 6 + h) * 64 + 16 * j + jn) * S + pos0 + 16 * i + 4 * q,
              acc[i][j][0] * rr[0], acc[i][j][1] * rr[1], acc[i][j][2] * rr[2], acc[i][j][3] * rr[3]);
      }
    }
  }
}

DI void prep_mla_tile(const Params& P, int l, int tt, char* lds, float* s_r, float* s_ss) {
  const int tid = opaque_tid();
  const int wave = __builtin_amdgcn_readfirstlane(tid >> 6), lane = tid & 63, q = lane >> 4, jn = lane & 15;
  const int wa = wave >> 1, wb = wave & 1;
  const int tok0 = tt * 128;
  const u16* proj = (const u16*)(P.ws + O_PROJ);
  const u16* Wq = (const u16*)(P.ws + O_WTUQ) + (size_t)l * 768 * 256;
  const u16* Wkv = (const u16*)(P.ws + O_WTUKV) + (size_t)l * 768 * 128;
  u16* mq = (u16*)(P.ws + O_MQ); u16* mk = (u16*)(P.ws + O_MK); u16* mvt = (u16*)(P.ws + O_MVT);
  const float2* r32 = (const float2*)(P.ws + O_R32);
  const float* gq = P.in[9] + l * 96; const float* gk = P.in[10] + l * 96;
  {
    const int row = tid >> 1, half = tid & 1;
    const u16* pq = proj + (size_t)(tok0 + row) * DINP + C_CQ + half * 128;
    const u16* pk = proj + (size_t)(tok0 + row) * DINP + C_CKV + half * 64;
    bf16x8 vq[16], vk[8];
#pragma unroll
    for (int u = 0; u < 16; ++u) vq[u] = ld8(pq + u * 8);
#pragma unroll
    for (int u = 0; u < 8; ++u) vk[u] = ld8(pk + u * 8);
    float sq = 0.f, sk = 0.f;
#pragma unroll
    for (int u = 0; u < 16; ++u)
#pragma unroll
      for (int j = 0; j < 8; ++j) { const float f = bf2f((u16)vq[u][j]); sq += f * f; }
#pragma unroll
    for (int u = 0; u < 8; ++u)
#pragma unroll
      for (int j = 0; j < 8; ++j) { const float f = bf2f((u16)vk[u][j]); sk += f * f; }
    sq += __shfl_xor(sq, 1); sk += __shfl_xor(sk, 1);
    if (half == 0) { s_r[row] = rsqrtf(sq * (1.0f / 256) + EPS); s_r[128 + row] = rsqrtf(sk * (1.0f / 128) + EPS); }
  }
  __syncthreads();
  const float qscale = 0.10206207261596577f * LOG2E;
#pragma unroll 1
  for (int h0 = 0; h0 < 6; ++h0) {
    int h = h0; asm volatile("" : "+s"(h));
    f32x4 acc[4][4]; zero_acc(acc);
    gemm_block(acc, Wq + (size_t)(h * 128) * 256, 256, proj + (size_t)tok0 * DINP + C_CQ, DINP, 256, lds, tid);
#pragma unroll
    for (int j = 0; j < 4; ++j) {
      const int tl = wb * 64 + 16 * j + jn; const float rq = s_r[tl];
      float ss = 0.f;
#pragma unroll
      for (int i = 0; i < 4; ++i)
#pragma unroll
        for (int r = 0; r < 4; ++r) { const float v = acc[i][j][r] * rq; acc[i][j][r] = v; ss += v * v; }
      ss = red4(ss);
      if (q == 0) s_ss[wa * 128 + tl] = ss;
    }
    __syncthreads();
#pragma unroll
    for (int j = 0; j < 4; ++j) {
      const int tl = wb * 64 + 16 * j + jn, tok = tok0 + tl, pos = tok & (S - 1);
      const float rs = rsqrtf((s_ss[tl] + s_ss[128 + tl]) * (1.0f / 96) + EPS);
      if (wa == 0) {
#pragma unroll
        for (int i = 0; i < 4; ++i) {
          const int d = 16 * i + 4 * q;
          st4(mq + (size_t)tok * 576 + h * 96 + d, acc[i][j][0] * rs * gq[d] * qscale, acc[i][j][1] * rs * gq[d + 1] * qscale,
              acc[i][j][2] * rs * gq[d + 2] * qscale, acc[i][j][3] * rs * gq[d + 3] * qscale);
        }
      } else {
        float y1[4], y2[4];
#pragma unroll
        for (int r = 0; r < 4; ++r) {
          const float2 cs = r32[pos * 16 + 4 * q + r];
          const float x1 = acc[0][j][r] * rs * gq[64 + 4 * q + r], x2 = acc[1][j][r] * rs * gq[80 + 4 * q + r];
          y1[r] = (x1 * cs.x - x2 * cs.y) * qscale; y2[r] = (x2 * cs.x + x1 * cs.y) * qscale;
        }
        st4(mq + (size_t)tok * 576 + h * 96 + 64 + 4 * q, y1[0], y1[1], y1[2], y1[3]);
        st4(mq + (size_t)tok * 576 + h * 96 + 80 + 4 * q, y2[0], y2[1], y2[2], y2[3]);
      }
    }
    __syncthreads();
  }
  const int b = tok0 >> 12, pos0 = tok0 & (S - 1);
#pragma unroll 1
  for (int h0 = 0; h0 < 6; ++h0) {
    int h = h0; asm volatile("" : "+s"(h));
    f32x4 acc[4][4]; zero_acc(acc);
    gemm_block(acc, Wkv + (size_t)(h * 128) * 128, 128, proj + (size_t)tok0 * DINP + C_CKV, DINP, 128, lds, tid, true);
    if (wa == 0) {
#pragma unroll
      for (int j = 0; j < 4; ++j) {
        const int tl = wb * 64 + 16 * j + jn, tok = tok0 + tl, pos = tok & (S - 1);
        const float rkv = s_r[128 + tl];
        const uint2 pl = ld4(proj + (size_t)tok * DINP + C_KPE + 4 * q);
        const uint2 ph = ld4(proj + (size_t)tok * DINP + C_KPE + 16 + 4 * q);
        const float kl[4] = {lo2f(pl.x), hi2f(pl.x), lo2f(pl.y), hi2f(pl.y)};
        const float kh[4] = {lo2f(ph.x), hi2f(ph.x), lo2f(ph.y), hi2f(ph.y)};
        float ss = 0.f;
#pragma unroll
        for (int i = 0; i < 4; ++i)
#pragma unroll
          for (int r = 0; r < 4; ++r) { const float v = acc[i][j][r] * rkv; acc[i][j][r] = v; ss += v * v; }
#pragma unroll
        for (int r = 0; r < 4; ++r) ss += kl[r] * kl[r] + kh[r] * kh[r];
        ss = red4(ss);
        const float rs = rsqrtf(ss * (1.0f / 96) + EPS);
#pragma unroll
        for (int i = 0; i < 4; ++i) {
          const int d = 16 * i + 4 * q;
          st4(mk + (size_t)tok * 576 + h * 96 + d, acc[i][j][0] * rs * gk[d], acc[i][j][1] * rs * gk[d + 1], acc[i][j][2] * rs * gk[d + 2], acc[i][j][3] * rs * gk[d + 3]);
        }
        float y1[4], y2[4];
#pragma unroll
        for (int r = 0; r < 4; ++r) {
          const float2 cs = r32[pos * 16 + 4 * q + r];
          const float x1 = kl[r] * rs * gk[64 + 4 * q + r], x2 = kh[r] * rs * gk[80 + 4 * q + r];
          y1[r] = x1 * cs.x - x2 * cs.y; y2[r] = x2 * cs.x + x1 * cs.y;
        }
        st4(mk + (size_t)tok * 576 + h * 96 + 64 + 4 * q, y1[0], y1[1], y1[2], y1[3]);
        st4(mk + (size_t)tok * 576 + h * 96 + 80 + 4 * q, y2[0], y2[1], y2[2], y2[3]);
      }
    } else {
#pragma unroll
      for (int i = 0; i < 4; ++i) {
        const int tl0 = wb * 64 + 16 * i + 4 * q;
        const float r0 = s_r[128 + tl0], r1 = s_r[128 + tl0 + 1], r2 = s_r[128 + tl0 + 2], r3 = s_r[128 + tl0 + 3];
#pragma unroll
        for (int j = 0; j < 4; ++j)
          st4(mvt + ((size_t)(b * 6 + h) * 64 + 16 * j + jn) * S + pos0 + tl0, acc[i][j][0] * r0, acc[i][j][1] * r1, acc[i][j][2] * r2, acc[i][j][3] * r3);
      }
    }
  }
}

DI void prep_dsa(const Params& P, int l, int tok0) {
  u16* proj = (u16*)(P.ws + O_PROJ);
  u16* avt = (u16*)(P.ws + O_AVT);
  const float2* r64 = (const float2*)(P.ws + O_R64);
  const float2* r32 = (const float2*)(P.ws + O_R32);
  const int tid = opaque_tid();
  for (int task = tid; task < 512; task += 256) {
    const int tok = tok0 + (task >> 2), c = task & 3, pos = tok & (S - 1);
    u16* row = proj + (size_t)tok * DINP;
    bf16x8 lo[7], hi[7];
#pragma unroll
    for (int hh = 0; hh < 7; ++hh) {
      const int base = (hh < 6) ? C_QA + 64 * hh : C_KA;
      lo[hh] = ld8(row + base + 8 * c); hi[hh] = ld8(row + base + 32 + 8 * c);
    }
    float2 cs[8];
    float gql[8], gqh[8], gkl[8], gkh[8];
    const float* gq = P.in[3] + l * 64; const float* gk = P.in[4] + l * 64;
#pragma unroll
    for (int j = 0; j < 8; ++j) {
      cs[j] = r64[pos * 32 + 8 * c + j];
      gql[j] = gq[8 * c + j]; gqh[j] = gq[32 + 8 * c + j]; gkl[j] = gk[8 * c + j]; gkh[j] = gk[32 + 8 * c + j];
    }
#pragma unroll
    for (int hh = 0; hh < 7; ++hh) {
      const int base = (hh < 6) ? C_QA + 64 * hh : C_KA;
      float xl[8], xh[8];
      float ss = 0.f;
#pragma unroll
      for (int j = 0; j < 8; ++j) { xl[j] = bf2f((u16)lo[hh][j]); xh[j] = bf2f((u16)hi[hh][j]); ss += xl[j] * xl[j] + xh[j] * xh[j]; }
      ss += __shfl_xor(ss, 1); ss += __shfl_xor(ss, 2);
      const float rs = rsqrtf(ss * (1.0f / 64) + EPS);
      const float sc = (hh < 6) ? 0.125f * LOG2E : 1.0f;
      float y1[8], y2[8];
#pragma unroll
      for (int j = 0; j < 8; ++j) {
        const float x1 = xl[j] * rs * ((hh < 6) ? gql[j] : gkl[j]), x2 = xh[j] * rs * ((hh < 6) ? gqh[j] : gkh[j]);
        y1[j] = (x1 * cs[j].x - x2 * cs[j].y) * sc; y2[j] = (x2 * cs[j].x + x1 * cs[j].y) * sc;
      }
      uint4 o; o.x = pack2(y1[0], y1[1]); o.y = pack2(y1[2], y1[3]); o.z = pack2(y1[4], y1[5]); o.w = pack2(y1[6], y1[7]);
      *reinterpret_cast<uint4*>(row + base + 8 * c) = o;
      o.x = pack2(y2[0], y2[1]); o.y = pack2(y2[2], y2[3]); o.z = pack2(y2[4], y2[5]); o.w = pack2(y2[6], y2[7]);
      *reinterpret_cast<uint4*>(row + base + 32 + 8 * c) = o;
    }
  }
  {
    const int tok = tok0 + (tid >> 1), c2 = tid & 1, pos = tok & (S - 1);
    u16* row = proj + (size_t)tok * DINP;
    bf16x8 lo[9], hi[9];
#pragma unroll
    for (int hh = 0; hh < 9; ++hh) {
      const int base = (hh < 8) ? C_IQ + 32 * hh : C_IK;
      lo[hh] = ld8(row + base + 8 * c2); hi[hh] = ld8(row + base + 16 + 8 * c2);
    }
    float2 cs[8];
#pragma unroll
    for (int j = 0; j < 8; ++j) cs[j] = r32[pos * 16 + 8 * c2 + j];
#pragma unroll
    for (int hh = 0; hh < 9; ++hh) {
      const int base = (hh < 8) ? C_IQ + 32 * hh : C_IK;
      float y1[8], y2[8];
#pragma unroll
      for (int j = 0; j < 8; ++j) {
        const float x1 = bf2f((u16)lo[hh][j]), x2 = bf2f((u16)hi[hh][j]);
        y1[j] = x1 * cs[j].x - x2 * cs[j].y; y2[j] = x2 * cs[j].x + x1 * cs[j].y;
      }
      uint4 o; o.x = pack2(y1[0], y1[1]); o.y = pack2(y1[2], y1[3]); o.z = pack2(y1[4], y1[5]); o.w = pack2(y1[6], y1[7]);
      *reinterpret_cast<uint4*>(row + base + 8 * c2) = o;
      o.x = pack2(y2[0], y2[1]); o.y = pack2(y2[2], y2[3]); o.z = pack2(y2[4], y2[5]); o.w = pack2(y2[6], y2[7]);
      *reinterpret_cast<uint4*>(row + base + 16 + 8 * c2) = o;
    }
  }
  {
    const int b = tok0 >> 12, pos0 = tok0 & (S - 1);
    const int dim = tid & 63, tg0 = tid >> 6;
    unsigned short v[8][4];
#pragma unroll
    for (int u = 0; u < 8; ++u) {
      const u16* p = proj + (size_t)(tok0 + 4 * (tg0 + 4 * u)) * DINP + C_VA + dim;
#pragma unroll
      for (int k = 0; k < 4; ++k) v[u][k] = p[k * DINP];
    }
#pragma unroll
    for (int u = 0; u < 8; ++u) {
      uint2 o; o.x = (unsigned)v[u][0] | ((unsigned)v[u][1] << 16); o.y = (unsigned)v[u][2] | ((unsigned)v[u][3] << 16);
      *reinterpret_cast<uint2*>(avt + ((size_t)b * 64 + dim) * S + pos0 + 4 * (tg0 + 4 * u)) = o;
    }
  }
}

DI void prep_tile(const Params& P, int l, int tile, char* lds, float* s_r) {
  const int tid = opaque_tid();
  const int wave = __builtin_amdgcn_readfirstlane(tid >> 6), lane = tid & 63;
  const int tok0 = tile * 128;
  prep_mla_tile(P, l, tile, lds, s_r, s_r + 256);
  prep_dsa(P, l, tok0);
}

DI void inproj_tile(const Params& P, int l, int tt, char* lds, float* s_rstd, float* s_prep) {
  const u16* W = (const u16*)(P.ws + O_WTIN) + (size_t)l * DINP * DM;
  const u16* xb = (const u16*)(P.ws + O_XB2);
  u16* proj = (u16*)(P.ws + O_PROJ);
  const int tid = opaque_tid();
  const int wave = __builtin_amdgcn_readfirstlane(tid >> 6), lane = tid & 63, q = lane >> 4, jn = lane & 15;
  {
    {
      const u16* rp = xb + (size_t)(tt * 128 + (tid >> 1)) * DM + (tid & 1) * 512;
      float ss = 0.f;
#pragma unroll 1
      for (int c = 0; c < 8; ++c) {
        bf16x8 v[8];
#pragma unroll
        for (int u = 0; u < 8; ++u) v[u] = ld8(rp + (c * 8 + u) * 8);
#pragma unroll
        for (int u = 0; u < 8; ++u)
#pragma unroll
          for (int j = 0; j < 8; ++j) { const float f = bf2f((u16)v[u][j]); ss += f * f; }
      }
      ss += __shfl_xor(ss, 1);
      if ((tid & 1) == 0) s_rstd[tid >> 1] = rsqrtf(ss * (1.0f / DM) + EPS);
    }
    __syncthreads();
#pragma unroll 1
    for (int ftile0 = 0; ftile0 < 20; ++ftile0) {
      int ftile = ftile0; asm volatile("" : "+s"(ftile));
      const int f0 = ftile * 128 + (wave >> 1) * 64, t0 = tt * 128 + (wave & 1) * 64;
      f32x4 acc[4][4]; zero_acc(acc);
      gemm_block(acc, W + (size_t)(ftile * 128) * DM, DM, xb + (size_t)(tt * 128) * DM, DM, DM, lds, tid);
#pragma unroll
      for (int j = 0; j < 4; ++j) {
        const int tok = t0 + 16 * j + jn; const float rs = s_rstd[(wave & 1) * 64 + 16 * j + jn];
#pragma unroll
        for (int i = 0; i < 4; ++i)
          st4(proj + (size_t)tok * DINP + f0 + 16 * i + 4 * q, acc[i][j][0] * rs, acc[i][j][1] * rs, acc[i][j][2] * rs, acc[i][j][3] * rs);
      }
    }
    asm volatile("s_waitcnt vmcnt(0)" ::: "memory");
    __syncthreads();
    prep_tile(P, l, tt, lds, s_prep);
    __syncthreads();
  }
}

DI void phase_inproj(const Params& P, int l, char* lds, float* s_rstd, float* s_prep) {
  for (int tt = blockIdx.x; tt < 512; tt += gridDim.x) inproj_tile(P, l, tt, lds, s_rstd, s_prep);
}

template <int KS, bool MASK>
DI void attn_block_v1(const u16* Qp, int qstride, const u16* Kp, int kstride, const u16* Vtp, const u64* maskp, int nkt_w, int nkt_max,
                   const u16* gatep, int gstride, u16* outp, int ostride, char* lds, int tid) {
  constexpr int DQK = KS * 32, KROW = DQK + 8, VROW = 72;
  constexpr int KCH = DQK / 8, NKC = 64 * KCH / 256;
  constexpr int K_BYTES = 64 * KROW * 2, BUF_BYTES = K_BYTES + 64 * VROW * 2;
  const int lane = tid & 63, q = lane >> 4, jn = lane & 15;
  const float NEG_INF = -__builtin_inff();
  uint4 kst[NKC], vst[2];
  auto gload = [&](int kt) {
#pragma unroll
    for (int i = 0; i < NKC; ++i) {
      const int c = tid + 256 * i, row = c / KCH, col = c % KCH;
      kst[i] = *reinterpret_cast<const uint4*>(Kp + (size_t)(kt * 64 + row) * kstride + col * 8);
    }
#pragma unroll
    for (int i = 0; i < 2; ++i) {
      const int c = tid + 256 * i, dim = c >> 3, part = c & 7;
      vst[i] = *reinterpret_cast<const uint4*>(Vtp + (size_t)dim * S + kt * 64 + part * 8);
    }
  };
  auto lstore = [&](int buf) {
    char* kb = lds + buf * BUF_BYTES; char* vb = kb + K_BYTES;
#pragma unroll
    for (int i = 0; i < NKC; ++i) {
      const int c = tid + 256 * i, row = c / KCH, col = c % KCH;
      *reinterpret_cast<uint4*>(kb + (row * KROW + col * 8) * 2) = kst[i];
    }
#pragma unroll
    for (int i = 0; i < 2; ++i) {
      const int c = tid + 256 * i, dim = c >> 3, part = c & 7;
      *reinterpret_cast<uint4*>(vb + (dim * VROW + part * 8) * 2) = vst[i];
    }
  };
  bf16x8 qf[2][KS];
#pragma unroll
  for (int c = 0; c < 2; ++c)
#pragma unroll
    for (int ks = 0; ks < KS; ++ks) qf[c][ks] = ld8(Qp + (size_t)(16 * c + jn) * qstride + ks * 32 + q * 8);
  f32x4 o[4][2]; zero_acc(o);
  float m[2] = {NEG_INF, NEG_INF}, lsum[2] = {0.f, 0.f};
  u64 mw[2] = {0ull, 0ull}, mwn[2] = {0ull, 0ull};
  if (MASK) {
#pragma unroll
    for (int c = 0; c < 2; ++c) mw[c] = maskp[(size_t)(16 * c + jn) * 64];
  }
  gload(0);
  lstore(0);
  __syncthreads();
  for (int kt = 0; kt < nkt_max; ++kt) {
    const bool more = kt + 1 < nkt_max;
    if (more) {
      gload(kt + 1);
      if (MASK) {
        if (kt + 1 < nkt_w) {
#pragma unroll
          for (int c = 0; c < 2; ++c) mwn[c] = maskp[(size_t)(16 * c + jn) * 64 + kt + 1];
        }
      }
    }
    if (kt < nkt_w) {
      const char* kb = lds + (kt & 1) * BUF_BYTES; const char* vb = kb + K_BYTES;
      f32x4 s[4][2]; zero_acc(s);
#pragma unroll
      for (int a = 0; a < 4; ++a)
#pragma unroll
        for (int ks = 0; ks < KS; ++ks) {
          const bf16x8 kf = *reinterpret_cast<const bf16x8*>(kb + ((16 * a + jn) * KROW + ks * 32 + q * 8) * 2);
#pragma unroll
          for (int c = 0; c < 2; ++c) s[a][c] = mfma16(kf, qf[c][ks], s[a][c]);
        }
      if (MASK) {
#pragma unroll
        for (int c = 0; c < 2; ++c) {
          const u64 w = mw[c] >> (4 * q);
#pragma unroll
          for (int a = 0; a < 4; ++a)
#pragma unroll
            for (int r = 0; r < 4; ++r)
              if (!((w >> (16 * a + r)) & 1ull)) s[a][c][r] = NEG_INF;
        }
      }
      float alpha[2];
#pragma unroll
      for (int c = 0; c < 2; ++c) {
        float mx = NEG_INF;
#pragma unroll
        for (int a = 0; a < 4; ++a)
#pragma unroll
          for (int r = 0; r < 4; ++r) mx = fmaxf(mx, s[a][c][r]);
        mx = fmaxf(mx, __shfl_xor(mx, 16)); mx = fmaxf(mx, __shfl_xor(mx, 32));
        const float mn = fmaxf(m[c], mx);
        const float mu = (mn == NEG_INF) ? 0.f : mn;
        alpha[c] = fexp2(m[c] - mu);
        m[c] = mn;
        float ps = 0.f;
#pragma unroll
        for (int a = 0; a < 4; ++a)
#pragma unroll
          for (int r = 0; r < 4; ++r) { float p = fexp2(s[a][c][r] - mu); s[a][c][r] = p; ps += p; }
        lsum[c] = lsum[c] * alpha[c] + ps;
      }
      if (__builtin_amdgcn_ballot_w64(alpha[0] != 1.0f || alpha[1] != 1.0f) != 0ull) {
#pragma unroll
        for (int c = 0; c < 2; ++c)
#pragma unroll
          for (int dt = 0; dt < 4; ++dt)
#pragma unroll
            for (int r = 0; r < 4; ++r) o[dt][c][r] *= alpha[c];
      }
#pragma unroll
      for (int kk = 0; kk < 2; ++kk) {
        bf16x8 pf[2];
#pragma unroll
        for (int c = 0; c < 2; ++c) {
          uint4 w; w.x = pack2(s[2 * kk][c][0], s[2 * kk][c][1]); w.y = pack2(s[2 * kk][c][2], s[2 * kk][c][3]);
          w.z = pack2(s[2 * kk + 1][c][0], s[2 * kk + 1][c][1]); w.w = pack2(s[2 * kk + 1][c][2], s[2 * kk + 1][c][3]);
          pf[c] = __builtin_bit_cast(bf16x8, w);
        }
#pragma unroll
        for (int dt = 0; dt < 4; ++dt) {
          const char* vp = vb + ((16 * dt + jn) * VROW + kk * 32 + 4 * q) * 2;
          const uint2 lo = *reinterpret_cast<const uint2*>(vp), hi = *reinterpret_cast<const uint2*>(vp + 32);
          uint4 w; w.x = lo.x; w.y = lo.y; w.z = hi.x; w.w = hi.y;
          const bf16x8 vf = __builtin_bit_cast(bf16x8, w);
#pragma unroll
          for (int c = 0; c < 2; ++c) o[dt][c] = mfma16(vf, pf[c], o[dt][c]);
        }
      }
    }
    if (more) lstore((kt + 1) & 1);
    if (MASK) { mw[0] = mwn[0]; mw[1] = mwn[1]; }
    __syncthreads();
  }
#pragma unroll
  for (int c = 0; c < 2; ++c) {
    const float inv = 1.0f / red4(lsum[c]);
    const int row = 16 * c + jn;
#pragma unroll
    for (int dt = 0; dt < 4; ++dt) {
      uint2 gw = ld4(gatep + (size_t)row * gstride + 16 * dt + 4 * q);
      st4(outp + (size_t)row * ostride + 16 * dt + 4 * q, o[dt][c][0] * inv * siluf_(lo2f(gw.x)), o[dt][c][1] * inv * siluf_(hi2f(gw.x)),
          o[dt][c][2] * inv * siluf_(lo2f(gw.y)), o[dt][c][3] * inv * siluf_(hi2f(gw.y)));
    }
  }
}

template <int KS, bool MASK, int NC, bool SH>
DI void attn_block(const u16* Qp, int qstride, const u16* Kp, int kstride, const u16* Vtp, const u64* maskp, int nkt_w, int nkt_max,
                   const u16* gatep, int gstride, u16* outp, int ostride, char* lds, int tid) {
  constexpr int DQK = KS * 32, KROW = DQK + 8, VROW = 72;
  constexpr int KCH = DQK / 8, NKC = 64 * KCH / 256;
  constexpr int K_BYTES = 64 * KROW * 2, BUF_BYTES = K_BYTES + 64 * VROW * 2;
  const int lane = tid & 63, q = lane >> 4, jn = lane & 15;
  const float NEG_INF = -__builtin_inff();
  uint4 xk0, xk1, xk2, xv0, xv1, yk0, yk1, yk2, yv0, yv1;
  xk2 = yk2 = make_uint4(0, 0, 0, 0);
  const int c0 = tid, c1 = tid + 256, c2 = tid + 512;
  const u16* kg0 = Kp + (size_t)(c0 / KCH) * kstride + (c0 % KCH) * 8;
  const u16* kg1 = Kp + (size_t)(c1 / KCH) * kstride + (c1 % KCH) * 8;
  const u16* kg2 = Kp + (size_t)(c2 / KCH) * kstride + (c2 % KCH) * 8;
  const u16* vg0 = Vtp + (size_t)(c0 >> 3) * S + (c0 & 7) * 8;
  const u16* vg1 = Vtp + (size_t)(c1 >> 3) * S + (c1 & 7) * 8;
  char* ks0 = lds + ((c0 / KCH) * KROW + (c0 % KCH) * 8) * 2;
  char* ks1 = lds + ((c1 / KCH) * KROW + (c1 % KCH) * 8) * 2;
  char* ks2 = lds + ((c2 / KCH) * KROW + (c2 % KCH) * 8) * 2;
  char* vs0 = lds + K_BYTES + ((c0 >> 3) * VROW + (c0 & 7) * 8) * 2;
  char* vs1 = lds + K_BYTES + ((c1 >> 3) * VROW + (c1 & 7) * 8) * 2;
#define A_LOAD(P, kt) { const size_t ko = (size_t)(kt) * 64 * kstride; const int vo = (kt) * 64;                     \
    P##k0 = *reinterpret_cast<const uint4*>(kg0 + ko); P##k1 = *reinterpret_cast<const uint4*>(kg1 + ko);            \
    if (NKC == 3) P##k2 = *reinterpret_cast<const uint4*>(kg2 + ko);                                                 \
    P##v0 = *reinterpret_cast<const uint4*>(vg0 + vo); P##v1 = *reinterpret_cast<const uint4*>(vg1 + vo); }
#define A_STORE(P, buf) { *reinterpret_cast<uint4*>(ks0 + (buf) * BUF_BYTES) = P##k0; *reinterpret_cast<uint4*>(ks1 + (buf) * BUF_BYTES) = P##k1; \
    if (NKC == 3) *reinterpret_cast<uint4*>(ks2 + (buf) * BUF_BYTES) = P##k2;                                        \
    *reinterpret_cast<uint4*>(vs0 + (buf) * BUF_BYTES) = P##v0; *reinterpret_cast<uint4*>(vs1 + (buf) * BUF_BYTES) = P##v1; }
  bf16x8 qf[NC][KS];
#pragma unroll
  for (int c = 0; c < NC; ++c)
#pragma unroll
    for (int ks = 0; ks < KS; ++ks) qf[c][ks] = ld8(Qp + (size_t)((SH ? 0 : 16 * c) + jn) * qstride + (SH ? 64 * c : 0) + ks * 32 + q * 8);
  f32x4 o[4][NC]; zero_acc(o);
  float m[NC], lsum[NC];
#pragma unroll
  for (int c = 0; c < NC; ++c) { m[c] = NEG_INF; lsum[c] = 0.f; }
  u64 mce0 = 0ull, mce1 = 0ull, mco0 = 0ull, mco1 = 0ull, mne0 = 0ull, mne1 = 0ull, mno0 = 0ull, mno1 = 0ull;
  const u64* mrow0 = maskp + (size_t)jn * 64;
  const u64* mrow1 = maskp + (size_t)(16 + jn) * 64;
  if (MASK) {
    mce0 = mrow0[0]; if (!SH) mce1 = mrow1[0];
    if (1 < nkt_w) { mco0 = mrow0[1]; if (!SH) mco1 = mrow1[1]; }
  }
  auto compute = [&](int buf, u64 w0, u64 w1) {
    const char* kb = lds + buf * BUF_BYTES; const char* vb = kb + K_BYTES;
    f32x4 s[4][NC]; zero_acc(s);
#pragma unroll
    for (int a = 0; a < 4; ++a)
#pragma unroll
      for (int ks = 0; ks < KS; ++ks) {
        const bf16x8 kf = *reinterpret_cast<const bf16x8*>(kb + ((16 * a + jn) * KROW + ks * 32 + q * 8) * 2);
#pragma unroll
        for (int c = 0; c < NC; ++c) s[a][c] = mfma16(kf, qf[c][ks], s[a][c]);
      }
    if (MASK) {
#pragma unroll
      for (int c = 0; c < NC; ++c) {
        const u64 w = ((SH || c == 0) ? w0 : w1) >> (4 * q);
#pragma unroll
        for (int a = 0; a < 4; ++a)
#pragma unroll
          for (int r = 0; r < 4; ++r)
            if (!((w >> (16 * a + r)) & 1ull)) s[a][c][r] = NEG_INF;
      }
    }
    float alpha[NC];
#pragma unroll
    for (int c = 0; c < NC; ++c) {
      float mx = NEG_INF;
#pragma unroll
      for (int a = 0; a < 4; ++a)
#pragma unroll
        for (int r = 0; r < 4; ++r) mx = fmaxf(mx, s[a][c][r]);
      mx = fmaxf(mx, __shfl_xor(mx, 16)); mx = fmaxf(mx, __shfl_xor(mx, 32));
      const float mn = fmaxf(m[c], mx);
      const float mu = (mn == NEG_INF) ? 0.f : mn;
      alpha[c] = fexp2(m[c] - mu);
      m[c] = mn;
      float ps = 0.f;
#pragma unroll
      for (int a = 0; a < 4; ++a)
#pragma unroll
        for (int r = 0; r < 4; ++r) { float p = fexp2(s[a][c][r] - mu); s[a][c][r] = p; ps += p; }
      lsum[c] = lsum[c] * alpha[c] + ps;
    }
    bool resc = false;
#pragma unroll
    for (int c = 0; c < NC; ++c) resc = resc || (alpha[c] != 1.0f);
    if (__builtin_amdgcn_ballot_w64(resc) != 0ull) {
#pragma unroll
      for (int c = 0; c < NC; ++c)
#pragma unroll
        for (int dt = 0; dt < 4; ++dt)
#pragma unroll
          for (int r = 0; r < 4; ++r) o[dt][c][r] *= alpha[c];
    }
#pragma unroll
    for (int kk = 0; kk < 2; ++kk) {
      bf16x8 pf[NC];
#pragma unroll
      for (int c = 0; c < NC; ++c) {
        uint4 w; w.x = pack2(s[2 * kk][c][0], s[2 * kk][c][1]); w.y = pack2(s[2 * kk][c][2], s[2 * kk][c][3]);
        w.z = pack2(s[2 * kk + 1][c][0], s[2 * kk + 1][c][1]); w.w = pack2(s[2 * kk + 1][c][2], s[2 * kk + 1][c][3]);
        pf[c] = __builtin_bit_cast(bf16x8, w);
      }
#pragma unroll
      for (int dt = 0; dt < 4; ++dt) {
        const char* vp = vb + ((16 * dt + jn) * VROW + kk * 32 + 4 * q) * 2;
        const uint2 lo = *reinterpret_cast<const uint2*>(vp), hi = *reinterpret_cast<const uint2*>(vp + 32);
        uint4 w; w.x = lo.x; w.y = lo.y; w.z = hi.x; w.w = hi.y;
        const bf16x8 vf = __builtin_bit_cast(bf16x8, w);
#pragma unroll
        for (int c = 0; c < NC; ++c) o[dt][c] = mfma16(vf, pf[c], o[dt][c]);
      }
    }
  };

  A_LOAD(x, 0);
  { const int t1 = (nkt_max > 1) ? 1 : 0; A_LOAD(y, t1); }
  A_STORE(x, 0);
  __syncthreads();
  for (int kt = 0; kt < nkt_max; kt += 2) {
    const bool more = kt + 2 < nkt_max;
    if (more) {
      A_LOAD(x, kt + 2);
      if (MASK) {
        if (kt + 2 < nkt_w) { mne0 = mrow0[kt + 2]; if (!SH) mne1 = mrow1[kt + 2]; }
        if (kt + 3 < nkt_w) { mno0 = mrow0[kt + 3]; if (!SH) mno1 = mrow1[kt + 3]; }
      }
    }
    if (kt < nkt_w) compute(0, mce0, mce1);
    A_STORE(y, 1);
    __syncthreads();
    if (kt + 3 < nkt_max) A_LOAD(y, kt + 3);
    if (kt + 1 < nkt_w) compute(1, mco0, mco1);
    if (more) A_STORE(x, 0);
    if (MASK) { mce0 = mne0; mce1 = mne1; mco0 = mno0; mco1 = mno1; }
    __syncthreads();
  }
#undef A_LOAD
#undef A_STORE
#pragma unroll
  for (int c = 0; c < NC; ++c) {
    const float inv = 1.0f / red4(lsum[c]);
    const int row = (SH ? 0 : 16 * c) + jn;
    const int hc = SH ? 64 * c : 0;
#pragma unroll
    for (int dt = 0; dt < 4; ++dt) {
      uint2 gw = ld4(gatep + (size_t)row * gstride + hc + 16 * dt + 4 * q);
      st4(outp + (size_t)row * ostride + hc + 16 * dt + 4 * q, o[dt][c][0] * inv * siluf_(lo2f(gw.x)), o[dt][c][1] * inv * siluf_(hi2f(gw.x)),
          o[dt][c][2] * inv * siluf_(lo2f(gw.y)), o[dt][c][3] * inv * siluf_(hi2f(gw.y)));
    }
  }
}

DI void mla_attn_item(const Params& P, int it, char* lds, int tid) {
  const int wave = __builtin_amdgcn_readfirstlane(tid >> 6);
  const int sh = it & 7, mloc = it >> 3;
  const int qb = 31 - (mloc & 31), bh = sh + 8 * (mloc >> 5), b = bh / 6, h = bh % 6;
  const int q0 = qb * 128 + wave * 32;
  const int nkt = (q0 >> 6) + 1;
  const u16* mq = (const u16*)(P.ws + O_MQ); const u16* mk = (const u16*)(P.ws + O_MK); const u16* mvt = (const u16*)(P.ws + O_MVT);
  const u16* proj = (const u16*)(P.ws + O_PROJ); u16* mixed = (u16*)(P.ws + O_XB);
  const size_t tok = (size_t)b * S + q0;
  attn_block<3, false, 2, false>(mq + tok * 576 + h * 96, 576, mk + (size_t)b * S * 576 + h * 96, 576, mvt + (size_t)(b * 6 + h) * 64 * S, nullptr, nkt, 2 * qb + 2,
                       proj + tok * DINP + C_GC + h * 64, DINP, mixed + tok * DM + 640 + h * 64, DM, lds, tid);
}

DI void dsa_attn_item(const Params& P, int it, char* lds, int tid) {
  const int wave = __builtin_amdgcn_readfirstlane(tid >> 6);
  const int ch = 63 - it / 32, bh = it % 32, b = bh >> 1, hg = bh & 1;
  const int q0 = ch * 64 + wave * 16;
  const int nkt = ch + 1;
  const u16* proj = (const u16*)(P.ws + O_PROJ); const u16* avt = (const u16*)(P.ws + O_AVT); u16* mixed = (u16*)(P.ws + O_XB);
  const u64* mask = (const u64*)(P.ws + O_MASK);
  const size_t tok = (size_t)b * S + q0;
  attn_block<2, true, 3, true>(proj + tok * DINP + C_QA + hg * 192, DINP, proj + (size_t)b * S * DINP + C_KA, DINP, avt + (size_t)b * 64 * S, mask + tok * 64, nkt, nkt,
                               proj + tok * DINP + C_GA + hg * 192, DINP, mixed + tok * DM + hg * 192, DM, lds, tid);
}

constexpr int SC_STRIDE = 4096 + 16;
DI unsigned fkey(float f) { unsigned u = __float_as_uint(f); return (u & 0x80000000u) ? ~u : (u | 0x80000000u); }
DI float funkey(unsigned k) { return __uint_as_float((k & 0x80000000u) ? (k ^ 0x80000000u) : ~k); }

template <int NR>
DI u64 select_wave(float* scw, int nreg, int lane) {
  unsigned key[NR];
  unsigned kmin = 0xffffffffu, kmax = 0u;
#pragma unroll
  for (int r = 0; r < NR; ++r) {
    const unsigned k = fkey(scw[64 * r + lane]);
    const bool ok = r < nreg;
    key[r] = ok ? k : 0u;
    kmin = min(kmin, ok ? k : 0xffffffffu); kmax = max(kmax, key[r]);
  }
#pragma unroll
  for (int o = 1; o < 64; o <<= 1) { kmin = min(kmin, (unsigned)__shfl_xor((int)kmin, o)); kmax = max(kmax, (unsigned)__shfl_xor((int)kmax, o)); }
  unsigned lo = __builtin_amdgcn_readfirstlane(kmin), hi = __builtin_amdgcn_readfirstlane(kmax);
  int clo = 64 * nreg, chi = 0;
  bool exact = false;
  int iter = 0;
  while (lo < hi && clo - chi > 512) {
    unsigned mid = fkey(0.5f * (funkey(lo) + funkey(hi)));
    if (iter >= 16) mid = lo + ((hi - lo + 1u) >> 1);
    if (mid <= lo) mid = lo + 1;
    if (mid > hi) mid = hi;
    ++iter;
    int cnt = 0;
#pragma unroll
    for (int r = 0; r < NR; ++r) cnt += __builtin_popcountll(__builtin_amdgcn_ballot_w64(key[r] >= mid));
    if (cnt >= 256) { lo = mid; clo = cnt; if (cnt == 256) { exact = true; break; } }
    else { hi = mid - 1; chi = cnt; }
  }
  if (!exact && lo < hi) {
    unsigned* cand = reinterpret_cast<unsigned*>(scw);
    int base = 0;
#pragma unroll
    for (int r = 0; r < NR; ++r) {
      const bool pred = (key[r] >= lo) && (key[r] <= hi);
      const u64 bal = __builtin_amdgcn_ballot_w64(pred);
      const int pos = base + __builtin_amdgcn_mbcnt_hi((unsigned)(bal >> 32), __builtin_amdgcn_mbcnt_lo((unsigned)bal, 0u));
      if (pred) cand[pos] = key[r];
      base += __builtin_popcountll(bal);
    }
    __builtin_amdgcn_fence(__ATOMIC_RELEASE, "wavefront");
    __builtin_amdgcn_fence(__ATOMIC_ACQUIRE, "wavefront");
    unsigned ck[8];
#pragma unroll
    for (int i = 0; i < 8; ++i) { const unsigned v = cand[64 * i + lane]; ck[i] = (64 * i + lane < base) ? v : 0u; }
    const int cabove = chi;
    while (lo < hi) {
      unsigned mid = fkey(0.5f * (funkey(lo) + funkey(hi)));
      if (iter >= 16) mid = lo + ((hi - lo + 1u) >> 1);
      if (mid <= lo) mid = lo + 1;
      if (mid > hi) mid = hi;
      ++iter;
      int cnt = cabove;
#pragma unroll
      for (int i = 0; i < 8; ++i) cnt += __builtin_popcountll(__builtin_amdgcn_ballot_w64(ck[i] >= mid));
      if (cnt >= 256) { lo = mid; if (cnt == 256) { exact = true; break; } }
      else { hi = mid - 1; }
    }
  }
  const unsigned thr = lo;
  u64 myword = 0ull;
  if (exact) {
#pragma unroll
    for (int r = 0; r < NR; ++r) { const u64 bal = __builtin_amdgcn_ballot_w64(key[r] >= thr); if (lane == r) myword = bal; }
  } else {
    int cgt = 0;
#pragma unroll
    for (int r = 0; r < NR; ++r) cgt += __builtin_popcountll(__builtin_amdgcn_ballot_w64(key[r] > thr));
    const int need = 256 - cgt;
    int run = 0;
    const u64 below = (1ull << lane) - 1ull;
#pragma unroll
    for (int r = 0; r < NR; ++r) {
      const u64 eq = __builtin_amdgcn_ballot_w64(key[r] == thr);
      const int rank = run + __builtin_popcountll(eq & below);
      const bool sel = (key[r] > thr) || ((key[r] == thr) && (rank < need));
      const u64 bal = __builtin_amdgcn_ballot_w64(sel);
      run += __builtin_popcountll(eq);
      if (lane == r) myword = bal;
    }
  }
  return myword;
}

DI void dsa_select_item(const Params& P, int it, float* sc, int wave, int lane) {
  const int qd = 1023 - it / 16, b = it % 16;
  const int t0 = qd * 4;
  const int N = ((t0 >> 6) + 1) * 64, nreg = N >> 6;
  const u16* base = (const u16*)(P.ws + O_PROJ) + (size_t)b * S * DINP;
  u64* mask = (u64*)(P.ws + O_MASK);
  const int q = lane >> 4, jn = lane & 15;
  if (N > 256) {
    const bf16x8 a0 = ld8(base + (size_t)(t0 + (jn >> 2)) * DINP + C_IQ + (jn & 3) * 32 + q * 8);
    const bf16x8 a1 = ld8(base + (size_t)(t0 + (jn >> 2)) * DINP + C_IQ + (4 + (jn & 3)) * 32 + q * 8);
    float w[8];
    {
      bf16x8 wv = ld8(base + (size_t)(t0 + q) * DINP + C_IW);
#pragma unroll
      for (int h = 0; h < 8; ++h) w[h] = bf2f((u16)wv[h]) * (0.35355339059327373f * 0.17677669529663687f);
    }
    const int tpw = N >> 6;
    const u16* kbase = base + (size_t)jn * DINP + C_IK + q * 8;
    for (int tl = 0; tl < tpw; tl += 16) {
      bf16x8 bk[16];
#pragma unroll
      for (int u = 0; u < 16; ++u) {
        const int t = (tl + u < tpw) ? tl + u : tpw - 1;
        bk[u] = ld8(kbase + (size_t)((wave * tpw + t) * 16) * DINP);
      }
#pragma unroll
      for (int u = 0; u < 16; ++u) {
        const int t = (tl + u < tpw) ? tl + u : tpw - 1;
        const int key0 = (wave * tpw + t) * 16;
        const f32x4 z = {0.f, 0.f, 0.f, 0.f};
        f32x4 d0 = mfma16(a0, bk[u], z), d1 = mfma16(a1, bk[u], z);
        float sv = 0.f;
#pragma unroll
        for (int r = 0; r < 4; ++r) sv += fmaxf(d0[r], 0.f) * w[r];
#pragma unroll
        for (int r = 0; r < 4; ++r) sv += fmaxf(d1[r], 0.f) * w[4 + r];
        sc[q * SC_STRIDE + key0 + jn] = sv;
      }
    }
  }
  __syncthreads();
  u64 myword = ~0ull;
  if (N > 256) {
    float* scw = sc + wave * SC_STRIDE;
    if (nreg <= 8) myword = select_wave<8>(scw, nreg, lane);
    else if (nreg <= 16) myword = select_wave<16>(scw, nreg, lane);
    else if (nreg <= 24) myword = select_wave<24>(scw, nreg, lane);
    else if (nreg <= 32) myword = select_wave<32>(scw, nreg, lane);
    else if (nreg <= 48) myword = select_wave<48>(scw, nreg, lane);
    else myword = select_wave<64>(scw, nreg, lane);
  }
  if (lane < nreg) mask[((size_t)b * S + t0 + wave) * 64 + lane] = myword;
  __syncthreads();
}

DI void s5_stage1_item(const Params& P, int l, int it, int wave, int lane) {
  const int b = it >> 4, g = it & 15, q = lane >> 4, jn = lane & 15;
  const u16* proj = (const u16*)(P.ws + O_PROJ);
  const u16* W1 = (const u16*)(P.ws + O_W1) + (size_t)(l * 16 + g) * 128 * 1024;
  float* s5s = (float*)(P.ws + O_S5S) + (size_t)it * 64 * 128;
  f32x4 acc[2][4]; zero_acc(acc);
  const u16* ap = W1 + (size_t)(wave * 32 + jn) * 1024 + q * 8;
  const u16* up = proj + ((size_t)b * S + (size_t)jn * 64 + (q >> 1)) * DINP + C_U + g * 16 + (q & 1) * 8;
  wgemm<2, 4>(acc, 32, [&](int i, int ks) { return ld8(ap + (size_t)i * 16 * 1024 + ks * 32); },
              [&](int j, int ks) { return ld8(up + ((size_t)j * 16 * 64 + 2 * ks) * DINP); });
#pragma unroll
  for (int j = 0; j < 4; ++j) {
    const int n = 16 * j + jn;
#pragma unroll
    for (int i = 0; i < 2; ++i)
      *reinterpret_cast<f32x4*>(s5s + (size_t)n * 128 + wave * 32 + 16 * i + 4 * q) = acc[i][j];
  }
}

constexpr int HS_STRIDE = 136;
DI void s5_stage3_item(const Params& P, int l, int it, u16* hs, int wave, int lane) {
  const int b = it >> 4, g = it & 15, q = lane >> 4, jn = lane & 15;
  const u16* proj = (const u16*)(P.ws + O_PROJ);
  const u16* Kt = (const u16*)(P.ws + O_KT) + (size_t)(l * 16 + g) * 64 * 256;
  const u16* W3 = (const u16*)(P.ws + O_W3) + (size_t)(l * 16 + g) * 1024 * 128;
  const float* s5s = (const float*)(P.ws + O_S5S) + (size_t)it * 64 * 128;
  const float2* pw = (const float2*)(P.ws + O_PW);
  u16* yg = (u16*)(P.ws + O_YG);
  const float* dsk = P.in[17] + (l * 16 + g) * 16;
  if (wave == 0) {
    const int p = lane;
    const float2 aL = pw[((size_t)(l * 16 + g) * 65 + 64) * 64 + p];
    float hr = 0.f, hi = 0.f;
#pragma unroll
    for (int half = 0; half < 2; ++half) {
      float2 sv[32];
#pragma unroll
      for (int n = 0; n < 32; ++n) sv[n] = *reinterpret_cast<const float2*>(s5s + (size_t)(half * 32 + n) * 128 + 2 * p);
#pragma unroll
      for (int n = 0; n < 32; ++n) {
        *reinterpret_cast<unsigned*>(hs + (half * 32 + n) * HS_STRIDE + 2 * p) = pack2(hr, hi);
        const float nr = aL.x * hr - aL.y * hi + sv[n].x, ni = aL.x * hi + aL.y * hr + sv[n].y;
        hr = nr; hi = ni;
      }
    }
  }
  __syncthreads();
  const u16* up = proj + ((size_t)b * S + (size_t)jn * 64 + (q >> 1)) * DINP + C_U + g * 16 + (q & 1) * 8;
  const bf16x8 zf = {0, 0, 0, 0, 0, 0, 0, 0};
  for (int gi = 0; gi < 8; ++gi) {
    const int jg = wave + 4 * (gi >> 1);
    const int th = gi & 1;
    f32x4 acc[4][2]; zero_acc(acc);
    wgemm<4, 2>(acc, 2 * jg + 2,
                [&](int i, int ks) { const int j = 4 * jg + i, ii = 2 * ks + (q >> 1); const int d = j - ii;
                                     return (d >= 0) ? ld8(Kt + ((size_t)d * 16 + jn) * 16 + (q & 1) * 8) : zf; },
                [&](int jt, int ks) { return ld8(up + ((size_t)(2 * th + jt) * 16 * 64 + 2 * ks) * DINP); });
    wgemm<4, 2>(acc, 4,
                [&](int i, int ks) { return ld8(W3 + ((size_t)(4 * jg + i) * 16 + jn) * 128 + ks * 32 + q * 8); },
                [&](int jt, int ks) { return *reinterpret_cast<const bf16x8*>(hs + (16 * (2 * th + jt) + jn) * HS_STRIDE + ks * 32 + q * 8); });
#pragma unroll
    for (int jt = 0; jt < 2; ++jt) {
      const int n = 16 * (2 * th + jt) + jn;
#pragma unroll
      for (int i = 0; i < 4; ++i) {
        const size_t tok = (size_t)b * S + n * 64 + 4 * jg + i;
        uint2 uw = ld4(proj + tok * DINP + C_U + g * 16 + 4 * q);
        const float y0 = acc[i][jt][0] + dsk[4 * q] * lo2f(uw.x), y1 = acc[i][jt][1] + dsk[4 * q + 1] * hi2f(uw.x);
        const float y2 = acc[i][jt][2] + dsk[4 * q + 2] * lo2f(uw.y), y3 = acc[i][jt][3] + dsk[4 * q + 3] * hi2f(uw.y);
        st4(yg + tok * 256 + g * 16 + 4 * q, geluf_(y0), geluf_(y1), geluf_(y2), geluf_(y3));
      }
    }
  }
  __syncthreads();
}

DI void glu_tile(const Params& P, int l, int tt, char* lds) {
  const u16* W = (const u16*)(P.ws + O_WTGLU) + (size_t)l * 256 * 256;
  const u16* yg = (const u16*)(P.ws + O_YG);
  const u16* proj = (const u16*)(P.ws + O_PROJ);
  u16* mixed = (u16*)(P.ws + O_XB);
  const int tid = opaque_tid();
  const int wave = __builtin_amdgcn_readfirstlane(tid >> 6), lane = tid & 63, q = lane >> 4, jn = lane & 15;
#pragma unroll 1
  for (int ftile = 0; ftile < 2; ++ftile) {
    const int f0 = ftile * 128 + (wave >> 1) * 64, t0 = tt * 128 + (wave & 1) * 64;
    f32x4 acc[4][4]; zero_acc(acc);
    gemm_block(acc, W + (size_t)(ftile * 128) * 256, 256, yg + (size_t)(tt * 128) * 256, 256, 256, lds, tid);
#pragma unroll
    for (int j = 0; j < 4; ++j) {
      const size_t tok = t0 + 16 * j + jn;
#pragma unroll
      for (int i = 0; i < 4; ++i) {
        const int f = f0 + 16 * i + 4 * q;
        uint2 gw = ld4(yg + tok * 256 + f), bw = ld4(proj + tok * DINP + C_GB + f);
        st4(mixed + tok * DM + 384 + f, lo2f(gw.x) * sigmoidf_(acc[i][j][0]) * siluf_(lo2f(bw.x)), hi2f(gw.x) * sigmoidf_(acc[i][j][1]) * siluf_(hi2f(bw.x)),
            lo2f(gw.y) * sigmoidf_(acc[i][j][2]) * siluf_(lo2f(bw.y)), hi2f(gw.y) * sigmoidf_(acc[i][j][3]) * siluf_(hi2f(bw.y)));
      }
    }
  }
}

DI void outproj_tile(const Params& P, int l, int tt, char* lds) {
  const u16* W = (const u16*)(P.ws + O_WTOUT) + (size_t)l * DM * DM;
  const u16* mixed = (const u16*)(P.ws + O_XB);
  float* xout = P.out;
  u16* xb2 = (u16*)(P.ws + O_XB2);
  const int tid = opaque_tid();
  const int wave = __builtin_amdgcn_readfirstlane(tid >> 6), lane = tid & 63, q = lane >> 4, jn = lane & 15;
#pragma unroll 1
  for (int ftile0 = 0; ftile0 < 8; ++ftile0) {
    int ftile = ftile0; asm volatile("" : "+s"(ftile));
    const int f0 = ftile * 128 + (wave >> 1) * 64, t0 = tt * 128 + (wave & 1) * 64;
    f32x4 acc[4][4]; zero_acc(acc);
    gemm_block(acc, W + (size_t)(ftile * 128) * DM, DM, mixed + (size_t)(tt * 128) * DM, DM, DM, lds, tid);
#pragma unroll
    for (int j = 0; j < 4; ++j) {
      const size_t tok = t0 + 16 * j + jn;
#pragma unroll
      for (int i = 0; i < 4; ++i) {
        const int f = f0 + 16 * i + 4 * q;
        const uint2 xw = ld4(xb2 + tok * DM + f);
        const f32x4 xv = f32x4{lo2f(xw.x), hi2f(xw.x), lo2f(xw.y), hi2f(xw.y)};
        const f32x4 xn = xv + acc[i][j];
        if (l == NL - 1) *reinterpret_cast<f32x4*>(xout + tok * DM + f) = xn;
        else st4(xb2 + tok * DM + f, xn[0], xn[1], xn[2], xn[3]);
      }
    }
  }
}

DI void phase_tail(const Params& P, int l, char* lds, float* s_rstd, float* s_prep) {
  for (int tt = blockIdx.x; tt < 512; tt += gridDim.x) {
    glu_tile(P, l, tt, lds);
    asm volatile("s_waitcnt vmcnt(0)" ::: "memory");
    __syncthreads();
    outproj_tile(P, l, tt, lds);
    if (l + 1 < NL) {
      asm volatile("s_waitcnt vmcnt(0)" ::: "memory");
      __syncthreads();
      inproj_tile(P, l + 1, tt, lds, s_rstd, s_prep);
    }
  }
}

DI void gbar(unsigned* ctr, unsigned& epoch) {
  asm volatile("s_waitcnt vmcnt(0)" ::: "memory");
  __syncthreads();
  epoch += gridDim.x;
  if (threadIdx.x == 0) {
    __builtin_amdgcn_fence(__ATOMIC_RELEASE, "agent");
    asm volatile("s_waitcnt vmcnt(0)" ::: "memory");
    __hip_atomic_fetch_add(ctr, 1u, __ATOMIC_RELAXED, __HIP_MEMORY_SCOPE_AGENT);
    while (__hip_atomic_load(ctr, __ATOMIC_RELAXED, __HIP_MEMORY_SCOPE_AGENT) < epoch) __builtin_amdgcn_s_sleep(8);
    __builtin_amdgcn_fence(__ATOMIC_ACQUIRE, "agent");
    asm volatile("s_waitcnt vmcnt(0)" ::: "memory");
  }
  __syncthreads();
}

__global__ void __launch_bounds__(256, 2) fwd_megakernel(Params P) {
  cg::grid_group grid = cg::this_grid();
  __shared__ __attribute__((aligned(16))) float lds_f[2 * G_BUF_BYTES / 4];
  static_assert(2 * G_BUF_BYTES >= 4 * SC_STRIDE * 4, "lds");
  __shared__ int s_item;
  __shared__ float s_rstd[128];
  __shared__ float s_prep[512];
  const long gtid = (long)blockIdx.x * 256 + threadIdx.x, gsz = (long)gridDim.x * 256;

  if (blockIdx.x == 0) { for (int w = threadIdx.x; w < 8192; w += 256) ((unsigned*)(P.ws + O_CTR))[w] = 0u; }
  phase_w0(P, gtid, gsz);
  grid.sync();
  unsigned* bar = (unsigned*)(P.ws + O_CTR) + 6144;
  unsigned epoch = 0u;
  phase_w1(P, gtid, gsz);
#ifdef DUP_W
  phase_w0(P, gtid, gsz);
  phase_w1(P, gtid, gsz);
#endif

  for (int tt = blockIdx.x; tt < 512; tt += gridDim.x) {
    {
      const float* x = P.in[0]; u16* xb = (u16*)(P.ws + O_XB2);
      const int tid = opaque_tid();
#pragma unroll 4
      for (int e = tid; e < 128 * 256; e += 256) {
        const float4 v = *reinterpret_cast<const float4*>(x + (size_t)tt * 128 * DM + (size_t)e * 4);
        st4(xb + (size_t)tt * 128 * DM + (size_t)e * 4, v.x, v.y, v.z, v.w);
      }
    }
    asm volatile("s_waitcnt vmcnt(0)" ::: "memory");
    __syncthreads();
    inproj_tile(P, 0, tt, (char*)lds_f, s_rstd, s_prep);
  }
  gbar(bar, epoch);
  for (int l = 0; l < NL; ++l) {
    {
      const int shard = blockIdx.x & 7;
      unsigned* ctr = (unsigned*)(P.ws + O_CTR) + ((l * 2) * 8 + shard) * 64;
      for (;;) {
        const int tid = opaque_tid();
        if (tid == 0) s_item = (int)atomicAdd(ctr, 1u) * 8 + shard;
        __syncthreads();
        const int it = s_item;
        __syncthreads();
        if (it >= 256 + 3072 + 4096) break;
        const int wave = __builtin_amdgcn_readfirstlane(tid >> 6), lane = tid & 63;
        if (it < 256) s5_stage1_item(P, l, it, wave, lane);
        else if (it < 256 + 3072) mla_attn_item(P, it - 256, (char*)lds_f, tid);
        else {
#pragma unroll 1
          for (int k = 0; k < 4; ++k) dsa_select_item(P, (it - 256 - 3072) * 4 + k, lds_f, wave, lane);
        }
      }
    }
    gbar(bar, epoch);
    {
      const int shard = blockIdx.x & 7;
      unsigned* ctr = (unsigned*)(P.ws + O_CTR) + ((l * 2 + 1) * 8 + shard) * 64;
      for (;;) {
        const int tid = opaque_tid();
        if (tid == 0) s_item = (int)atomicAdd(ctr, 1u) * 8 + shard;
        __syncthreads();
        const int it = s_item;
        __syncthreads();
        if (it >= 256 + 2048) break;
        const int wave = __builtin_amdgcn_readfirstlane(tid >> 6), lane = tid & 63;
        if (it < 256) s5_stage3_item(P, l, it, (u16*)lds_f, wave, lane);
        else {
          const int iu = __builtin_amdgcn_readfirstlane(it - 256), ml = iu >> 3;
          dsa_attn_item(P, (ml & 63) * 32 + (iu & 7) + 8 * (ml >> 6), (char*)lds_f, tid);
        }
      }
    }
    gbar(bar, epoch);
    phase_tail(P, l, (char*)lds_f, s_rstd, s_prep);
    if (l + 1 < NL) gbar(bar, epoch);
  }
}

extern "C" void kernel_launch(void* const* d_in, const int* in_sizes, int n_in, void* d_out, int out_size, void* d_ws, size_t ws_size,
                              hipStream_t stream) {
  static int grid_blocks = 0;
  if (!grid_blocks) {
    int dev = 0, cus = 0, per_cu = 0;
    hipGetDevice(&dev);
    hipDeviceGetAttribute(&cus, hipDeviceAttributeMultiprocessorCount, dev);
    hipOccupancyMaxActiveBlocksPerMultiprocessor(&per_cu, fwd_megakernel, 256, 0);
    if (per_cu < 1) per_cu = 1;
    if (per_cu > 2) per_cu = 2;
    grid_blocks = cus * per_cu;
    if (ws_size < O_END) fprintf(stderr, "workspace too small: %zu < %zu\n", ws_size, (size_t)O_END);
  }
  Params p{};
  for (int i = 0; i < 21; ++i) p.in[i] = (const float*)d_in[i];
  p.out = (float*)d_out;
  p.ws = (char*)d_ws;
  void* args[] = {&p};
  hipError_t e = hipLaunchCooperativeKernel((void*)fwd_megakernel, dim3(grid_blocks), dim3(256), args, 0, stream);
  if (e != hipSuccess) fprintf(stderr, "cooperative launch failed: %s (grid %d)\n", hipGetErrorString(e), grid_blocks);
}
```
